# Optimizing an MI355X kernel written in HIP

```python
import jax, jax.numpy as jnp
from jax import lax
import numpy as np

D_MODEL = 4096
BATCH = 2
SEQ = 4096
DEPTH = 2

CHUNK = 64
Q_BLOCK = 128
SB_HEADS = 16
SB_HEAD_DIM = 128
MLA_HEADS = 16
MLA_NOPE_DIM = 128
MLA_ROPE_DIM = 64
MLA_V_DIM = 128
MLA_Q_RANK = 1024
MLA_KV_RANK = 512
D_FF = 4 * D_MODEL
ROPE_THETA = 10000.0
EPS = 1e-6
SB_WIDTH = SB_HEADS * SB_HEAD_DIM
MLA_WIDTH = MLA_HEADS * MLA_V_DIM
IN_WIDTH = 3 * SB_WIDTH + MLA_Q_RANK + MLA_KV_RANK + MLA_ROPE_DIM + 2 * D_MODEL

kernel_name = "hybrid_stickbreak_mla_block"


def _in_split_points():
    sizes = [SB_WIDTH, SB_WIDTH, SB_WIDTH, MLA_Q_RANK, MLA_KV_RANK + MLA_ROPE_DIM, D_MODEL, D_MODEL]
    pts, acc = [], 0
    for s in sizes[:-1]:
        acc += s
        pts.append(acc)
    return pts


def rms_norm(x, g):
    xf = x.astype(jnp.float32)
    y = xf * lax.rsqrt(jnp.mean(xf * xf, axis=-1, keepdims=True) + EPS)
    return (y * g.astype(jnp.float32)).astype(x.dtype)


def modulate(h, shift, scale):
    return h * (1.0 + scale[:, None, :]) + shift[:, None, :]


def rope_tables(positions, dtype):
    half = MLA_ROPE_DIM // 2
    inv_freq = ROPE_THETA ** (-jnp.arange(half, dtype=jnp.float32) / half)
    ang = positions.astype(jnp.float32)[..., None] * inv_freq
    return jnp.cos(ang).astype(dtype), jnp.sin(ang).astype(dtype)


def apply_rope(x, cos, sin):
    x1, x2 = jnp.split(x, 2, axis=-1)
    return jnp.concatenate([x1 * cos - x2 * sin, x2 * cos + x1 * sin], axis=-1)


def stick_breaking_attention(q, k, v):
    B, S, H, Dh = q.shape
    nb = S // Q_BLOCK
    scale = Dh ** -0.5
    q_blocks = q.reshape(B, nb, Q_BLOCK, H, Dh).swapaxes(0, 1)
    key_pos = jnp.arange(S)

    def block(args):
        q_blk, i = args
        z = jnp.einsum('bqhd,bkhd->bhqk', q_blk, k, preferred_element_type=jnp.float32) * scale
        q_pos = i * Q_BLOCK + jnp.arange(Q_BLOCK)
        strict = key_pos[None, :] < q_pos[:, None]
        log_fail = jnp.where(strict, jax.nn.log_sigmoid(-z), 0.0)
        after = lax.cumsum(log_fail, axis=3, reverse=True) - log_fail
        w = jnp.where(strict, jnp.exp(jax.nn.log_sigmoid(z) + after), 0.0)
        return jnp.einsum('bhqk,bkhd->bqhd', w, v.astype(jnp.float32))

    out = lax.map(block, (q_blocks, jnp.arange(nb)))
    return out.swapaxes(0, 1).reshape(B, S, H * Dh).astype(q.dtype)


def latent_attention(q_nope, q_rope, k_nope, k_rope, v):
    B, S, H, Dn = q_nope.shape
    Dv = v.shape[-1]
    nb = S // Q_BLOCK
    scale = (Dn + q_rope.shape[-1]) ** -0.5
    qn_b = q_nope.reshape(B, nb, Q_BLOCK, H, Dn).swapaxes(0, 1)
    qr_b = q_rope.reshape(B, nb, Q_BLOCK, H, -1).swapaxes(0, 1)
    key_chunk = jnp.arange(S) // CHUNK

    def block(args):
        qn, qr, i = args
        s = (jnp.einsum('bqhd,bkhd->bhqk', qn, k_nope, preferred_element_type=jnp.float32)
             + jnp.einsum('bqhr,bkr->bhqk', qr, k_rope, preferred_element_type=jnp.float32)) * scale
        q_chunk = (i * Q_BLOCK + jnp.arange(Q_BLOCK)) // CHUNK
        mask = key_chunk[None, :] <= q_chunk[:, None]
        p = jax.nn.softmax(jnp.where(mask, s, -jnp.inf), axis=-1)
        return jnp.einsum('bhqk,bkhd->bqhd', p, v.astype(jnp.float32))

    out = lax.map(block, (qn_b, qr_b, jnp.arange(nb)))
    return out.swapaxes(0, 1).reshape(B, S, H * Dv).astype(v.dtype)


def setup_inputs(seed: int = 0) -> dict:
    key = jax.random.key(seed)
    ks = jax.random.split(key, 24)
    L = DEPTH

    def nrm(k, shape, scale):
        return jax.random.normal(k, shape, jnp.float32) * scale

    def gain(k, n):
        return 1.0 + 0.1 * nrm(k, (L, n), 1.0)

    x = nrm(ks[0], (BATCH, SEQ, D_MODEL), 1.0)
    c = nrm(ks[1], (BATCH, D_MODEL), 1.0)
    offset = jax.random.randint(ks[2], (BATCH, 1), 0, 4096)
    positions = (offset + jnp.arange(SEQ)[None, :]).astype(jnp.int32)
    return {
        "x": x,
        "c": c,
        "positions": positions,
        "w_ada": nrm(ks[3], (L, D_MODEL, 6 * D_MODEL), 0.5 * D_MODEL ** -0.5),
        "b_ada": nrm(ks[4], (L, 6 * D_MODEL), 0.02),
        "g_pre_mix": gain(ks[5], D_MODEL),
        "g_post_mix": gain(ks[6], D_MODEL),
        "g_pre_mlp": gain(ks[7], D_MODEL),
        "g_post_mlp": gain(ks[8], D_MODEL),
        "w_in": nrm(ks[9], (L, D_MODEL, IN_WIDTH), D_MODEL ** -0.5),
        "g_q_lora": gain(ks[10], MLA_Q_RANK),
        "w_uq": nrm(ks[11], (L, MLA_Q_RANK, MLA_HEADS * (MLA_NOPE_DIM + MLA_ROPE_DIM)), MLA_Q_RANK ** -0.5),
        "g_kv_lora": gain(ks[12], MLA_KV_RANK),
        "w_ukv": nrm(ks[13], (L, MLA_KV_RANK, MLA_HEADS * (MLA_NOPE_DIM + MLA_V_DIM)), MLA_KV_RANK ** -0.5),
        "w_o_sb": nrm(ks[14], (L, SB_WIDTH, D_MODEL), SB_WIDTH ** -0.5),
        "w_o_mla": nrm(ks[15], (L, MLA_WIDTH, D_MODEL), MLA_WIDTH ** -0.5),
        "w_out": nrm(ks[16], (L, D_MODEL, D_MODEL), D_MODEL ** -0.5),
        "w_up": nrm(ks[17], (L, D_MODEL, D_FF), D_MODEL ** -0.5),
        "w_down": nrm(ks[18], (L, D_FF, D_MODEL), D_FF ** -0.5),
    }


def reference(x, c, positions, w_ada, b_ada, g_pre_mix, g_post_mix, g_pre_mlp, g_post_mlp, w_in,
              g_q_lora, w_uq, g_kv_lora, w_ukv, w_o_sb, w_o_mla, w_out, w_up, w_down):
    B, S, _ = x.shape
    cos, sin = rope_tables(positions, x.dtype)
    split_pts = _in_split_points()
    c_act = jax.nn.silu(c)
    for l in range(DEPTH):
        ada = c_act @ w_ada[l] + b_ada[l]
        sh1, sc1, gt1, sh2, sc2, gt2 = jnp.split(ada, 6, axis=-1)

        h = modulate(rms_norm(x, g_pre_mix[l]), sh1, sc1)
        proj = h @ w_in[l]
        q_sb, k_sb, v_sb, q_down, kv_down, gl_sb, gl_mla = jnp.split(proj, split_pts, axis=-1)

        o_sb = stick_breaking_attention(
            q_sb.reshape(B, S, SB_HEADS, SB_HEAD_DIM),
            k_sb.reshape(B, S, SB_HEADS, SB_HEAD_DIM),
            v_sb.reshape(B, S, SB_HEADS, SB_HEAD_DIM))
        br_sb = o_sb @ w_o_sb[l]

        c_q = rms_norm(q_down, g_q_lora[l])
        q = (c_q @ w_uq[l]).reshape(B, S, MLA_HEADS, MLA_NOPE_DIM + MLA_ROPE_DIM)
        q_nope, q_rope = q[..., :MLA_NOPE_DIM], q[..., MLA_NOPE_DIM:]
        q_rope = apply_rope(q_rope, cos[:, :, None, :], sin[:, :, None, :])
        c_kv = rms_norm(kv_down[..., :MLA_KV_RANK], g_kv_lora[l])
        k_rope = apply_rope(kv_down[..., MLA_KV_RANK:], cos, sin)
        kv = (c_kv @ w_ukv[l]).reshape(B, S, MLA_HEADS, MLA_NOPE_DIM + MLA_V_DIM)
        k_nope, v_mla = kv[..., :MLA_NOPE_DIM], kv[..., MLA_NOPE_DIM:]
        o_mla = latent_attention(q_nope, q_rope, k_nope, k_rope, v_mla)
        br_mla = o_mla @ w_o_mla[l]

        merged = jax.nn.sigmoid(gl_sb) * br_sb + jax.nn.sigmoid(gl_mla) * br_mla
        y = merged @ w_out[l]
        x = x + gt1[:, None, :] * rms_norm(y, g_post_mix[l])

        h = modulate(rms_norm(x, g_pre_mlp[l]), sh2, sc2)
        y = jnp.square(jax.nn.relu(h @ w_up[l])) @ w_down[l]
        x = x + gt2[:, None, :] * rms_norm(y, g_post_mlp[l])
    return x
```

```cpp
#include <hip/hip_runtime.h>
#include <cstdio>
#include <cstdint>
#include <cmath>
#ifndef PG8_WGM
#define PG8_WGM 8
#endif
namespace pg8 {
#define PG8_LAS __attribute__((address_space(3)))
typedef unsigned short bf16_t;
typedef short bf16x8 __attribute__((ext_vector_type(8)));
typedef float f32x4 __attribute__((ext_vector_type(4)));
typedef unsigned u32x4 __attribute__((ext_vector_type(4)));
constexpr int BM = 256, BK = 64, HALF = 128, HTB = HALF * BK * 2  , STAGE_BYTES = 8 * HTB, NXCD = 8, WGM = PG8_WGM;

__host__ __device__ __forceinline__ int lds_byte(int r, int c) { const int st = (r >> 4) * 2 + (c >> 5), rr = r & 15, cc = c & 31, ob = rr * 64 + cc * 2; return st * 1024 + (ob ^ (((ob >> 9) & 1) << 5)); }
__host__ __device__ __forceinline__ void stage_rc(int b, int& R, int& C) { const int st = b / 1024, sb = b % 1024, swz = sb ^ (((sb >> 9) & 1) << 5); R = (st >> 1) * 16 + swz / 64; C = (st & 1) * 32 + (swz % 64) / 2; }
__host__ __device__ __forceinline__ int perm32(int rho) { const int n = rho >> 4, i = rho & 15; return 8 * (i >> 2) + 4 * n + (i & 3); }

struct Unit { int pm, pn; };
struct Gemm { const bf16_t* A; const bf16_t* Bt; int M, N, K; };

struct StaticOrder {
    int nM, nN, nwg, G, c;
    __host__ __device__ void init(int M, int N, int G_, int c_) { nM = M / BM; nN = N / BM; nwg = nM * nN; G = G_; c = c_; }
    __host__ __device__ bool next(int i, Unit& u) const {
        const long L = (long)i * G + c; if (L >= nwg) return false;
        int wgid = (int)L; { const int q = nwg / NXCD, r = nwg % NXCD, xcd = wgid % NXCD, off = wgid / NXCD; wgid = (xcd < r ? xcd * (q + 1) : r * (q + 1) + (xcd - r) * q) + off; }
        const int nig = WGM * nN, gid = wgid / nig, fm = gid * WGM, gsz = (nM - fm) < WGM ? (nM - fm) : WGM;
        u.pm = fm + ((wgid % nig) % gsz); u.pn = (wgid % nig) / gsz; return true;
    }
    __device__ __forceinline__ void a_ready(const Unit&) const {}
    __device__ __forceinline__ void done(const Unit&) const {}
};

struct UnevenOrder : StaticOrder {
    __host__ __device__ bool next(int i, Unit& u) const {
        long L; const int h = G / 2;
        if (c < h) { if (i > 0) return false; L = c; } else { if (i > 2) return false; L = h + (long)h * i + (c - h); }
        if (L >= nwg) return false;
        int wgid = (int)L; { const int q = nwg / NXCD, r = nwg % NXCD, xcd = wgid % NXCD, off = wgid / NXCD; wgid = (xcd < r ? xcd * (q + 1) : r * (q + 1) + (xcd - r) * q) + off; }
        const int nig = WGM * nN, gid = wgid / nig, fm = gid * WGM, gsz = (nM - fm) < WGM ? (nM - fm) : WGM;
        u.pm = fm + ((wgid % nig) % gsz); u.pn = (wgid % nig) / gsz; return true;
    }
};

__device__ __forceinline__ unsigned cvt_pk_bf16(float lo, float hi) { unsigned r; asm volatile("v_cvt_pk_bf16_f32 %0, %1, %2" : "=v"(r) : "v"(lo), "v"(hi)); return r; }
typedef float f32x2 __attribute__((ext_vector_type(2)));

__device__ __forceinline__ float bf_lo(unsigned w) { return __builtin_bit_cast(float, w << 16); }
__device__ __forceinline__ float bf_hi(unsigned w) { return __builtin_bit_cast(float, w & 0xffff0000u); }
__device__ __forceinline__ float sigmoidf_fast(float x) { return __builtin_amdgcn_rcpf(1.0f + __builtin_amdgcn_exp2f(-1.4426950408889634f * x)); }

template <int ACT  > struct EpiBf16 {
    static constexpr bool PERM = true, AFTER_DRAIN = false, MID = false;
    bf16_t* O; int ldc;
    __device__ __forceinline__ void operator()(const f32x4 (&acc)[2][2][4][2], const Unit& u, int wr, int wc, int fr, int fq) const {
        const int row0 = u.pm * BM + wr * 64 + fr, col0 = u.pn * BM + wc * 32 + 8 * fq;
#pragma unroll
        for (int ai = 0; ai < 2; ++ai)
#pragma unroll
            for (int m = 0; m < 4; ++m) { bf16_t* rowp = O + (size_t)(row0 + ai * HALF + m * 16) * ldc + col0;
#pragma unroll
                for (int bj = 0; bj < 2; ++bj) { f32x4 v0 = acc[ai][bj][m][0], v1 = acc[ai][bj][m][1];
                    if (ACT == 1) {
#pragma unroll
                        for (int j = 0; j < 4; ++j) { const float a = fmaxf(v0[j], 0.f), b = fmaxf(v1[j], 0.f); v0[j] = a * a; v1[j] = b * b; } }
                    u32x4 w; w.x = cvt_pk_bf16(v0[0], v0[1]); w.y = cvt_pk_bf16(v0[2], v0[3]); w.z = cvt_pk_bf16(v1[0], v1[1]); w.w = cvt_pk_bf16(v1[2], v1[3]);
                    *(u32x4*)(rowp + bj * HALF) = w;
                    } }
    }
};
struct EpiRope {
    static constexpr bool PERM = true, AFTER_DRAIN = false, MID = false;
    bf16_t* O; int ldc; const float* tab;
    __device__ __forceinline__ void operator()(const f32x4 (&acc)[2][2][4][2], const Unit& u, int wr, int wc, int fr, int fq) const {
        const int row0 = u.pm * BM + wr * 64 + fr, col0 = u.pn * BM + wc * 32 + 8 * fq;
#pragma unroll
        for (int ai = 0; ai < 2; ++ai)
#pragma unroll
            for (int m = 0; m < 4; ++m) { const int row = row0 + ai * HALF + m * 16; bf16_t* rowp = O + (size_t)row * ldc + col0;
#pragma unroll
                for (int bj = 0; bj < 2; ++bj) { f32x4 v0 = acc[ai][bj][m][0], v1 = acc[ai][bj][m][1];
                    const int j = (col0 + bj * HALF) % 192;
                    if (j >= 128) { const float* tp = tab + (size_t)row * 64 + (j - 128);
                        const f32x4 t0 = *(const f32x4*)tp, t1 = *(const f32x4*)(tp + 4);
                        f32x4 r0, r1;
                        r0[0] = v0[0] * t0[0] - v0[1] * t0[1]; r0[1] = v0[1] * t0[0] + v0[0] * t0[1];
                        r0[2] = v0[2] * t0[2] - v0[3] * t0[3]; r0[3] = v0[3] * t0[2] + v0[2] * t0[3];
                        r1[0] = v1[0] * t1[0] - v1[1] * t1[1]; r1[1] = v1[1] * t1[0] + v1[0] * t1[1];
                        r1[2] = v1[2] * t1[2] - v1[3] * t1[3]; r1[3] = v1[3] * t1[2] + v1[2] * t1[3];
                        v0 = r0; v1 = r1; }
                    u32x4 w; w.x = cvt_pk_bf16(v0[0], v0[1]); w.y = cvt_pk_bf16(v0[2], v0[3]); w.z = cvt_pk_bf16(v1[0], v1[1]); w.w = cvt_pk_bf16(v1[2], v1[3]);
                    *(u32x4*)(rowp + bj * HALF) = w; }
                asm volatile("" ::: "memory"); }
    }
};
struct EpiGateMerge {
    static constexpr bool PERM = true, AFTER_DRAIN = false, MID = true;
    bf16_t* O; int ldo; const bf16_t* G1; const bf16_t* G2; int ldg;
    __device__ __forceinline__ void mid(f32x4 (&acc)[2][2][4][2], const Unit& u, int wr, int wc, int fr, int fq) const {
        int fr_ = fr, fq_ = fq; asm volatile("" : "+v"(fr_), "+v"(fq_));
        const int row0 = u.pm * BM + wr * 64 + fr_, col0 = u.pn * BM + wc * 32 + 8 * fq_;
#pragma unroll
        for (int ai = 0; ai < 2; ++ai)
#pragma unroll
            for (int m = 0; m < 4; ++m) { const int row = row0 + ai * HALF + m * 16; const bf16_t* g1p = G1 + (size_t)row * ldg + col0; const bf16_t* g2p = G2 + (size_t)row * ldg + col0;
#pragma unroll
                for (int bj = 0; bj < 2; ++bj) { const u32x4 a = *(const u32x4*)(g1p + bj * HALF), b = *(const u32x4*)(g2p + bj * HALF);
                    const unsigned aw[4] = {a.x, a.y, a.z, a.w}, bw[4] = {b.x, b.y, b.z, b.w};
#pragma unroll
                    for (int q = 0; q < 4; ++q) {
                        const float r0 = (1.0f + __builtin_amdgcn_exp2f(-1.4426950408889634f * bf_lo(bw[q]))) * __builtin_amdgcn_rcpf(1.0f + __builtin_amdgcn_exp2f(-1.4426950408889634f * bf_lo(aw[q])));
                        const float r1 = (1.0f + __builtin_amdgcn_exp2f(-1.4426950408889634f * bf_hi(bw[q]))) * __builtin_amdgcn_rcpf(1.0f + __builtin_amdgcn_exp2f(-1.4426950408889634f * bf_hi(aw[q])));
                        acc[ai][bj][m][q >> 1][2 * (q & 1)] *= r0; acc[ai][bj][m][q >> 1][2 * (q & 1) + 1] *= r1; } }
                asm volatile("" ::: "memory"); }
    }
    __device__ __forceinline__ void operator()(const f32x4 (&acc)[2][2][4][2], const Unit& u, int wr, int wc, int fr, int fq) const {
        const int row0 = u.pm * BM + wr * 64 + fr, col0 = u.pn * BM + wc * 32 + 8 * fq;
#pragma unroll
        for (int ai = 0; ai < 2; ++ai)
#pragma unroll
            for (int m = 0; m < 4; ++m) { const int row = row0 + ai * HALF + m * 16; const bf16_t* gp = G2 + (size_t)row * ldg + col0; bf16_t* op = O + (size_t)row * ldo + col0;
#pragma unroll
                for (int bj = 0; bj < 2; ++bj) { const f32x4 v0 = acc[ai][bj][m][0], v1 = acc[ai][bj][m][1];
                    const u32x4 g = *(const u32x4*)(gp + bj * HALF);
                    u32x4 w; w.x = cvt_pk_bf16(v0[0] * sigmoidf_fast(bf_lo(g.x)), v0[1] * sigmoidf_fast(bf_hi(g.x))); w.y = cvt_pk_bf16(v0[2] * sigmoidf_fast(bf_lo(g.y)), v0[3] * sigmoidf_fast(bf_hi(g.y)));
                    w.z = cvt_pk_bf16(v1[0] * sigmoidf_fast(bf_lo(g.z)), v1[1] * sigmoidf_fast(bf_hi(g.z))); w.w = cvt_pk_bf16(v1[2] * sigmoidf_fast(bf_lo(g.w)), v1[3] * sigmoidf_fast(bf_hi(g.w)));
                    *(u32x4*)(op + bj * HALF) = w; }
                asm volatile("" ::: "memory"); }
    }
};

template <class Epi, class Sched, bool ALIGN_EPI = false, bool SP2 = false>
__device__ __forceinline__ void gemm_phase(PG8_LAS unsigned char* lds, const Gemm g, const Sched& S, const Epi& E) {
    int tid_ = threadIdx.x; asm volatile("" : "+v"(tid_));
    const int tid = tid_, wid = __builtin_amdgcn_readfirstlane(tid >> 6), lane = tid & 63, wr = wid >> 2, wc = wid & 3, fr = lane & 15, fq = lane >> 4;
    const int K = g.K, nt = K / BK;
    unsigned voffA[2], voffB[2];
#pragma unroll
    for (int i = 0; i < 2; ++i) { int R, C; stage_rc(tid * 16 + i * 8192, R, C); const int Rb = Epi::PERM ? ((R & ~31) + perm32(R & 31)) : R;
        voffA[i] = (unsigned)(R * K + C) * 2u; voffB[i] = (unsigned)(Rb * K + C) * 2u; }
    const size_t kstep = (size_t)(BK * 2);
    const size_t hstep = (size_t)HALF * K * 2;
    const size_t tstep = 2 * hstep;
    const unsigned ldsw = (unsigned)wid * 1024u;
    const int aoff = lds_byte(wr * 64 + fr, fq * 8), boff = lds_byte(wc * 32 + fr, fq * 8);
#define PG8_SA(b, h) (((b) * 2 + (h)) * HTB)
#define PG8_SB(b, h) ((4 + (b) * 2 + (h)) * HTB)
#define PG8_STAGE(bufoff, gbase, voff) do { _Pragma("unroll") for (int _i = 0; _i < 2; ++_i) \
        __builtin_amdgcn_global_load_lds((const unsigned*)((const char*)(gbase) + (voff)[_i]), (PG8_LAS unsigned*)(lds + (bufoff) + ldsw + _i * 8192), 16, 0, 0); } while (0)
#define PG8_LDA(dst, b, h) do { _Pragma("unroll") for (int m = 0; m < 4; ++m) _Pragma("unroll") for (int k = 0; k < 2; ++k) dst[m][k] = *(const PG8_LAS bf16x8*)(lds + PG8_SA(b, h) + aoff + m * 2048 + k * 1024); } while (0)
#define PG8_LDB(dst, b, h) do { _Pragma("unroll") for (int n = 0; n < 2; ++n) _Pragma("unroll") for (int k = 0; k < 2; ++k) dst[n][k] = *(const PG8_LAS bf16x8*)(lds + PG8_SB(b, h) + boff + n * 2048 + k * 1024); } while (0)
#define PG8_MMA(ai, bj, At, Bt) do { __builtin_amdgcn_s_setprio(1); _Pragma("unroll") for (int m = 0; m < 4; ++m) _Pragma("unroll") for (int n = 0; n < 2; ++n) _Pragma("unroll") for (int k = 0; k < 2; ++k) \
        acc[ai][bj][m][n] = __builtin_amdgcn_mfma_f32_16x16x32_bf16(Bt[n][k], At[m][k], acc[ai][bj][m][n], 0, 0, 0); __builtin_amdgcn_s_setprio(0); } while (0)
#define PG8_WAIT_V(n) asm volatile("s_waitcnt vmcnt(" #n ")" ::: "memory")
#define PG8_WAIT_L(n) asm volatile("s_waitcnt lgkmcnt(" #n ")" ::: "memory")
#define PG8_BAR __builtin_amdgcn_s_barrier()
#define PG8_SCHED __builtin_amdgcn_sched_barrier(0)
    Unit cur, nxt; int ui = 0;
    if (!S.next(0, cur)) return;
    f32x4 acc[2][2][4][2];
#pragma unroll
    for (int a = 0; a < 2; ++a)
#pragma unroll
        for (int b = 0; b < 2; ++b)
#pragma unroll
            for (int m = 0; m < 4; ++m)
#pragma unroll
                for (int n = 0; n < 2; ++n) acc[a][b][m][n] = (f32x4){0.f, 0.f, 0.f, 0.f};
    bf16x8 At[4][2], B0[2][2], B1[2][2];
    const char* cA = (const char*)g.A + (size_t)cur.pm * tstep; const char* cB = (const char*)g.Bt + (size_t)cur.pn * tstep;
    S.a_ready(cur);
    if constexpr (SP2) {
        PG8_STAGE(PG8_SB(0, 0), cB, voffB); PG8_STAGE(PG8_SB(0, 1), cB + hstep, voffB); PG8_STAGE(PG8_SA(0, 0), cA, voffA); PG8_STAGE(PG8_SA(0, 1), cA + hstep, voffA);
        if (wr == 1) PG8_BAR;
        PG8_WAIT_V(2); PG8_BAR;
        PG8_STAGE(PG8_SB(1, 0), cB + kstep, voffB); PG8_STAGE(PG8_SA(1, 0), cA + kstep, voffA); PG8_STAGE(PG8_SB(1, 1), cB + hstep + kstep, voffB);
        PG8_WAIT_V(6); PG8_BAR;
    } else {
        PG8_STAGE(PG8_SB(0, 0), cB, voffB); PG8_STAGE(PG8_SA(0, 0), cA, voffA); PG8_STAGE(PG8_SB(0, 1), cB + hstep, voffB); PG8_STAGE(PG8_SA(0, 1), cA + hstep, voffA);
        if (wr == 1) PG8_BAR;
        PG8_WAIT_V(4); PG8_BAR;
        PG8_STAGE(PG8_SB(1, 0), cB + kstep, voffB); PG8_STAGE(PG8_SA(1, 0), cA + kstep, voffA); PG8_STAGE(PG8_SB(1, 1), cB + hstep + kstep, voffB);
        PG8_WAIT_V(6); PG8_BAR;
    }
    for (;;) {
        const bool has_next = S.next(ui + 1, nxt);
        const char* nA = has_next ? (const char*)g.A + (size_t)nxt.pm * tstep : cA; const char* nB = has_next ? (const char*)g.Bt + (size_t)nxt.pn * tstep : cB;
        for (int t = 0; t < nt; t += 2) {
            const bool last = (t == nt - 2);
            const char* a1 = cA + (size_t)(t + 1) * kstep;
            const char* a2 = last ? nA : cA + (size_t)(t + 2) * kstep; const char* b2 = last ? nB : cB + (size_t)(t + 2) * kstep;
            const char* a3 = a2 + kstep; const char* b3 = b2 + kstep;
            if (last && has_next) S.a_ready(nxt);
            if constexpr (Epi::MID) { if (t == (nt >> 1)) E.mid(acc, cur, wr, wc, fr, fq); }
            if constexpr (SP2) {
            PG8_LDB(B0, 0, 0); PG8_LDB(B1, 0, 1); PG8_SCHED; PG8_LDA(At, 0, 0); PG8_STAGE(PG8_SA(1, 1), a1 + hstep, voffA);
            PG8_WAIT_V(8); PG8_WAIT_L(0); PG8_BAR; PG8_MMA(0, 0, At, B0); PG8_MMA(0, 1, At, B1); PG8_BAR; PG8_SCHED;
            PG8_LDA(At, 0, 1); PG8_STAGE(PG8_SB(0, 0), b2, voffB); PG8_STAGE(PG8_SB(0, 1), b2 + hstep, voffB); PG8_STAGE(PG8_SA(0, 0), a2, voffA);
            PG8_WAIT_V(8); PG8_WAIT_L(0); PG8_BAR; PG8_MMA(1, 0, At, B0); PG8_MMA(1, 1, At, B1); PG8_BAR; PG8_SCHED;
            PG8_LDB(B0, 1, 0); PG8_LDB(B1, 1, 1); PG8_SCHED; PG8_LDA(At, 1, 0); PG8_STAGE(PG8_SA(0, 1), a2 + hstep, voffA);
            PG8_WAIT_V(8); PG8_WAIT_L(0); PG8_BAR; PG8_MMA(0, 0, At, B0); PG8_MMA(0, 1, At, B1); PG8_BAR; PG8_SCHED;
            PG8_LDA(At, 1, 1); PG8_STAGE(PG8_SB(1, 0), b3, voffB); PG8_STAGE(PG8_SB(1, 1), b3 + hstep, voffB); PG8_STAGE(PG8_SA(1, 0), a3, voffA);
            PG8_WAIT_V(8); PG8_WAIT_L(0); PG8_BAR; PG8_MMA(1, 0, At, B0); PG8_MMA(1, 1, At, B1); PG8_BAR; PG8_SCHED;
            } else {
            PG8_LDB(B0, 0, 0); PG8_SCHED; PG8_LDA(At, 0, 0); PG8_STAGE(PG8_SA(1, 1), a1 + hstep, voffA);
            PG8_WAIT_L(8); PG8_BAR; PG8_WAIT_L(0); PG8_MMA(0, 0, At, B0); PG8_BAR; PG8_SCHED;
            PG8_LDB(B1, 0, 1); PG8_STAGE(PG8_SB(0, 0), b2, voffB);
            PG8_BAR; PG8_WAIT_L(0); PG8_MMA(0, 1, At, B1); PG8_BAR;
            PG8_LDA(At, 0, 1); PG8_STAGE(PG8_SA(0, 0), a2, voffA);
            PG8_BAR; PG8_WAIT_L(0); PG8_MMA(1, 0, At, B0); PG8_BAR; PG8_SCHED;
            PG8_STAGE(PG8_SB(0, 1), b2 + hstep, voffB);
            PG8_WAIT_V(6); PG8_BAR; PG8_MMA(1, 1, At, B1); PG8_BAR;
            PG8_LDB(B0, 1, 0); PG8_SCHED; PG8_LDA(At, 1, 0); PG8_STAGE(PG8_SA(0, 1), a2 + hstep, voffA);
            PG8_WAIT_L(8); PG8_BAR; PG8_WAIT_L(0); PG8_MMA(0, 0, At, B0); PG8_BAR; PG8_SCHED;
            PG8_LDB(B1, 1, 1); PG8_STAGE(PG8_SB(1, 0), b3, voffB);
            PG8_BAR; PG8_WAIT_L(0); PG8_MMA(0, 1, At, B1); PG8_BAR;
            PG8_LDA(At, 1, 1); PG8_STAGE(PG8_SA(1, 0), a3, voffA);
            PG8_BAR; PG8_WAIT_L(0); PG8_MMA(1, 0, At, B0); PG8_BAR; PG8_SCHED;
            PG8_STAGE(PG8_SB(1, 1), b3 + hstep, voffB);
            PG8_WAIT_V(6); PG8_BAR; PG8_MMA(1, 1, At, B1); PG8_BAR;
            }
        }
        if constexpr (ALIGN_EPI) { if (wr == 0) PG8_BAR; }
        if constexpr (!Epi::AFTER_DRAIN) { E(acc, cur, wr, wc, fr, fq); S.done(cur); }
        if (!has_next) break;
#pragma unroll
        for (int a = 0; a < 2; ++a)
#pragma unroll
            for (int b = 0; b < 2; ++b)
#pragma unroll
                for (int m = 0; m < 4; ++m)
#pragma unroll
                    for (int n = 0; n < 2; ++n) acc[a][b][m][n] = (f32x4){0.f, 0.f, 0.f, 0.f};
        cur = nxt; cA = nA; cB = nB; ++ui;
        if constexpr (ALIGN_EPI) { if (wr == 1) PG8_BAR; }
    }
    PG8_WAIT_V(0);
    if constexpr (!ALIGN_EPI) { if (wr == 0) PG8_BAR; }
    PG8_BAR;
    if constexpr (Epi::AFTER_DRAIN) { E.fused(acc, cur, wr, wc, fr, fq, lds, wid, lane); S.done(cur); }
#undef PG8_SA
#undef PG8_SB
#undef PG8_STAGE
#undef PG8_LDA
#undef PG8_LDB
#undef PG8_MMA
#undef PG8_WAIT_V
#undef PG8_WAIT_L
#undef PG8_BAR
#undef PG8_SCHED
}
}

namespace att {
#define ATT_LAS __attribute__((address_space(3)))
typedef unsigned short bf16_t;
typedef short bf16x8 __attribute__((ext_vector_type(8)));
typedef short s16x4 __attribute__((ext_vector_type(4)));
typedef float f32x16 __attribute__((ext_vector_type(16)));
typedef unsigned u32x4 __attribute__((ext_vector_type(4)));
constexpr int SHM_V = 16384, SHM_K = 16384, SHM_R = 8192, BUFB = SHM_V + SHM_K + SHM_R;
constexpr int LDS_SCR = 2 * BUFB;
constexpr int LDS_FLAGS = LDS_SCR + 8 * 256;
constexpr int LDS_QR = LDS_FLAGS + 64;
constexpr int ATT_LDS_BYTES = LDS_QR + 8 * 4096;
#define KSWZ(row, colB) ((row) * 256 + ((colB) ^ (((row) & 7) << 4)))
#define RSWZ(row, colB) ((row) * 128 + ((colB) ^ ((((row) >> 1) & 7) << 4)))
__device__ __forceinline__ int v_st(int k, int c) { const int kk = (k & ~0xC) | ((k & 4) << 1) | ((k & 8) >> 1); return ((kk >> 3) * 4 + (c >> 5)) * 512 + ((kk & 7) * 32 + (c & 31)) * 2; }
__device__ __forceinline__ int v_rd_base(int lane) { return ((lane & 3) << 3) | (((lane >> 2) & 3) << 6) | (((lane >> 4) & 1) << 5) | (((lane >> 5) & 1) << 8); }
constexpr int v_rd_off(int d0, int ks, int half) { return d0 * 512 + ks * 4096 + half * 2048; }
__device__ __forceinline__ int crow(int r, int hi) { return (r & 3) + 8 * (r >> 2) + 4 * hi; }
__device__ __forceinline__ unsigned cvtpk(float lo, float hi) { unsigned r; asm volatile("v_cvt_pk_bf16_f32 %0, %1, %2" : "=v"(r) : "v"(lo), "v"(hi)); return r; }
#define ATT_SBAR() __builtin_amdgcn_sched_barrier(0)

template <int ND>
__device__ __forceinline__ void qkt_half(f32x16& p, const ATT_LAS char* Kb, const ATT_LAS char* Rb, int r32, int hi, const bf16x8* qr, const ATT_LAS char* qrl, int lane, int half) {
    p = f32x16{};
#pragma unroll
    for (int d0 = 0; d0 < 8; ++d0) { const ATT_LAS char* a = Kb + KSWZ(r32, ((d0 & 3) * 16 + hi * 8) * 2) + (d0 >> 2) * 128 + half * (32 * 256);
        const bf16x8 b = *(const ATT_LAS bf16x8*)a;
        p = __builtin_amdgcn_mfma_f32_32x32x16_bf16(b, qr[d0], p, 0, 0, 0); }
    if constexpr (ND == 12) {
#pragma unroll
        for (int dr = 0; dr < 4; ++dr) { const ATT_LAS char* a = Rb + RSWZ(r32, (dr * 16 + hi * 8) * 2) + half * (32 * 128);
            const bf16x8 b = *(const ATT_LAS bf16x8*)a; const bf16x8 q = *(const ATT_LAS bf16x8*)(qrl + dr * 1024 + lane * 16);
            p = __builtin_amdgcn_mfma_f32_32x32x16_bf16(b, q, p, 0, 0, 0); } }
}
__device__ __forceinline__ void pv_tile(f32x16* o, int vb, bf16x8 pa0, bf16x8 pa1, bf16x8 pa2, bf16x8 pa3) {
#define ATT_TRRD(dst, off) asm volatile("ds_read_b64_tr_b16 %0, %1 offset:%2" : "=&v"(dst) : "v"(vb), "i"(off) : "memory")
#define ATT_PV_D0(d0) do { s16x4 l0, l1, l2, l3, h0, h1, h2, h3; constexpr int b_ = v_rd_off(d0, 0, 0); \
        ATT_TRRD(l0, b_); ATT_TRRD(h0, b_ + 2048); ATT_TRRD(l1, b_ + 4096); ATT_TRRD(h1, b_ + 6144); ATT_TRRD(l2, b_ + 8192); ATT_TRRD(h2, b_ + 10240); ATT_TRRD(l3, b_ + 12288); ATT_TRRD(h3, b_ + 14336); \
        asm volatile("s_waitcnt lgkmcnt(0)" ::: "memory"); ATT_SBAR(); \
        o[d0] = __builtin_amdgcn_mfma_f32_32x32x16_bf16(pa0, (bf16x8){l0[0], l0[1], l0[2], l0[3], h0[0], h0[1], h0[2], h0[3]}, o[d0], 0, 0, 0); \
        o[d0] = __builtin_amdgcn_mfma_f32_32x32x16_bf16(pa1, (bf16x8){l1[0], l1[1], l1[2], l1[3], h1[0], h1[1], h1[2], h1[3]}, o[d0], 0, 0, 0); \
        o[d0] = __builtin_amdgcn_mfma_f32_32x32x16_bf16(pa2, (bf16x8){l2[0], l2[1], l2[2], l2[3], h2[0], h2[1], h2[2], h2[3]}, o[d0], 0, 0, 0); \
        o[d0] = __builtin_amdgcn_mfma_f32_32x32x16_bf16(pa3, (bf16x8){l3[0], l3[1], l3[2], l3[3], h3[0], h3[1], h3[2], h3[3]}, o[d0], 0, 0, 0); } while (0)
    ATT_PV_D0(0); ATT_PV_D0(1); ATT_PV_D0(2); ATT_PV_D0(3);
#undef ATT_PV_D0
#undef ATT_TRRD
}
__device__ __forceinline__ void pack_half(const f32x16& p, bf16x8& pa0, bf16x8& pa1) {
#define ATT_PK4(P, B_, OUT) do { unsigned a0 = cvtpk(P[B_+0], P[B_+1]), a1 = cvtpk(P[B_+2], P[B_+3]); \
        unsigned b0 = cvtpk(P[B_+4], P[B_+5]), b1 = cvtpk(P[B_+6], P[B_+7]); \
        auto r0 = __builtin_amdgcn_permlane32_swap(a0, b0, false, false); auto r1 = __builtin_amdgcn_permlane32_swap(a1, b1, false, false); \
        u32x4 w = {r0[0], r1[0], r0[1], r1[1]}; OUT = __builtin_bit_cast(bf16x8, w); } while (0)
    ATT_PK4(p, 0, pa0); ATT_PK4(p, 8, pa1);
#undef ATT_PK4
}
__device__ __forceinline__ void half_xchg(float x, float& lo, float& hi) {
    unsigned a = __builtin_bit_cast(unsigned, x), b;
    asm volatile("s_nop 1\n\tv_mov_b32 %1, %0\n\ts_nop 1\n\tv_permlane32_swap_b32 %0, %1" : "+v"(a), "=&v"(b));
    lo = __builtin_bit_cast(float, a); hi = __builtin_bit_cast(float, b);
}
__device__ __forceinline__ float half_sum(float v) { float lo, hi; half_xchg(v, lo, hi); return lo + hi; }
__device__ __forceinline__ float half_max(float v) { float lo, hi; half_xchg(v, lo, hi); return fmaxf(lo, hi); }

struct Tensors { const bf16_t* Q; int ldq; const bf16_t* K; int ldk; const bf16_t* V; int ldv; const bf16_t* R; bf16_t* O; int ldo; };

template <int MODE>
__device__ __forceinline__ void attn_unit(const Tensors& T, int qb, float sc2, ATT_LAS char* lds) {
    constexpr int ND = MODE == 1 ? 12 : 8;
    int tid_ = threadIdx.x; asm volatile("" : "+v"(tid_));
    const int tid = tid_, wid = __builtin_amdgcn_readfirstlane(tid >> 6), lane = tid & 63, r32 = lane & 31, hi = lane >> 5;
    const int q0 = qb * 256, qw = q0 + wid * 32;
    const int NT = 4 * (qb + 1);
    const int wlast = 4 * qb + (wid >> 1);
    const int tq = qw + r32;
    ATT_LAS float* scr = (ATT_LAS float*)(lds + LDS_SCR) + wid * 64;
    volatile ATT_LAS unsigned* flags = (volatile ATT_LAS unsigned*)(lds + LDS_FLAGS);
    const ATT_LAS char* qrl = lds + LDS_QR + wid * 4096;
    bf16x8 qr[8];
    { const bf16_t* qp = T.Q + (size_t)tq * T.ldq + hi * 8;
#pragma unroll
      for (int d0 = 0; d0 < 8; ++d0) qr[d0] = *(const bf16x8*)(qp + d0 * 16);
      if constexpr (MODE == 1) {
#pragma unroll
          for (int dr = 0; dr < 4; ++dr) *(ATT_LAS bf16x8*)(lds + LDS_QR + wid * 4096 + dr * 1024 + lane * 16) = *(const bf16x8*)(qp + 128 + dr * 16); } }
    const int sr = tid >> 4, sc = (tid & 15) * 8, kws = KSWZ(sr, sc * 2), vst0 = v_st(sr, sc), vst1 = v_st(32 + sr, sc);
    const int rr_ = tid >> 3, rc = (tid & 7) * 8, rws = RSWZ(rr_, rc * 2);
    bf16x8 sk0, sk1, sv0, sv1, srp;
#define ATT_LOAD(kt) do { const size_t k0_ = (size_t)(kt) * 64; \
        sk0 = *(const bf16x8*)(T.K + (k0_ + sr) * T.ldk + sc); sk1 = *(const bf16x8*)(T.K + (k0_ + 32 + sr) * T.ldk + sc); \
        sv0 = *(const bf16x8*)(T.V + (k0_ + sr) * T.ldv + sc); sv1 = *(const bf16x8*)(T.V + (k0_ + 32 + sr) * T.ldv + sc); \
        if constexpr (MODE == 1) srp = *(const bf16x8*)(T.R + (k0_ + rr_) * 64 + rc); } while (0)
#define ATT_WRITE(bf) do { ATT_LAS char* b_ = lds + (bf) * BUFB; \
        *(ATT_LAS bf16x8*)(b_ + vst0) = sv0; *(ATT_LAS bf16x8*)(b_ + vst1) = sv1; \
        *(ATT_LAS bf16x8*)(b_ + SHM_V + kws) = sk0; *(ATT_LAS bf16x8*)(b_ + SHM_V + kws + 32 * 256) = sk1; \
        if constexpr (MODE == 1) *(ATT_LAS bf16x8*)(b_ + SHM_V + SHM_K + rws) = srp; } while (0)
#define ATT_TILE(it) (MODE == 0 ? (NT - 1 - (it)) : (it))
    f32x16 o[4] = {};
    float carry = 0.f;
    float m_reg = -1e30f, l_reg = 0.f;
    bool dead = false;
    const float hsel = hi ? 0.f : 1.f;
    ATT_LOAD(ATT_TILE(0)); asm volatile("s_waitcnt vmcnt(0)" ::: "memory"); ATT_WRITE(0);
    __syncthreads();
    for (int it = 0; it < NT; ++it) {
        const int cur = it & 1, kt = ATT_TILE(it), kb = kt * 64;
        if (it + 1 < NT) ATT_LOAD(ATT_TILE(it + 1));
        const ATT_LAS char* bufp = lds + cur * BUFB;
        if (kt <= wlast && !dead) {
            f32x16 p0, p1;
            bf16x8 pa0, pa1, pa2, pa3;
            if constexpr (MODE == 0) {
                const bool diag = (kb + 63 >= qw);
                qkt_half<ND>(p1, bufp + SHM_V, bufp + SHM_V + SHM_K, r32, hi, qr, qrl, lane, 1);
                qkt_half<ND>(p0, bufp + SHM_V, bufp + SHM_V + SHM_K, r32, hi, qr, qrl, lane, 0);
                float tsum = carry;
#define ATT_SB_HALF(P, KOFF) do { f32x16 f; \
                    _Pragma("unroll") for (int r = 0; r < 16; ++r) { P[r] *= sc2; \
                        f[r] = fminf(-P[r], 0.f) - __builtin_amdgcn_logf(1.0f + __builtin_amdgcn_exp2f(-__builtin_fabsf(P[r]))); } \
                    if (diag) { _Pragma("unroll") for (int r = 0; r < 16; ++r) { if (kb + (KOFF) + crow(r, hi) >= tq) f[r] = 0.f; } } \
                    float gs_[4], oh_[4], ps_[4]; \
                    _Pragma("unroll") for (int i = 0; i < 4; ++i) { f[4*i+2] += f[4*i+3]; f[4*i+1] += f[4*i+2]; f[4*i] += f[4*i+1]; gs_[i] = f[4*i]; } \
                    _Pragma("unroll") for (int i = 0; i < 4; ++i) { float lo_; half_xchg(gs_[i], lo_, oh_[i]); ps_[i] = lo_ + oh_[i]; } \
                    _Pragma("unroll") for (int i = 3; i >= 0; --i) { const float Tg = tsum + hsel * oh_[i]; \
                        _Pragma("unroll") for (int e = 0; e < 4; ++e) P[4*i+e] = __builtin_amdgcn_exp2f(P[4*i+e] + f[4*i+e] + Tg); \
                        tsum += ps_[i]; } \
                    if (diag) { _Pragma("unroll") for (int r = 0; r < 16; ++r) { if (kb + (KOFF) + crow(r, hi) >= tq) P[r] = 0.f; } } } while (0)
                ATT_SB_HALF(p1, 32);
                pack_half(p1, pa2, pa3);
                ATT_SB_HALF(p0, 0);
                pack_half(p0, pa0, pa1);
#undef ATT_SB_HALF
                carry = tsum;
                pv_tile(o, (int)(uintptr_t)(bufp) + v_rd_base(lane), pa0, pa1, pa2, pa3);
                if (__all(carry < -140.f)) dead = true;
            } else {
                qkt_half<ND>(p0, bufp + SHM_V, bufp + SHM_V + SHM_K, r32, hi, qr, qrl, lane, 0);
                qkt_half<ND>(p1, bufp + SHM_V, bufp + SHM_V + SHM_K, r32, hi, qr, qrl, lane, 1);
                float pmax = p0[0];
#pragma unroll
                for (int r = 1; r < 16; ++r) pmax = fmaxf(pmax, p0[r]);
#pragma unroll
                for (int r = 0; r < 16; ++r) pmax = fmaxf(pmax, p1[r]);
                pmax = half_max(pmax);
                const float mn = fmaxf(m_reg, pmax), alpha = __builtin_amdgcn_exp2f((m_reg - mn) * sc2); m_reg = mn;
                const float mnL = -mn * sc2;
                float psum = 0.f;
#pragma unroll
                for (int r = 0; r < 16; ++r) { p0[r] = __builtin_amdgcn_exp2f(fmaf(p0[r], sc2, mnL)); psum += p0[r]; }
                pack_half(p0, pa0, pa1);
#pragma unroll
                for (int r = 0; r < 16; ++r) { p1[r] = __builtin_amdgcn_exp2f(fmaf(p1[r], sc2, mnL)); psum += p1[r]; }
                pack_half(p1, pa2, pa3);
                l_reg = l_reg * alpha + half_sum(psum);
                if (__any(alpha < 1.f))
                { if (hi == 0) scr[r32] = alpha; asm volatile("s_waitcnt lgkmcnt(0)" ::: "memory");
#pragma unroll
                    for (int r = 0; r < 16; ++r) { const float a = scr[crow(r, hi)];
#pragma unroll
                        for (int d = 0; d < 4; ++d) o[d][r] *= a; } }
                pv_tile(o, (int)(uintptr_t)(bufp) + v_rd_base(lane), pa0, pa1, pa2, pa3);
            }
        }
        if (it + 1 < NT) { asm volatile("s_waitcnt vmcnt(0)" ::: "memory"); ATT_WRITE(cur ^ 1); }
        if constexpr (MODE == 0) { if (lane == 0) flags[cur * 8 + wid] = dead ? 1u : 0u; }
        __syncthreads();
        if constexpr (MODE == 0) {
            unsigned alld = 1u;
#pragma unroll
            for (int w = 0; w < 8; ++w) alld &= flags[cur * 8 + w];
            if (alld) break;
        }
    }
    if constexpr (MODE == 1) { if (hi == 0) scr[32 + r32] = l_reg; asm volatile("s_waitcnt lgkmcnt(0)" ::: "memory"); }
    bf16_t* Ow = T.O + (size_t)qw * T.ldo;
    int obase = 4 * hi * T.ldo + r32; asm volatile("" : "+v"(obase));
#pragma unroll
    for (int r = 0; r < 16; ++r) { const int orow = crow(r, hi);
        float rl = 1.f; if constexpr (MODE == 1) rl = __builtin_amdgcn_rcpf(scr[32 + orow]);
        int ro = obase + ((r & 3) + 8 * (r >> 2)) * T.ldo; asm volatile("" : "+v"(ro));
#pragma unroll
        for (int d0 = 0; d0 < 4; ++d0) { const float v = o[d0][r] * rl; const float vn = __shfl_xor(v, 1);
            if ((r32 & 1) == 0) *(unsigned*)(Ow + ro + d0 * 32) = cvtpk(v, vn); } }
    __syncthreads();
#undef ATT_LOAD
#undef ATT_WRITE
#undef ATT_TILE
}
}

constexpr int BATCH = 2, SEQ = 4096, D = 4096, M = BATCH * SEQ, DEPTH = 2;
constexpr int SBW = 2048, QRANK = 1024, KVRANK = 512, ROPE = 64, DFF = 16384;
constexpr int IN_W = 3 * SBW + QRANK + KVRANK + ROPE + 2 * D;
constexpr int C_QD = 3 * SBW, C_KVD = C_QD + QRANK, C_GATE_SRC = C_KVD + KVRANK + ROPE;
constexpr int C_GSB = 7936, C_GMLA = C_GSB + D, PROJ_W = C_GMLA + D;
constexpr int QW = 16 * 192, KVW = 16 * 256;
constexpr float EPS = 1e-6f;
static_assert(IN_W == 15936 && PROJ_W == 16128 && PROJ_W % 256 == 0 && C_GSB % 256 == 0, "projection layout");

constexpr size_t MiB = 1u << 20;
constexpr size_t WS_CTL = 0, CTL_ZERO_BYTES = 1 * MiB;
constexpr size_t WS_ADA = 1 * MiB;
constexpr size_t WS_TAB = 2 * MiB;
constexpr size_t WS_ADAP = 4 * MiB;
constexpr size_t WS_W = 32 * MiB;
constexpr size_t W_IN = 0, W_UQ = 126 * MiB, W_UKV = 132 * MiB, W_OSB = 136 * MiB, W_OMLA = 152 * MiB, W_OUT = 168 * MiB, W_UP = 200 * MiB, W_DOWN = 328 * MiB, W_LAYER = 456 * MiB;
constexpr size_t WS_ACT = WS_W + DEPTH * W_LAYER;
constexpr size_t A_H = WS_ACT, A_PROJ = A_H + 64 * MiB, A_CQ = A_PROJ + 252 * MiB, A_CKV = A_CQ + 16 * MiB, A_KR = A_CKV + 8 * MiB, A_Q = A_KR + 1 * MiB, A_KV = A_Q + 48 * MiB,
                 A_OSB = A_KV + 64 * MiB, A_OMLA = A_OSB + 32 * MiB, A_TMP = A_OMLA + 32 * MiB, A_MRG = A_TMP + 128 * MiB, A_Y = A_MRG + 64 * MiB, A_U = A_Y + 128 * MiB, WS_END = A_U + 256 * MiB;
static_assert((size_t)PROJ_W * D * 2 == 126 * MiB && (size_t)M * PROJ_W * 2 == 252 * MiB, "sizes");
constexpr int CW_TMO = 0;
constexpr int CW_BAR = 4096;

constexpr int RING_BYTES = 135168;
constexpr int LDSCTL_OFF = RING_BYTES, MISC_OFF = LDSCTL_OFF + 320;
constexpr int LDS_BYTES = RING_BYTES + 1024;
constexpr int NWAVES = 8;
static_assert(att::ATT_LDS_BYTES <= RING_BYTES && pg8::STAGE_BYTES <= RING_BYTES, "LDS map");

#define GAS __attribute__((address_space(1)))
#define LAS __attribute__((address_space(3)))
typedef unsigned short bf16;
typedef unsigned v4u __attribute__((ext_vector_type(4)));
typedef unsigned v2u __attribute__((ext_vector_type(2)));
typedef float f32x4 __attribute__((ext_vector_type(4)));
typedef GAS unsigned gu32;
#define RLX_AGENT __ATOMIC_RELAXED, __HIP_MEMORY_SCOPE_AGENT
#define LDS_WAIT() asm volatile("s_waitcnt lgkmcnt(0)" ::: "memory")
#define VM_WAIT() asm volatile("s_waitcnt vmcnt(0)" ::: "memory")
__device__ __forceinline__ unsigned pk2(float lo, float hi) { return pg8::cvt_pk_bf16(lo, hi); }
__device__ __forceinline__ float bflo(unsigned w) { return __builtin_bit_cast(float, w << 16); }
__device__ __forceinline__ float bfhi(unsigned w) { return __builtin_bit_cast(float, w & 0xffff0000u); }

#define XB_TMO      128
#define XB_XCNT(j)  (256  + 64 * (j))
#define XB_XSUB(j)  (1280 + 64 * (j))
#define XB_XGEN(j)  (2304 + 64 * (j))
#define XB_TOP      3328
#define XB_TOPGEN   3392
#define XCD_BAR_WORDS 3456
#define XB_SPIN_CAP (1u << 21)

__device__ __forceinline__ unsigned xb_ld(unsigned* p)              { return __hip_atomic_load(p, __ATOMIC_RELAXED, __HIP_MEMORY_SCOPE_AGENT); }
__device__ __forceinline__ unsigned xb_add(unsigned* p, unsigned v) { return __hip_atomic_fetch_add(p, v, __ATOMIC_RELAXED, __HIP_MEMORY_SCOPE_AGENT); }
__device__ __forceinline__ unsigned xb_xcc_id() { return (unsigned)__builtin_amdgcn_s_getreg((3 << 11) | 20) & 0xFu; }
#define XB_SPIN(cond, bar) do { unsigned _sp = 0; while (cond) { __builtin_amdgcn_s_sleep(1); \
    if ((++_sp & 255u) == 0u) { if (xb_ld(&(bar)[XB_TMO])) break; if (_sp > XB_SPIN_CAP) { atomicAdd(&(bar)[XB_TMO], 1u); break; } } } } while (0)

struct XcdBarrier {
    unsigned* bar; unsigned x;
    volatile LAS unsigned* st;
};

__device__ __forceinline__ XcdBarrier xcd_barrier_post(unsigned* bar, volatile LAS unsigned* st) {
    XcdBarrier b; b.bar = bar; b.x = xb_xcc_id(); b.st = st;
    if (threadIdx.x == 0) (void)xb_add(&bar[XB_XCNT(b.x)], 1u);
    return b;
}
__device__ __forceinline__ void xcd_barrier_complete(unsigned* bar, unsigned x, unsigned& nloc, unsigned& nx) {
    const unsigned G = gridDim.x * gridDim.y * gridDim.z;
    unsigned sum, cnt, mine, sp = 0u;
    for (;;) {
        sum = 0u; cnt = 0u; mine = 0u;
#pragma unroll
        for (unsigned j = 0; j < 16; ++j) { const unsigned c = xb_ld(&bar[XB_XCNT(j)]); sum += c; cnt += (c > 0u) ? 1u : 0u; mine = (j == x) ? c : mine; }
        if (sum == G) break;
        __builtin_amdgcn_s_sleep(1);
        if ((++sp & 255u) == 0u) { if (xb_ld(&bar[XB_TMO])) break; if (sp > XB_SPIN_CAP) { atomicAdd(&bar[XB_TMO], 1u); break; } }
    }
    nloc = mine > 0u ? mine : 1u; nx = cnt > 0u ? cnt : 1u;
}

__device__ __forceinline__ void xcd_barrier(const XcdBarrier& b) {
    asm volatile("s_waitcnt vmcnt(0)" ::: "memory");
    __syncthreads();
    if (threadIdx.x == 0) {
        unsigned* bar = b.bar;
        __builtin_amdgcn_s_waitcnt(0);
        unsigned nloc = b.st[0], nx = b.st[1];
        if (nloc == 0u) { xcd_barrier_complete(bar, b.x, nloc, nx); b.st[0] = nloc; b.st[1] = nx; }
        const unsigned old = xb_add(&bar[XB_XSUB(b.x)], 1u);
        const unsigned gen = old / nloc;
        if (old + 1u == (gen + 1u) * nloc) {
            __builtin_amdgcn_fence(__ATOMIC_RELEASE, "agent");
            asm volatile("s_waitcnt vmcnt(0)" ::: "memory");
            const unsigned og = xb_add(&bar[XB_TOP], 1u);
            const unsigned tg = og / nx;
            if (og + 1u == (tg + 1u) * nx) xb_add(&bar[XB_TOPGEN], 1u);
            else XB_SPIN(xb_ld(&bar[XB_TOPGEN]) == tg, bar);
            __builtin_amdgcn_fence(__ATOMIC_ACQUIRE, "agent");
            xb_add(&bar[XB_XGEN(b.x)], 1u);
            asm volatile("s_waitcnt vmcnt(0)" ::: "memory");
        } else {
            XB_SPIN(xb_ld(&bar[XB_XGEN(b.x)]) == gen, bar);
            __builtin_amdgcn_fence(__ATOMIC_ACQUIRE, "agent");
            asm volatile("s_waitcnt vmcnt(0)" ::: "memory");
        }
    }
    __syncthreads();
}


struct Frame {
    LAS unsigned char* lds;
    int tid, lane, wave, G, gw, NGW;
};
__device__ __forceinline__ float wave_sum(float v) {
#pragma unroll
    for (int o = 1; o < 64; o <<= 1) v += __shfl_xor(v, o);
    return v;
}

__device__ __forceinline__ void transpose_item(const float* W, int N, bf16* WT, int ldt, int kb, int nb, int rowbase, bool ropeperm, LAS float* scr, int lane) {
    const int k0 = 64 * kb, n0 = 64 * nb;
    const float* src = W + (size_t)(k0 + (lane >> 4)) * N + n0 + 4 * (lane & 15);
#pragma unroll 4
    for (int i = 0; i < 16; ++i) { const f32x4 v = *(const f32x4*)(src + (size_t)(4 * i) * N); LAS float* d = scr + (4 * i + (lane >> 4)) * 65 + 4 * (lane & 15);
        d[0] = v[0]; d[1] = v[1]; d[2] = v[2]; d[3] = v[3]; }
    LDS_WAIT(); asm volatile("" ::: "memory");
    const int c = lane & 7;
#pragma unroll
    for (int j = 0; j < 8; ++j) { const int nn = (lane >> 3) + 8 * j; const LAS float* s = scr + (8 * c) * 65 + nn;
        v4u o; o.x = pk2(s[0 * 65], s[1 * 65]); o.y = pk2(s[2 * 65], s[3 * 65]); o.z = pk2(s[4 * 65], s[5 * 65]); o.w = pk2(s[6 * 65], s[7 * 65]);
        const int orow = rowbase + (ropeperm ? (2 * (nn & 31) + (nn >> 5)) : nn);
        *(GAS v4u*)(WT + (size_t)orow * ldt + k0 + 8 * c) = o; }
    LDS_WAIT(); asm volatile("" ::: "memory");
}

__device__ __forceinline__ void norm_mod_row(const f32x4 (&v)[16], float ssq, const float* g, const float* scv, const float* shv, bf16* orow, int lane) {
    const float r = 1.0f / sqrtf(ssq * (1.0f / D) + EPS);
#pragma unroll
    for (int j = 0; j < 16; ++j) { int c = 4 * lane + 256 * j; asm volatile("" : "+v"(c));
        const f32x4 gg = *(const f32x4*)(g + c), ss = *(const f32x4*)(scv + c), hh = *(const f32x4*)(shv + c);
        f32x4 o;
#pragma unroll
        for (int e = 0; e < 4; ++e) o[e] = v[j][e] * r * gg[e] * (1.0f + ss[e]) + hh[e];
        v2u w; w.x = pk2(o[0], o[1]); w.y = pk2(o[2], o[3]);
        *(GAS v2u*)(orow + c) = w; }
}


template <bool HAS_Y, bool HAS_H>
__device__ __forceinline__ void thin_phase(Frame& F, const float* xin, float* xout, const bf16* Yb, bf16* Hout,
                                           const float* gpost, const float* gate0, const float* gpre, const float* sc0, const float* sh0) {
    LAS float* cA1 = (LAS float*)F.lds; LAS float* cA2 = cA1 + D; LAS float* cB2 = cA2 + D;
    for (int chunk = blockIdx.x; chunk < M / 32; chunk += F.G) {
        int tid = F.tid; asm volatile("" : "+v"(tid));
        const int b = (chunk * 32) / SEQ;
        __syncthreads();
#pragma unroll
        for (int i = 0; i < 2; ++i) { const int c = 4 * tid + 2048 * i;
            if constexpr (HAS_Y) { const f32x4 g = *(const f32x4*)(gpost + c), t = *(const f32x4*)(gate0 + (size_t)b * 6 * D + c); *(LAS f32x4*)(cA1 + c) = g * t; }
            if constexpr (HAS_H) { const f32x4 g = *(const f32x4*)(gpre + c), s = *(const f32x4*)(sc0 + (size_t)b * 6 * D + c), h = *(const f32x4*)(sh0 + (size_t)b * 6 * D + c);
                *(LAS f32x4*)(cA2 + c) = g * (s + 1.0f); *(LAS f32x4*)(cB2 + c) = h; } }
        __syncthreads();
        const int LN = tid & 63;
#pragma unroll 1
        for (int i = 0; i < 4; ++i) {
            const size_t m = (size_t)chunk * 32 + F.wave * 4 + i;
            v4u yv[8]; f32x4 xv[16];
#pragma unroll
            for (int j = 0; j < 8; ++j) { const int c = 8 * LN + 512 * j;
                if constexpr (HAS_Y) yv[j] = *(const GAS v4u*)(Yb + m * D + c);
                xv[2 * j] = *(const f32x4*)(xin + m * D + c); xv[2 * j + 1] = *(const f32x4*)(xin + m * D + c + 4); }
            float ssq2 = 0.f;
            if constexpr (HAS_Y) {
                float ssq = 0.f;
#pragma unroll
                for (int j = 0; j < 8; ++j) { const unsigned w[4] = {yv[j].x, yv[j].y, yv[j].z, yv[j].w};
#pragma unroll
                    for (int q = 0; q < 4; ++q) { const float a = bflo(w[q]), c2 = bfhi(w[q]); ssq += a * a + c2 * c2; } }
                ssq = wave_sum(ssq); const float r = 1.0f / sqrtf(ssq * (1.0f / D) + EPS);
#pragma unroll
                for (int j = 0; j < 8; ++j) { const int c = 8 * LN + 512 * j; const unsigned w[4] = {yv[j].x, yv[j].y, yv[j].z, yv[j].w};
                    const f32x4 a0 = *(const LAS f32x4*)(cA1 + c), a1 = *(const LAS f32x4*)(cA1 + c + 4);
                    f32x4 y0 = {bflo(w[0]), bfhi(w[0]), bflo(w[1]), bfhi(w[1])}, y1 = {bflo(w[2]), bfhi(w[2]), bflo(w[3]), bfhi(w[3])};
                    xv[2 * j] = xv[2 * j] + a0 * (y0 * r); xv[2 * j + 1] = xv[2 * j + 1] + a1 * (y1 * r);
                    *(f32x4*)(xout + m * D + c) = xv[2 * j]; *(f32x4*)(xout + m * D + c + 4) = xv[2 * j + 1]; } }
            if constexpr (HAS_H) {
#pragma unroll
                for (int j = 0; j < 16; ++j) ssq2 += (xv[j][0] * xv[j][0] + xv[j][1] * xv[j][1]) + (xv[j][2] * xv[j][2] + xv[j][3] * xv[j][3]);
                ssq2 = wave_sum(ssq2); const float r2 = 1.0f / sqrtf(ssq2 * (1.0f / D) + EPS);
#pragma unroll
                for (int j = 0; j < 8; ++j) { const int c = 8 * LN + 512 * j;
                    const f32x4 a0 = *(const LAS f32x4*)(cA2 + c), a1 = *(const LAS f32x4*)(cA2 + c + 4), b0 = *(const LAS f32x4*)(cB2 + c), b1 = *(const LAS f32x4*)(cB2 + c + 4);
                    const f32x4 h0 = (xv[2 * j] * r2) * a0 + b0, h1 = (xv[2 * j + 1] * r2) * a1 + b1;
                    v4u w; w.x = pk2(h0[0], h0[1]); w.y = pk2(h0[2], h0[3]); w.z = pk2(h1[0], h1[1]); w.w = pk2(h1[2], h1[3]);
                    *(GAS v4u*)(Hout + m * D + c) = w; } }
        }
    }
    __syncthreads();
}

#ifndef PG8_SP2
#define PG8_SP2 true
#endif
#ifndef PG8_ALIGN
#define PG8_ALIGN false
#endif
#ifndef PH_MASK
#define PH_MASK 0xFFFFFFFFu
#endif
#define PH(k) ((PH_MASK >> (k)) & 1u)
struct Args { const float* in[19]; float* out; unsigned char* ws; };
enum { I_X = 0, I_C, I_POS, I_WADA, I_BADA, I_GPREMIX, I_GPOSTMIX, I_GPREMLP, I_GPOSTMLP, I_WIN, I_GQ, I_WUQ, I_GKV, I_WUKV, I_WOSB, I_WOMLA, I_WOUT, I_WUP, I_WDOWN };

typedef __attribute__((address_space(4))) const unsigned char* kargp_t;
__device__ __forceinline__ unsigned char* lw_(unsigned char* p) { asm volatile("" : "+s"(p)); return p; }
__device__ __forceinline__ kargp_t lwk_() { kargp_t p = (kargp_t)__builtin_amdgcn_kernarg_segment_ptr(); asm volatile("" : "+s"(p)); return p; }
#define KIN(k) (*(const float* const __attribute__((address_space(4)))*)(lwk_() + 8 * (k)))
__global__ void __launch_bounds__(NWAVES * 64, 2) hybrid_fwd(Args args) {
    extern __shared__ __attribute__((aligned(16))) unsigned char lds_raw[];
    Frame F;
    F.lds = (LAS unsigned char*)lds_raw;
    F.tid = threadIdx.x; F.lane = F.tid & 63; F.wave = __builtin_amdgcn_readfirstlane(F.tid >> 6);
    F.G = gridDim.x; F.gw = blockIdx.x * NWAVES + F.wave; F.NGW = F.G * NWAVES;
    unsigned char* ws = args.ws;
    gu32* ctl = (gu32*)(ws + WS_CTL);
    for (int u = F.tid; u < (LDS_BYTES - LDSCTL_OFF) / 4; u += NWAVES * 64) ((LAS unsigned*)(F.lds + LDSCTL_OFF))[u] = 0u;
    __syncthreads();
    XcdBarrier bar = xcd_barrier_post((unsigned*)(ctl + CW_BAR), (volatile LAS unsigned*)(F.lds + MISC_OFF) + 8);
#define GRID_BAR() xcd_barrier(bar)

#define ada ((float*)(lw_(ws) + WS_ADA))
#define tab ((float*)(lw_(ws) + WS_TAB))
#define adap ((float*)(lw_(ws) + WS_ADAP))
#define Hb ((bf16*)(lw_(ws) + A_H))
#define PROJ ((bf16*)(lw_(ws) + A_PROJ))
#define CQ ((bf16*)(lw_(ws) + A_CQ))
#define CKV ((bf16*)(lw_(ws) + A_CKV))
#define KR ((bf16*)(lw_(ws) + A_KR))
#define QF ((bf16*)(lw_(ws) + A_Q))
#define KVF ((bf16*)(lw_(ws) + A_KV))
#define OSB ((bf16*)(lw_(ws) + A_OSB))
#define MRG ((bf16*)(lw_(ws) + A_MRG))
#define Yb ((bf16*)(lw_(ws) + A_Y))
#define U ((bf16*)(lw_(ws) + A_U))
#define x_in KIN(I_X)
#define wl (lw_(ws) + WS_W + (size_t)l * W_LAYER)
#define adl (ada + (size_t)l * BATCH * 6 * D)
    float* xo = args.out;


    if (PH(0)) {
        LAS float* cact = (LAS float*)F.lds;
        for (int i = F.tid; i < BATCH * D; i += NWAVES * 64) { const float cv = KIN(I_C)[i]; cact[i] = cv / (1.0f + __expf(-cv)); }
        __syncthreads();
        for (int task = blockIdx.x; task < DEPTH * 32 * 12; task += F.G) {
            const int l = task / (32 * 12), s = (task / 12) % 32, cb = task % 12;
            const int col = cb * 2048 + F.tid * 4;
            const float* wp = KIN(I_WADA) + ((size_t)l * D + s * 128) * (6 * D) + col;
            f32x4 a0 = {0.f, 0.f, 0.f, 0.f}, a1 = {0.f, 0.f, 0.f, 0.f};
#pragma unroll 8
            for (int k = 0; k < 128; ++k) { const f32x4 w = *(const f32x4*)(wp + (size_t)k * (6 * D)); const float c0 = cact[s * 128 + k], c1 = cact[D + s * 128 + k];
                a0 += w * c0; a1 += w * c1; }
            *(f32x4*)(adap + (((size_t)s * DEPTH + l) * BATCH + 0) * (6 * D) + col) = a0;
            *(f32x4*)(adap + (((size_t)s * DEPTH + l) * BATCH + 1) * (6 * D) + col) = a1;
        }
        __syncthreads();
        for (int e = blockIdx.x * (NWAVES * 64) + F.tid; e < M * 32; e += F.G * NWAVES * 64) {
            const int m = e >> 5, i = e & 31;
            const float inv = powf(10000.0f, -(float)i / 32.0f);
            const float ang = (float)(((const int*)KIN(I_POS))[m]) * inv;
            const double rev = (double)ang * 0.15915494309189533577; const float fr = (float)(rev - rint(rev));
            tab[2 * e] = __builtin_amdgcn_cosf(fr); tab[2 * e + 1] = __builtin_amdgcn_sinf(fr);
        }
        for (int l = 0; l < DEPTH; ++l) { v4u* z = (v4u*)(ws + WS_W + l * W_LAYER + W_IN + (size_t)C_GATE_SRC * D * 2);
            for (int i = blockIdx.x * (NWAVES * 64) + F.tid; i < 192 * D * 2 / 16; i += F.G * NWAVES * 64) z[i] = (v4u){0u, 0u, 0u, 0u}; }
        LAS float* scr = (LAS float*)(F.lds) + F.wave * (64 * 65);
        constexpr int NB_IN = IN_W / 64, I_IN = (D / 64) * NB_IN, I_UQ = (QRANK / 64) * (QW / 64), I_UKV = (KVRANK / 64) * (KVW / 64), I_OSB = (SBW / 64) * (D / 64), I_OMLA = I_OSB,
                      I_OUT = (D / 64) * (D / 64), I_UP = (D / 64) * (DFF / 64), I_DOWN = (DFF / 64) * (D / 64), I_LAYER = I_IN + I_UQ + I_UKV + I_OSB + I_OMLA + I_OUT + I_UP + I_DOWN;
        for (int it = F.gw; it < DEPTH * I_LAYER; it += F.NGW) {
            const int l = it / I_LAYER; int r = it % I_LAYER;
            if (r < I_IN) { const int kb = r / NB_IN, nb = r % NB_IN, n0 = nb * 64; transpose_item(KIN(I_WIN) + (size_t)l * D * IN_W, IN_W, (bf16*)(wl + W_IN), D, kb, nb, n0 < C_GATE_SRC ? n0 : n0 + (C_GSB - C_GATE_SRC), false, scr, F.lane); continue; } r -= I_IN;
            if (r < I_UQ) { const int kb = r / (QW / 64), nb = r % (QW / 64); transpose_item(KIN(I_WUQ) + (size_t)l * QRANK * QW, QW, (bf16*)(wl + W_UQ), QRANK, kb, nb, nb * 64, (nb % 3) == 2, scr, F.lane); continue; } r -= I_UQ;
            if (r < I_UKV) { const int kb = r / (KVW / 64), nb = r % (KVW / 64); transpose_item(KIN(I_WUKV) + (size_t)l * KVRANK * KVW, KVW, (bf16*)(wl + W_UKV), KVRANK, kb, nb, nb * 64, false, scr, F.lane); continue; } r -= I_UKV;
            if (r < I_OSB) { const int kb = r / (D / 64), nb = r % (D / 64); transpose_item(KIN(I_WOSB) + (size_t)l * SBW * D, D, (bf16*)(wl + W_OSB), 2 * SBW, kb, nb, nb * 64, false, scr, F.lane); continue; } r -= I_OSB;
            if (r < I_OMLA) { const int kb = r / (D / 64), nb = r % (D / 64); transpose_item(KIN(I_WOMLA) + (size_t)l * SBW * D, D, (bf16*)(wl + W_OSB) + SBW, 2 * SBW, kb, nb, nb * 64, false, scr, F.lane); continue; } r -= I_OMLA;
            if (r < I_OUT) { const int kb = r / (D / 64), nb = r % (D / 64); transpose_item(KIN(I_WOUT) + (size_t)l * D * D, D, (bf16*)(wl + W_OUT), D, kb, nb, nb * 64, false, scr, F.lane); continue; } r -= I_OUT;
            if (r < I_UP) { const int kb = r / (DFF / 64), nb = r % (DFF / 64); transpose_item(KIN(I_WUP) + (size_t)l * D * DFF, DFF, (bf16*)(wl + W_UP), D, kb, nb, nb * 64, false, scr, F.lane); continue; } r -= I_UP;
            { const int kb = r / (D / 64), nb = r % (D / 64); transpose_item(KIN(I_WDOWN) + (size_t)l * DFF * D, D, (bf16*)(wl + W_DOWN), DFF, kb, nb, nb * 64, false, scr, F.lane); }
        }
    }
    GRID_BAR();
    if (PH(1)) for (int e = blockIdx.x * (NWAVES * 64) + F.tid; e < DEPTH * BATCH * 6 * D; e += F.G * NWAVES * 64) {
        const int l = e / (BATCH * 6 * D), n = e % (6 * D);
        float s = KIN(I_BADA)[(size_t)l * 6 * D + n];
#pragma unroll 8
        for (int k = 0; k < 32; ++k) s += adap[(size_t)k * (DEPTH * BATCH * 6 * D) + e];
        ada[e] = s;
    }
    GRID_BAR();
    if (PH(2)) thin_phase<false, true>(F, x_in, nullptr, nullptr, Hb, nullptr, nullptr, KIN(I_GPREMIX), ada + D, ada);
    GRID_BAR();

    for (int l = 0; l < DEPTH; ++l) {
        if (PH(3)) { pg8::Gemm g{Hb, (const bf16*)(wl + W_IN), M, PROJ_W, D}; pg8::StaticOrder S; S.init(M, PROJ_W, F.G, (int)blockIdx.x);
          pg8::EpiBf16<0> E{PROJ, PROJ_W};
          pg8::gemm_phase<pg8::EpiBf16<0>, pg8::StaticOrder, PG8_ALIGN, PG8_SP2>(F.lds, g, S, E); }
        GRID_BAR();
        if (PH(4)) for (int m = F.gw; m < M; m += F.NGW) {
            int LN = F.lane; asm volatile("" : "+v"(LN));
            const bf16* pr = PROJ + (size_t)m * PROJ_W;
            { const v4u a = *(const GAS v4u*)(pr + C_QD + 16 * LN), b2 = *(const GAS v4u*)(pr + C_QD + 16 * LN + 8);
              float f[16] = {bflo(a.x), bfhi(a.x), bflo(a.y), bfhi(a.y), bflo(a.z), bfhi(a.z), bflo(a.w), bfhi(a.w), bflo(b2.x), bfhi(b2.x), bflo(b2.y), bfhi(b2.y), bflo(b2.z), bfhi(b2.z), bflo(b2.w), bfhi(b2.w)};
              float ssq = 0.f;
#pragma unroll
              for (int e = 0; e < 16; ++e) ssq += f[e] * f[e];
              ssq = wave_sum(ssq); const float r = 1.0f / sqrtf(ssq * (1.0f / QRANK) + EPS);
              const float* gq = KIN(I_GQ) + (size_t)l * QRANK + 16 * LN;
              v4u o0, o1;
              o0.x = pk2(f[0] * r * gq[0], f[1] * r * gq[1]); o0.y = pk2(f[2] * r * gq[2], f[3] * r * gq[3]); o0.z = pk2(f[4] * r * gq[4], f[5] * r * gq[5]); o0.w = pk2(f[6] * r * gq[6], f[7] * r * gq[7]);
              o1.x = pk2(f[8] * r * gq[8], f[9] * r * gq[9]); o1.y = pk2(f[10] * r * gq[10], f[11] * r * gq[11]); o1.z = pk2(f[12] * r * gq[12], f[13] * r * gq[13]); o1.w = pk2(f[14] * r * gq[14], f[15] * r * gq[15]);
              *(GAS v4u*)(CQ + (size_t)m * QRANK + 16 * LN) = o0; *(GAS v4u*)(CQ + (size_t)m * QRANK + 16 * LN + 8) = o1; }
            { const v4u a = *(const GAS v4u*)(pr + C_KVD + 8 * LN);
              float f[8] = {bflo(a.x), bfhi(a.x), bflo(a.y), bfhi(a.y), bflo(a.z), bfhi(a.z), bflo(a.w), bfhi(a.w)};
              float ssq = 0.f;
#pragma unroll
              for (int e = 0; e < 8; ++e) ssq += f[e] * f[e];
              ssq = wave_sum(ssq); const float r = 1.0f / sqrtf(ssq * (1.0f / KVRANK) + EPS);
              const float* gk = KIN(I_GKV) + (size_t)l * KVRANK + 8 * LN;
              v4u o0; o0.x = pk2(f[0] * r * gk[0], f[1] * r * gk[1]); o0.y = pk2(f[2] * r * gk[2], f[3] * r * gk[3]); o0.z = pk2(f[4] * r * gk[4], f[5] * r * gk[5]); o0.w = pk2(f[6] * r * gk[6], f[7] * r * gk[7]);
              *(GAS v4u*)(CKV + (size_t)m * KVRANK + 8 * LN) = o0; }
            if (LN < 32) { const int i = LN; const bf16* kp = pr + C_KVD + KVRANK;
              const float x1 = bflo((unsigned)kp[i]), x2 = bflo((unsigned)kp[32 + i]); const float cs = tab[((size_t)m * 32 + i) * 2], sn = tab[((size_t)m * 32 + i) * 2 + 1];
              *(GAS unsigned*)(KR + (size_t)m * ROPE + 2 * i) = pk2(x1 * cs - x2 * sn, x2 * cs + x1 * sn); }
        }
        GRID_BAR();
        if (PH(5)) { pg8::Gemm g{CQ, (const bf16*)(wl + W_UQ), M, QW, QRANK}; pg8::StaticOrder S; S.init(M, QW, F.G, (int)blockIdx.x);
          pg8::EpiRope E{QF, QW, tab};
          pg8::gemm_phase<pg8::EpiRope, pg8::StaticOrder, PG8_ALIGN, PG8_SP2>(F.lds, g, S, E); }
        if (PH(5)) { pg8::Gemm g{CKV, (const bf16*)(wl + W_UKV), M, KVW, KVRANK}; pg8::EpiBf16<0> E{KVF, KVW};
          if (F.G == 256) { pg8::UnevenOrder S; S.init(M, KVW, F.G, (int)blockIdx.x);
            pg8::gemm_phase<pg8::EpiBf16<0>, pg8::UnevenOrder, PG8_ALIGN, PG8_SP2>(F.lds, g, S, E); }
          else { pg8::StaticOrder S; S.init(M, KVW, F.G, (int)blockIdx.x);
            pg8::gemm_phase<pg8::EpiBf16<0>, pg8::StaticOrder, PG8_ALIGN, PG8_SP2>(F.lds, g, S, E); } }
        GRID_BAR();
        if (PH(6)) for (int item = blockIdx.x; item < 512; item += F.G) {
            const int kind = item >> 8, c = item & 255, bh = (c & 7) * 4 + ((c >> 3) >> 3), y = (c >> 3) & 7, b = bh >> 4, h = bh & 15;
            const size_t rb = (size_t)b * SEQ;
            if (kind == 0) { if (PH(14)) {
                att::Tensors T{PROJ + rb * PROJ_W + h * 128, PROJ_W, PROJ + rb * PROJ_W + SBW + h * 128, PROJ_W, PROJ + rb * PROJ_W + 2 * SBW + h * 128, PROJ_W, nullptr, OSB + rb * (2 * SBW) + h * 128, 2 * SBW};
                att::attn_unit<0>(T, 15 - y, 0.08838834764831845f * 1.4426950408889634f, (LAS char*)F.lds);
                att::attn_unit<0>(T, y, 0.08838834764831845f * 1.4426950408889634f, (LAS char*)F.lds); }
            } else if (PH(15)) {
                att::Tensors T{QF + rb * QW + h * 192, QW, KVF + rb * KVW + h * 256, KVW, KVF + rb * KVW + h * 256 + 128, KVW, KR + rb * ROPE, OSB + rb * (2 * SBW) + SBW + h * 128, 2 * SBW};
                att::attn_unit<1>(T, 15 - y, 0.07216878364870323f * 1.4426950408889634f, (LAS char*)F.lds);
                att::attn_unit<1>(T, y, 0.07216878364870323f * 1.4426950408889634f, (LAS char*)F.lds);
            }
        }
        GRID_BAR();
        if (PH(7)) { pg8::Gemm g{OSB, (const bf16*)(wl + W_OSB), M, D, 2 * SBW}; pg8::StaticOrder S; S.init(M, D, F.G, (int)blockIdx.x);
          pg8::EpiGateMerge E{MRG, D, PROJ + C_GSB, PROJ + C_GMLA, PROJ_W};
          pg8::gemm_phase<pg8::EpiGateMerge, pg8::StaticOrder, PG8_ALIGN, PG8_SP2>(F.lds, g, S, E); }
        GRID_BAR();
        if (PH(9)) { pg8::Gemm g{MRG, (const bf16*)(wl + W_OUT), M, D, D}; pg8::StaticOrder S; S.init(M, D, F.G, (int)blockIdx.x);
          pg8::EpiBf16<0> E{Yb, D};
          pg8::gemm_phase<pg8::EpiBf16<0>, pg8::StaticOrder, PG8_ALIGN, PG8_SP2>(F.lds, g, S, E); }
        GRID_BAR();
        if (PH(10)) thin_phase<true, true>(F, l == 0 ? x_in : (const float*)xo, xo, Yb, Hb, KIN(I_GPOSTMIX) + (size_t)l * D, adl + 2 * D, KIN(I_GPREMLP) + (size_t)l * D, adl + 4 * D, adl + 3 * D);
        GRID_BAR();
        if (PH(11)) { pg8::Gemm g{Hb, (const bf16*)(wl + W_UP), M, DFF, D}; pg8::StaticOrder S; S.init(M, DFF, F.G, (int)blockIdx.x);
          pg8::EpiBf16<1> E{U, DFF};
          pg8::gemm_phase<pg8::EpiBf16<1>, pg8::StaticOrder, PG8_ALIGN, PG8_SP2>(F.lds, g, S, E); }
        GRID_BAR();
        if (PH(12)) { pg8::Gemm g{U, (const bf16*)(wl + W_DOWN), M, D, DFF}; pg8::StaticOrder S; S.init(M, D, F.G, (int)blockIdx.x);
          pg8::EpiBf16<0> E{Yb, D};
          pg8::gemm_phase<pg8::EpiBf16<0>, pg8::StaticOrder, PG8_ALIGN, PG8_SP2>(F.lds, g, S, E); }
        GRID_BAR();
        if (PH(13)) { if (l + 1 < DEPTH) { const float* adn = ada + (size_t)(l + 1) * BATCH * 6 * D;
                thin_phase<true, true>(F, xo, xo, Yb, Hb, KIN(I_GPOSTMLP) + (size_t)l * D, adl + 5 * D, KIN(I_GPREMIX) + (size_t)(l + 1) * D, adn + D, adn); }
            else thin_phase<true, false>(F, xo, xo, Yb, nullptr, KIN(I_GPOSTMLP) + (size_t)l * D, adl + 5 * D, nullptr, nullptr, nullptr); }
        if (l + 1 < DEPTH) GRID_BAR();
    }
    if (blockIdx.x == 0 && F.tid == 0 && __hip_atomic_load((unsigned*)(ctl + CW_BAR) + XB_TMO, RLX_AGENT) != 0u) xo[0] = __builtin_nanf("");
}
#undef ada
#undef tab
#undef adap
#undef Hb
#undef PROJ
#undef CQ
#undef CKV
#undef KR
#undef QF
#undef KVF
#undef OSB
#undef MRG
#undef Yb
#undef U
#undef x_in
#undef wl
#undef adl


extern "C" void kernel_launch(void* const* d_in, const int* in_sizes, int n_in, void* d_out, int out_size, void* d_ws, size_t ws_size, hipStream_t stream) {
    static int grid = 0;
    if (grid == 0) {
        if (n_in != 19 || out_size != M * D || ws_size < WS_END) { fprintf(stderr, "kernel_launch: unexpected shapes (n_in %d, out %d, ws %zu < %zu)\n", n_in, out_size, ws_size, (size_t)WS_END); grid = -1; return; }
        int dev = 0, cus = 0, per_cu = 0;
        if (hipGetDevice(&dev) != hipSuccess || hipDeviceGetAttribute(&cus, hipDeviceAttributeMultiprocessorCount, dev) != hipSuccess) { grid = -1; return; }
        if (hipFuncSetAttribute((const void*)hybrid_fwd, hipFuncAttributeMaxDynamicSharedMemorySize, LDS_BYTES) != hipSuccess) { fprintf(stderr, "kernel_launch: hipFuncSetAttribute failed\n"); grid = -1; return; }
        if (hipOccupancyMaxActiveBlocksPerMultiprocessor(&per_cu, (const void*)hybrid_fwd, NWAVES * 64, LDS_BYTES) != hipSuccess || per_cu < 1) { fprintf(stderr, "kernel_launch: occupancy query says %d\n", per_cu); (void)hipGetLastError(); }
        grid = cus;
    }
    if (grid < 0) return;
    if (hipMemsetAsync((char*)d_ws + WS_CTL, 0, CTL_ZERO_BYTES, stream) != hipSuccess) return;
    Args a{};
    for (int i = 0; i < 19; ++i) a.in[i] = (const float*)d_in[i];
    a.out = (float*)d_out; a.ws = (unsigned char*)d_ws;
    hipLaunchKernelGGL(hybrid_fwd, dim3(grid), dim3(NWAVES * 64), LDS_BYTES, stream, a);
#ifdef DBG_CHECK
    hipLaunchKernelGGL(dbg_check, dim3(DBG_NCHK), dim3(256), 0, stream, a, (unsigned*)((char*)d_ws + 4096));
    hipLaunchKernelGGL(dbg_report, dim3(1), dim3(64), 0, stream, (float*)d_out, (const unsigned*)((char*)d_ws + 4096));
#endif
}
```

```cpp
#include <hip/hip_runtime.h>
#include <cstdio>
#include <cstdint>
#include <cmath>
#ifndef PG8_WGM
#define PG8_WGM 8
#endif
namespace pg8 {
#define PG8_LAS __attribute__((address_space(3)))
typedef unsigned short bf16_t;
typedef short bf16x8 __attribute__((ext_vector_type(8)));
typedef float f32x4 __attribute__((ext_vector_type(4)));
typedef unsigned u32x4 __attribute__((ext_vector_type(4)));
constexpr int BM = 256, BK = 64, HALF = 128, HTB = HALF * BK * 2  , STAGE_BYTES = 8 * HTB, NXCD = 8, WGM = PG8_WGM;

__host__ __device__ __forceinline__ int lds_byte(int r, int c) { const int st = (r >> 4) * 2 + (c >> 5), rr = r & 15, cc = c & 31, ob = rr * 64 + cc * 2; return st * 1024 + (ob ^ (((ob >> 9) & 1) << 5)); }
__host__ __device__ __forceinline__ void stage_rc(int b, int& R, int& C) { const int st = b / 1024, sb = b % 1024, swz = sb ^ (((sb >> 9) & 1) << 5); R = (st >> 1) * 16 + swz / 64; C = (st & 1) * 32 + (swz % 64) / 2; }
__host__ __device__ __forceinline__ int perm32(int rho) { const int n = rho >> 4, i = rho & 15; return 8 * (i >> 2) + 4 * n + (i & 3); }

struct Unit { int pm, pn; };
struct Gemm { const bf16_t* A; const bf16_t* Bt; int M, N, K; };

struct StaticOrder {
    int nM, nN, nwg, G, c;
    __host__ __device__ void init(int M, int N, int G_, int c_) { nM = M / BM; nN = N / BM; nwg = nM * nN; G = G_; c = c_; }
    __host__ __device__ bool next(int i, Unit& u) const {
        const long L = (long)i * G + c; if (L >= nwg) return false;
        int wgid = (int)L; { const int q = nwg / NXCD, r = nwg % NXCD, xcd = wgid % NXCD, off = wgid / NXCD; wgid = (xcd < r ? xcd * (q + 1) : r * (q + 1) + (xcd - r) * q) + off; }
        const int nig = WGM * nN, gid = wgid / nig, fm = gid * WGM, gsz = (nM - fm) < WGM ? (nM - fm) : WGM;
        u.pm = fm + ((wgid % nig) % gsz); u.pn = (wgid % nig) / gsz; return true;
    }
    __device__ __forceinline__ void a_ready(const Unit&) const {}
    __device__ __forceinline__ void done(const Unit&) const {}
};

struct UnevenOrder : StaticOrder {
    __host__ __device__ bool next(int i, Unit& u) const {
        long L; const int h = G / 2;
        if (c < h) { if (i > 0) return false; L = c; } else { if (i > 2) return false; L = h + (long)h * i + (c - h); }
        if (L >= nwg) return false;
        int wgid = (int)L; { const int q = nwg / NXCD, r = nwg % NXCD, xcd = wgid % NXCD, off = wgid / NXCD; wgid = (xcd < r ? xcd * (q + 1) : r * (q + 1) + (xcd - r) * q) + off; }
        const int nig = WGM * nN, gid = wgid / nig, fm = gid * WGM, gsz = (nM - fm) < WGM ? (nM - fm) : WGM;
        u.pm = fm + ((wgid % nig) % gsz); u.pn = (wgid % nig) / gsz; return true;
    }
};

__device__ __forceinline__ unsigned cvt_pk_bf16(float lo, float hi) { unsigned r; asm volatile("v_cvt_pk_bf16_f32 %0, %1, %2" : "=v"(r) : "v"(lo), "v"(hi)); return r; }
typedef float f32x2 __attribute__((ext_vector_type(2)));

__device__ __forceinline__ float bf_lo(unsigned w) { return __builtin_bit_cast(float, w << 16); }
__device__ __forceinline__ float bf_hi(unsigned w) { return __builtin_bit_cast(float, w & 0xffff0000u); }
__device__ __forceinline__ float sigmoidf_fast(float x) { return __builtin_amdgcn_rcpf(1.0f + __builtin_amdgcn_exp2f(-1.4426950408889634f * x)); }

template <int ACT  > struct EpiBf16 {
    static constexpr bool PERM = true, AFTER_DRAIN = false, MID = false;
    bf16_t* O; int ldc;
    __device__ __forceinline__ void operator()(const f32x4 (&acc)[2][2][4][2], const Unit& u, int wr, int wc, int fr, int fq) const {
        const int row0 = u.pm * BM + wr * 64 + fr, col0 = u.pn * BM + wc * 32 + 8 * fq;
#pragma unroll
        for (int ai = 0; ai < 2; ++ai)
#pragma unroll
            for (int m = 0; m < 4; ++m) { bf16_t* rowp = O + (size_t)(row0 + ai * HALF + m * 16) * ldc + col0;
#pragma unroll
                for (int bj = 0; bj < 2; ++bj) { f32x4 v0 = acc[ai][bj][m][0], v1 = acc[ai][bj][m][1];
                    if (ACT == 1) {
#pragma unroll
                        for (int j = 0; j < 4; ++j) { const float a = fmaxf(v0[j], 0.f), b = fmaxf(v1[j], 0.f); v0[j] = a * a; v1[j] = b * b; } }
                    u32x4 w; w.x = cvt_pk_bf16(v0[0], v0[1]); w.y = cvt_pk_bf16(v0[2], v0[3]); w.z = cvt_pk_bf16(v1[0], v1[1]); w.w = cvt_pk_bf16(v1[2], v1[3]);
                    *(u32x4*)(rowp + bj * HALF) = w;
                    } }
    }
};
struct EpiRope {
    static constexpr bool PERM = true, AFTER_DRAIN = false, MID = false;
    bf16_t* O; int ldc; const float* tab;
    __device__ __forceinline__ void operator()(const f32x4 (&acc)[2][2][4][2], const Unit& u, int wr, int wc, int fr, int fq) const {
        const int row0 = u.pm * BM + wr * 64 + fr, col0 = u.pn * BM + wc * 32 + 8 * fq;
#pragma unroll
        for (int ai = 0; ai < 2; ++ai)
#pragma unroll
            for (int m = 0; m < 4; ++m) { const int row = row0 + ai * HALF + m * 16; bf16_t* rowp = O + (size_t)row * ldc + col0;
#pragma unroll
                for (int bj = 0; bj < 2; ++bj) { f32x4 v0 = acc[ai][bj][m][0], v1 = acc[ai][bj][m][1];
                    const int j = (col0 + bj * HALF) % 192;
                    if (j >= 128) { const float* tp = tab + (size_t)row * 64 + (j - 128);
                        const f32x4 t0 = *(const f32x4*)tp, t1 = *(const f32x4*)(tp + 4);
                        f32x4 r0, r1;
                        r0[0] = v0[0] * t0[0] - v0[1] * t0[1]; r0[1] = v0[1] * t0[0] + v0[0] * t0[1];
                        r0[2] = v0[2] * t0[2] - v0[3] * t0[3]; r0[3] = v0[3] * t0[2] + v0[2] * t0[3];
                        r1[0] = v1[0] * t1[0] - v1[1] * t1[1]; r1[1] = v1[1] * t1[0] + v1[0] * t1[1];
                        r1[2] = v1[2] * t1[2] - v1[3] * t1[3]; r1[3] = v1[3] * t1[2] + v1[2] * t1[3];
                        v0 = r0; v1 = r1; }
                    u32x4 w; w.x = cvt_pk_bf16(v0[0], v0[1]); w.y = cvt_pk_bf16(v0[2], v0[3]); w.z = cvt_pk_bf16(v1[0], v1[1]); w.w = cvt_pk_bf16(v1[2], v1[3]);
                    *(u32x4*)(rowp + bj * HALF) = w; }
                asm volatile("" ::: "memory"); }
    }
};
struct EpiGateMerge {
    static constexpr bool PERM = true, AFTER_DRAIN = false, MID = true;
    bf16_t* O; int ldo; const bf16_t* G1; const bf16_t* G2; int ldg;
    __device__ __forceinline__ void mid(f32x4 (&acc)[2][2][4][2], const Unit& u, int wr, int wc, int fr, int fq) const {
        int fr_ = fr, fq_ = fq; asm volatile("" : "+v"(fr_), "+v"(fq_));
        const int row0 = u.pm * BM + wr * 64 + fr_, col0 = u.pn * BM + wc * 32 + 8 * fq_;
#pragma unroll
        for (int ai = 0; ai < 2; ++ai)
#pragma unroll
            for (int m = 0; m < 4; ++m) { const int row = row0 + ai * HALF + m * 16; const bf16_t* g1p = G1 + (size_t)row * ldg + col0; const bf16_t* g2p = G2 + (size_t)row * ldg + col0;
#pragma unroll
                for (int bj = 0; bj < 2; ++bj) { const u32x4 a = *(const u32x4*)(g1p + bj * HALF), b = *(const u32x4*)(g2p + bj * HALF);
                    const unsigned aw[4] = {a.x, a.y, a.z, a.w}, bw[4] = {b.x, b.y, b.z, b.w};
#pragma unroll
                    for (int q = 0; q < 4; ++q) {
                        const float r0 = (1.0f + __builtin_amdgcn_exp2f(-1.4426950408889634f * bf_lo(bw[q]))) * __builtin_amdgcn_rcpf(1.0f + __builtin_amdgcn_exp2f(-1.4426950408889634f * bf_lo(aw[q])));
                        const float r1 = (1.0f + __builtin_amdgcn_exp2f(-1.4426950408889634f * bf_hi(bw[q]))) * __builtin_amdgcn_rcpf(1.0f + __builtin_amdgcn_exp2f(-1.4426950408889634f * bf_hi(aw[q])));
                        acc[ai][bj][m][q >> 1][2 * (q & 1)] *= r0; acc[ai][bj][m][q >> 1][2 * (q & 1) + 1] *= r1; } }
                asm volatile("" ::: "memory"); }
    }
    __device__ __forceinline__ void operator()(const f32x4 (&acc)[2][2][4][2], const Unit& u, int wr, int wc, int fr, int fq) const {
        const int row0 = u.pm * BM + wr * 64 + fr, col0 = u.pn * BM + wc * 32 + 8 * fq;
#pragma unroll
        for (int ai = 0; ai < 2; ++ai)
#pragma unroll
            for (int m = 0; m < 4; ++m) { const int row = row0 + ai * HALF + m * 16; const bf16_t* gp = G2 + (size_t)row * ldg + col0; bf16_t* op = O + (size_t)row * ldo + col0;
#pragma unroll
                for (int bj = 0; bj < 2; ++bj) { const f32x4 v0 = acc[ai][bj][m][0], v1 = acc[ai][bj][m][1];
                    const u32x4 g = *(const u32x4*)(gp + bj * HALF);
                    u32x4 w; w.x = cvt_pk_bf16(v0[0] * sigmoidf_fast(bf_lo(g.x)), v0[1] * sigmoidf_fast(bf_hi(g.x))); w.y = cvt_pk_bf16(v0[2] * sigmoidf_fast(bf_lo(g.y)), v0[3] * sigmoidf_fast(bf_hi(g.y)));
                    w.z = cvt_pk_bf16(v1[0] * sigmoidf_fast(bf_lo(g.z)), v1[1] * sigmoidf_fast(bf_hi(g.z))); w.w = cvt_pk_bf16(v1[2] * sigmoidf_fast(bf_lo(g.w)), v1[3] * sigmoidf_fast(bf_hi(g.w)));
                    *(u32x4*)(op + bj * HALF) = w; }
                asm volatile("" ::: "memory"); }
    }
};

template <class Epi, class Sched, bool ALIGN_EPI = false, bool SP2 = false>
__device__ __forceinline__ void gemm_phase(PG8_LAS unsigned char* lds, const Gemm g, const Sched& S, const Epi& E) {
    int tid_ = threadIdx.x; asm volatile("" : "+v"(tid_));
    const int tid = tid_, wid = __builtin_amdgcn_readfirstlane(tid >> 6), lane = tid & 63, wr = wid >> 2, wc = wid & 3, fr = lane & 15, fq = lane >> 4;
    const int K = g.K, nt = K / BK;
    unsigned voffA[2], voffB[2];
#pragma unroll
    for (int i = 0; i < 2; ++i) { int R, C; stage_rc(tid * 16 + i * 8192, R, C); const int Rb = Epi::PERM ? ((R & ~31) + perm32(R & 31)) : R;
        voffA[i] = (unsigned)(R * K + C) * 2u; voffB[i] = (unsigned)(Rb * K + C) * 2u; }
    const size_t kstep = (size_t)(BK * 2);
    const size_t hstep = (size_t)HALF * K * 2;
    const size_t tstep = 2 * hstep;
    const unsigned ldsw = (unsigned)wid * 1024u;
    const int aoff = lds_byte(wr * 64 + fr, fq * 8), boff = lds_byte(wc * 32 + fr, fq * 8);
#define PG8_SA(b, h) (((b) * 2 + (h)) * HTB)
#define PG8_SB(b, h) ((4 + (b) * 2 + (h)) * HTB)
#define PG8_STAGE(bufoff, gbase, voff) do { _Pragma("unroll") for (int _i = 0; _i < 2; ++_i) \
        __builtin_amdgcn_global_load_lds((const unsigned*)((const char*)(gbase) + (voff)[_i]), (PG8_LAS unsigned*)(lds + (bufoff) + ldsw + _i * 8192), 16, 0, 0); } while (0)
#define PG8_LDA(dst, b, h) do { _Pragma("unroll") for (int m = 0; m < 4; ++m) _Pragma("unroll") for (int k = 0; k < 2; ++k) dst[m][k] = *(const PG8_LAS bf16x8*)(lds + PG8_SA(b, h) + aoff + m * 2048 + k * 1024); } while (0)
#define PG8_LDB(dst, b, h) do { _Pragma("unroll") for (int n = 0; n < 2; ++n) _Pragma("unroll") for (int k = 0; k < 2; ++k) dst[n][k] = *(const PG8_LAS bf16x8*)(lds + PG8_SB(b, h) + boff + n * 2048 + k * 1024); } while (0)
#ifndef PG8_PRIO
#define PG8_PRIO 1
#endif
#define PG8_MMA(ai, bj, At, Bt) do { if (PG8_PRIO) __builtin_amdgcn_s_setprio(PG8_PRIO); _Pragma("unroll") for (int m = 0; m < 4; ++m) _Pragma("unroll") for (int n = 0; n < 2; ++n) _Pragma("unroll") for (int k = 0; k < 2; ++k) \
        acc[ai][bj][m][n] = __builtin_amdgcn_mfma_f32_16x16x32_bf16(Bt[n][k], At[m][k], acc[ai][bj][m][n], 0, 0, 0); if (PG8_PRIO) __builtin_amdgcn_s_setprio(0); } while (0)
#define PG8_WAIT_V(n) asm volatile("s_waitcnt vmcnt(" #n ")" ::: "memory")
#define PG8_WAIT_L(n) asm volatile("s_waitcnt lgkmcnt(" #n ")" ::: "memory")
#define PG8_BAR __builtin_amdgcn_s_barrier()
#define PG8_SCHED __builtin_amdgcn_sched_barrier(0)
    Unit cur, nxt; int ui = 0;
    if (!S.next(0, cur)) return;
    f32x4 acc[2][2][4][2];
#pragma unroll
    for (int a = 0; a < 2; ++a)
#pragma unroll
        for (int b = 0; b < 2; ++b)
#pragma unroll
            for (int m = 0; m < 4; ++m)
#pragma unroll
                for (int n = 0; n < 2; ++n) acc[a][b][m][n] = (f32x4){0.f, 0.f, 0.f, 0.f};
    bf16x8 At[4][2], B0[2][2], B1[2][2];
    const char* cA = (const char*)g.A + (size_t)cur.pm * tstep; const char* cB = (const char*)g.Bt + (size_t)cur.pn * tstep;
    S.a_ready(cur);
    if constexpr (SP2) {
        PG8_STAGE(PG8_SB(0, 0), cB, voffB); PG8_STAGE(PG8_SB(0, 1), cB + hstep, voffB); PG8_STAGE(PG8_SA(0, 0), cA, voffA); PG8_STAGE(PG8_SA(0, 1), cA + hstep, voffA);
        if (wr == 1) PG8_BAR;
        PG8_WAIT_V(2); PG8_BAR;
        PG8_STAGE(PG8_SB(1, 0), cB + kstep, voffB); PG8_STAGE(PG8_SA(1, 0), cA + kstep, voffA); PG8_STAGE(PG8_SB(1, 1), cB + hstep + kstep, voffB);
        PG8_WAIT_V(6); PG8_BAR;
    } else {
        PG8_STAGE(PG8_SB(0, 0), cB, voffB); PG8_STAGE(PG8_SA(0, 0), cA, voffA); PG8_STAGE(PG8_SB(0, 1), cB + hstep, voffB); PG8_STAGE(PG8_SA(0, 1), cA + hstep, voffA);
        if (wr == 1) PG8_BAR;
        PG8_WAIT_V(4); PG8_BAR;
        PG8_STAGE(PG8_SB(1, 0), cB + kstep, voffB); PG8_STAGE(PG8_SA(1, 0), cA + kstep, voffA); PG8_STAGE(PG8_SB(1, 1), cB + hstep + kstep, voffB);
        PG8_WAIT_V(6); PG8_BAR;
    }
    for (;;) {
        const bool has_next = S.next(ui + 1, nxt);
        const char* nA = has_next ? (const char*)g.A + (size_t)nxt.pm * tstep : cA; const char* nB = has_next ? (const char*)g.Bt + (size_t)nxt.pn * tstep : cB;
        for (int t = 0; t < nt; t += 2) {
            const bool last = (t == nt - 2);
            const char* a1 = cA + (size_t)(t + 1) * kstep;
            const char* a2 = last ? nA : cA + (size_t)(t + 2) * kstep; const char* b2 = last ? nB : cB + (size_t)(t + 2) * kstep;
            const char* a3 = a2 + kstep; const char* b3 = b2 + kstep;
            if (last && has_next) S.a_ready(nxt);
            if constexpr (Epi::MID) { if (t == (nt >> 1)) E.mid(acc, cur, wr, wc, fr, fq); }
            if constexpr (SP2) {
            PG8_LDB(B0, 0, 0); PG8_LDB(B1, 0, 1); PG8_SCHED; PG8_LDA(At, 0, 0); PG8_STAGE(PG8_SA(1, 1), a1 + hstep, voffA);
            PG8_WAIT_V(8); PG8_WAIT_L(0); PG8_BAR; PG8_MMA(0, 0, At, B0); PG8_MMA(0, 1, At, B1); PG8_BAR; PG8_SCHED;
            PG8_LDA(At, 0, 1); PG8_STAGE(PG8_SB(0, 0), b2, voffB); PG8_STAGE(PG8_SB(0, 1), b2 + hstep, voffB); PG8_STAGE(PG8_SA(0, 0), a2, voffA);
            PG8_WAIT_V(8); PG8_WAIT_L(0); PG8_BAR; PG8_MMA(1, 0, At, B0); PG8_MMA(1, 1, At, B1); PG8_BAR; PG8_SCHED;
            PG8_LDB(B0, 1, 0); PG8_LDB(B1, 1, 1); PG8_SCHED; PG8_LDA(At, 1, 0); PG8_STAGE(PG8_SA(0, 1), a2 + hstep, voffA);
            PG8_WAIT_V(8); PG8_WAIT_L(0); PG8_BAR; PG8_MMA(0, 0, At, B0); PG8_MMA(0, 1, At, B1); PG8_BAR; PG8_SCHED;
            PG8_LDA(At, 1, 1); PG8_STAGE(PG8_SB(1, 0), b3, voffB); PG8_STAGE(PG8_SB(1, 1), b3 + hstep, voffB); PG8_STAGE(PG8_SA(1, 0), a3, voffA);
            PG8_WAIT_V(8); PG8_WAIT_L(0); PG8_BAR; PG8_MMA(1, 0, At, B0); PG8_MMA(1, 1, At, B1); PG8_BAR; PG8_SCHED;
            } else {
            PG8_LDB(B0, 0, 0); PG8_SCHED; PG8_LDA(At, 0, 0); PG8_STAGE(PG8_SA(1, 1), a1 + hstep, voffA);
            PG8_WAIT_L(8); PG8_BAR; PG8_WAIT_L(0); PG8_MMA(0, 0, At, B0); PG8_BAR; PG8_SCHED;
            PG8_LDB(B1, 0, 1); PG8_STAGE(PG8_SB(0, 0), b2, voffB);
            PG8_BAR; PG8_WAIT_L(0); PG8_MMA(0, 1, At, B1); PG8_BAR;
            PG8_LDA(At, 0, 1); PG8_STAGE(PG8_SA(0, 0), a2, voffA);
            PG8_BAR; PG8_WAIT_L(0); PG8_MMA(1, 0, At, B0); PG8_BAR; PG8_SCHED;
            PG8_STAGE(PG8_SB(0, 1), b2 + hstep, voffB);
            PG8_WAIT_V(6); PG8_BAR; PG8_MMA(1, 1, At, B1); PG8_BAR;
            PG8_LDB(B0, 1, 0); PG8_SCHED; PG8_LDA(At, 1, 0); PG8_STAGE(PG8_SA(0, 1), a2 + hstep, voffA);
            PG8_WAIT_L(8); PG8_BAR; PG8_WAIT_L(0); PG8_MMA(0, 0, At, B0); PG8_BAR; PG8_SCHED;
            PG8_LDB(B1, 1, 1); PG8_STAGE(PG8_SB(1, 0), b3, voffB);
            PG8_BAR; PG8_WAIT_L(0); PG8_MMA(0, 1, At, B1); PG8_BAR;
            PG8_LDA(At, 1, 1); PG8_STAGE(PG8_SA(1, 0), a3, voffA);
            PG8_BAR; PG8_WAIT_L(0); PG8_MMA(1, 0, At, B0); PG8_BAR; PG8_SCHED;
            PG8_STAGE(PG8_SB(1, 1), b3 + hstep, voffB);
            PG8_WAIT_V(6); PG8_BAR; PG8_MMA(1, 1, At, B1); PG8_BAR;
            }
        }
        if constexpr (ALIGN_EPI) { if (wr == 0) PG8_BAR; }
        if constexpr (!Epi::AFTER_DRAIN) { E(acc, cur, wr, wc, fr, fq); S.done(cur); }
        if (!has_next) break;
#pragma unroll
        for (int a = 0; a < 2; ++a)
#pragma unroll
            for (int b = 0; b < 2; ++b)
#pragma unroll
                for (int m = 0; m < 4; ++m)
#pragma unroll
                    for (int n = 0; n < 2; ++n) acc[a][b][m][n] = (f32x4){0.f, 0.f, 0.f, 0.f};
        cur = nxt; cA = nA; cB = nB; ++ui;
        if constexpr (ALIGN_EPI) { if (wr == 1) PG8_BAR; }
    }
    PG8_WAIT_V(0);
    if constexpr (!ALIGN_EPI) { if (wr == 0) PG8_BAR; }
    PG8_BAR;
    if constexpr (Epi::AFTER_DRAIN) { E.fused(acc, cur, wr, wc, fr, fq, lds, wid, lane); S.done(cur); }
#undef PG8_SA
#undef PG8_SB
#undef PG8_STAGE
#undef PG8_LDA
#undef PG8_LDB
#undef PG8_MMA
#undef PG8_WAIT_V
#undef PG8_WAIT_L
#undef PG8_BAR
#undef PG8_SCHED
}
}

namespace att {
#define ATT_LAS __attribute__((address_space(3)))
typedef unsigned short bf16_t;
typedef short bf16x8 __attribute__((ext_vector_type(8)));
typedef short s16x4 __attribute__((ext_vector_type(4)));
typedef float f32x16 __attribute__((ext_vector_type(16)));
typedef unsigned u32x4 __attribute__((ext_vector_type(4)));
constexpr int SHM_V = 16384, SHM_K = 16384, SHM_R = 8192, BUFB = SHM_V + SHM_K + SHM_R;
constexpr int LDS_SCR = 2 * BUFB;
constexpr int LDS_FLAGS = LDS_SCR + 8 * 256;
constexpr int LDS_QR = LDS_FLAGS + 64;
constexpr int ATT_LDS_BYTES = LDS_QR + 8 * 4096;
#define KSWZ(row, colB) ((row) * 256 + ((colB) ^ (((row) & 7) << 4)))
#define RSWZ(row, colB) ((row) * 128 + ((colB) ^ ((((row) >> 1) & 7) << 4)))
__device__ __forceinline__ int v_st(int k, int c) { const int kk = (k & ~0xC) | ((k & 4) << 1) | ((k & 8) >> 1); return ((kk >> 3) * 4 + (c >> 5)) * 512 + ((kk & 7) * 32 + (c & 31)) * 2; }
__device__ __forceinline__ int v_rd_base(int lane) { return ((lane & 3) << 3) | (((lane >> 2) & 3) << 6) | (((lane >> 4) & 1) << 5) | (((lane >> 5) & 1) << 8); }
constexpr int v_rd_off(int d0, int ks, int half) { return d0 * 512 + ks * 4096 + half * 2048; }
__device__ __forceinline__ int crow(int r, int hi) { return (r & 3) + 8 * (r >> 2) + 4 * hi; }
__device__ __forceinline__ unsigned cvtpk(float lo, float hi) { unsigned r; asm volatile("v_cvt_pk_bf16_f32 %0, %1, %2" : "=v"(r) : "v"(lo), "v"(hi)); return r; }
#define ATT_SBAR() __builtin_amdgcn_sched_barrier(0)
#ifndef ATT_PRIO
#define ATT_PRIO 0
#endif
#ifndef ATT_EARLYW
#define ATT_EARLYW 0
#endif

template <int ND>
__device__ __forceinline__ void qkt_half(f32x16& p, const ATT_LAS char* Kb, const ATT_LAS char* Rb, int r32, int hi, const bf16x8* qr, const ATT_LAS char* qrl, int lane, int half) {
    p = f32x16{};
    if (ATT_PRIO) __builtin_amdgcn_s_setprio(1);
#pragma unroll
    for (int d0 = 0; d0 < 8; ++d0) { const ATT_LAS char* a = Kb + KSWZ(r32, ((d0 & 3) * 16 + hi * 8) * 2) + (d0 >> 2) * 128 + half * (32 * 256);
        const bf16x8 b = *(const ATT_LAS bf16x8*)a;
        p = __builtin_amdgcn_mfma_f32_32x32x16_bf16(b, qr[d0], p, 0, 0, 0); }
    if constexpr (ND == 12) {
#pragma unroll
        for (int dr = 0; dr < 4; ++dr) { const ATT_LAS char* a = Rb + RSWZ(r32, (dr * 16 + hi * 8) * 2) + half * (32 * 128);
            const bf16x8 b = *(const ATT_LAS bf16x8*)a; const bf16x8 q = *(const ATT_LAS bf16x8*)(qrl + dr * 1024 + lane * 16);
            p = __builtin_amdgcn_mfma_f32_32x32x16_bf16(b, q, p, 0, 0, 0); } }
    if (ATT_PRIO) __builtin_amdgcn_s_setprio(0);
}
__device__ __forceinline__ void pv_tile(f32x16* o, int vb, bf16x8 pa0, bf16x8 pa1, bf16x8 pa2, bf16x8 pa3) {
#define ATT_TRRD(dst, off) asm volatile("ds_read_b64_tr_b16 %0, %1 offset:%2" : "=&v"(dst) : "v"(vb), "i"(off) : "memory")
#define ATT_PV_D0(d0) do { s16x4 l0, l1, l2, l3, h0, h1, h2, h3; constexpr int b_ = v_rd_off(d0, 0, 0); \
        ATT_TRRD(l0, b_); ATT_TRRD(h0, b_ + 2048); ATT_TRRD(l1, b_ + 4096); ATT_TRRD(h1, b_ + 6144); ATT_TRRD(l2, b_ + 8192); ATT_TRRD(h2, b_ + 10240); ATT_TRRD(l3, b_ + 12288); ATT_TRRD(h3, b_ + 14336); \
        asm volatile("s_waitcnt lgkmcnt(0)" ::: "memory"); ATT_SBAR(); \
        o[d0] = __builtin_amdgcn_mfma_f32_32x32x16_bf16(pa0, (bf16x8){l0[0], l0[1], l0[2], l0[3], h0[0], h0[1], h0[2], h0[3]}, o[d0], 0, 0, 0); \
        o[d0] = __builtin_amdgcn_mfma_f32_32x32x16_bf16(pa1, (bf16x8){l1[0], l1[1], l1[2], l1[3], h1[0], h1[1], h1[2], h1[3]}, o[d0], 0, 0, 0); \
        o[d0] = __builtin_amdgcn_mfma_f32_32x32x16_bf16(pa2, (bf16x8){l2[0], l2[1], l2[2], l2[3], h2[0], h2[1], h2[2], h2[3]}, o[d0], 0, 0, 0); \
        o[d0] = __builtin_amdgcn_mfma_f32_32x32x16_bf16(pa3, (bf16x8){l3[0], l3[1], l3[2], l3[3], h3[0], h3[1], h3[2], h3[3]}, o[d0], 0, 0, 0); } while (0)
    if (ATT_PRIO) __builtin_amdgcn_s_setprio(1);
    ATT_PV_D0(0); ATT_PV_D0(1); ATT_PV_D0(2); ATT_PV_D0(3);
    if (ATT_PRIO) __builtin_amdgcn_s_setprio(0);
#undef ATT_PV_D0
#undef ATT_TRRD
}
__device__ __forceinline__ void pack_half(const f32x16& p, bf16x8& pa0, bf16x8& pa1) {
#define ATT_PK4(P, B_, OUT) do { unsigned a0 = cvtpk(P[B_+0], P[B_+1]), a1 = cvtpk(P[B_+2], P[B_+3]); \
        unsigned b0 = cvtpk(P[B_+4], P[B_+5]), b1 = cvtpk(P[B_+6], P[B_+7]); \
        auto r0 = __builtin_amdgcn_permlane32_swap(a0, b0, false, false); auto r1 = __builtin_amdgcn_permlane32_swap(a1, b1, false, false); \
        u32x4 w = {r0[0], r1[0], r0[1], r1[1]}; OUT = __builtin_bit_cast(bf16x8, w); } while (0)
    ATT_PK4(p, 0, pa0); ATT_PK4(p, 8, pa1);
#undef ATT_PK4
}
__device__ __forceinline__ void half_xchg(float x, float& lo, float& hi) {
    unsigned a = __builtin_bit_cast(unsigned, x), b;
    asm volatile("s_nop 1\n\tv_mov_b32 %1, %0\n\ts_nop 1\n\tv_permlane32_swap_b32 %0, %1" : "+v"(a), "=&v"(b));
    lo = __builtin_bit_cast(float, a); hi = __builtin_bit_cast(float, b);
}
__device__ __forceinline__ float half_sum(float v) { float lo, hi; half_xchg(v, lo, hi); return lo + hi; }
__device__ __forceinline__ float half_max(float v) { float lo, hi; half_xchg(v, lo, hi); return fmaxf(lo, hi); }

struct Tensors { const bf16_t* Q; int ldq; const bf16_t* K; int ldk; const bf16_t* V; int ldv; const bf16_t* R; bf16_t* O; int ldo; };

template <int MODE>
__device__ __forceinline__ void attn_unit(const Tensors& T, int qb, float sc2, ATT_LAS char* lds) {
    constexpr int ND = MODE == 1 ? 12 : 8;
    int tid_ = threadIdx.x; asm volatile("" : "+v"(tid_));
    const int tid = tid_, wid = __builtin_amdgcn_readfirstlane(tid >> 6), lane = tid & 63, r32 = lane & 31, hi = lane >> 5;
    const int q0 = qb * 256, qw = q0 + wid * 32;
    const int NT = 4 * (qb + 1);
    const int wlast = 4 * qb + (wid >> 1);
    const int tq = qw + r32;
    ATT_LAS float* scr = (ATT_LAS float*)(lds + LDS_SCR) + wid * 64;
    volatile ATT_LAS unsigned* flags = (volatile ATT_LAS unsigned*)(lds + LDS_FLAGS);
    const ATT_LAS char* qrl = lds + LDS_QR + wid * 4096;
    bf16x8 qr[8];
    { const bf16_t* qp = T.Q + (size_t)tq * T.ldq + hi * 8;
#pragma unroll
      for (int d0 = 0; d0 < 8; ++d0) qr[d0] = *(const bf16x8*)(qp + d0 * 16);
      if constexpr (MODE == 1) {
#pragma unroll
          for (int dr = 0; dr < 4; ++dr) *(ATT_LAS bf16x8*)(lds + LDS_QR + wid * 4096 + dr * 1024 + lane * 16) = *(const bf16x8*)(qp + 128 + dr * 16); } }
    const int sr = tid >> 4, sc = (tid & 15) * 8, kws = KSWZ(sr, sc * 2), vst0 = v_st(sr, sc), vst1 = v_st(32 + sr, sc);
    const int rr_ = tid >> 3, rc = (tid & 7) * 8, rws = RSWZ(rr_, rc * 2);
    bf16x8 sk0, sk1, sv0, sv1, srp;
#define ATT_LOAD(kt) do { const size_t k0_ = (size_t)(kt) * 64; \
        sk0 = *(const bf16x8*)(T.K + (k0_ + sr) * T.ldk + sc); sk1 = *(const bf16x8*)(T.K + (k0_ + 32 + sr) * T.ldk + sc); \
        sv0 = *(const bf16x8*)(T.V + (k0_ + sr) * T.ldv + sc); sv1 = *(const bf16x8*)(T.V + (k0_ + 32 + sr) * T.ldv + sc); \
        if constexpr (MODE == 1) srp = *(const bf16x8*)(T.R + (k0_ + rr_) * 64 + rc); } while (0)
#define ATT_WRITE(bf) do { ATT_LAS char* b_ = lds + (bf) * BUFB; \
        *(ATT_LAS bf16x8*)(b_ + vst0) = sv0; *(ATT_LAS bf16x8*)(b_ + vst1) = sv1; \
        *(ATT_LAS bf16x8*)(b_ + SHM_V + kws) = sk0; *(ATT_LAS bf16x8*)(b_ + SHM_V + kws + 32 * 256) = sk1; \
        if constexpr (MODE == 1) *(ATT_LAS bf16x8*)(b_ + SHM_V + SHM_K + rws) = srp; } while (0)
#define ATT_TILE(it) (MODE == 0 ? (NT - 1 - (it)) : (it))
    f32x16 o[4] = {};
    float carry = 0.f;
    float m_reg = -1e30f, l_reg = 0.f;
    bool dead = false;
    const float hsel = hi ? 0.f : 1.f;
    ATT_LOAD(ATT_TILE(0)); asm volatile("s_waitcnt vmcnt(0)" ::: "memory"); ATT_WRITE(0);
    __syncthreads();
    for (int it = 0; it < NT; ++it) {
        const int cur = it & 1, kt = ATT_TILE(it), kb = kt * 64;
        if (it + 1 < NT) ATT_LOAD(ATT_TILE(it + 1));
        const ATT_LAS char* bufp = lds + cur * BUFB;
        bool staged = false;
        if (kt <= wlast && !dead) {
            f32x16 p0, p1;
            bf16x8 pa0, pa1, pa2, pa3;
            if constexpr (MODE == 0) {
                const bool diag = (kb + 63 >= qw);
                qkt_half<ND>(p1, bufp + SHM_V, bufp + SHM_V + SHM_K, r32, hi, qr, qrl, lane, 1);
                qkt_half<ND>(p0, bufp + SHM_V, bufp + SHM_V + SHM_K, r32, hi, qr, qrl, lane, 0);
                float tsum = carry;
#define ATT_SB_HALF(P, KOFF) do { f32x16 f; \
                    _Pragma("unroll") for (int r = 0; r < 16; ++r) { P[r] *= sc2; \
                        f[r] = fminf(-P[r], 0.f) - __builtin_amdgcn_logf(1.0f + __builtin_amdgcn_exp2f(-__builtin_fabsf(P[r]))); } \
                    if (diag) { _Pragma("unroll") for (int r = 0; r < 16; ++r) { if (kb + (KOFF) + crow(r, hi) >= tq) f[r] = 0.f; } } \
                    float gs_[4], oh_[4], ps_[4]; \
                    _Pragma("unroll") for (int i = 0; i < 4; ++i) { f[4*i+2] += f[4*i+3]; f[4*i+1] += f[4*i+2]; f[4*i] += f[4*i+1]; gs_[i] = f[4*i]; } \
                    _Pragma("unroll") for (int i = 0; i < 4; ++i) { float lo_; half_xchg(gs_[i], lo_, oh_[i]); ps_[i] = lo_ + oh_[i]; } \
                    _Pragma("unroll") for (int i = 3; i >= 0; --i) { const float Tg = tsum + hsel * oh_[i]; \
                        _Pragma("unroll") for (int e = 0; e < 4; ++e) P[4*i+e] = __builtin_amdgcn_exp2f(P[4*i+e] + f[4*i+e] + Tg); \
                        tsum += ps_[i]; } \
                    if (diag) { _Pragma("unroll") for (int r = 0; r < 16; ++r) { if (kb + (KOFF) + crow(r, hi) >= tq) P[r] = 0.f; } } } while (0)
                ATT_SB_HALF(p1, 32);
                pack_half(p1, pa2, pa3);
                ATT_SB_HALF(p0, 0);
                pack_half(p0, pa0, pa1);
#undef ATT_SB_HALF
                carry = tsum;
                pv_tile(o, (int)(uintptr_t)(bufp) + v_rd_base(lane), pa0, pa1, pa2, pa3);
                if (__all(carry < -140.f)) dead = true;
            } else {
                qkt_half<ND>(p0, bufp + SHM_V, bufp + SHM_V + SHM_K, r32, hi, qr, qrl, lane, 0);
                qkt_half<ND>(p1, bufp + SHM_V, bufp + SHM_V + SHM_K, r32, hi, qr, qrl, lane, 1);
                float pmax = p0[0];
#pragma unroll
                for (int r = 1; r < 16; ++r) pmax = fmaxf(pmax, p0[r]);
#pragma unroll
                for (int r = 0; r < 16; ++r) pmax = fmaxf(pmax, p1[r]);
                pmax = half_max(pmax);
                const float mn = fmaxf(m_reg, pmax), alpha = __builtin_amdgcn_exp2f((m_reg - mn) * sc2); m_reg = mn;
                const float mnL = -mn * sc2;
                float psum = 0.f;
#pragma unroll
                for (int r = 0; r < 16; ++r) { p0[r] = __builtin_amdgcn_exp2f(fmaf(p0[r], sc2, mnL)); psum += p0[r]; }
                pack_half(p0, pa0, pa1);
#pragma unroll
                for (int r = 0; r < 16; ++r) { p1[r] = __builtin_amdgcn_exp2f(fmaf(p1[r], sc2, mnL)); psum += p1[r]; }
                pack_half(p1, pa2, pa3);
                l_reg = l_reg * alpha + half_sum(psum);
                if (__any(alpha < 1.f))
                { if (hi == 0) scr[r32] = alpha; asm volatile("s_waitcnt lgkmcnt(0)" ::: "memory");
#pragma unroll
                    for (int r = 0; r < 16; ++r) { const float a = scr[crow(r, hi)];
#pragma unroll
                        for (int d = 0; d < 4; ++d) o[d][r] *= a; } }
#if ATT_EARLYW
                if (it + 1 < NT) { asm volatile("s_waitcnt vmcnt(0)" ::: "memory"); ATT_WRITE(cur ^ 1); staged = true; }
#endif
                pv_tile(o, (int)(uintptr_t)(bufp) + v_rd_base(lane), pa0, pa1, pa2, pa3);
            }
        }
        if (it + 1 < NT && !staged) { asm volatile("s_waitcnt vmcnt(0)" ::: "memory"); ATT_WRITE(cur ^ 1); }
        if constexpr (MODE == 0) { if (lane == 0) flags[cur * 8 + wid] = dead ? 1u : 0u; }
        __syncthreads();
        if constexpr (MODE == 0) {
            unsigned alld = 1u;
#pragma unroll
            for (int w = 0; w < 8; ++w) alld &= flags[cur * 8 + w];
            if (alld) break;
        }
    }
    if constexpr (MODE == 1) { if (hi == 0) scr[32 + r32] = l_reg; asm volatile("s_waitcnt lgkmcnt(0)" ::: "memory"); }
    bf16_t* Ow = T.O + (size_t)qw * T.ldo;
    int obase = 4 * hi * T.ldo + r32; asm volatile("" : "+v"(obase));
#pragma unroll
    for (int r = 0; r < 16; ++r) { const int orow = crow(r, hi);
        float rl = 1.f; if constexpr (MODE == 1) rl = __builtin_amdgcn_rcpf(scr[32 + orow]);
        int ro = obase + ((r & 3) + 8 * (r >> 2)) * T.ldo; asm volatile("" : "+v"(ro));
#pragma unroll
        for (int d0 = 0; d0 < 4; ++d0) { const float v = o[d0][r] * rl; const float vn = __shfl_xor(v, 1);
            if ((r32 & 1) == 0) *(unsigned*)(Ow + ro + d0 * 32) = cvtpk(v, vn); } }
    __syncthreads();
#undef ATT_LOAD
#undef ATT_WRITE
#undef ATT_TILE
}
}

constexpr int BATCH = 2, SEQ = 4096, D = 4096, M = BATCH * SEQ, DEPTH = 2;
constexpr int SBW = 2048, QRANK = 1024, KVRANK = 512, ROPE = 64, DFF = 16384;
constexpr int IN_W = 3 * SBW + QRANK + KVRANK + ROPE + 2 * D;
constexpr int C_QD = 3 * SBW, C_KVD = C_QD + QRANK, C_GATE_SRC = C_KVD + KVRANK + ROPE;
constexpr int C_GSB = 7936, C_GMLA = C_GSB + D, PROJ_W = C_GMLA + D;
constexpr int QW = 16 * 192, KVW = 16 * 256;
constexpr float EPS = 1e-6f;
static_assert(IN_W == 15936 && PROJ_W == 16128 && PROJ_W % 256 == 0 && C_GSB % 256 == 0, "projection layout");

constexpr size_t MiB = 1u << 20;
constexpr size_t WS_CTL = 0, CTL_ZERO_BYTES = 1 * MiB;
constexpr size_t WS_ADA = 1 * MiB;
constexpr size_t WS_TAB = 2 * MiB;
constexpr size_t WS_ADAP = 4 * MiB;
constexpr size_t WS_W = 32 * MiB;
constexpr size_t W_IN = 0, W_UQ = 126 * MiB, W_UKV = 132 * MiB, W_OSB = 136 * MiB, W_OMLA = 152 * MiB, W_OUT = 168 * MiB, W_UP = 200 * MiB, W_DOWN = 328 * MiB, W_LAYER = 456 * MiB;
constexpr size_t WS_ACT = WS_W + DEPTH * W_LAYER;
constexpr size_t A_H = WS_ACT, A_PROJ = A_H + 64 * MiB, A_CQ = A_PROJ + 252 * MiB, A_CKV = A_CQ + 16 * MiB, A_KR = A_CKV + 8 * MiB, A_Q = A_KR + 1 * MiB, A_KV = A_Q + 48 * MiB,
                 A_OSB = A_KV + 64 * MiB, A_OMLA = A_OSB + 32 * MiB, A_TMP = A_OMLA + 32 * MiB, A_MRG = A_TMP + 128 * MiB, A_Y = A_MRG + 64 * MiB, A_U = A_Y + 128 * MiB, WS_END = A_U + 256 * MiB;
static_assert((size_t)PROJ_W * D * 2 == 126 * MiB && (size_t)M * PROJ_W * 2 == 252 * MiB, "sizes");
constexpr int CW_TMO = 0;
constexpr int CW_BAR = 4096;

constexpr int RING_BYTES = 135168;
constexpr int LDSCTL_OFF = RING_BYTES, MISC_OFF = LDSCTL_OFF + 320;
constexpr int LDS_BYTES = RING_BYTES + 1024;
constexpr int NWAVES = 8;
static_assert(att::ATT_LDS_BYTES <= RING_BYTES && pg8::STAGE_BYTES <= RING_BYTES, "LDS map");

#define GAS __attribute__((address_space(1)))
#define LAS __attribute__((address_space(3)))
typedef unsigned short bf16;
typedef unsigned v4u __attribute__((ext_vector_type(4)));
typedef unsigned v2u __attribute__((ext_vector_type(2)));
typedef float f32x4 __attribute__((ext_vector_type(4)));
typedef GAS unsigned gu32;
#define RLX_AGENT __ATOMIC_RELAXED, __HIP_MEMORY_SCOPE_AGENT
#define LDS_WAIT() asm volatile("s_waitcnt lgkmcnt(0)" ::: "memory")
#define VM_WAIT() asm volatile("s_waitcnt vmcnt(0)" ::: "memory")
__device__ __forceinline__ unsigned pk2(float lo, float hi) { return pg8::cvt_pk_bf16(lo, hi); }
__device__ __forceinline__ float bflo(unsigned w) { return __builtin_bit_cast(float, w << 16); }
__device__ __forceinline__ float bfhi(unsigned w) { return __builtin_bit_cast(float, w & 0xffff0000u); }

#define XB_TMO      128
#define XB_XCNT(j)  (256  + 64 * (j))
#define XB_XSUB(j)  (1280 + 64 * (j))
#define XB_XGEN(j)  (2304 + 64 * (j))
#define XB_TOP      3328
#define XB_TOPGEN   3392
#define XCD_BAR_WORDS 3456
#define XB_SPIN_CAP (1u << 21)

__device__ __forceinline__ unsigned xb_ld(unsigned* p)              { return __hip_atomic_load(p, __ATOMIC_RELAXED, __HIP_MEMORY_SCOPE_AGENT); }
__device__ __forceinline__ unsigned xb_add(unsigned* p, unsigned v) { return __hip_atomic_fetch_add(p, v, __ATOMIC_RELAXED, __HIP_MEMORY_SCOPE_AGENT); }
__device__ __forceinline__ unsigned xb_xcc_id() { return (unsigned)__builtin_amdgcn_s_getreg((3 << 11) | 20) & 0xFu; }
#define XB_SPIN(cond, bar) do { unsigned _sp = 0; while (cond) { __builtin_amdgcn_s_sleep(1); \
    if ((++_sp & 255u) == 0u) { if (xb_ld(&(bar)[XB_TMO])) break; if (_sp > XB_SPIN_CAP) { atomicAdd(&(bar)[XB_TMO], 1u); break; } } } } while (0)

struct XcdBarrier {
    unsigned* bar; unsigned x;
    volatile LAS unsigned* st;
};

__device__ __forceinline__ XcdBarrier xcd_barrier_post(unsigned* bar, volatile LAS unsigned* st) {
    XcdBarrier b; b.bar = bar; b.x = xb_xcc_id(); b.st = st;
    if (threadIdx.x == 0) (void)xb_add(&bar[XB_XCNT(b.x)], 1u);
    return b;
}
__device__ __forceinline__ void xcd_barrier_complete(unsigned* bar, unsigned x, unsigned& nloc, unsigned& nx) {
    const unsigned G = gridDim.x * gridDim.y * gridDim.z;
    unsigned sum, cnt, mine, sp = 0u;
    for (;;) {
        sum = 0u; cnt = 0u; mine = 0u;
#pragma unroll
        for (unsigned j = 0; j < 16; ++j) { const unsigned c = xb_ld(&bar[XB_XCNT(j)]); sum += c; cnt += (c > 0u) ? 1u : 0u; mine = (j == x) ? c : mine; }
        if (sum == G) break;
        __builtin_amdgcn_s_sleep(1);
        if ((++sp & 255u) == 0u) { if (xb_ld(&bar[XB_TMO])) break; if (sp > XB_SPIN_CAP) { atomicAdd(&bar[XB_TMO], 1u); break; } }
    }
    nloc = mine > 0u ? mine : 1u; nx = cnt > 0u ? cnt : 1u;
}

__device__ __forceinline__ void xcd_barrier(const XcdBarrier& b) {
    asm volatile("s_waitcnt vmcnt(0)" ::: "memory");
    __syncthreads();
    if (threadIdx.x == 0) {
        unsigned* bar = b.bar;
        __builtin_amdgcn_s_waitcnt(0);
        unsigned nloc = b.st[0], nx = b.st[1];
        if (nloc == 0u) { xcd_barrier_complete(bar, b.x, nloc, nx); b.st[0] = nloc; b.st[1] = nx; }
        const unsigned old = xb_add(&bar[XB_XSUB(b.x)], 1u);
        const unsigned gen = old / nloc;
        if (old + 1u == (gen + 1u) * nloc) {
            __builtin_amdgcn_fence(__ATOMIC_RELEASE, "agent");
            asm volatile("s_waitcnt vmcnt(0)" ::: "memory");
            const unsigned og = xb_add(&bar[XB_TOP], 1u);
            const unsigned tg = og / nx;
            if (og + 1u == (tg + 1u) * nx) xb_add(&bar[XB_TOPGEN], 1u);
            else XB_SPIN(xb_ld(&bar[XB_TOPGEN]) == tg, bar);
            __builtin_amdgcn_fence(__ATOMIC_ACQUIRE, "agent");
            xb_add(&bar[XB_XGEN(b.x)], 1u);
            asm volatile("s_waitcnt vmcnt(0)" ::: "memory");
        } else {
            XB_SPIN(xb_ld(&bar[XB_XGEN(b.x)]) == gen, bar);
            __builtin_amdgcn_fence(__ATOMIC_ACQUIRE, "agent");
            asm volatile("s_waitcnt vmcnt(0)" ::: "memory");
        }
    }
    __syncthreads();
}


struct Frame {
    LAS unsigned char* lds;
    int tid, lane, wave, G, gw, NGW;
};
__device__ __forceinline__ float wave_sum(float v) {
#pragma unroll
    for (int o = 1; o < 64; o <<= 1) v += __shfl_xor(v, o);
    return v;
}

__device__ __forceinline__ void transpose_item(const float* W, int N, bf16* WT, int ldt, int kb, int nb, int rowbase, bool ropeperm, LAS float* scr, int lane) {
    const int k0 = 64 * kb, n0 = 64 * nb;
    const float* src = W + (size_t)(k0 + (lane >> 4)) * N + n0 + 4 * (lane & 15);
#pragma unroll 4
    for (int i = 0; i < 16; ++i) { const f32x4 v = *(const f32x4*)(src + (size_t)(4 * i) * N); LAS float* d = scr + (4 * i + (lane >> 4)) * 65 + 4 * (lane & 15);
        d[0] = v[0]; d[1] = v[1]; d[2] = v[2]; d[3] = v[3]; }
    LDS_WAIT(); asm volatile("" ::: "memory");
    const int c = lane & 7;
#pragma unroll
    for (int j = 0; j < 8; ++j) { const int nn = (lane >> 3) + 8 * j; const LAS float* s = scr + (8 * c) * 65 + nn;
        v4u o; o.x = pk2(s[0 * 65], s[1 * 65]); o.y = pk2(s[2 * 65], s[3 * 65]); o.z = pk2(s[4 * 65], s[5 * 65]); o.w = pk2(s[6 * 65], s[7 * 65]);
        const int orow = rowbase + (ropeperm ? (2 * (nn & 31) + (nn >> 5)) : nn);
        *(GAS v4u*)(WT + (size_t)orow * ldt + k0 + 8 * c) = o; }
    LDS_WAIT(); asm volatile("" ::: "memory");
}

__device__ __forceinline__ void norm_mod_row(const f32x4 (&v)[16], float ssq, const float* g, const float* scv, const float* shv, bf16* orow, int lane) {
    const float r = 1.0f / sqrtf(ssq * (1.0f / D) + EPS);
#pragma unroll
    for (int j = 0; j < 16; ++j) { int c = 4 * lane + 256 * j; asm volatile("" : "+v"(c));
        const f32x4 gg = *(const f32x4*)(g + c), ss = *(const f32x4*)(scv + c), hh = *(const f32x4*)(shv + c);
        f32x4 o;
#pragma unroll
        for (int e = 0; e < 4; ++e) o[e] = v[j][e] * r * gg[e] * (1.0f + ss[e]) + hh[e];
        v2u w; w.x = pk2(o[0], o[1]); w.y = pk2(o[2], o[3]);
        *(GAS v2u*)(orow + c) = w; }
}


template <bool HAS_Y, bool HAS_H>
__device__ __forceinline__ void thin_phase(Frame& F, const float* xin, float* xout, const bf16* Yb, bf16* Hout,
                                           const float* gpost, const float* gate0, const float* gpre, const float* sc0, const float* sh0) {
    LAS float* cA1 = (LAS float*)F.lds; LAS float* cA2 = cA1 + D; LAS float* cB2 = cA2 + D;
    for (int chunk = blockIdx.x; chunk < M / 32; chunk += F.G) {
        int tid = F.tid; asm volatile("" : "+v"(tid));
        const int b = (chunk * 32) / SEQ;
        __syncthreads();
#pragma unroll
        for (int i = 0; i < 2; ++i) { const int c = 4 * tid + 2048 * i;
            if constexpr (HAS_Y) { const f32x4 g = *(const f32x4*)(gpost + c), t = *(const f32x4*)(gate0 + (size_t)b * 6 * D + c); *(LAS f32x4*)(cA1 + c) = g * t; }
            if constexpr (HAS_H) { const f32x4 g = *(const f32x4*)(gpre + c), s = *(const f32x4*)(sc0 + (size_t)b * 6 * D + c), h = *(const f32x4*)(sh0 + (size_t)b * 6 * D + c);
                *(LAS f32x4*)(cA2 + c) = g * (s + 1.0f); *(LAS f32x4*)(cB2 + c) = h; } }
        __syncthreads();
        const int LN = tid & 63;
#pragma unroll 1
        for (int i = 0; i < 4; ++i) {
            const size_t m = (size_t)chunk * 32 + F.wave * 4 + i;
            v4u yv[8]; f32x4 xv[16];
#pragma unroll
            for (int j = 0; j < 8; ++j) { const int c = 8 * LN + 512 * j;
                if constexpr (HAS_Y) yv[j] = *(const GAS v4u*)(Yb + m * D + c);
                xv[2 * j] = *(const f32x4*)(xin + m * D + c); xv[2 * j + 1] = *(const f32x4*)(xin + m * D + c + 4); }
            float ssq2 = 0.f;
            if constexpr (HAS_Y) {
                float ssq = 0.f;
#pragma unroll
                for (int j = 0; j < 8; ++j) { const unsigned w[4] = {yv[j].x, yv[j].y, yv[j].z, yv[j].w};
#pragma unroll
                    for (int q = 0; q < 4; ++q) { const float a = bflo(w[q]), c2 = bfhi(w[q]); ssq += a * a + c2 * c2; } }
                ssq = wave_sum(ssq); const float r = 1.0f / sqrtf(ssq * (1.0f / D) + EPS);
#pragma unroll
                for (int j = 0; j < 8; ++j) { const int c = 8 * LN + 512 * j; const unsigned w[4] = {yv[j].x, yv[j].y, yv[j].z, yv[j].w};
                    const f32x4 a0 = *(const LAS f32x4*)(cA1 + c), a1 = *(const LAS f32x4*)(cA1 + c + 4);
                    f32x4 y0 = {bflo(w[0]), bfhi(w[0]), bflo(w[1]), bfhi(w[1])}, y1 = {bflo(w[2]), bfhi(w[2]), bflo(w[3]), bfhi(w[3])};
                    xv[2 * j] = xv[2 * j] + a0 * (y0 * r); xv[2 * j + 1] = xv[2 * j + 1] + a1 * (y1 * r);
                    *(f32x4*)(xout + m * D + c) = xv[2 * j]; *(f32x4*)(xout + m * D + c + 4) = xv[2 * j + 1]; } }
            if constexpr (HAS_H) {
#pragma unroll
                for (int j = 0; j < 16; ++j) ssq2 += (xv[j][0] * xv[j][0] + xv[j][1] * xv[j][1]) + (xv[j][2] * xv[j][2] + xv[j][3] * xv[j][3]);
                ssq2 = wave_sum(ssq2); const float r2 = 1.0f / sqrtf(ssq2 * (1.0f / D) + EPS);
#pragma unroll
                for (int j = 0; j < 8; ++j) { const int c = 8 * LN + 512 * j;
                    const f32x4 a0 = *(const LAS f32x4*)(cA2 + c), a1 = *(const LAS f32x4*)(cA2 + c + 4), b0 = *(const LAS f32x4*)(cB2 + c), b1 = *(const LAS f32x4*)(cB2 + c + 4);
                    const f32x4 h0 = (xv[2 * j] * r2) * a0 + b0, h1 = (xv[2 * j + 1] * r2) * a1 + b1;
                    v4u w; w.x = pk2(h0[0], h0[1]); w.y = pk2(h0[2], h0[3]); w.z = pk2(h1[0], h1[1]); w.w = pk2(h1[2], h1[3]);
                    *(GAS v4u*)(Hout + m * D + c) = w; } }
        }
    }
    __syncthreads();
}

constexpr int NB_IN = IN_W / 64, I_IN = (D / 64) * NB_IN, I_UQ = (QRANK / 64) * (QW / 64), I_UKV = (KVRANK / 64) * (KVW / 64), I_OSB = (SBW / 64) * (D / 64), I_OMLA = I_OSB,
              I_OUT = (D / 64) * (D / 64), I_UP = (D / 64) * (DFF / 64), I_DOWN = (DFF / 64) * (D / 64), I_LAYER = I_IN + I_UQ + I_UKV + I_OSB + I_OMLA + I_OUT + I_UP + I_DOWN;
#define CONVERT_ITEMS(lo, hi, start, stride) do { int cl_ = F.lane; asm volatile("" : "+v"(cl_));     \
        for (int it = (lo) + (start); it < (hi); it += (stride)) { \
            const int l = it / I_LAYER; int r = it % I_LAYER; \
            if (r < I_IN) { const int kb = r / NB_IN, nb = r % NB_IN, n0 = nb * 64; transpose_item(KIN(I_WIN) + (size_t)l * D * IN_W, IN_W, (bf16*)(wl + W_IN), D, kb, nb, n0 < C_GATE_SRC ? n0 : n0 + (C_GSB - C_GATE_SRC), false, scr, cl_); continue; } r -= I_IN; \
            if (r < I_UQ) { const int kb = r / (QW / 64), nb = r % (QW / 64); transpose_item(KIN(I_WUQ) + (size_t)l * QRANK * QW, QW, (bf16*)(wl + W_UQ), QRANK, kb, nb, nb * 64, (nb % 3) == 2, scr, cl_); continue; } r -= I_UQ; \
            if (r < I_UKV) { const int kb = r / (KVW / 64), nb = r % (KVW / 64); transpose_item(KIN(I_WUKV) + (size_t)l * KVRANK * KVW, KVW, (bf16*)(wl + W_UKV), KVRANK, kb, nb, nb * 64, false, scr, cl_); continue; } r -= I_UKV; \
            if (r < I_OSB) { const int kb = r / (D / 64), nb = r % (D / 64); transpose_item(KIN(I_WOSB) + (size_t)l * SBW * D, D, (bf16*)(wl + W_OSB), 2 * SBW, kb, nb, nb * 64, false, scr, cl_); continue; } r -= I_OSB; \
            if (r < I_OMLA) { const int kb = r / (D / 64), nb = r % (D / 64); transpose_item(KIN(I_WOMLA) + (size_t)l * SBW * D, D, (bf16*)(wl + W_OSB) + SBW, 2 * SBW, kb, nb, nb * 64, false, scr, cl_); continue; } r -= I_OMLA; \
            if (r < I_OUT) { const int kb = r / (D / 64), nb = r % (D / 64); transpose_item(KIN(I_WOUT) + (size_t)l * D * D, D, (bf16*)(wl + W_OUT), D, kb, nb, nb * 64, false, scr, cl_); continue; } r -= I_OUT; \
            if (r < I_UP) { const int kb = r / (DFF / 64), nb = r % (DFF / 64); transpose_item(KIN(I_WUP) + (size_t)l * D * DFF, DFF, (bf16*)(wl + W_UP), D, kb, nb, nb * 64, false, scr, cl_); continue; } r -= I_UP; \
            { const int kb = r / (D / 64), nb = r % (D / 64); transpose_item(KIN(I_WDOWN) + (size_t)l * DFF * D, D, (bf16*)(wl + W_DOWN), DFF, kb, nb, nb * 64, false, scr, cl_); } \
        } } while (0)

#ifndef PG8_SP2
#define PG8_SP2 true
#endif
#ifndef PG8_ALIGN
#define PG8_ALIGN false
#endif
#ifndef PH_MASK
#define PH_MASK 0xFFFFFFFFu
#endif
#define PH(k) ((PH_MASK >> (k)) & 1u)
struct Args { const float* in[19]; float* out; unsigned char* ws; };
enum { I_X = 0, I_C, I_POS, I_WADA, I_BADA, I_GPREMIX, I_GPOSTMIX, I_GPREMLP, I_GPOSTMLP, I_WIN, I_GQ, I_WUQ, I_GKV, I_WUKV, I_WOSB, I_WOMLA, I_WOUT, I_WUP, I_WDOWN };

typedef __attribute__((address_space(4))) const unsigned char* kargp_t;
__device__ __forceinline__ __attribute__((address_space(1))) unsigned char* lw_(unsigned char* p) { __attribute__((address_space(1))) unsigned char* q = (__attribute__((address_space(1))) unsigned char*)p; asm volatile("" : "+s"(q)); return q; }
__device__ __forceinline__ kargp_t lwk_() { kargp_t p = (kargp_t)__builtin_amdgcn_kernarg_segment_ptr(); asm volatile("" : "+s"(p)); return p; }
#define KIN(k) ((const float*)(*(const __attribute__((address_space(1))) float* const __attribute__((address_space(4)))*)(lwk_() + 8 * (k))))
__global__ void __launch_bounds__(NWAVES * 64, 2) hybrid_fwd(Args args) {
    extern __shared__ __attribute__((aligned(16))) unsigned char lds_raw[];
    Frame F;
    F.lds = (LAS unsigned char*)lds_raw;
    F.tid = threadIdx.x; F.lane = F.tid & 63; F.wave = __builtin_amdgcn_readfirstlane(F.tid >> 6);
    F.G = gridDim.x; F.gw = blockIdx.x * NWAVES + F.wave; F.NGW = F.G * NWAVES;
    unsigned char* ws = args.ws;
    gu32* ctl = (gu32*)(ws + WS_CTL);
    for (int u = F.tid; u < (LDS_BYTES - LDSCTL_OFF) / 4; u += NWAVES * 64) ((LAS unsigned*)(F.lds + LDSCTL_OFF))[u] = 0u;
    __syncthreads();
    XcdBarrier bar = xcd_barrier_post((unsigned*)(ctl + CW_BAR), (volatile LAS unsigned*)(F.lds + MISC_OFF) + 8);
#define GRID_BAR() xcd_barrier(bar)

#define ada ((float*)(lw_(ws) + WS_ADA))
#define tab ((float*)(lw_(ws) + WS_TAB))
#define adap ((float*)(lw_(ws) + WS_ADAP))
#define Hb ((bf16*)(lw_(ws) + A_H))
#define PROJ ((bf16*)(lw_(ws) + A_PROJ))
#define CQ ((bf16*)(lw_(ws) + A_CQ))
#define CKV ((bf16*)(lw_(ws) + A_CKV))
#define KR ((bf16*)(lw_(ws) + A_KR))
#define QF ((bf16*)(lw_(ws) + A_Q))
#define KVF ((bf16*)(lw_(ws) + A_KV))
#define OSB ((bf16*)(lw_(ws) + A_OSB))
#define MRG ((bf16*)(lw_(ws) + A_MRG))
#define Yb ((bf16*)(lw_(ws) + A_Y))
#define U ((bf16*)(lw_(ws) + A_U))
#define x_in KIN(I_X)
#define wl (lw_(ws) + WS_W + (size_t)l * W_LAYER)
#define adl (ada + (size_t)l * BATCH * 6 * D)
    float* xo = args.out;


    if (PH(0)) {
        LAS float* cact = (LAS float*)F.lds;
        for (int i = F.tid; i < BATCH * D; i += NWAVES * 64) { const float cv = KIN(I_C)[i]; cact[i] = cv / (1.0f + __expf(-cv)); }
        __syncthreads();
        for (int task = blockIdx.x; task < DEPTH * 32 * 12; task += F.G) {
            const int l = task / (32 * 12), s = (task / 12) % 32, cb = task % 12;
            const int col = cb * 2048 + F.tid * 4;
            const float* wp = KIN(I_WADA) + ((size_t)l * D + s * 128) * (6 * D) + col;
            f32x4 a0 = {0.f, 0.f, 0.f, 0.f}, a1 = {0.f, 0.f, 0.f, 0.f};
#pragma unroll 8
            for (int k = 0; k < 128; ++k) { const f32x4 w = *(const f32x4*)(wp + (size_t)k * (6 * D)); const float c0 = cact[s * 128 + k], c1 = cact[D + s * 128 + k];
                a0 += w * c0; a1 += w * c1; }
            *(f32x4*)(adap + (((size_t)s * DEPTH + l) * BATCH + 0) * (6 * D) + col) = a0;
            *(f32x4*)(adap + (((size_t)s * DEPTH + l) * BATCH + 1) * (6 * D) + col) = a1;
        }
        __syncthreads();
        for (int e = blockIdx.x * (NWAVES * 64) + F.tid; e < M * 32; e += F.G * NWAVES * 64) {
            const int m = e >> 5, i = e & 31;
            const float inv = powf(10000.0f, -(float)i / 32.0f);
            const float ang = (float)(((const int*)KIN(I_POS))[m]) * inv;
            const double rev = (double)ang * 0.15915494309189533577; const float fr = (float)(rev - rint(rev));
            tab[2 * e] = __builtin_amdgcn_cosf(fr); tab[2 * e + 1] = __builtin_amdgcn_sinf(fr);
        }
        for (int l = 0; l < DEPTH; ++l) { v4u* z = (v4u*)(ws + WS_W + l * W_LAYER + W_IN + (size_t)C_GATE_SRC * D * 2);
            for (int i = blockIdx.x * (NWAVES * 64) + F.tid; i < 192 * D * 2 / 16; i += F.G * NWAVES * 64) z[i] = (v4u){0u, 0u, 0u, 0u}; }
        LAS float* scr = (LAS float*)(F.lds) + F.wave * (64 * 65);
        CONVERT_ITEMS(0, DEPTH * I_LAYER, F.gw, F.NGW);
    }
    GRID_BAR();
    if (PH(1)) for (int e = blockIdx.x * (NWAVES * 64) + F.tid; e < DEPTH * BATCH * 6 * D; e += F.G * NWAVES * 64) {
        const int l = e / (BATCH * 6 * D), n = e % (6 * D);
        float s = KIN(I_BADA)[(size_t)l * 6 * D + n];
#pragma unroll 8
        for (int k = 0; k < 32; ++k) s += adap[(size_t)k * (DEPTH * BATCH * 6 * D) + e];
        ada[e] = s;
    }
    GRID_BAR();
    if (PH(2)) thin_phase<false, true>(F, x_in, nullptr, nullptr, Hb, nullptr, nullptr, KIN(I_GPREMIX), ada + D, ada);
    GRID_BAR();

    for (int l = 0; l < DEPTH; ++l) {
        if (PH(3)) { pg8::Gemm g{Hb, (const bf16*)(wl + W_IN), M, PROJ_W, D}; pg8::StaticOrder S; S.init(M, PROJ_W, F.G, (int)blockIdx.x);
          pg8::EpiBf16<0> E{PROJ, PROJ_W};
          pg8::gemm_phase<pg8::EpiBf16<0>, pg8::StaticOrder, PG8_ALIGN, PG8_SP2>(F.lds, g, S, E); }
        GRID_BAR();
        if (PH(4)) for (int m = F.gw; m < M; m += F.NGW) {
            int LN = F.lane; asm volatile("" : "+v"(LN));
            const bf16* pr = PROJ + (size_t)m * PROJ_W;
            { const v4u a = *(const GAS v4u*)(pr + C_QD + 16 * LN), b2 = *(const GAS v4u*)(pr + C_QD + 16 * LN + 8);
              float f[16] = {bflo(a.x), bfhi(a.x), bflo(a.y), bfhi(a.y), bflo(a.z), bfhi(a.z), bflo(a.w), bfhi(a.w), bflo(b2.x), bfhi(b2.x), bflo(b2.y), bfhi(b2.y), bflo(b2.z), bfhi(b2.z), bflo(b2.w), bfhi(b2.w)};
              float ssq = 0.f;
#pragma unroll
              for (int e = 0; e < 16; ++e) ssq += f[e] * f[e];
              ssq = wave_sum(ssq); const float r = 1.0f / sqrtf(ssq * (1.0f / QRANK) + EPS);
              const float* gq = KIN(I_GQ) + (size_t)l * QRANK + 16 * LN;
              v4u o0, o1;
              o0.x = pk2(f[0] * r * gq[0], f[1] * r * gq[1]); o0.y = pk2(f[2] * r * gq[2], f[3] * r * gq[3]); o0.z = pk2(f[4] * r * gq[4], f[5] * r * gq[5]); o0.w = pk2(f[6] * r * gq[6], f[7] * r * gq[7]);
              o1.x = pk2(f[8] * r * gq[8], f[9] * r * gq[9]); o1.y = pk2(f[10] * r * gq[10], f[11] * r * gq[11]); o1.z = pk2(f[12] * r * gq[12], f[13] * r * gq[13]); o1.w = pk2(f[14] * r * gq[14], f[15] * r * gq[15]);
              *(GAS v4u*)(CQ + (size_t)m * QRANK + 16 * LN) = o0; *(GAS v4u*)(CQ + (size_t)m * QRANK + 16 * LN + 8) = o1; }
            { const v4u a = *(const GAS v4u*)(pr + C_KVD + 8 * LN);
              float f[8] = {bflo(a.x), bfhi(a.x), bflo(a.y), bfhi(a.y), bflo(a.z), bfhi(a.z), bflo(a.w), bfhi(a.w)};
              float ssq = 0.f;
#pragma unroll
              for (int e = 0; e < 8; ++e) ssq += f[e] * f[e];
              ssq = wave_sum(ssq); const float r = 1.0f / sqrtf(ssq * (1.0f / KVRANK) + EPS);
              const float* gk = KIN(I_GKV) + (size_t)l * KVRANK + 8 * LN;
              v4u o0; o0.x = pk2(f[0] * r * gk[0], f[1] * r * gk[1]); o0.y = pk2(f[2] * r * gk[2], f[3] * r * gk[3]); o0.z = pk2(f[4] * r * gk[4], f[5] * r * gk[5]); o0.w = pk2(f[6] * r * gk[6], f[7] * r * gk[7]);
              *(GAS v4u*)(CKV + (size_t)m * KVRANK + 8 * LN) = o0; }
            if (LN < 32) { const int i = LN; const bf16* kp = pr + C_KVD + KVRANK;
              const float x1 = bflo((unsigned)kp[i]), x2 = bflo((unsigned)kp[32 + i]); const float cs = tab[((size_t)m * 32 + i) * 2], sn = tab[((size_t)m * 32 + i) * 2 + 1];
              *(GAS unsigned*)(KR + (size_t)m * ROPE + 2 * i) = pk2(x1 * cs - x2 * sn, x2 * cs + x1 * sn); }
        }
        GRID_BAR();
        if (PH(5)) { pg8::Gemm g{CQ, (const bf16*)(wl + W_UQ), M, QW, QRANK}; pg8::StaticOrder S; S.init(M, QW, F.G, (int)blockIdx.x);
          pg8::EpiRope E{QF, QW, tab};
          pg8::gemm_phase<pg8::EpiRope, pg8::StaticOrder, PG8_ALIGN, PG8_SP2>(F.lds, g, S, E); }
        if (PH(5)) { pg8::Gemm g{CKV, (const bf16*)(wl + W_UKV), M, KVW, KVRANK}; pg8::EpiBf16<0> E{KVF, KVW};
          if (F.G == 256) { pg8::UnevenOrder S; S.init(M, KVW, F.G, (int)blockIdx.x);
            pg8::gemm_phase<pg8::EpiBf16<0>, pg8::UnevenOrder, PG8_ALIGN, PG8_SP2>(F.lds, g, S, E); }
          else { pg8::StaticOrder S; S.init(M, KVW, F.G, (int)blockIdx.x);
            pg8::gemm_phase<pg8::EpiBf16<0>, pg8::StaticOrder, PG8_ALIGN, PG8_SP2>(F.lds, g, S, E); } }
        GRID_BAR();
        if (PH(6)) for (int item = blockIdx.x; item < 512; item += F.G) {
            const int kind = item >> 8, c = item & 255, bh = (c & 7) * 4 + ((c >> 3) >> 3), y = (c >> 3) & 7, b = bh >> 4, h = bh & 15;
            const size_t rb = (size_t)b * SEQ;
            if (kind == 0) { if (PH(14)) {
                att::Tensors T{PROJ + rb * PROJ_W + h * 128, PROJ_W, PROJ + rb * PROJ_W + SBW + h * 128, PROJ_W, PROJ + rb * PROJ_W + 2 * SBW + h * 128, PROJ_W, nullptr, OSB + rb * (2 * SBW) + h * 128, 2 * SBW};
                att::attn_unit<0>(T, 15 - y, 0.08838834764831845f * 1.4426950408889634f, (LAS char*)F.lds);
                att::attn_unit<0>(T, y, 0.08838834764831845f * 1.4426950408889634f, (LAS char*)F.lds); }
            } else if (PH(15)) {
                att::Tensors T{QF + rb * QW + h * 192, QW, KVF + rb * KVW + h * 256, KVW, KVF + rb * KVW + h * 256 + 128, KVW, KR + rb * ROPE, OSB + rb * (2 * SBW) + SBW + h * 128, 2 * SBW};
                att::attn_unit<1>(T, 15 - y, 0.07216878364870323f * 1.4426950408889634f, (LAS char*)F.lds);
                att::attn_unit<1>(T, y, 0.07216878364870323f * 1.4426950408889634f, (LAS char*)F.lds);
            }
        }
        GRID_BAR();
        if (PH(7)) { pg8::Gemm g{OSB, (const bf16*)(wl + W_OSB), M, D, 2 * SBW}; pg8::StaticOrder S; S.init(M, D, F.G, (int)blockIdx.x);
          pg8::EpiGateMerge E{MRG, D, PROJ + C_GSB, PROJ + C_GMLA, PROJ_W};
          pg8::gemm_phase<pg8::EpiGateMerge, pg8::StaticOrder, PG8_ALIGN, PG8_SP2>(F.lds, g, S, E); }
        GRID_BAR();
        if (PH(9)) { pg8::Gemm g{MRG, (const bf16*)(wl + W_OUT), M, D, D}; pg8::StaticOrder S; S.init(M, D, F.G, (int)blockIdx.x);
          pg8::EpiBf16<0> E{Yb, D};
          pg8::gemm_phase<pg8::EpiBf16<0>, pg8::StaticOrder, PG8_ALIGN, PG8_SP2>(F.lds, g, S, E); }
        GRID_BAR();
        if (PH(10)) thin_phase<true, true>(F, l == 0 ? x_in : (const float*)xo, xo, Yb, Hb, KIN(I_GPOSTMIX) + (size_t)l * D, adl + 2 * D, KIN(I_GPREMLP) + (size_t)l * D, adl + 4 * D, adl + 3 * D);
        GRID_BAR();
        if (PH(11)) { pg8::Gemm g{Hb, (const bf16*)(wl + W_UP), M, DFF, D}; pg8::StaticOrder S; S.init(M, DFF, F.G, (int)blockIdx.x);
          pg8::EpiBf16<1> E{U, DFF};
          pg8::gemm_phase<pg8::EpiBf16<1>, pg8::StaticOrder, PG8_ALIGN, PG8_SP2>(F.lds, g, S, E); }
        GRID_BAR();
        if (PH(12)) { pg8::Gemm g{U, (const bf16*)(wl + W_DOWN), M, D, DFF}; pg8::StaticOrder S; S.init(M, D, F.G, (int)blockIdx.x);
          pg8::EpiBf16<0> E{Yb, D};
          pg8::gemm_phase<pg8::EpiBf16<0>, pg8::StaticOrder, PG8_ALIGN, PG8_SP2>(F.lds, g, S, E); }
        GRID_BAR();
        if (PH(13)) { if (l + 1 < DEPTH) { const float* adn = ada + (size_t)(l + 1) * BATCH * 6 * D;
                thin_phase<true, true>(F, xo, xo, Yb, Hb, KIN(I_GPOSTMLP) + (size_t)l * D, adl + 5 * D, KIN(I_GPREMIX) + (size_t)(l + 1) * D, adn + D, adn); }
            else thin_phase<true, false>(F, xo, xo, Yb, nullptr, KIN(I_GPOSTMLP) + (size_t)l * D, adl + 5 * D, nullptr, nullptr, nullptr); }
        if (l + 1 < DEPTH) GRID_BAR();
    }
    if (blockIdx.x == 0 && F.tid == 0 && __hip_atomic_load((unsigned*)(ctl + CW_BAR) + XB_TMO, RLX_AGENT) != 0u) xo[0] = __builtin_nanf("");
}
#undef ada
#undef tab
#undef adap
#undef Hb
#undef PROJ
#undef CQ
#undef CKV
#undef KR
#undef QF
#undef KVF
#undef OSB
#undef MRG
#undef Yb
#undef U
#undef x_in
#undef wl
#undef adl


extern "C" void kernel_launch(void* const* d_in, const int* in_sizes, int n_in, void* d_out, int out_size, void* d_ws, size_t ws_size, hipStream_t stream) {
    static int grid = 0;
    if (grid == 0) {
        if (n_in != 19 || out_size != M * D || ws_size < WS_END) { fprintf(stderr, "kernel_launch: unexpected shapes (n_in %d, out %d, ws %zu < %zu)\n", n_in, out_size, ws_size, (size_t)WS_END); grid = -1; return; }
        int dev = 0, cus = 0, per_cu = 0;
        if (hipGetDevice(&dev) != hipSuccess || hipDeviceGetAttribute(&cus, hipDeviceAttributeMultiprocessorCount, dev) != hipSuccess) { grid = -1; return; }
        if (hipFuncSetAttribute((const void*)hybrid_fwd, hipFuncAttributeMaxDynamicSharedMemorySize, LDS_BYTES) != hipSuccess) { fprintf(stderr, "kernel_launch: hipFuncSetAttribute failed\n"); grid = -1; return; }
        if (hipOccupancyMaxActiveBlocksPerMultiprocessor(&per_cu, (const void*)hybrid_fwd, NWAVES * 64, LDS_BYTES) != hipSuccess || per_cu < 1) { fprintf(stderr, "kernel_launch: occupancy query says %d\n", per_cu); (void)hipGetLastError(); }
        grid = cus;
    }
    if (grid < 0) return;
    if (hipMemsetAsync((char*)d_ws + WS_CTL, 0, CTL_ZERO_BYTES, stream) != hipSuccess) return;
    Args a{};
    for (int i = 0; i < 19; ++i) a.in[i] = (const float*)d_in[i];
    a.out = (float*)d_out; a.ws = (unsigned char*)d_ws;
    hipLaunchKernelGGL(hybrid_fwd, dim3(grid), dim3(NWAVES * 64), LDS_BYTES, stream, a);
#ifdef DBG_CHECK
    hipLaunchKernelGGL(dbg_check, dim3(DBG_NCHK), dim3(256), 0, stream, a, (unsigned*)((char*)d_ws + 4096));
    hipLaunchKernelGGL(dbg_report, dim3(1), dim3(64), 0, stream, (float*)d_out, (const unsigned*)((char*)d_ws + 4096));
#endif
}
```

```cpp
#include <hip/hip_runtime.h>
#include <cstdio>
#include <cstdint>
#include <cmath>
#ifndef PG8_WGM
#define PG8_WGM 8
#endif
namespace pg8 {
#define PG8_LAS __attribute__((address_space(3)))
typedef unsigned short bf16_t;
typedef short bf16x8 __attribute__((ext_vector_type(8)));
typedef float f32x4 __attribute__((ext_vector_type(4)));
typedef unsigned u32x4 __attribute__((ext_vector_type(4)));
constexpr int BM = 256, BK = 64, HALF = 128, HTB = HALF * BK * 2  , STAGE_BYTES = 8 * HTB, NXCD = 8, WGM = PG8_WGM;

__host__ __device__ __forceinline__ int lds_byte(int r, int c) { const int st = (r >> 4) * 2 + (c >> 5), rr = r & 15, cc = c & 31, ob = rr * 64 + cc * 2; return st * 1024 + (ob ^ (((ob >> 9) & 1) << 5)); }
__host__ __device__ __forceinline__ void stage_rc(int b, int& R, int& C) { const int st = b / 1024, sb = b % 1024, swz = sb ^ (((sb >> 9) & 1) << 5); R = (st >> 1) * 16 + swz / 64; C = (st & 1) * 32 + (swz % 64) / 2; }
__host__ __device__ __forceinline__ int perm32(int rho) { const int n = rho >> 4, i = rho & 15; return 8 * (i >> 2) + 4 * n + (i & 3); }

struct Unit { int pm, pn; };
struct Gemm { const bf16_t* A; const bf16_t* Bt; int M, N, K; };

struct StaticOrder {
    int nM, nN, nwg, G, c;
    __host__ __device__ void init(int M, int N, int G_, int c_) { nM = M / BM; nN = N / BM; nwg = nM * nN; G = G_; c = c_; }
    __host__ __device__ bool next(int i, Unit& u) const {
        const long L = (long)i * G + c; if (L >= nwg) return false;
        int wgid = (int)L; { const int q = nwg / NXCD, r = nwg % NXCD, xcd = wgid % NXCD, off = wgid / NXCD; wgid = (xcd < r ? xcd * (q + 1) : r * (q + 1) + (xcd - r) * q) + off; }
        const int nig = WGM * nN, gid = wgid / nig, fm = gid * WGM, gsz = (nM - fm) < WGM ? (nM - fm) : WGM;
        u.pm = fm + ((wgid % nig) % gsz); u.pn = (wgid % nig) / gsz; return true;
    }
    __device__ __forceinline__ void a_ready(const Unit&) const {}
    __device__ __forceinline__ void done(const Unit&) const {}
};

struct UnevenOrder : StaticOrder {
    __host__ __device__ bool next(int i, Unit& u) const {
        long L; const int h = G / 2;
        if (c < h) { if (i > 0) return false; L = c; } else { if (i > 2) return false; L = h + (long)h * i + (c - h); }
        if (L >= nwg) return false;
        int wgid = (int)L; { const int q = nwg / NXCD, r = nwg % NXCD, xcd = wgid % NXCD, off = wgid / NXCD; wgid = (xcd < r ? xcd * (q + 1) : r * (q + 1) + (xcd - r) * q) + off; }
        const int nig = WGM * nN, gid = wgid / nig, fm = gid * WGM, gsz = (nM - fm) < WGM ? (nM - fm) : WGM;
        u.pm = fm + ((wgid % nig) % gsz); u.pn = (wgid % nig) / gsz; return true;
    }
};

__device__ __forceinline__ unsigned cvt_pk_bf16(float lo, float hi) { unsigned r; asm volatile("v_cvt_pk_bf16_f32 %0, %1, %2" : "=v"(r) : "v"(lo), "v"(hi)); return r; }
typedef float f32x2 __attribute__((ext_vector_type(2)));

__device__ __forceinline__ float bf_lo(unsigned w) { return __builtin_bit_cast(float, w << 16); }
__device__ __forceinline__ float bf_hi(unsigned w) { return __builtin_bit_cast(float, w & 0xffff0000u); }
__device__ __forceinline__ float sigmoidf_fast(float x) { return __builtin_amdgcn_rcpf(1.0f + __builtin_amdgcn_exp2f(-1.4426950408889634f * x)); }

template <int ACT  > struct EpiBf16 {
    static constexpr bool PERM = true, AFTER_DRAIN = false, MID = false;
    bf16_t* O; int ldc;
    __device__ __forceinline__ void operator()(const f32x4 (&acc)[2][2][4][2], const Unit& u, int wr, int wc, int fr, int fq) const {
        const int row0 = u.pm * BM + wr * 64 + fr, col0 = u.pn * BM + wc * 32 + 8 * fq;
#pragma unroll
        for (int ai = 0; ai < 2; ++ai)
#pragma unroll
            for (int m = 0; m < 4; ++m) { bf16_t* rowp = O + (size_t)(row0 + ai * HALF + m * 16) * ldc + col0;
#pragma unroll
                for (int bj = 0; bj < 2; ++bj) { f32x4 v0 = acc[ai][bj][m][0], v1 = acc[ai][bj][m][1];
                    if (ACT == 1) {
#pragma unroll
                        for (int j = 0; j < 4; ++j) { const float a = fmaxf(v0[j], 0.f), b = fmaxf(v1[j], 0.f); v0[j] = a * a; v1[j] = b * b; } }
                    u32x4 w; w.x = cvt_pk_bf16(v0[0], v0[1]); w.y = cvt_pk_bf16(v0[2], v0[3]); w.z = cvt_pk_bf16(v1[0], v1[1]); w.w = cvt_pk_bf16(v1[2], v1[3]);
                    *(u32x4*)(rowp + bj * HALF) = w;
                    } }
    }
};
struct EpiRope {
    static constexpr bool PERM = true, AFTER_DRAIN = false, MID = false;
    bf16_t* O; int ldc; const float* tab;
    __device__ __forceinline__ void operator()(const f32x4 (&acc)[2][2][4][2], const Unit& u, int wr, int wc, int fr, int fq) const {
        const int row0 = u.pm * BM + wr * 64 + fr, col0 = u.pn * BM + wc * 32 + 8 * fq;
#pragma unroll
        for (int ai = 0; ai < 2; ++ai)
#pragma unroll
            for (int m = 0; m < 4; ++m) { const int row = row0 + ai * HALF + m * 16; bf16_t* rowp = O + (size_t)row * ldc + col0;
#pragma unroll
                for (int bj = 0; bj < 2; ++bj) { f32x4 v0 = acc[ai][bj][m][0], v1 = acc[ai][bj][m][1];
                    const int j = (col0 + bj * HALF) % 192;
                    if (j >= 128) { const float* tp = tab + (size_t)row * 64 + (j - 128);
                        const f32x4 t0 = *(const f32x4*)tp, t1 = *(const f32x4*)(tp + 4);
                        f32x4 r0, r1;
                        r0[0] = v0[0] * t0[0] - v0[1] * t0[1]; r0[1] = v0[1] * t0[0] + v0[0] * t0[1];
                        r0[2] = v0[2] * t0[2] - v0[3] * t0[3]; r0[3] = v0[3] * t0[2] + v0[2] * t0[3];
                        r1[0] = v1[0] * t1[0] - v1[1] * t1[1]; r1[1] = v1[1] * t1[0] + v1[0] * t1[1];
                        r1[2] = v1[2] * t1[2] - v1[3] * t1[3]; r1[3] = v1[3] * t1[2] + v1[2] * t1[3];
                        v0 = r0; v1 = r1; }
                    u32x4 w; w.x = cvt_pk_bf16(v0[0], v0[1]); w.y = cvt_pk_bf16(v0[2], v0[3]); w.z = cvt_pk_bf16(v1[0], v1[1]); w.w = cvt_pk_bf16(v1[2], v1[3]);
                    *(u32x4*)(rowp + bj * HALF) = w; }
                asm volatile("" ::: "memory"); }
    }
};
struct EpiGateMerge {
    static constexpr bool PERM = true, AFTER_DRAIN = false, MID = true;
    bf16_t* O; int ldo; const bf16_t* G1; const bf16_t* G2; int ldg;
    __device__ __forceinline__ void mid(f32x4 (&acc)[2][2][4][2], const Unit& u, int wr, int wc, int fr, int fq) const {
        int fr_ = fr, fq_ = fq; asm volatile("" : "+v"(fr_), "+v"(fq_));
        const int row0 = u.pm * BM + wr * 64 + fr_, col0 = u.pn * BM + wc * 32 + 8 * fq_;
#pragma unroll
        for (int ai = 0; ai < 2; ++ai)
#pragma unroll
            for (int m = 0; m < 4; ++m) { const int row = row0 + ai * HALF + m * 16; const bf16_t* g1p = G1 + (size_t)row * ldg + col0; const bf16_t* g2p = G2 + (size_t)row * ldg + col0;
#pragma unroll
                for (int bj = 0; bj < 2; ++bj) { const u32x4 a = *(const u32x4*)(g1p + bj * HALF), b = *(const u32x4*)(g2p + bj * HALF);
                    const unsigned aw[4] = {a.x, a.y, a.z, a.w}, bw[4] = {b.x, b.y, b.z, b.w};
#pragma unroll
                    for (int q = 0; q < 4; ++q) {
                        const float r0 = (1.0f + __builtin_amdgcn_exp2f(-1.4426950408889634f * bf_lo(bw[q]))) * __builtin_amdgcn_rcpf(1.0f + __builtin_amdgcn_exp2f(-1.4426950408889634f * bf_lo(aw[q])));
                        const float r1 = (1.0f + __builtin_amdgcn_exp2f(-1.4426950408889634f * bf_hi(bw[q]))) * __builtin_amdgcn_rcpf(1.0f + __builtin_amdgcn_exp2f(-1.4426950408889634f * bf_hi(aw[q])));
                        acc[ai][bj][m][q >> 1][2 * (q & 1)] *= r0; acc[ai][bj][m][q >> 1][2 * (q & 1) + 1] *= r1; } }
                asm volatile("" ::: "memory"); }
    }
    __device__ __forceinline__ void operator()(const f32x4 (&acc)[2][2][4][2], const Unit& u, int wr, int wc, int fr, int fq) const {
        const int row0 = u.pm * BM + wr * 64 + fr, col0 = u.pn * BM + wc * 32 + 8 * fq;
#pragma unroll
        for (int ai = 0; ai < 2; ++ai)
#pragma unroll
            for (int m = 0; m < 4; ++m) { const int row = row0 + ai * HALF + m * 16; const bf16_t* gp = G2 + (size_t)row * ldg + col0; bf16_t* op = O + (size_t)row * ldo + col0;
#pragma unroll
                for (int bj = 0; bj < 2; ++bj) { const f32x4 v0 = acc[ai][bj][m][0], v1 = acc[ai][bj][m][1];
                    const u32x4 g = *(const u32x4*)(gp + bj * HALF);
                    u32x4 w; w.x = cvt_pk_bf16(v0[0] * sigmoidf_fast(bf_lo(g.x)), v0[1] * sigmoidf_fast(bf_hi(g.x))); w.y = cvt_pk_bf16(v0[2] * sigmoidf_fast(bf_lo(g.y)), v0[3] * sigmoidf_fast(bf_hi(g.y)));
                    w.z = cvt_pk_bf16(v1[0] * sigmoidf_fast(bf_lo(g.z)), v1[1] * sigmoidf_fast(bf_hi(g.z))); w.w = cvt_pk_bf16(v1[2] * sigmoidf_fast(bf_lo(g.w)), v1[3] * sigmoidf_fast(bf_hi(g.w)));
                    *(u32x4*)(op + bj * HALF) = w; }
                asm volatile("" ::: "memory"); }
    }
};

template <class Epi, class Sched, bool ALIGN_EPI = false, bool SP2 = false>
__device__ __forceinline__ void gemm_phase(PG8_LAS unsigned char* lds, const Gemm g, const Sched& S, const Epi& E) {
    int tid_ = threadIdx.x; asm volatile("" : "+v"(tid_));
    const int tid = tid_, wid = __builtin_amdgcn_readfirstlane(tid >> 6), lane = tid & 63, wr = wid >> 2, wc = wid & 3, fr = lane & 15, fq = lane >> 4;
    const int K = g.K, nt = K / BK;
    unsigned voffA[2], voffB[2];
#pragma unroll
    for (int i = 0; i < 2; ++i) { int R, C; stage_rc(tid * 16 + i * 8192, R, C); const int Rb = Epi::PERM ? ((R & ~31) + perm32(R & 31)) : R;
        voffA[i] = (unsigned)(R * K + C) * 2u; voffB[i] = (unsigned)(Rb * K + C) * 2u; }
    const size_t kstep = (size_t)(BK * 2);
    const size_t hstep = (size_t)HALF * K * 2;
    const size_t tstep = 2 * hstep;
    const unsigned ldsw = (unsigned)wid * 1024u;
    const int aoff = lds_byte(wr * 64 + fr, fq * 8), boff = lds_byte(wc * 32 + fr, fq * 8);
#define PG8_SA(b, h) (((b) * 2 + (h)) * HTB)
#define PG8_SB(b, h) ((4 + (b) * 2 + (h)) * HTB)
#define PG8_STAGE(bufoff, gbase, voff) do { _Pragma("unroll") for (int _i = 0; _i < 2; ++_i) \
        __builtin_amdgcn_global_load_lds((const unsigned*)((const char*)(gbase) + (voff)[_i]), (PG8_LAS unsigned*)(lds + (bufoff) + ldsw + _i * 8192), 16, 0, 0); } while (0)
#define PG8_LDA(dst, b, h) do { _Pragma("unroll") for (int m = 0; m < 4; ++m) _Pragma("unroll") for (int k = 0; k < 2; ++k) dst[m][k] = *(const PG8_LAS bf16x8*)(lds + PG8_SA(b, h) + aoff + m * 2048 + k * 1024); } while (0)
#define PG8_LDB(dst, b, h) do { _Pragma("unroll") for (int n = 0; n < 2; ++n) _Pragma("unroll") for (int k = 0; k < 2; ++k) dst[n][k] = *(const PG8_LAS bf16x8*)(lds + PG8_SB(b, h) + boff + n * 2048 + k * 1024); } while (0)
#ifndef PG8_PRIO
#define PG8_PRIO 1
#endif
#define PG8_MMA(ai, bj, At, Bt) do { if (PG8_PRIO) __builtin_amdgcn_s_setprio(PG8_PRIO); _Pragma("unroll") for (int m = 0; m < 4; ++m) _Pragma("unroll") for (int n = 0; n < 2; ++n) _Pragma("unroll") for (int k = 0; k < 2; ++k) \
        acc[ai][bj][m][n] = __builtin_amdgcn_mfma_f32_16x16x32_bf16(Bt[n][k], At[m][k], acc[ai][bj][m][n], 0, 0, 0); if (PG8_PRIO) __builtin_amdgcn_s_setprio(0); } while (0)
#define PG8_WAIT_V(n) asm volatile("s_waitcnt vmcnt(" #n ")" ::: "memory")
#define PG8_WAIT_L(n) asm volatile("s_waitcnt lgkmcnt(" #n ")" ::: "memory")
#define PG8_BAR __builtin_amdgcn_s_barrier()
#define PG8_SCHED __builtin_amdgcn_sched_barrier(0)
    Unit cur, nxt; int ui = 0;
    if (!S.next(0, cur)) return;
    f32x4 acc[2][2][4][2];
#pragma unroll
    for (int a = 0; a < 2; ++a)
#pragma unroll
        for (int b = 0; b < 2; ++b)
#pragma unroll
            for (int m = 0; m < 4; ++m)
#pragma unroll
                for (int n = 0; n < 2; ++n) acc[a][b][m][n] = (f32x4){0.f, 0.f, 0.f, 0.f};
    bf16x8 At[4][2], B0[2][2], B1[2][2];
    const char* cA = (const char*)g.A + (size_t)cur.pm * tstep; const char* cB = (const char*)g.Bt + (size_t)cur.pn * tstep;
    S.a_ready(cur);
    if constexpr (SP2) {
        PG8_STAGE(PG8_SB(0, 0), cB, voffB); PG8_STAGE(PG8_SB(0, 1), cB + hstep, voffB); PG8_STAGE(PG8_SA(0, 0), cA, voffA); PG8_STAGE(PG8_SA(0, 1), cA + hstep, voffA);
        if (wr == 1) PG8_BAR;
        PG8_WAIT_V(2); PG8_BAR;
        PG8_STAGE(PG8_SB(1, 0), cB + kstep, voffB); PG8_STAGE(PG8_SA(1, 0), cA + kstep, voffA); PG8_STAGE(PG8_SB(1, 1), cB + hstep + kstep, voffB);
        PG8_WAIT_V(6); PG8_BAR;
    } else {
        PG8_STAGE(PG8_SB(0, 0), cB, voffB); PG8_STAGE(PG8_SA(0, 0), cA, voffA); PG8_STAGE(PG8_SB(0, 1), cB + hstep, voffB); PG8_STAGE(PG8_SA(0, 1), cA + hstep, voffA);
        if (wr == 1) PG8_BAR;
        PG8_WAIT_V(4); PG8_BAR;
        PG8_STAGE(PG8_SB(1, 0), cB + kstep, voffB); PG8_STAGE(PG8_SA(1, 0), cA + kstep, voffA); PG8_STAGE(PG8_SB(1, 1), cB + hstep + kstep, voffB);
        PG8_WAIT_V(6); PG8_BAR;
    }
    for (;;) {
        const bool has_next = S.next(ui + 1, nxt);
        const char* nA = has_next ? (const char*)g.A + (size_t)nxt.pm * tstep : cA; const char* nB = has_next ? (const char*)g.Bt + (size_t)nxt.pn * tstep : cB;
        for (int t = 0; t < nt; t += 2) {
            const bool last = (t == nt - 2);
            const char* a1 = cA + (size_t)(t + 1) * kstep;
            const char* a2 = last ? nA : cA + (size_t)(t + 2) * kstep; const char* b2 = last ? nB : cB + (size_t)(t + 2) * kstep;
            const char* a3 = a2 + kstep; const char* b3 = b2 + kstep;
            if (last && has_next) S.a_ready(nxt);
            if constexpr (Epi::MID) { if (t == (nt >> 1)) E.mid(acc, cur, wr, wc, fr, fq); }
            if constexpr (SP2) {
            PG8_LDB(B0, 0, 0); PG8_LDB(B1, 0, 1); PG8_SCHED; PG8_LDA(At, 0, 0); PG8_STAGE(PG8_SA(1, 1), a1 + hstep, voffA);
            PG8_WAIT_V(8); PG8_WAIT_L(0); PG8_BAR; PG8_MMA(0, 0, At, B0); PG8_MMA(0, 1, At, B1); PG8_BAR; PG8_SCHED;
            PG8_LDA(At, 0, 1); PG8_STAGE(PG8_SB(0, 0), b2, voffB); PG8_STAGE(PG8_SB(0, 1), b2 + hstep, voffB); PG8_STAGE(PG8_SA(0, 0), a2, voffA);
            PG8_WAIT_V(8); PG8_WAIT_L(0); PG8_BAR; PG8_MMA(1, 0, At, B0); PG8_MMA(1, 1, At, B1); PG8_BAR; PG8_SCHED;
            PG8_LDB(B0, 1, 0); PG8_LDB(B1, 1, 1); PG8_SCHED; PG8_LDA(At, 1, 0); PG8_STAGE(PG8_SA(0, 1), a2 + hstep, voffA);
            PG8_WAIT_V(8); PG8_WAIT_L(0); PG8_BAR; PG8_MMA(0, 0, At, B0); PG8_MMA(0, 1, At, B1); PG8_BAR; PG8_SCHED;
            PG8_LDA(At, 1, 1); PG8_STAGE(PG8_SB(1, 0), b3, voffB); PG8_STAGE(PG8_SB(1, 1), b3 + hstep, voffB); PG8_STAGE(PG8_SA(1, 0), a3, voffA);
            PG8_WAIT_V(8); PG8_WAIT_L(0); PG8_BAR; PG8_MMA(1, 0, At, B0); PG8_MMA(1, 1, At, B1); PG8_BAR; PG8_SCHED;
            } else {
            PG8_LDB(B0, 0, 0); PG8_SCHED; PG8_LDA(At, 0, 0); PG8_STAGE(PG8_SA(1, 1), a1 + hstep, voffA);
            PG8_WAIT_L(8); PG8_BAR; PG8_WAIT_L(0); PG8_MMA(0, 0, At, B0); PG8_BAR; PG8_SCHED;
            PG8_LDB(B1, 0, 1); PG8_STAGE(PG8_SB(0, 0), b2, voffB);
            PG8_BAR; PG8_WAIT_L(0); PG8_MMA(0, 1, At, B1); PG8_BAR;
            PG8_LDA(At, 0, 1); PG8_STAGE(PG8_SA(0, 0), a2, voffA);
            PG8_BAR; PG8_WAIT_L(0); PG8_MMA(1, 0, At, B0); PG8_BAR; PG8_SCHED;
            PG8_STAGE(PG8_SB(0, 1), b2 + hstep, voffB);
            PG8_WAIT_V(6); PG8_BAR; PG8_MMA(1, 1, At, B1); PG8_BAR;
            PG8_LDB(B0, 1, 0); PG8_SCHED; PG8_LDA(At, 1, 0); PG8_STAGE(PG8_SA(0, 1), a2 + hstep, voffA);
            PG8_WAIT_L(8); PG8_BAR; PG8_WAIT_L(0); PG8_MMA(0, 0, At, B0); PG8_BAR; PG8_SCHED;
            PG8_LDB(B1, 1, 1); PG8_STAGE(PG8_SB(1, 0), b3, voffB);
            PG8_BAR; PG8_WAIT_L(0); PG8_MMA(0, 1, At, B1); PG8_BAR;
            PG8_LDA(At, 1, 1); PG8_STAGE(PG8_SA(1, 0), a3, voffA);
            PG8_BAR; PG8_WAIT_L(0); PG8_MMA(1, 0, At, B0); PG8_BAR; PG8_SCHED;
            PG8_STAGE(PG8_SB(1, 1), b3 + hstep, voffB);
            PG8_WAIT_V(6); PG8_BAR; PG8_MMA(1, 1, At, B1); PG8_BAR;
            }
        }
        if constexpr (ALIGN_EPI) { if (wr == 0) PG8_BAR; }
        if constexpr (!Epi::AFTER_DRAIN) { E(acc, cur, wr, wc, fr, fq); S.done(cur); }
        if (!has_next) break;
#pragma unroll
        for (int a = 0; a < 2; ++a)
#pragma unroll
            for (int b = 0; b < 2; ++b)
#pragma unroll
                for (int m = 0; m < 4; ++m)
#pragma unroll
                    for (int n = 0; n < 2; ++n) acc[a][b][m][n] = (f32x4){0.f, 0.f, 0.f, 0.f};
        cur = nxt; cA = nA; cB = nB; ++ui;
        if constexpr (ALIGN_EPI) { if (wr == 1) PG8_BAR; }
    }
    PG8_WAIT_V(0);
    if constexpr (!ALIGN_EPI) { if (wr == 0) PG8_BAR; }
    PG8_BAR;
    if constexpr (Epi::AFTER_DRAIN) { E.fused(acc, cur, wr, wc, fr, fq, lds, wid, lane); S.done(cur); }
#undef PG8_SA
#undef PG8_SB
#undef PG8_STAGE
#undef PG8_LDA
#undef PG8_LDB
#undef PG8_MMA
#undef PG8_WAIT_V
#undef PG8_WAIT_L
#undef PG8_BAR
#undef PG8_SCHED
}
}

namespace att {
#define ATT_LAS __attribute__((address_space(3)))
typedef unsigned short bf16_t;
typedef short bf16x8 __attribute__((ext_vector_type(8)));
typedef short s16x4 __attribute__((ext_vector_type(4)));
typedef float f32x16 __attribute__((ext_vector_type(16)));
typedef unsigned u32x4 __attribute__((ext_vector_type(4)));
constexpr int SHM_V = 16384, SHM_K = 16384, SHM_R = 8192, BUFB = SHM_V + SHM_K + SHM_R;
constexpr int LDS_SCR = 2 * BUFB;
constexpr int LDS_FLAGS = LDS_SCR + 8 * 256;
constexpr int LDS_QR = LDS_FLAGS + 64;
constexpr int ATT_LDS_BYTES = LDS_QR + 8 * 4096;
#define KSWZ(row, colB) ((row) * 256 + ((colB) ^ (((row) & 7) << 4)))
#define RSWZ(row, colB) ((row) * 128 + ((colB) ^ ((((row) >> 1) & 7) << 4)))
__device__ __forceinline__ int v_st(int k, int c) { const int kk = (k & ~0xC) | ((k & 4) << 1) | ((k & 8) >> 1); return ((kk >> 3) * 4 + (c >> 5)) * 512 + ((kk & 7) * 32 + (c & 31)) * 2; }
__device__ __forceinline__ int v_rd_base(int lane) { return ((lane & 3) << 3) | (((lane >> 2) & 3) << 6) | (((lane >> 4) & 1) << 5) | (((lane >> 5) & 1) << 8); }
constexpr int v_rd_off(int d0, int ks, int half) { return d0 * 512 + ks * 4096 + half * 2048; }
__device__ __forceinline__ int crow(int r, int hi) { return (r & 3) + 8 * (r >> 2) + 4 * hi; }
__device__ __forceinline__ unsigned cvtpk(float lo, float hi) { unsigned r; asm volatile("v_cvt_pk_bf16_f32 %0, %1, %2" : "=v"(r) : "v"(lo), "v"(hi)); return r; }
#define ATT_SBAR() __builtin_amdgcn_sched_barrier(0)
#ifndef ATT_PRIO
#define ATT_PRIO 0
#endif
#ifndef ATT_EARLYW
#define ATT_EARLYW 0
#endif

template <int ND>
__device__ __forceinline__ void qkt_half(f32x16& p, const ATT_LAS char* Kb, const ATT_LAS char* Rb, int r32, int hi, const bf16x8* qr, const ATT_LAS char* qrl, int lane, int half) {
    bf16x8 kf[8];
#pragma unroll
    for (int d0 = 0; d0 < 8; ++d0) kf[d0] = *(const ATT_LAS bf16x8*)(Kb + KSWZ(r32, ((d0 & 3) * 16 + hi * 8) * 2) + (d0 >> 2) * 128 + half * (32 * 256));
    ATT_SBAR();
    p = f32x16{};
    if constexpr (ND == 12) {
        bf16x8 rf[4], qf[4];
#pragma unroll
        for (int d0 = 0; d0 < 4; ++d0) p = __builtin_amdgcn_mfma_f32_32x32x16_bf16(kf[d0], qr[d0], p, 0, 0, 0);
        ATT_SBAR();
#pragma unroll
        for (int dr = 0; dr < 4; ++dr) { rf[dr] = *(const ATT_LAS bf16x8*)(Rb + RSWZ(r32, (dr * 16 + hi * 8) * 2) + half * (32 * 128)); qf[dr] = *(const ATT_LAS bf16x8*)(qrl + dr * 1024 + lane * 16); }
        ATT_SBAR();
#pragma unroll
        for (int d0 = 4; d0 < 8; ++d0) p = __builtin_amdgcn_mfma_f32_32x32x16_bf16(kf[d0], qr[d0], p, 0, 0, 0);
#pragma unroll
        for (int dr = 0; dr < 4; ++dr) p = __builtin_amdgcn_mfma_f32_32x32x16_bf16(rf[dr], qf[dr], p, 0, 0, 0);
    } else {
#pragma unroll
        for (int d0 = 0; d0 < 8; ++d0) p = __builtin_amdgcn_mfma_f32_32x32x16_bf16(kf[d0], qr[d0], p, 0, 0, 0);
    }
}
__device__ __forceinline__ void pv_tile(f32x16* o, int vb, bf16x8 pa0, bf16x8 pa1, bf16x8 pa2, bf16x8 pa3) {
#define ATT_TRRD(dst, off) asm volatile("ds_read_b64_tr_b16 %0, %1 offset:%2" : "=&v"(dst) : "v"(vb), "i"(off) : "memory")
#define ATT_PV_D0(d0) do { s16x4 l0, l1, l2, l3, h0, h1, h2, h3; constexpr int b_ = v_rd_off(d0, 0, 0); \
        ATT_TRRD(l0, b_); ATT_TRRD(h0, b_ + 2048); ATT_TRRD(l1, b_ + 4096); ATT_TRRD(h1, b_ + 6144); ATT_TRRD(l2, b_ + 8192); ATT_TRRD(h2, b_ + 10240); ATT_TRRD(l3, b_ + 12288); ATT_TRRD(h3, b_ + 14336); \
        asm volatile("s_waitcnt lgkmcnt(0)" ::: "memory"); ATT_SBAR(); \
        o[d0] = __builtin_amdgcn_mfma_f32_32x32x16_bf16(pa0, (bf16x8){l0[0], l0[1], l0[2], l0[3], h0[0], h0[1], h0[2], h0[3]}, o[d0], 0, 0, 0); \
        o[d0] = __builtin_amdgcn_mfma_f32_32x32x16_bf16(pa1, (bf16x8){l1[0], l1[1], l1[2], l1[3], h1[0], h1[1], h1[2], h1[3]}, o[d0], 0, 0, 0); \
        o[d0] = __builtin_amdgcn_mfma_f32_32x32x16_bf16(pa2, (bf16x8){l2[0], l2[1], l2[2], l2[3], h2[0], h2[1], h2[2], h2[3]}, o[d0], 0, 0, 0); \
        o[d0] = __builtin_amdgcn_mfma_f32_32x32x16_bf16(pa3, (bf16x8){l3[0], l3[1], l3[2], l3[3], h3[0], h3[1], h3[2], h3[3]}, o[d0], 0, 0, 0); } while (0)
    if (ATT_PRIO) __builtin_amdgcn_s_setprio(1);
    ATT_PV_D0(0); ATT_PV_D0(1); ATT_PV_D0(2); ATT_PV_D0(3);
    if (ATT_PRIO) __builtin_amdgcn_s_setprio(0);
#undef ATT_PV_D0
#undef ATT_TRRD
}
__device__ __forceinline__ void pack_half(const f32x16& p, bf16x8& pa0, bf16x8& pa1) {
#define ATT_PK4(P, B_, OUT) do { unsigned a0 = cvtpk(P[B_+0], P[B_+1]), a1 = cvtpk(P[B_+2], P[B_+3]); \
        unsigned b0 = cvtpk(P[B_+4], P[B_+5]), b1 = cvtpk(P[B_+6], P[B_+7]); \
        auto r0 = __builtin_amdgcn_permlane32_swap(a0, b0, false, false); auto r1 = __builtin_amdgcn_permlane32_swap(a1, b1, false, false); \
        u32x4 w = {r0[0], r1[0], r0[1], r1[1]}; OUT = __builtin_bit_cast(bf16x8, w); } while (0)
    ATT_PK4(p, 0, pa0); ATT_PK4(p, 8, pa1);
#undef ATT_PK4
}
__device__ __forceinline__ void half_xchg(float x, float& lo, float& hi) {
    unsigned a = __builtin_bit_cast(unsigned, x), b;
    asm volatile("s_nop 1\n\tv_mov_b32 %1, %0\n\ts_nop 1\n\tv_permlane32_swap_b32 %0, %1" : "+v"(a), "=&v"(b));
    lo = __builtin_bit_cast(float, a); hi = __builtin_bit_cast(float, b);
}
__device__ __forceinline__ float half_sum(float v) { float lo, hi; half_xchg(v, lo, hi); return lo + hi; }
__device__ __forceinline__ float half_max(float v) { float lo, hi; half_xchg(v, lo, hi); return fmaxf(lo, hi); }

struct Tensors { const bf16_t* Q; int ldq; const bf16_t* K; int ldk; const bf16_t* V; int ldv; const bf16_t* R; bf16_t* O; int ldo; };

template <int MODE>
__device__ __forceinline__ void attn_unit(const Tensors& T, int qb, float sc2, ATT_LAS char* lds) {
    constexpr int ND = MODE == 1 ? 12 : 8;
    int tid_ = threadIdx.x; asm volatile("" : "+v"(tid_));
    const int tid = tid_, wid = __builtin_amdgcn_readfirstlane(tid >> 6), lane = tid & 63, r32 = lane & 31, hi = lane >> 5;
    const int q0 = qb * 256, qw = q0 + wid * 32;
    const int NT = 4 * (qb + 1);
    const int wlast = 4 * qb + (wid >> 1);
    const int tq = qw + r32;
    ATT_LAS float* scr = (ATT_LAS float*)(lds + LDS_SCR) + wid * 64;
    volatile ATT_LAS unsigned* flags = (volatile ATT_LAS unsigned*)(lds + LDS_FLAGS);
    const ATT_LAS char* qrl = lds + LDS_QR + wid * 4096;
    bf16x8 qr[8];
    { const bf16_t* qp = T.Q + (size_t)tq * T.ldq + hi * 8;
#pragma unroll
      for (int d0 = 0; d0 < 8; ++d0) qr[d0] = *(const bf16x8*)(qp + d0 * 16);
      if constexpr (MODE == 1) {
#pragma unroll
          for (int dr = 0; dr < 4; ++dr) *(ATT_LAS bf16x8*)(lds + LDS_QR + wid * 4096 + dr * 1024 + lane * 16) = *(const bf16x8*)(qp + 128 + dr * 16); } }
    const int sr = tid >> 4, sc = (tid & 15) * 8, kws = KSWZ(sr, sc * 2), vst0 = v_st(sr, sc), vst1 = v_st(32 + sr, sc);
    const int rr_ = tid >> 3, rc = (tid & 7) * 8, rws = RSWZ(rr_, rc * 2);
    bf16x8 sk0, sk1, sv0, sv1, srp;
#define ATT_LOAD(kt) do { const size_t k0_ = (size_t)(kt) * 64; \
        sk0 = *(const bf16x8*)(T.K + (k0_ + sr) * T.ldk + sc); sk1 = *(const bf16x8*)(T.K + (k0_ + 32 + sr) * T.ldk + sc); \
        sv0 = *(const bf16x8*)(T.V + (k0_ + sr) * T.ldv + sc); sv1 = *(const bf16x8*)(T.V + (k0_ + 32 + sr) * T.ldv + sc); \
        if constexpr (MODE == 1) srp = *(const bf16x8*)(T.R + (k0_ + rr_) * 64 + rc); } while (0)
#define ATT_WRITE(bf) do { ATT_LAS char* b_ = lds + (bf) * BUFB; \
        *(ATT_LAS bf16x8*)(b_ + vst0) = sv0; *(ATT_LAS bf16x8*)(b_ + vst1) = sv1; \
        *(ATT_LAS bf16x8*)(b_ + SHM_V + kws) = sk0; *(ATT_LAS bf16x8*)(b_ + SHM_V + kws + 32 * 256) = sk1; \
        if constexpr (MODE == 1) *(ATT_LAS bf16x8*)(b_ + SHM_V + SHM_K + rws) = srp; } while (0)
#define ATT_TILE(it) (MODE == 0 ? (NT - 1 - (it)) : (it))
    f32x16 o[4] = {};
    float carry = 0.f;
    float m_reg = -1e30f, l_reg = 0.f;
    bool dead = false;
    const float hsel = hi ? 0.f : 1.f;
    ATT_LOAD(ATT_TILE(0)); asm volatile("s_waitcnt vmcnt(0)" ::: "memory"); ATT_WRITE(0);
    __syncthreads();
    for (int it = 0; it < NT; ++it) {
        const int cur = it & 1, kt = ATT_TILE(it), kb = kt * 64;
        if (it + 1 < NT) ATT_LOAD(ATT_TILE(it + 1));
        const ATT_LAS char* bufp = lds + cur * BUFB;
        bool staged = false;
        if (kt <= wlast && !dead) {
            f32x16 p0, p1;
            bf16x8 pa0, pa1, pa2, pa3;
            if constexpr (MODE == 0) {
                const bool diag = (kb + 63 >= qw);
                qkt_half<ND>(p1, bufp + SHM_V, bufp + SHM_V + SHM_K, r32, hi, qr, qrl, lane, 1);
                qkt_half<ND>(p0, bufp + SHM_V, bufp + SHM_V + SHM_K, r32, hi, qr, qrl, lane, 0);
                float tsum = carry;
#define ATT_SB_HALF(P, KOFF) do { f32x16 f; \
                    _Pragma("unroll") for (int r = 0; r < 16; ++r) { P[r] *= sc2; \
                        f[r] = fminf(-P[r], 0.f) - __builtin_amdgcn_logf(1.0f + __builtin_amdgcn_exp2f(-__builtin_fabsf(P[r]))); } \
                    if (diag) { _Pragma("unroll") for (int r = 0; r < 16; ++r) { if (kb + (KOFF) + crow(r, hi) >= tq) f[r] = 0.f; } } \
                    float gs_[4], oh_[4], ps_[4]; \
                    _Pragma("unroll") for (int i = 0; i < 4; ++i) { f[4*i+2] += f[4*i+3]; f[4*i+1] += f[4*i+2]; f[4*i] += f[4*i+1]; gs_[i] = f[4*i]; } \
                    _Pragma("unroll") for (int i = 0; i < 4; ++i) { float lo_; half_xchg(gs_[i], lo_, oh_[i]); ps_[i] = lo_ + oh_[i]; } \
                    _Pragma("unroll") for (int i = 3; i >= 0; --i) { const float Tg = tsum + hsel * oh_[i]; \
                        _Pragma("unroll") for (int e = 0; e < 4; ++e) P[4*i+e] = __builtin_amdgcn_exp2f(P[4*i+e] + f[4*i+e] + Tg); \
                        tsum += ps_[i]; } \
                    if (diag) { _Pragma("unroll") for (int r = 0; r < 16; ++r) { if (kb + (KOFF) + crow(r, hi) >= tq) P[r] = 0.f; } } } while (0)
                ATT_SB_HALF(p1, 32);
                pack_half(p1, pa2, pa3);
                ATT_SB_HALF(p0, 0);
                pack_half(p0, pa0, pa1);
#undef ATT_SB_HALF
                carry = tsum;
                pv_tile(o, (int)(uintptr_t)(bufp) + v_rd_base(lane), pa0, pa1, pa2, pa3);
                if (__all(carry < -140.f)) dead = true;
            } else {
                qkt_half<ND>(p0, bufp + SHM_V, bufp + SHM_V + SHM_K, r32, hi, qr, qrl, lane, 0);
                qkt_half<ND>(p1, bufp + SHM_V, bufp + SHM_V + SHM_K, r32, hi, qr, qrl, lane, 1);
                float pmax = p0[0];
#pragma unroll
                for (int r = 1; r < 16; ++r) pmax = fmaxf(pmax, p0[r]);
#pragma unroll
                for (int r = 0; r < 16; ++r) pmax = fmaxf(pmax, p1[r]);
                pmax = half_max(pmax);
                const float mn = fmaxf(m_reg, pmax), alpha = __builtin_amdgcn_exp2f((m_reg - mn) * sc2); m_reg = mn;
                const float mnL = -mn * sc2;
                float psum = 0.f;
#pragma unroll
                for (int r = 0; r < 16; ++r) { p0[r] = __builtin_amdgcn_exp2f(fmaf(p0[r], sc2, mnL)); psum += p0[r]; }
                pack_half(p0, pa0, pa1);
#pragma unroll
                for (int r = 0; r < 16; ++r) { p1[r] = __builtin_amdgcn_exp2f(fmaf(p1[r], sc2, mnL)); psum += p1[r]; }
                pack_half(p1, pa2, pa3);
                l_reg = l_reg * alpha + half_sum(psum);
                if (__any(alpha < 1.f))
                { if (hi == 0) scr[r32] = alpha; asm volatile("s_waitcnt lgkmcnt(0)" ::: "memory");
#pragma unroll
                    for (int r = 0; r < 16; ++r) { const float a = scr[crow(r, hi)];
#pragma unroll
                        for (int d = 0; d < 4; ++d) o[d][r] *= a; } }
#if ATT_EARLYW
                if (it + 1 < NT) { asm volatile("s_waitcnt vmcnt(0)" ::: "memory"); ATT_WRITE(cur ^ 1); staged = true; }
#endif
                pv_tile(o, (int)(uintptr_t)(bufp) + v_rd_base(lane), pa0, pa1, pa2, pa3);
            }
        }
        if (it + 1 < NT && !staged) { asm volatile("s_waitcnt vmcnt(0)" ::: "memory"); ATT_WRITE(cur ^ 1); }
        if constexpr (MODE == 0) { if (lane == 0) flags[cur * 8 + wid] = dead ? 1u : 0u; }
        __syncthreads();
        if constexpr (MODE == 0) {
            unsigned alld = 1u;
#pragma unroll
            for (int w = 0; w < 8; ++w) alld &= flags[cur * 8 + w];
            if (alld) break;
        }
    }
    if constexpr (MODE == 1) { if (hi == 0) scr[32 + r32] = l_reg; asm volatile("s_waitcnt lgkmcnt(0)" ::: "memory"); }
    bf16_t* Ow = T.O + (size_t)qw * T.ldo;
    int obase = 4 * hi * T.ldo + r32; asm volatile("" : "+v"(obase));
#pragma unroll
    for (int r = 0; r < 16; ++r) { const int orow = crow(r, hi);
        float rl = 1.f; if constexpr (MODE == 1) rl = __builtin_amdgcn_rcpf(scr[32 + orow]);
        int ro = obase + ((r & 3) + 8 * (r >> 2)) * T.ldo; asm volatile("" : "+v"(ro));
#pragma unroll
        for (int d0 = 0; d0 < 4; ++d0) { const float v = o[d0][r] * rl; const float vn = __shfl_xor(v, 1);
            if ((r32 & 1) == 0) *(unsigned*)(Ow + ro + d0 * 32) = cvtpk(v, vn); } }
    __syncthreads();
#undef ATT_LOAD
#undef ATT_WRITE
#undef ATT_TILE
}
}

constexpr int BATCH = 2, SEQ = 4096, D = 4096, M = BATCH * SEQ, DEPTH = 2;
constexpr int SBW = 2048, QRANK = 1024, KVRANK = 512, ROPE = 64, DFF = 16384;
constexpr int IN_W = 3 * SBW + QRANK + KVRANK + ROPE + 2 * D;
constexpr int C_QD = 3 * SBW, C_KVD = C_QD + QRANK, C_GATE_SRC = C_KVD + KVRANK + ROPE;
constexpr int C_GSB = 7936, C_GMLA = C_GSB + D, PROJ_W = C_GMLA + D;
constexpr int QW = 16 * 192, KVW = 16 * 256;
constexpr float EPS = 1e-6f;
static_assert(IN_W == 15936 && PROJ_W == 16128 && PROJ_W % 256 == 0 && C_GSB % 256 == 0, "projection layout");

constexpr size_t MiB = 1u << 20;
constexpr size_t WS_CTL = 0, CTL_ZERO_BYTES = 1 * MiB;
constexpr size_t WS_ADA = 1 * MiB;
constexpr size_t WS_TAB = 2 * MiB;
constexpr size_t WS_ADAP = 4 * MiB;
constexpr size_t WS_W = 32 * MiB;
constexpr size_t W_IN = 0, W_UQ = 126 * MiB, W_UKV = 132 * MiB, W_OSB = 136 * MiB, W_OMLA = 152 * MiB, W_OUT = 168 * MiB, W_UP = 200 * MiB, W_DOWN = 328 * MiB, W_LAYER = 456 * MiB;
constexpr size_t WS_ACT = WS_W + DEPTH * W_LAYER;
constexpr size_t A_H = WS_ACT, A_PROJ = A_H + 64 * MiB, A_CQ = A_PROJ + 252 * MiB, A_CKV = A_CQ + 16 * MiB, A_KR = A_CKV + 8 * MiB, A_Q = A_KR + 1 * MiB, A_KV = A_Q + 48 * MiB,
                 A_OSB = A_KV + 64 * MiB, A_OMLA = A_OSB + 32 * MiB, A_TMP = A_OMLA + 32 * MiB, A_MRG = A_TMP + 128 * MiB, A_Y = A_MRG + 64 * MiB, A_U = A_Y + 128 * MiB, WS_END = A_U + 256 * MiB;
static_assert((size_t)PROJ_W * D * 2 == 126 * MiB && (size_t)M * PROJ_W * 2 == 252 * MiB, "sizes");
constexpr int CW_TMO = 0;
constexpr int CW_BAR = 4096;

constexpr int RING_BYTES = 135168;
constexpr int LDSCTL_OFF = RING_BYTES, MISC_OFF = LDSCTL_OFF + 320;
constexpr int LDS_BYTES = RING_BYTES + 1024;
constexpr int NWAVES = 8;
static_assert(att::ATT_LDS_BYTES <= RING_BYTES && pg8::STAGE_BYTES <= RING_BYTES, "LDS map");

#define GAS __attribute__((address_space(1)))
#define LAS __attribute__((address_space(3)))
typedef unsigned short bf16;
typedef unsigned v4u __attribute__((ext_vector_type(4)));
typedef unsigned v2u __attribute__((ext_vector_type(2)));
typedef float f32x4 __attribute__((ext_vector_type(4)));
typedef GAS unsigned gu32;
#define RLX_AGENT __ATOMIC_RELAXED, __HIP_MEMORY_SCOPE_AGENT
#define LDS_WAIT() asm volatile("s_waitcnt lgkmcnt(0)" ::: "memory")
#define VM_WAIT() asm volatile("s_waitcnt vmcnt(0)" ::: "memory")
__device__ __forceinline__ unsigned pk2(float lo, float hi) { return pg8::cvt_pk_bf16(lo, hi); }
__device__ __forceinline__ float bflo(unsigned w) { return __builtin_bit_cast(float, w << 16); }
__device__ __forceinline__ float bfhi(unsigned w) { return __builtin_bit_cast(float, w & 0xffff0000u); }

#define XB_TMO      128
#define XB_XCNT(j)  (256  + 64 * (j))
#define XB_XSUB(j)  (1280 + 64 * (j))
#define XB_XGEN(j)  (2304 + 64 * (j))
#define XB_TOP      3328
#define XB_TOPGEN   3392
#define XCD_BAR_WORDS 3456
#define XB_SPIN_CAP (1u << 21)

__device__ __forceinline__ unsigned xb_ld(unsigned* p)              { return __hip_atomic_load(p, __ATOMIC_RELAXED, __HIP_MEMORY_SCOPE_AGENT); }
__device__ __forceinline__ unsigned xb_add(unsigned* p, unsigned v) { return __hip_atomic_fetch_add(p, v, __ATOMIC_RELAXED, __HIP_MEMORY_SCOPE_AGENT); }
__device__ __forceinline__ unsigned xb_xcc_id() { return (unsigned)__builtin_amdgcn_s_getreg((3 << 11) | 20) & 0xFu; }
#define XB_SPIN(cond, bar) do { unsigned _sp = 0; while (cond) { __builtin_amdgcn_s_sleep(1); \
    if ((++_sp & 255u) == 0u) { if (xb_ld(&(bar)[XB_TMO])) break; if (_sp > XB_SPIN_CAP) { atomicAdd(&(bar)[XB_TMO], 1u); break; } } } } while (0)

struct XcdBarrier {
    unsigned* bar; unsigned x;
    volatile LAS unsigned* st;
};

__device__ __forceinline__ XcdBarrier xcd_barrier_post(unsigned* bar, volatile LAS unsigned* st) {
    XcdBarrier b; b.bar = bar; b.x = xb_xcc_id(); b.st = st;
    if (threadIdx.x == 0) (void)xb_add(&bar[XB_XCNT(b.x)], 1u);
    return b;
}
__device__ __forceinline__ void xcd_barrier_complete(unsigned* bar, unsigned x, unsigned& nloc, unsigned& nx) {
    const unsigned G = gridDim.x * gridDim.y * gridDim.z;
    unsigned sum, cnt, mine, sp = 0u;
    for (;;) {
        sum = 0u; cnt = 0u; mine = 0u;
#pragma unroll
        for (unsigned j = 0; j < 16; ++j) { const unsigned c = xb_ld(&bar[XB_XCNT(j)]); sum += c; cnt += (c > 0u) ? 1u : 0u; mine = (j == x) ? c : mine; }
        if (sum == G) break;
        __builtin_amdgcn_s_sleep(1);
        if ((++sp & 255u) == 0u) { if (xb_ld(&bar[XB_TMO])) break; if (sp > XB_SPIN_CAP) { atomicAdd(&bar[XB_TMO], 1u); break; } }
    }
    nloc = mine > 0u ? mine : 1u; nx = cnt > 0u ? cnt : 1u;
}

__device__ __forceinline__ void xcd_barrier(const XcdBarrier& b) {
    asm volatile("s_waitcnt vmcnt(0)" ::: "memory");
    __syncthreads();
    if (threadIdx.x == 0) {
        unsigned* bar = b.bar; unsigned bx_ = b.x; asm volatile("" : "+s"(bar), "+s"(bx_));
        __builtin_amdgcn_s_waitcnt(0);
        unsigned nloc = b.st[0], nx = b.st[1];
        if (nloc == 0u) { xcd_barrier_complete(bar, bx_, nloc, nx); b.st[0] = nloc; b.st[1] = nx; }
        const unsigned old = xb_add(&bar[XB_XSUB(bx_)], 1u);
        const unsigned gen = old / nloc;
        if (old + 1u == (gen + 1u) * nloc) {
            __builtin_amdgcn_fence(__ATOMIC_RELEASE, "agent");
            asm volatile("s_waitcnt vmcnt(0)" ::: "memory");
            const unsigned og = xb_add(&bar[XB_TOP], 1u);
            const unsigned tg = og / nx;
            if (og + 1u == (tg + 1u) * nx) xb_add(&bar[XB_TOPGEN], 1u);
            else XB_SPIN(xb_ld(&bar[XB_TOPGEN]) == tg, bar);
            __builtin_amdgcn_fence(__ATOMIC_ACQUIRE, "agent");
            xb_add(&bar[XB_XGEN(bx_)], 1u);
            asm volatile("s_waitcnt vmcnt(0)" ::: "memory");
        } else {
            XB_SPIN(xb_ld(&bar[XB_XGEN(bx_)]) == gen, bar);
            __builtin_amdgcn_fence(__ATOMIC_ACQUIRE, "agent");
            asm volatile("s_waitcnt vmcnt(0)" ::: "memory");
        }
    }
    __syncthreads();
}


struct Frame {
    LAS unsigned char* lds;
    int tid, lane, wave, G, gw, NGW;
};
__device__ __forceinline__ float wave_sum(float v) {
#pragma unroll
    for (int o = 1; o < 64; o <<= 1) v += __shfl_xor(v, o);
    return v;
}

__device__ __forceinline__ void transpose_item(const float* W, int N, bf16* WT, int ldt, int kb, int nb, int rowbase, bool ropeperm, LAS float* scr, int lane) {
    const int k0 = 64 * kb, n0 = 64 * nb;
    const float* src = W + (size_t)(k0 + (lane >> 4)) * N + n0 + 4 * (lane & 15);
#pragma unroll 4
    for (int i = 0; i < 16; ++i) { const f32x4 v = *(const f32x4*)(src + (size_t)(4 * i) * N); LAS float* d = scr + (4 * i + (lane >> 4)) * 65 + 4 * (lane & 15);
        d[0] = v[0]; d[1] = v[1]; d[2] = v[2]; d[3] = v[3]; }
    LDS_WAIT(); asm volatile("" ::: "memory");
    const int c = lane & 7;
#pragma unroll
    for (int j = 0; j < 8; ++j) { const int nn = (lane >> 3) + 8 * j; const LAS float* s = scr + (8 * c) * 65 + nn;
        v4u o; o.x = pk2(s[0 * 65], s[1 * 65]); o.y = pk2(s[2 * 65], s[3 * 65]); o.z = pk2(s[4 * 65], s[5 * 65]); o.w = pk2(s[6 * 65], s[7 * 65]);
        const int orow = rowbase + (ropeperm ? (2 * (nn & 31) + (nn >> 5)) : nn);
        *(GAS v4u*)(WT + (size_t)orow * ldt + k0 + 8 * c) = o; }
    LDS_WAIT(); asm volatile("" ::: "memory");
}

__device__ __forceinline__ void norm_mod_row(const f32x4 (&v)[16], float ssq, const float* g, const float* scv, const float* shv, bf16* orow, int lane) {
    const float r = 1.0f / sqrtf(ssq * (1.0f / D) + EPS);
#pragma unroll
    for (int j = 0; j < 16; ++j) { int c = 4 * lane + 256 * j; asm volatile("" : "+v"(c));
        const f32x4 gg = *(const f32x4*)(g + c), ss = *(const f32x4*)(scv + c), hh = *(const f32x4*)(shv + c);
        f32x4 o;
#pragma unroll
        for (int e = 0; e < 4; ++e) o[e] = v[j][e] * r * gg[e] * (1.0f + ss[e]) + hh[e];
        v2u w; w.x = pk2(o[0], o[1]); w.y = pk2(o[2], o[3]);
        *(GAS v2u*)(orow + c) = w; }
}


template <bool HAS_Y, bool HAS_H>
__device__ __forceinline__ void thin_phase(Frame& F, const float* xin, float* xout, const bf16* Yb, bf16* Hout,
                                           const float* gpost, const float* gate0, const float* gpre, const float* sc0, const float* sh0) {
    LAS float* cA1 = (LAS float*)F.lds; LAS float* cA2 = cA1 + D; LAS float* cB2 = cA2 + D;
    for (int chunk = blockIdx.x; chunk < M / 32; chunk += F.G) {
        int tid = F.tid; asm volatile("" : "+v"(tid));
        const int b = (chunk * 32) / SEQ;
        __syncthreads();
#pragma unroll
        for (int i = 0; i < 2; ++i) { const int c = 4 * tid + 2048 * i;
            if constexpr (HAS_Y) { const f32x4 g = *(const f32x4*)(gpost + c), t = *(const f32x4*)(gate0 + (size_t)b * 6 * D + c); *(LAS f32x4*)(cA1 + c) = g * t; }
            if constexpr (HAS_H) { const f32x4 g = *(const f32x4*)(gpre + c), s = *(const f32x4*)(sc0 + (size_t)b * 6 * D + c), h = *(const f32x4*)(sh0 + (size_t)b * 6 * D + c);
                *(LAS f32x4*)(cA2 + c) = g * (s + 1.0f); *(LAS f32x4*)(cB2 + c) = h; } }
        __syncthreads();
        const int LN = tid & 63;
#pragma unroll 1
        for (int i = 0; i < 4; ++i) {
            const size_t m = (size_t)chunk * 32 + F.wave * 4 + i;
            v4u yv[8]; f32x4 xv[16];
#pragma unroll
            for (int j = 0; j < 8; ++j) { const int c = 8 * LN + 512 * j;
                if constexpr (HAS_Y) yv[j] = *(const GAS v4u*)(Yb + m * D + c);
                xv[2 * j] = *(const f32x4*)(xin + m * D + c); xv[2 * j + 1] = *(const f32x4*)(xin + m * D + c + 4); }
            float ssq2 = 0.f;
            if constexpr (HAS_Y) {
                float ssq = 0.f;
#pragma unroll
                for (int j = 0; j < 8; ++j) { const unsigned w[4] = {yv[j].x, yv[j].y, yv[j].z, yv[j].w};
#pragma unroll
                    for (int q = 0; q < 4; ++q) { const float a = bflo(w[q]), c2 = bfhi(w[q]); ssq += a * a + c2 * c2; } }
                ssq = wave_sum(ssq); const float r = 1.0f / sqrtf(ssq * (1.0f / D) + EPS);
#pragma unroll
                for (int j = 0; j < 8; ++j) { const int c = 8 * LN + 512 * j; const unsigned w[4] = {yv[j].x, yv[j].y, yv[j].z, yv[j].w};
                    const f32x4 a0 = *(const LAS f32x4*)(cA1 + c), a1 = *(const LAS f32x4*)(cA1 + c + 4);
                    f32x4 y0 = {bflo(w[0]), bfhi(w[0]), bflo(w[1]), bfhi(w[1])}, y1 = {bflo(w[2]), bfhi(w[2]), bflo(w[3]), bfhi(w[3])};
                    xv[2 * j] = xv[2 * j] + a0 * (y0 * r); xv[2 * j + 1] = xv[2 * j + 1] + a1 * (y1 * r);
                    *(f32x4*)(xout + m * D + c) = xv[2 * j]; *(f32x4*)(xout + m * D + c + 4) = xv[2 * j + 1]; } }
            if constexpr (HAS_H) {
#pragma unroll
                for (int j = 0; j < 16; ++j) ssq2 += (xv[j][0] * xv[j][0] + xv[j][1] * xv[j][1]) + (xv[j][2] * xv[j][2] + xv[j][3] * xv[j][3]);
                ssq2 = wave_sum(ssq2); const float r2 = 1.0f / sqrtf(ssq2 * (1.0f / D) + EPS);
#pragma unroll
                for (int j = 0; j < 8; ++j) { const int c = 8 * LN + 512 * j;
                    const f32x4 a0 = *(const LAS f32x4*)(cA2 + c), a1 = *(const LAS f32x4*)(cA2 + c + 4), b0 = *(const LAS f32x4*)(cB2 + c), b1 = *(const LAS f32x4*)(cB2 + c + 4);
                    const f32x4 h0 = (xv[2 * j] * r2) * a0 + b0, h1 = (xv[2 * j + 1] * r2) * a1 + b1;
                    v4u w; w.x = pk2(h0[0], h0[1]); w.y = pk2(h0[2], h0[3]); w.z = pk2(h1[0], h1[1]); w.w = pk2(h1[2], h1[3]);
                    *(GAS v4u*)(Hout + m * D + c) = w; } }
        }
    }
    __syncthreads();
}

constexpr int NB_IN = IN_W / 64, I_IN = (D / 64) * NB_IN, I_UQ = (QRANK / 64) * (QW / 64), I_UKV = (KVRANK / 64) * (KVW / 64), I_OSB = (SBW / 64) * (D / 64), I_OMLA = I_OSB,
              I_OUT = (D / 64) * (D / 64), I_UP = (D / 64) * (DFF / 64), I_DOWN = (DFF / 64) * (D / 64), I_LAYER = I_IN + I_UQ + I_UKV + I_OSB + I_OMLA + I_OUT + I_UP + I_DOWN;
#define CONVERT_ITEMS(lo, hi, start, stride) do { int cl_ = F.lane; asm volatile("" : "+v"(cl_));     \
        for (int it = (lo) + (start); it < (hi); it += (stride)) { \
            const int l = it / I_LAYER; int r = it % I_LAYER; \
            if (r < I_IN) { const int kb = r / NB_IN, nb = r % NB_IN, n0 = nb * 64; transpose_item(KIN(I_WIN) + (size_t)l * D * IN_W, IN_W, (bf16*)(wl + W_IN), D, kb, nb, n0 < C_GATE_SRC ? n0 : n0 + (C_GSB - C_GATE_SRC), false, scr, cl_); continue; } r -= I_IN; \
            if (r < I_UQ) { const int kb = r / (QW / 64), nb = r % (QW / 64); transpose_item(KIN(I_WUQ) + (size_t)l * QRANK * QW, QW, (bf16*)(wl + W_UQ), QRANK, kb, nb, nb * 64, (nb % 3) == 2, scr, cl_); continue; } r -= I_UQ; \
            if (r < I_UKV) { const int kb = r / (KVW / 64), nb = r % (KVW / 64); transpose_item(KIN(I_WUKV) + (size_t)l * KVRANK * KVW, KVW, (bf16*)(wl + W_UKV), KVRANK, kb, nb, nb * 64, false, scr, cl_); continue; } r -= I_UKV; \
            if (r < I_OSB) { const int kb = r / (D / 64), nb = r % (D / 64); transpose_item(KIN(I_WOSB) + (size_t)l * SBW * D, D, (bf16*)(wl + W_OSB), 2 * SBW, kb, nb, nb * 64, false, scr, cl_); continue; } r -= I_OSB; \
            if (r < I_OMLA) { const int kb = r / (D / 64), nb = r % (D / 64); transpose_item(KIN(I_WOMLA) + (size_t)l * SBW * D, D, (bf16*)(wl + W_OSB) + SBW, 2 * SBW, kb, nb, nb * 64, false, scr, cl_); continue; } r -= I_OMLA; \
            if (r < I_OUT) { const int kb = r / (D / 64), nb = r % (D / 64); transpose_item(KIN(I_WOUT) + (size_t)l * D * D, D, (bf16*)(wl + W_OUT), D, kb, nb, nb * 64, false, scr, cl_); continue; } r -= I_OUT; \
            if (r < I_UP) { const int kb = r / (DFF / 64), nb = r % (DFF / 64); transpose_item(KIN(I_WUP) + (size_t)l * D * DFF, DFF, (bf16*)(wl + W_UP), D, kb, nb, nb * 64, false, scr, cl_); continue; } r -= I_UP; \
            { const int kb = r / (D / 64), nb = r % (D / 64); transpose_item(KIN(I_WDOWN) + (size_t)l * DFF * D, D, (bf16*)(wl + W_DOWN), DFF, kb, nb, nb * 64, false, scr, cl_); } \
        } } while (0)

#ifndef PG8_SP2
#define PG8_SP2 true
#endif
#ifndef PG8_ALIGN
#define PG8_ALIGN false
#endif
#ifndef PH_MASK
#define PH_MASK 0xFFFFFFFFu
#endif
#define PH(k) ((PH_MASK >> (k)) & 1u)
struct Args { const float* in[19]; float* out; unsigned char* ws; };
enum { I_X = 0, I_C, I_POS, I_WADA, I_BADA, I_GPREMIX, I_GPOSTMIX, I_GPREMLP, I_GPOSTMLP, I_WIN, I_GQ, I_WUQ, I_GKV, I_WUKV, I_WOSB, I_WOMLA, I_WOUT, I_WUP, I_WDOWN };

typedef __attribute__((address_space(4))) const unsigned char* kargp_t;
__device__ __forceinline__ __attribute__((address_space(1))) unsigned char* lw_(unsigned char* p) { __attribute__((address_space(1))) unsigned char* q = (__attribute__((address_space(1))) unsigned char*)p; asm volatile("" : "+s"(q)); return q; }
__device__ __forceinline__ kargp_t lwk_() { kargp_t p = (kargp_t)__builtin_amdgcn_kernarg_segment_ptr(); asm volatile("" : "+s"(p)); return p; }
#define KIN(k) ((const float*)(*(const __attribute__((address_space(1))) float* const __attribute__((address_space(4)))*)(lwk_() + 8 * (k))))
__global__ void __launch_bounds__(NWAVES * 64, 2) hybrid_fwd(Args args) {
    extern __shared__ __attribute__((aligned(16))) unsigned char lds_raw[];
    Frame F;
    F.lds = (LAS unsigned char*)lds_raw;
    F.tid = threadIdx.x; F.lane = F.tid & 63; F.wave = __builtin_amdgcn_readfirstlane(F.tid >> 6);
    F.G = gridDim.x; F.gw = blockIdx.x * NWAVES + F.wave; F.NGW = F.G * NWAVES;
    unsigned char* ws = args.ws;
    gu32* ctl = (gu32*)(ws + WS_CTL);
    for (int u = F.tid; u < (LDS_BYTES - LDSCTL_OFF) / 4; u += NWAVES * 64) ((LAS unsigned*)(F.lds + LDSCTL_OFF))[u] = 0u;
    __syncthreads();
    XcdBarrier bar = xcd_barrier_post((unsigned*)(ctl + CW_BAR), (volatile LAS unsigned*)(F.lds + MISC_OFF) + 8);
#define GRID_BAR() xcd_barrier(bar)

#define ada ((float*)(lw_(ws) + WS_ADA))
#define tab ((float*)(lw_(ws) + WS_TAB))
#define adap ((float*)(lw_(ws) + WS_ADAP))
#define Hb ((bf16*)(lw_(ws) + A_H))
#define PROJ ((bf16*)(lw_(ws) + A_PROJ))
#define CQ ((bf16*)(lw_(ws) + A_CQ))
#define CKV ((bf16*)(lw_(ws) + A_CKV))
#define KR ((bf16*)(lw_(ws) + A_KR))
#define QF ((bf16*)(lw_(ws) + A_Q))
#define KVF ((bf16*)(lw_(ws) + A_KV))
#define OSB ((bf16*)(lw_(ws) + A_OSB))
#define MRG ((bf16*)(lw_(ws) + A_MRG))
#define Yb ((bf16*)(lw_(ws) + A_Y))
#define U ((bf16*)(lw_(ws) + A_U))
#define x_in KIN(I_X)
#define wl (lw_(ws) + WS_W + (size_t)l * W_LAYER)
#define adl (ada + (size_t)l * BATCH * 6 * D)
    float* xo = args.out;


    if (PH(0)) {
        LAS float* cact = (LAS float*)F.lds;
        for (int i = F.tid; i < BATCH * D; i += NWAVES * 64) { const float cv = KIN(I_C)[i]; cact[i] = cv / (1.0f + __expf(-cv)); }
        __syncthreads();
        for (int task = blockIdx.x; task < DEPTH * 32 * 12; task += F.G) {
            const int l = task / (32 * 12), s = (task / 12) % 32, cb = task % 12;
            const int col = cb * 2048 + F.tid * 4;
            const float* wp = KIN(I_WADA) + ((size_t)l * D + s * 128) * (6 * D) + col;
            f32x4 a0 = {0.f, 0.f, 0.f, 0.f}, a1 = {0.f, 0.f, 0.f, 0.f};
#pragma unroll 8
            for (int k = 0; k < 128; ++k) { const f32x4 w = *(const f32x4*)(wp + (size_t)k * (6 * D)); const float c0 = cact[s * 128 + k], c1 = cact[D + s * 128 + k];
                a0 += w * c0; a1 += w * c1; }
            *(f32x4*)(adap + (((size_t)s * DEPTH + l) * BATCH + 0) * (6 * D) + col) = a0;
            *(f32x4*)(adap + (((size_t)s * DEPTH + l) * BATCH + 1) * (6 * D) + col) = a1;
        }
        __syncthreads();
        for (int e = blockIdx.x * (NWAVES * 64) + F.tid; e < M * 32; e += F.G * NWAVES * 64) {
            const int m = e >> 5, i = e & 31;
            const float inv = powf(10000.0f, -(float)i / 32.0f);
            const float ang = (float)(((const int*)KIN(I_POS))[m]) * inv;
            const double rev = (double)ang * 0.15915494309189533577; const float fr = (float)(rev - rint(rev));
            tab[2 * e] = __builtin_amdgcn_cosf(fr); tab[2 * e + 1] = __builtin_amdgcn_sinf(fr);
        }
        for (int l = 0; l < DEPTH; ++l) { v4u* z = (v4u*)(ws + WS_W + l * W_LAYER + W_IN + (size_t)C_GATE_SRC * D * 2);
            for (int i = blockIdx.x * (NWAVES * 64) + F.tid; i < 192 * D * 2 / 16; i += F.G * NWAVES * 64) z[i] = (v4u){0u, 0u, 0u, 0u}; }
        LAS float* scr = (LAS float*)(F.lds) + F.wave * (64 * 65);
        CONVERT_ITEMS(0, DEPTH * I_LAYER, F.gw, F.NGW);
    }
    GRID_BAR();
    if (PH(1)) for (int e = blockIdx.x * (NWAVES * 64) + F.tid; e < DEPTH * BATCH * 6 * D; e += F.G * NWAVES * 64) {
        const int l = e / (BATCH * 6 * D), n = e % (6 * D);
        float s = KIN(I_BADA)[(size_t)l * 6 * D + n];
#pragma unroll 8
        for (int k = 0; k < 32; ++k) s += adap[(size_t)k * (DEPTH * BATCH * 6 * D) + e];
        ada[e] = s;
    }
    GRID_BAR();
    if (PH(2)) thin_phase<false, true>(F, x_in, nullptr, nullptr, Hb, nullptr, nullptr, KIN(I_GPREMIX), ada + D, ada);
    GRID_BAR();

    for (int l = 0; l < DEPTH; ++l) {
        if (PH(3)) { pg8::Gemm g{Hb, (const bf16*)(wl + W_IN), M, PROJ_W, D}; pg8::StaticOrder S; S.init(M, PROJ_W, F.G, (int)blockIdx.x);
          pg8::EpiBf16<0> E{PROJ, PROJ_W};
          pg8::gemm_phase<pg8::EpiBf16<0>, pg8::StaticOrder, PG8_ALIGN, PG8_SP2>(F.lds, g, S, E); }
        GRID_BAR();
        if (PH(4)) for (int m = F.gw; m < M; m += F.NGW) {
            int LN = F.lane; asm volatile("" : "+v"(LN));
            const bf16* pr = PROJ + (size_t)m * PROJ_W;
            { const v4u a = *(const GAS v4u*)(pr + C_QD + 16 * LN), b2 = *(const GAS v4u*)(pr + C_QD + 16 * LN + 8);
              float f[16] = {bflo(a.x), bfhi(a.x), bflo(a.y), bfhi(a.y), bflo(a.z), bfhi(a.z), bflo(a.w), bfhi(a.w), bflo(b2.x), bfhi(b2.x), bflo(b2.y), bfhi(b2.y), bflo(b2.z), bfhi(b2.z), bflo(b2.w), bfhi(b2.w)};
              float ssq = 0.f;
#pragma unroll
              for (int e = 0; e < 16; ++e) ssq += f[e] * f[e];
              ssq = wave_sum(ssq); const float r = 1.0f / sqrtf(ssq * (1.0f / QRANK) + EPS);
              const float* gq = KIN(I_GQ) + (size_t)l * QRANK + 16 * LN;
              v4u o0, o1;
              o0.x = pk2(f[0] * r * gq[0], f[1] * r * gq[1]); o0.y = pk2(f[2] * r * gq[2], f[3] * r * gq[3]); o0.z = pk2(f[4] * r * gq[4], f[5] * r * gq[5]); o0.w = pk2(f[6] * r * gq[6], f[7] * r * gq[7]);
              o1.x = pk2(f[8] * r * gq[8], f[9] * r * gq[9]); o1.y = pk2(f[10] * r * gq[10], f[11] * r * gq[11]); o1.z = pk2(f[12] * r * gq[12], f[13] * r * gq[13]); o1.w = pk2(f[14] * r * gq[14], f[15] * r * gq[15]);
              *(GAS v4u*)(CQ + (size_t)m * QRANK + 16 * LN) = o0; *(GAS v4u*)(CQ + (size_t)m * QRANK + 16 * LN + 8) = o1; }
            { const v4u a = *(const GAS v4u*)(pr + C_KVD + 8 * LN);
              float f[8] = {bflo(a.x), bfhi(a.x), bflo(a.y), bfhi(a.y), bflo(a.z), bfhi(a.z), bflo(a.w), bfhi(a.w)};
              float ssq = 0.f;
#pragma unroll
              for (int e = 0; e < 8; ++e) ssq += f[e] * f[e];
              ssq = wave_sum(ssq); const float r = 1.0f / sqrtf(ssq * (1.0f / KVRANK) + EPS);
              const float* gk = KIN(I_GKV) + (size_t)l * KVRANK + 8 * LN;
              v4u o0; o0.x = pk2(f[0] * r * gk[0], f[1] * r * gk[1]); o0.y = pk2(f[2] * r * gk[2], f[3] * r * gk[3]); o0.z = pk2(f[4] * r * gk[4], f[5] * r * gk[5]); o0.w = pk2(f[6] * r * gk[6], f[7] * r * gk[7]);
              *(GAS v4u*)(CKV + (size_t)m * KVRANK + 8 * LN) = o0; }
            if (LN < 32) { const int i = LN; const bf16* kp = pr + C_KVD + KVRANK;
              const float x1 = bflo((unsigned)kp[i]), x2 = bflo((unsigned)kp[32 + i]); const float cs = tab[((size_t)m * 32 + i) * 2], sn = tab[((size_t)m * 32 + i) * 2 + 1];
              *(GAS unsigned*)(KR + (size_t)m * ROPE + 2 * i) = pk2(x1 * cs - x2 * sn, x2 * cs + x1 * sn); }
        }
        GRID_BAR();
        if (PH(5)) { pg8::Gemm g{CQ, (const bf16*)(wl + W_UQ), M, QW, QRANK}; pg8::StaticOrder S; S.init(M, QW, F.G, (int)blockIdx.x);
          pg8::EpiRope E{QF, QW, tab};
          pg8::gemm_phase<pg8::EpiRope, pg8::StaticOrder, PG8_ALIGN, PG8_SP2>(F.lds, g, S, E); }
        if (PH(5)) { pg8::Gemm g{CKV, (const bf16*)(wl + W_UKV), M, KVW, KVRANK}; pg8::EpiBf16<0> E{KVF, KVW};
          if (F.G == 256) { pg8::UnevenOrder S; S.init(M, KVW, F.G, (int)blockIdx.x);
            pg8::gemm_phase<pg8::EpiBf16<0>, pg8::UnevenOrder, PG8_ALIGN, PG8_SP2>(F.lds, g, S, E); }
          else { pg8::StaticOrder S; S.init(M, KVW, F.G, (int)blockIdx.x);
            pg8::gemm_phase<pg8::EpiBf16<0>, pg8::StaticOrder, PG8_ALIGN, PG8_SP2>(F.lds, g, S, E); } }
        GRID_BAR();
        if (PH(6)) for (int item = blockIdx.x; item < 512; item += F.G) {
            const int kind = item >> 8, c = item & 255, bh = (c & 7) * 4 + ((c >> 3) >> 3), y = (c >> 3) & 7, b = bh >> 4, h = bh & 15;
            const size_t rb = (size_t)b * SEQ;
            if (kind == 0) { if (PH(14)) {
                att::Tensors T{PROJ + rb * PROJ_W + h * 128, PROJ_W, PROJ + rb * PROJ_W + SBW + h * 128, PROJ_W, PROJ + rb * PROJ_W + 2 * SBW + h * 128, PROJ_W, nullptr, OSB + rb * (2 * SBW) + h * 128, 2 * SBW};
                att::attn_unit<0>(T, 15 - y, 0.08838834764831845f * 1.4426950408889634f, (LAS char*)F.lds);
                att::attn_unit<0>(T, y, 0.08838834764831845f * 1.4426950408889634f, (LAS char*)F.lds); }
            } else if (PH(15)) {
                att::Tensors T{QF + rb * QW + h * 192, QW, KVF + rb * KVW + h * 256, KVW, KVF + rb * KVW + h * 256 + 128, KVW, KR + rb * ROPE, OSB + rb * (2 * SBW) + SBW + h * 128, 2 * SBW};
                att::attn_unit<1>(T, 15 - y, 0.07216878364870323f * 1.4426950408889634f, (LAS char*)F.lds);
                att::attn_unit<1>(T, y, 0.07216878364870323f * 1.4426950408889634f, (LAS char*)F.lds);
            }
        }
        GRID_BAR();
        if (PH(7)) { pg8::Gemm g{OSB, (const bf16*)(wl + W_OSB), M, D, 2 * SBW}; pg8::StaticOrder S; S.init(M, D, F.G, (int)blockIdx.x);
          pg8::EpiGateMerge E{MRG, D, PROJ + C_GSB, PROJ + C_GMLA, PROJ_W};
          pg8::gemm_phase<pg8::EpiGateMerge, pg8::StaticOrder, PG8_ALIGN, PG8_SP2>(F.lds, g, S, E); }
        GRID_BAR();
        if (PH(9)) { pg8::Gemm g{MRG, (const bf16*)(wl + W_OUT), M, D, D}; pg8::StaticOrder S; S.init(M, D, F.G, (int)blockIdx.x);
          pg8::EpiBf16<0> E{Yb, D};
          pg8::gemm_phase<pg8::EpiBf16<0>, pg8::StaticOrder, PG8_ALIGN, PG8_SP2>(F.lds, g, S, E); }
        GRID_BAR();
        if (PH(10)) thin_phase<true, true>(F, l == 0 ? x_in : (const float*)xo, xo, Yb, Hb, KIN(I_GPOSTMIX) + (size_t)l * D, adl + 2 * D, KIN(I_GPREMLP) + (size_t)l * D, adl + 4 * D, adl + 3 * D);
        GRID_BAR();
        if (PH(11)) { pg8::Gemm g{Hb, (const bf16*)(wl + W_UP), M, DFF, D}; pg8::StaticOrder S; S.init(M, DFF, F.G, (int)blockIdx.x);
          pg8::EpiBf16<1> E{U, DFF};
          pg8::gemm_phase<pg8::EpiBf16<1>, pg8::StaticOrder, PG8_ALIGN, PG8_SP2>(F.lds, g, S, E); }
        GRID_BAR();
        if (PH(12)) { pg8::Gemm g{U, (const bf16*)(wl + W_DOWN), M, D, DFF}; pg8::StaticOrder S; S.init(M, D, F.G, (int)blockIdx.x);
          pg8::EpiBf16<0> E{Yb, D};
          pg8::gemm_phase<pg8::EpiBf16<0>, pg8::StaticOrder, PG8_ALIGN, PG8_SP2>(F.lds, g, S, E); }
        GRID_BAR();
        if (PH(13)) { if (l + 1 < DEPTH) { const float* adn = ada + (size_t)(l + 1) * BATCH * 6 * D;
                thin_phase<true, true>(F, xo, xo, Yb, Hb, KIN(I_GPOSTMLP) + (size_t)l * D, adl + 5 * D, KIN(I_GPREMIX) + (size_t)(l + 1) * D, adn + D, adn); }
            else thin_phase<true, false>(F, xo, xo, Yb, nullptr, KIN(I_GPOSTMLP) + (size_t)l * D, adl + 5 * D, nullptr, nullptr, nullptr); }
        if (l + 1 < DEPTH) GRID_BAR();
    }
    if (blockIdx.x == 0 && F.tid == 0 && __hip_atomic_load((unsigned*)(ctl + CW_BAR) + XB_TMO, RLX_AGENT) != 0u) xo[0] = __builtin_nanf("");
}
#undef ada
#undef tab
#undef adap
#undef Hb
#undef PROJ
#undef CQ
#undef CKV
#undef KR
#undef QF
#undef KVF
#undef OSB
#undef MRG
#undef Yb
#undef U
#undef x_in
#undef wl
#undef adl


extern "C" void kernel_launch(void* const* d_in, const int* in_sizes, int n_in, void* d_out, int out_size, void* d_ws, size_t ws_size, hipStream_t stream) {
    static int grid = 0;
    if (grid == 0) {
        if (n_in != 19 || out_size != M * D || ws_size < WS_END) { fprintf(stderr, "kernel_launch: unexpected shapes (n_in %d, out %d, ws %zu < %zu)\n", n_in, out_size, ws_size, (size_t)WS_END); grid = -1; return; }
        int dev = 0, cus = 0, per_cu = 0;
        if (hipGetDevice(&dev) != hipSuccess || hipDeviceGetAttribute(&cus, hipDeviceAttributeMultiprocessorCount, dev) != hipSuccess) { grid = -1; return; }
        if (hipFuncSetAttribute((const void*)hybrid_fwd, hipFuncAttributeMaxDynamicSharedMemorySize, LDS_BYTES) != hipSuccess) { fprintf(stderr, "kernel_launch: hipFuncSetAttribute failed\n"); grid = -1; return; }
        if (hipOccupancyMaxActiveBlocksPerMultiprocessor(&per_cu, (const void*)hybrid_fwd, NWAVES * 64, LDS_BYTES) != hipSuccess || per_cu < 1) { fprintf(stderr, "kernel_launch: occupancy query says %d\n", per_cu); (void)hipGetLastError(); }
        grid = cus;
    }
    if (grid < 0) return;
    if (hipMemsetAsync((char*)d_ws + WS_CTL, 0, CTL_ZERO_BYTES, stream) != hipSuccess) return;
    Args a{};
    for (int i = 0; i < 19; ++i) a.in[i] = (const float*)d_in[i];
    a.out = (float*)d_out; a.ws = (unsigned char*)d_ws;
    hipLaunchKernelGGL(hybrid_fwd, dim3(grid), dim3(NWAVES * 64), LDS_BYTES, stream, a);
#ifdef DBG_CHECK
    hipLaunchKernelGGL(dbg_check, dim3(DBG_NCHK), dim3(256), 0, stream, a, (unsigned*)((char*)d_ws + 4096));
    hipLaunchKernelGGL(dbg_report, dim3(1), dim3(64), 0, stream, (float*)d_out, (const unsigned*)((char*)d_ws + 4096));
#endif
}
```

```cpp
#include <hip/hip_runtime.h>
#include <cstdio>
#include <cstdint>
#include <cmath>
#ifndef PG8_WGM
#define PG8_WGM 8
#endif
namespace pg8 {
#define PG8_LAS __attribute__((address_space(3)))
typedef unsigned short bf16_t;
typedef short bf16x8 __attribute__((ext_vector_type(8)));
typedef float f32x4 __attribute__((ext_vector_type(4)));
typedef unsigned u32x4 __attribute__((ext_vector_type(4)));
constexpr int BM = 256, BK = 64, HALF = 128, HTB = HALF * BK * 2  , STAGE_BYTES = 8 * HTB, NXCD = 8, WGM = PG8_WGM;

__host__ __device__ __forceinline__ int lds_byte(int r, int c) { const int st = (r >> 4) * 2 + (c >> 5), rr = r & 15, cc = c & 31, ob = rr * 64 + cc * 2; return st * 1024 + (ob ^ (((ob >> 9) & 1) << 5)); }
__host__ __device__ __forceinline__ void stage_rc(int b, int& R, int& C) { const int st = b / 1024, sb = b % 1024, swz = sb ^ (((sb >> 9) & 1) << 5); R = (st >> 1) * 16 + swz / 64; C = (st & 1) * 32 + (swz % 64) / 2; }
__host__ __device__ __forceinline__ int perm32(int rho) { const int n = rho >> 4, i = rho & 15; return 8 * (i >> 2) + 4 * n + (i & 3); }

struct Unit { int pm, pn; };
struct Gemm { const bf16_t* A; const bf16_t* Bt; int M, N, K; };

struct StaticOrder {
    int nM, nN, nwg, G, c;
    __host__ __device__ void init(int M, int N, int G_, int c_) { nM = M / BM; nN = N / BM; nwg = nM * nN; G = G_; c = c_; }
    __host__ __device__ bool next(int i, Unit& u) const {
        const long L = (long)i * G + c; if (L >= nwg) return false;
        int wgid = (int)L; { const int q = nwg / NXCD, r = nwg % NXCD, xcd = wgid % NXCD, off = wgid / NXCD; wgid = (xcd < r ? xcd * (q + 1) : r * (q + 1) + (xcd - r) * q) + off; }
        const int nig = WGM * nN, gid = wgid / nig, fm = gid * WGM, gsz = (nM - fm) < WGM ? (nM - fm) : WGM;
        u.pm = fm + ((wgid % nig) % gsz); u.pn = (wgid % nig) / gsz; return true;
    }
    __device__ __forceinline__ void a_ready(const Unit&) const {}
    __device__ __forceinline__ void done(const Unit&) const {}
};

struct UnevenOrder : StaticOrder {
    __host__ __device__ bool next(int i, Unit& u) const {
        long L; const int h = G / 2;
        if (c < h) { if (i > 0) return false; L = c; } else { if (i > 2) return false; L = h + (long)h * i + (c - h); }
        if (L >= nwg) return false;
        int wgid = (int)L; { const int q = nwg / NXCD, r = nwg % NXCD, xcd = wgid % NXCD, off = wgid / NXCD; wgid = (xcd < r ? xcd * (q + 1) : r * (q + 1) + (xcd - r) * q) + off; }
        const int nig = WGM * nN, gid = wgid / nig, fm = gid * WGM, gsz = (nM - fm) < WGM ? (nM - fm) : WGM;
        u.pm = fm + ((wgid % nig) % gsz); u.pn = (wgid % nig) / gsz; return true;
    }
};

__device__ __forceinline__ unsigned cvt_pk_bf16(float lo, float hi) { unsigned r; asm volatile("v_cvt_pk_bf16_f32 %0, %1, %2" : "=v"(r) : "v"(lo), "v"(hi)); return r; }
typedef float f32x2 __attribute__((ext_vector_type(2)));

__device__ __forceinline__ float bf_lo(unsigned w) { return __builtin_bit_cast(float, w << 16); }
__device__ __forceinline__ float bf_hi(unsigned w) { return __builtin_bit_cast(float, w & 0xffff0000u); }
__device__ __forceinline__ float sigmoidf_fast(float x) { return __builtin_amdgcn_rcpf(1.0f + __builtin_amdgcn_exp2f(-1.4426950408889634f * x)); }

#ifndef EPI_WT
#define EPI_WT 0
#endif
__device__ __forceinline__ void st16_out(bf16_t* p, u32x4 w) {
#if EPI_WT
    asm volatile("global_store_dwordx4 %0, %1, off sc1" :: "v"((__attribute__((address_space(1))) u32x4*)p), "v"(w) : "memory");
#else
    *(u32x4*)p = w;
#endif
}
template <int ACT  > struct EpiBf16 {
    static constexpr bool PERM = true, AFTER_DRAIN = false, MID = false;
    bf16_t* O; int ldc;
    __device__ __forceinline__ void operator()(const f32x4 (&acc)[2][2][4][2], const Unit& u, int wr, int wc, int fr, int fq) const {
        const int row0 = u.pm * BM + wr * 64 + fr, col0 = u.pn * BM + wc * 32 + 8 * fq;
#pragma unroll
        for (int ai = 0; ai < 2; ++ai)
#pragma unroll
            for (int m = 0; m < 4; ++m) { bf16_t* rowp = O + (size_t)(row0 + ai * HALF + m * 16) * ldc + col0;
#pragma unroll
                for (int bj = 0; bj < 2; ++bj) { f32x4 v0 = acc[ai][bj][m][0], v1 = acc[ai][bj][m][1];
                    if (ACT == 1) {
#pragma unroll
                        for (int j = 0; j < 4; ++j) { const float a = fmaxf(v0[j], 0.f), b = fmaxf(v1[j], 0.f); v0[j] = a * a; v1[j] = b * b; } }
                    u32x4 w; w.x = cvt_pk_bf16(v0[0], v0[1]); w.y = cvt_pk_bf16(v0[2], v0[3]); w.z = cvt_pk_bf16(v1[0], v1[1]); w.w = cvt_pk_bf16(v1[2], v1[3]);
                    st16_out(rowp + bj * HALF, w);
                    } }
    }
};
struct EpiRope {
    static constexpr bool PERM = true, AFTER_DRAIN = false, MID = false;
    bf16_t* O; int ldc; const float* tab;
    __device__ __forceinline__ void operator()(const f32x4 (&acc)[2][2][4][2], const Unit& u, int wr, int wc, int fr, int fq) const {
        const int row0 = u.pm * BM + wr * 64 + fr, col0 = u.pn * BM + wc * 32 + 8 * fq;
#pragma unroll
        for (int ai = 0; ai < 2; ++ai)
#pragma unroll
            for (int m = 0; m < 4; ++m) { const int row = row0 + ai * HALF + m * 16; bf16_t* rowp = O + (size_t)row * ldc + col0;
#pragma unroll
                for (int bj = 0; bj < 2; ++bj) { f32x4 v0 = acc[ai][bj][m][0], v1 = acc[ai][bj][m][1];
                    const int j = (col0 + bj * HALF) % 192;
                    if (j >= 128) { const float* tp = tab + (size_t)row * 64 + (j - 128);
                        const f32x4 t0 = *(const f32x4*)tp, t1 = *(const f32x4*)(tp + 4);
                        f32x4 r0, r1;
                        r0[0] = v0[0] * t0[0] - v0[1] * t0[1]; r0[1] = v0[1] * t0[0] + v0[0] * t0[1];
                        r0[2] = v0[2] * t0[2] - v0[3] * t0[3]; r0[3] = v0[3] * t0[2] + v0[2] * t0[3];
                        r1[0] = v1[0] * t1[0] - v1[1] * t1[1]; r1[1] = v1[1] * t1[0] + v1[0] * t1[1];
                        r1[2] = v1[2] * t1[2] - v1[3] * t1[3]; r1[3] = v1[3] * t1[2] + v1[2] * t1[3];
                        v0 = r0; v1 = r1; }
                    u32x4 w; w.x = cvt_pk_bf16(v0[0], v0[1]); w.y = cvt_pk_bf16(v0[2], v0[3]); w.z = cvt_pk_bf16(v1[0], v1[1]); w.w = cvt_pk_bf16(v1[2], v1[3]);
                    st16_out(rowp + bj * HALF, w); }
                asm volatile("" ::: "memory"); }
    }
};
struct EpiGateMerge {
    static constexpr bool PERM = true, AFTER_DRAIN = false, MID = true;
    bf16_t* O; int ldo; const bf16_t* G1; const bf16_t* G2; int ldg;
    __device__ __forceinline__ void mid(f32x4 (&acc)[2][2][4][2], const Unit& u, int wr, int wc, int fr, int fq) const {
        int fr_ = fr, fq_ = fq; asm volatile("" : "+v"(fr_), "+v"(fq_));
        const int row0 = u.pm * BM + wr * 64 + fr_, col0 = u.pn * BM + wc * 32 + 8 * fq_;
#pragma unroll
        for (int ai = 0; ai < 2; ++ai)
#pragma unroll
            for (int m = 0; m < 4; ++m) { const int row = row0 + ai * HALF + m * 16; const bf16_t* g1p = G1 + (size_t)row * ldg + col0; const bf16_t* g2p = G2 + (size_t)row * ldg + col0;
#pragma unroll
                for (int bj = 0; bj < 2; ++bj) { const u32x4 a = *(const u32x4*)(g1p + bj * HALF), b = *(const u32x4*)(g2p + bj * HALF);
                    const unsigned aw[4] = {a.x, a.y, a.z, a.w}, bw[4] = {b.x, b.y, b.z, b.w};
#pragma unroll
                    for (int q = 0; q < 4; ++q) {
                        const float r0 = (1.0f + __builtin_amdgcn_exp2f(-1.4426950408889634f * bf_lo(bw[q]))) * __builtin_amdgcn_rcpf(1.0f + __builtin_amdgcn_exp2f(-1.4426950408889634f * bf_lo(aw[q])));
                        const float r1 = (1.0f + __builtin_amdgcn_exp2f(-1.4426950408889634f * bf_hi(bw[q]))) * __builtin_amdgcn_rcpf(1.0f + __builtin_amdgcn_exp2f(-1.4426950408889634f * bf_hi(aw[q])));
                        acc[ai][bj][m][q >> 1][2 * (q & 1)] *= r0; acc[ai][bj][m][q >> 1][2 * (q & 1) + 1] *= r1; } }
                asm volatile("" ::: "memory"); }
    }
    __device__ __forceinline__ void operator()(const f32x4 (&acc)[2][2][4][2], const Unit& u, int wr, int wc, int fr, int fq) const {
        const int row0 = u.pm * BM + wr * 64 + fr, col0 = u.pn * BM + wc * 32 + 8 * fq;
#pragma unroll
        for (int ai = 0; ai < 2; ++ai)
#pragma unroll
            for (int m = 0; m < 4; ++m) { const int row = row0 + ai * HALF + m * 16; const bf16_t* gp = G2 + (size_t)row * ldg + col0; bf16_t* op = O + (size_t)row * ldo + col0;
#pragma unroll
                for (int bj = 0; bj < 2; ++bj) { const f32x4 v0 = acc[ai][bj][m][0], v1 = acc[ai][bj][m][1];
                    const u32x4 g = *(const u32x4*)(gp + bj * HALF);
                    u32x4 w; w.x = cvt_pk_bf16(v0[0] * sigmoidf_fast(bf_lo(g.x)), v0[1] * sigmoidf_fast(bf_hi(g.x))); w.y = cvt_pk_bf16(v0[2] * sigmoidf_fast(bf_lo(g.y)), v0[3] * sigmoidf_fast(bf_hi(g.y)));
                    w.z = cvt_pk_bf16(v1[0] * sigmoidf_fast(bf_lo(g.z)), v1[1] * sigmoidf_fast(bf_hi(g.z))); w.w = cvt_pk_bf16(v1[2] * sigmoidf_fast(bf_lo(g.w)), v1[3] * sigmoidf_fast(bf_hi(g.w)));
                    st16_out(op + bj * HALF, w); }
                asm volatile("" ::: "memory"); }
    }
};

template <class Epi, class Sched, bool ALIGN_EPI = false, bool SP2 = false>
__device__ __forceinline__ void gemm_phase(PG8_LAS unsigned char* lds, const Gemm g, const Sched& S, const Epi& E) {
    int tid_ = threadIdx.x; asm volatile("" : "+v"(tid_));
    const int tid = tid_, wid = __builtin_amdgcn_readfirstlane(tid >> 6), lane = tid & 63, wr = wid >> 2, wc = wid & 3, fr = lane & 15, fq = lane >> 4;
    const int K = g.K, nt = K / BK;
    unsigned voffA[2], voffB[2];
#pragma unroll
    for (int i = 0; i < 2; ++i) { int R, C; stage_rc(tid * 16 + i * 8192, R, C); const int Rb = Epi::PERM ? ((R & ~31) + perm32(R & 31)) : R;
        voffA[i] = (unsigned)(R * K + C) * 2u; voffB[i] = (unsigned)(Rb * K + C) * 2u; }
    const size_t kstep = (size_t)(BK * 2);
    const size_t hstep = (size_t)HALF * K * 2;
    const size_t tstep = 2 * hstep;
    const unsigned ldsw = (unsigned)wid * 1024u;
    const int aoff = lds_byte(wr * 64 + fr, fq * 8), boff = lds_byte(wc * 32 + fr, fq * 8);
#define PG8_SA(b, h) (((b) * 2 + (h)) * HTB)
#define PG8_SB(b, h) ((4 + (b) * 2 + (h)) * HTB)
#define PG8_STAGE(bufoff, gbase, voff) do { _Pragma("unroll") for (int _i = 0; _i < 2; ++_i) \
        __builtin_amdgcn_global_load_lds((const unsigned*)((const char*)(gbase) + (voff)[_i]), (PG8_LAS unsigned*)(lds + (bufoff) + ldsw + _i * 8192), 16, 0, 0); } while (0)
#define PG8_LDA(dst, b, h) do { _Pragma("unroll") for (int m = 0; m < 4; ++m) _Pragma("unroll") for (int k = 0; k < 2; ++k) dst[m][k] = *(const PG8_LAS bf16x8*)(lds + PG8_SA(b, h) + aoff + m * 2048 + k * 1024); } while (0)
#define PG8_LDB(dst, b, h) do { _Pragma("unroll") for (int n = 0; n < 2; ++n) _Pragma("unroll") for (int k = 0; k < 2; ++k) dst[n][k] = *(const PG8_LAS bf16x8*)(lds + PG8_SB(b, h) + boff + n * 2048 + k * 1024); } while (0)
#ifndef PG8_PRIO
#define PG8_PRIO 1
#endif
#define PG8_MMA(ai, bj, At, Bt) do { if (PG8_PRIO) __builtin_amdgcn_s_setprio(PG8_PRIO); _Pragma("unroll") for (int m = 0; m < 4; ++m) _Pragma("unroll") for (int n = 0; n < 2; ++n) _Pragma("unroll") for (int k = 0; k < 2; ++k) \
        acc[ai][bj][m][n] = __builtin_amdgcn_mfma_f32_16x16x32_bf16(Bt[n][k], At[m][k], acc[ai][bj][m][n], 0, 0, 0); if (PG8_PRIO) __builtin_amdgcn_s_setprio(0); } while (0)
#define PG8_WAIT_V(n) asm volatile("s_waitcnt vmcnt(" #n ")" ::: "memory")
#define PG8_WAIT_L(n) asm volatile("s_waitcnt lgkmcnt(" #n ")" ::: "memory")
#define PG8_BAR __builtin_amdgcn_s_barrier()
#define PG8_SCHED __builtin_amdgcn_sched_barrier(0)
    Unit cur, nxt; int ui = 0;
    if (!S.next(0, cur)) return;
    f32x4 acc[2][2][4][2];
#pragma unroll
    for (int a = 0; a < 2; ++a)
#pragma unroll
        for (int b = 0; b < 2; ++b)
#pragma unroll
            for (int m = 0; m < 4; ++m)
#pragma unroll
                for (int n = 0; n < 2; ++n) acc[a][b][m][n] = (f32x4){0.f, 0.f, 0.f, 0.f};
    bf16x8 At[4][2], B0[2][2], B1[2][2];
    const char* cA = (const char*)g.A + (size_t)cur.pm * tstep; const char* cB = (const char*)g.Bt + (size_t)cur.pn * tstep;
    S.a_ready(cur);
    if constexpr (SP2) {
        PG8_STAGE(PG8_SB(0, 0), cB, voffB); PG8_STAGE(PG8_SB(0, 1), cB + hstep, voffB); PG8_STAGE(PG8_SA(0, 0), cA, voffA); PG8_STAGE(PG8_SA(0, 1), cA + hstep, voffA);
        if (wr == 1) PG8_BAR;
        PG8_WAIT_V(2); PG8_BAR;
        PG8_STAGE(PG8_SB(1, 0), cB + kstep, voffB); PG8_STAGE(PG8_SA(1, 0), cA + kstep, voffA); PG8_STAGE(PG8_SB(1, 1), cB + hstep + kstep, voffB);
        PG8_WAIT_V(6); PG8_BAR;
    } else {
        PG8_STAGE(PG8_SB(0, 0), cB, voffB); PG8_STAGE(PG8_SA(0, 0), cA, voffA); PG8_STAGE(PG8_SB(0, 1), cB + hstep, voffB); PG8_STAGE(PG8_SA(0, 1), cA + hstep, voffA);
        if (wr == 1) PG8_BAR;
        PG8_WAIT_V(4); PG8_BAR;
        PG8_STAGE(PG8_SB(1, 0), cB + kstep, voffB); PG8_STAGE(PG8_SA(1, 0), cA + kstep, voffA); PG8_STAGE(PG8_SB(1, 1), cB + hstep + kstep, voffB);
        PG8_WAIT_V(6); PG8_BAR;
    }
    for (;;) {
        const bool has_next = S.next(ui + 1, nxt);
        const char* nA = has_next ? (const char*)g.A + (size_t)nxt.pm * tstep : cA; const char* nB = has_next ? (const char*)g.Bt + (size_t)nxt.pn * tstep : cB;
        for (int t = 0; t < nt; t += 2) {
            const bool last = (t == nt - 2);
            const char* a1 = cA + (size_t)(t + 1) * kstep;
            const char* a2 = last ? nA : cA + (size_t)(t + 2) * kstep; const char* b2 = last ? nB : cB + (size_t)(t + 2) * kstep;
            const char* a3 = a2 + kstep; const char* b3 = b2 + kstep;
            if (last && has_next) S.a_ready(nxt);
            if constexpr (Epi::MID) { if (t == (nt >> 1)) E.mid(acc, cur, wr, wc, fr, fq); }
            if constexpr (SP2) {
            PG8_LDB(B0, 0, 0); PG8_LDB(B1, 0, 1); PG8_SCHED; PG8_LDA(At, 0, 0); PG8_STAGE(PG8_SA(1, 1), a1 + hstep, voffA);
            PG8_WAIT_V(8); PG8_WAIT_L(0); PG8_BAR; PG8_MMA(0, 0, At, B0); PG8_MMA(0, 1, At, B1); PG8_BAR; PG8_SCHED;
            PG8_LDA(At, 0, 1); PG8_STAGE(PG8_SB(0, 0), b2, voffB); PG8_STAGE(PG8_SB(0, 1), b2 + hstep, voffB); PG8_STAGE(PG8_SA(0, 0), a2, voffA);
            PG8_WAIT_V(8); PG8_WAIT_L(0); PG8_BAR; PG8_MMA(1, 0, At, B0); PG8_MMA(1, 1, At, B1); PG8_BAR; PG8_SCHED;
            PG8_LDB(B0, 1, 0); PG8_LDB(B1, 1, 1); PG8_SCHED; PG8_LDA(At, 1, 0); PG8_STAGE(PG8_SA(0, 1), a2 + hstep, voffA);
            PG8_WAIT_V(8); PG8_WAIT_L(0); PG8_BAR; PG8_MMA(0, 0, At, B0); PG8_MMA(0, 1, At, B1); PG8_BAR; PG8_SCHED;
            PG8_LDA(At, 1, 1); PG8_STAGE(PG8_SB(1, 0), b3, voffB); PG8_STAGE(PG8_SB(1, 1), b3 + hstep, voffB); PG8_STAGE(PG8_SA(1, 0), a3, voffA);
            PG8_WAIT_V(8); PG8_WAIT_L(0); PG8_BAR; PG8_MMA(1, 0, At, B0); PG8_MMA(1, 1, At, B1); PG8_BAR; PG8_SCHED;
            } else {
            PG8_LDB(B0, 0, 0); PG8_SCHED; PG8_LDA(At, 0, 0); PG8_STAGE(PG8_SA(1, 1), a1 + hstep, voffA);
            PG8_WAIT_L(8); PG8_BAR; PG8_WAIT_L(0); PG8_MMA(0, 0, At, B0); PG8_BAR; PG8_SCHED;
            PG8_LDB(B1, 0, 1); PG8_STAGE(PG8_SB(0, 0), b2, voffB);
            PG8_BAR; PG8_WAIT_L(0); PG8_MMA(0, 1, At, B1); PG8_BAR;
            PG8_LDA(At, 0, 1); PG8_STAGE(PG8_SA(0, 0), a2, voffA);
            PG8_BAR; PG8_WAIT_L(0); PG8_MMA(1, 0, At, B0); PG8_BAR; PG8_SCHED;
            PG8_STAGE(PG8_SB(0, 1), b2 + hstep, voffB);
            PG8_WAIT_V(6); PG8_BAR; PG8_MMA(1, 1, At, B1); PG8_BAR;
            PG8_LDB(B0, 1, 0); PG8_SCHED; PG8_LDA(At, 1, 0); PG8_STAGE(PG8_SA(0, 1), a2 + hstep, voffA);
            PG8_WAIT_L(8); PG8_BAR; PG8_WAIT_L(0); PG8_MMA(0, 0, At, B0); PG8_BAR; PG8_SCHED;
            PG8_LDB(B1, 1, 1); PG8_STAGE(PG8_SB(1, 0), b3, voffB);
            PG8_BAR; PG8_WAIT_L(0); PG8_MMA(0, 1, At, B1); PG8_BAR;
            PG8_LDA(At, 1, 1); PG8_STAGE(PG8_SA(1, 0), a3, voffA);
            PG8_BAR; PG8_WAIT_L(0); PG8_MMA(1, 0, At, B0); PG8_BAR; PG8_SCHED;
            PG8_STAGE(PG8_SB(1, 1), b3 + hstep, voffB);
            PG8_WAIT_V(6); PG8_BAR; PG8_MMA(1, 1, At, B1); PG8_BAR;
            }
        }
        if constexpr (ALIGN_EPI) { if (wr == 0) PG8_BAR; }
        if constexpr (!Epi::AFTER_DRAIN) { E(acc, cur, wr, wc, fr, fq); S.done(cur); }
        if (!has_next) break;
#pragma unroll
        for (int a = 0; a < 2; ++a)
#pragma unroll
            for (int b = 0; b < 2; ++b)
#pragma unroll
                for (int m = 0; m < 4; ++m)
#pragma unroll
                    for (int n = 0; n < 2; ++n) acc[a][b][m][n] = (f32x4){0.f, 0.f, 0.f, 0.f};
        cur = nxt; cA = nA; cB = nB; ++ui;
        if constexpr (ALIGN_EPI) { if (wr == 1) PG8_BAR; }
    }
    PG8_WAIT_V(0);
    if constexpr (!ALIGN_EPI) { if (wr == 0) PG8_BAR; }
    PG8_BAR;
    if constexpr (Epi::AFTER_DRAIN) { E.fused(acc, cur, wr, wc, fr, fq, lds, wid, lane); S.done(cur); }
#undef PG8_SA
#undef PG8_SB
#undef PG8_STAGE
#undef PG8_LDA
#undef PG8_LDB
#undef PG8_MMA
#undef PG8_WAIT_V
#undef PG8_WAIT_L
#undef PG8_BAR
#undef PG8_SCHED
}
}

namespace att {
#define ATT_LAS __attribute__((address_space(3)))
typedef unsigned short bf16_t;
typedef short bf16x8 __attribute__((ext_vector_type(8)));
typedef short s16x4 __attribute__((ext_vector_type(4)));
typedef float f32x16 __attribute__((ext_vector_type(16)));
typedef unsigned u32x4 __attribute__((ext_vector_type(4)));
constexpr int SHM_V = 16384, SHM_K = 16384, SHM_R = 8192, BUFB = SHM_V + SHM_K + SHM_R;
constexpr int LDS_SCR = 2 * BUFB;
constexpr int LDS_FLAGS = LDS_SCR + 8 * 256;
constexpr int LDS_QR = LDS_FLAGS + 64;
constexpr int ATT_LDS_BYTES = LDS_QR + 8 * 4096;
#define KSWZ(row, colB) ((row) * 256 + ((colB) ^ (((row) & 7) << 4)))
#define RSWZ(row, colB) ((row) * 128 + ((colB) ^ ((((row) >> 1) & 7) << 4)))
__device__ __forceinline__ int v_st(int k, int c) { const int kk = (k & ~0xC) | ((k & 4) << 1) | ((k & 8) >> 1); return ((kk >> 3) * 4 + (c >> 5)) * 512 + ((kk & 7) * 32 + (c & 31)) * 2; }
__device__ __forceinline__ int v_rd_base(int lane) { return ((lane & 3) << 3) | (((lane >> 2) & 3) << 6) | (((lane >> 4) & 1) << 5) | (((lane >> 5) & 1) << 8); }
constexpr int v_rd_off(int d0, int ks, int half) { return d0 * 512 + ks * 4096 + half * 2048; }
__device__ __forceinline__ int crow(int r, int hi) { return (r & 3) + 8 * (r >> 2) + 4 * hi; }
__device__ __forceinline__ unsigned cvtpk(float lo, float hi) { unsigned r; asm volatile("v_cvt_pk_bf16_f32 %0, %1, %2" : "=v"(r) : "v"(lo), "v"(hi)); return r; }
#define ATT_SBAR() __builtin_amdgcn_sched_barrier(0)
#ifndef ATT_PRIO
#define ATT_PRIO 0
#endif
#ifndef ATT_EARLYW
#define ATT_EARLYW 0
#endif

template <int ND>
__device__ __forceinline__ void qkt_half(f32x16& p, const ATT_LAS char* Kb, const ATT_LAS char* Rb, int r32, int hi, const bf16x8* qr, const ATT_LAS char* qrl, int lane, int half) {
    bf16x8 kf[8];
#pragma unroll
    for (int d0 = 0; d0 < 8; ++d0) kf[d0] = *(const ATT_LAS bf16x8*)(Kb + KSWZ(r32, ((d0 & 3) * 16 + hi * 8) * 2) + (d0 >> 2) * 128 + half * (32 * 256));
    ATT_SBAR();
    p = f32x16{};
    if constexpr (ND == 12) {
        bf16x8 rf[4], qf[4];
#pragma unroll
        for (int d0 = 0; d0 < 4; ++d0) p = __builtin_amdgcn_mfma_f32_32x32x16_bf16(kf[d0], qr[d0], p, 0, 0, 0);
        ATT_SBAR();
#pragma unroll
        for (int dr = 0; dr < 4; ++dr) { rf[dr] = *(const ATT_LAS bf16x8*)(Rb + RSWZ(r32, (dr * 16 + hi * 8) * 2) + half * (32 * 128)); qf[dr] = *(const ATT_LAS bf16x8*)(qrl + dr * 1024 + lane * 16); }
        ATT_SBAR();
#pragma unroll
        for (int d0 = 4; d0 < 8; ++d0) p = __builtin_amdgcn_mfma_f32_32x32x16_bf16(kf[d0], qr[d0], p, 0, 0, 0);
#pragma unroll
        for (int dr = 0; dr < 4; ++dr) p = __builtin_amdgcn_mfma_f32_32x32x16_bf16(rf[dr], qf[dr], p, 0, 0, 0);
    } else {
#pragma unroll
        for (int d0 = 0; d0 < 8; ++d0) p = __builtin_amdgcn_mfma_f32_32x32x16_bf16(kf[d0], qr[d0], p, 0, 0, 0);
    }
}
__device__ __forceinline__ void pv_tile(f32x16* o, int vb, bf16x8 pa0, bf16x8 pa1, bf16x8 pa2, bf16x8 pa3) {
#define ATT_TRRD(dst, off) asm volatile("ds_read_b64_tr_b16 %0, %1 offset:%2" : "=&v"(dst) : "v"(vb), "i"(off) : "memory")
#define ATT_PV_D0(d0) do { s16x4 l0, l1, l2, l3, h0, h1, h2, h3; constexpr int b_ = v_rd_off(d0, 0, 0); \
        ATT_TRRD(l0, b_); ATT_TRRD(h0, b_ + 2048); ATT_TRRD(l1, b_ + 4096); ATT_TRRD(h1, b_ + 6144); ATT_TRRD(l2, b_ + 8192); ATT_TRRD(h2, b_ + 10240); ATT_TRRD(l3, b_ + 12288); ATT_TRRD(h3, b_ + 14336); \
        asm volatile("s_waitcnt lgkmcnt(0)" ::: "memory"); ATT_SBAR(); \
        o[d0] = __builtin_amdgcn_mfma_f32_32x32x16_bf16(pa0, (bf16x8){l0[0], l0[1], l0[2], l0[3], h0[0], h0[1], h0[2], h0[3]}, o[d0], 0, 0, 0); \
        o[d0] = __builtin_amdgcn_mfma_f32_32x32x16_bf16(pa1, (bf16x8){l1[0], l1[1], l1[2], l1[3], h1[0], h1[1], h1[2], h1[3]}, o[d0], 0, 0, 0); \
        o[d0] = __builtin_amdgcn_mfma_f32_32x32x16_bf16(pa2, (bf16x8){l2[0], l2[1], l2[2], l2[3], h2[0], h2[1], h2[2], h2[3]}, o[d0], 0, 0, 0); \
        o[d0] = __builtin_amdgcn_mfma_f32_32x32x16_bf16(pa3, (bf16x8){l3[0], l3[1], l3[2], l3[3], h3[0], h3[1], h3[2], h3[3]}, o[d0], 0, 0, 0); } while (0)
    if (ATT_PRIO) __builtin_amdgcn_s_setprio(1);
    ATT_PV_D0(0); ATT_PV_D0(1); ATT_PV_D0(2); ATT_PV_D0(3);
    if (ATT_PRIO) __builtin_amdgcn_s_setprio(0);
#undef ATT_PV_D0
#undef ATT_TRRD
}
__device__ __forceinline__ void pack_half(const f32x16& p, bf16x8& pa0, bf16x8& pa1) {
#define ATT_PK4(P, B_, OUT) do { unsigned a0 = cvtpk(P[B_+0], P[B_+1]), a1 = cvtpk(P[B_+2], P[B_+3]); \
        unsigned b0 = cvtpk(P[B_+4], P[B_+5]), b1 = cvtpk(P[B_+6], P[B_+7]); \
        auto r0 = __builtin_amdgcn_permlane32_swap(a0, b0, false, false); auto r1 = __builtin_amdgcn_permlane32_swap(a1, b1, false, false); \
        u32x4 w = {r0[0], r1[0], r0[1], r1[1]}; OUT = __builtin_bit_cast(bf16x8, w); } while (0)
    ATT_PK4(p, 0, pa0); ATT_PK4(p, 8, pa1);
#undef ATT_PK4
}
__device__ __forceinline__ void half_xchg(float x, float& lo, float& hi) {
    unsigned a = __builtin_bit_cast(unsigned, x), b;
    asm volatile("s_nop 1\n\tv_mov_b32 %1, %0\n\ts_nop 1\n\tv_permlane32_swap_b32 %0, %1" : "+v"(a), "=&v"(b));
    lo = __builtin_bit_cast(float, a); hi = __builtin_bit_cast(float, b);
}
__device__ __forceinline__ float half_sum(float v) { float lo, hi; half_xchg(v, lo, hi); return lo + hi; }
__device__ __forceinline__ float half_max(float v) { float lo, hi; half_xchg(v, lo, hi); return fmaxf(lo, hi); }

struct Tensors { const bf16_t* Q; int ldq; const bf16_t* K; int ldk; const bf16_t* V; int ldv; const bf16_t* R; bf16_t* O; int ldo; };

template <int MODE>
__device__ __forceinline__ void attn_unit(const Tensors& T, int qb, float sc2, ATT_LAS char* lds) {
    constexpr int ND = MODE == 1 ? 12 : 8;
    int tid_ = threadIdx.x; asm volatile("" : "+v"(tid_));
    const int tid = tid_, wid = __builtin_amdgcn_readfirstlane(tid >> 6), lane = tid & 63, r32 = lane & 31, hi = lane >> 5;
    const int q0 = qb * 256, qw = q0 + wid * 32;
    const int NT = 4 * (qb + 1);
    const int wlast = 4 * qb + (wid >> 1);
    const int tq = qw + r32;
    ATT_LAS float* scr = (ATT_LAS float*)(lds + LDS_SCR) + wid * 64;
    volatile ATT_LAS unsigned* flags = (volatile ATT_LAS unsigned*)(lds + LDS_FLAGS);
    const ATT_LAS char* qrl = lds + LDS_QR + wid * 4096;
    bf16x8 qr[8];
    { const bf16_t* qp = T.Q + (size_t)tq * T.ldq + hi * 8;
#pragma unroll
      for (int d0 = 0; d0 < 8; ++d0) qr[d0] = *(const bf16x8*)(qp + d0 * 16);
      if constexpr (MODE == 1) {
#pragma unroll
          for (int dr = 0; dr < 4; ++dr) *(ATT_LAS bf16x8*)(lds + LDS_QR + wid * 4096 + dr * 1024 + lane * 16) = *(const bf16x8*)(qp + 128 + dr * 16); } }
    const int sr = tid >> 4, sc = (tid & 15) * 8, kws = KSWZ(sr, sc * 2), vst0 = v_st(sr, sc), vst1 = v_st(32 + sr, sc);
    const int rr_ = tid >> 3, rc = (tid & 7) * 8, rws = RSWZ(rr_, rc * 2);
    bf16x8 sk0, sk1, sv0, sv1, srp;
#define ATT_LOAD(kt) do { const size_t k0_ = (size_t)(kt) * 64; \
        sk0 = *(const bf16x8*)(T.K + (k0_ + sr) * T.ldk + sc); sk1 = *(const bf16x8*)(T.K + (k0_ + 32 + sr) * T.ldk + sc); \
        sv0 = *(const bf16x8*)(T.V + (k0_ + sr) * T.ldv + sc); sv1 = *(const bf16x8*)(T.V + (k0_ + 32 + sr) * T.ldv + sc); \
        if constexpr (MODE == 1) srp = *(const bf16x8*)(T.R + (k0_ + rr_) * 64 + rc); } while (0)
#define ATT_WRITE(bf) do { ATT_LAS char* b_ = lds + (bf) * BUFB; \
        *(ATT_LAS bf16x8*)(b_ + vst0) = sv0; *(ATT_LAS bf16x8*)(b_ + vst1) = sv1; \
        *(ATT_LAS bf16x8*)(b_ + SHM_V + kws) = sk0; *(ATT_LAS bf16x8*)(b_ + SHM_V + kws + 32 * 256) = sk1; \
        if constexpr (MODE == 1) *(ATT_LAS bf16x8*)(b_ + SHM_V + SHM_K + rws) = srp; } while (0)
#define ATT_TILE(it) (MODE == 0 ? (NT - 1 - (it)) : (it))
    f32x16 o[4] = {};
    float carry = 0.f;
    float m_reg = -1e30f, l_reg = 0.f;
    bool dead = false;
    const float hsel = hi ? 0.f : 1.f;
    ATT_LOAD(ATT_TILE(0)); asm volatile("s_waitcnt vmcnt(0)" ::: "memory"); ATT_WRITE(0);
    __syncthreads();
    for (int it = 0; it < NT; ++it) {
        const int cur = it & 1, kt = ATT_TILE(it), kb = kt * 64;
        if (it + 1 < NT) ATT_LOAD(ATT_TILE(it + 1));
        const ATT_LAS char* bufp = lds + cur * BUFB;
        bool staged = false;
        if (kt <= wlast && !dead) {
            f32x16 p0, p1;
            bf16x8 pa0, pa1, pa2, pa3;
            if constexpr (MODE == 0) {
                const bool diag = (kb + 63 >= qw);
                qkt_half<ND>(p1, bufp + SHM_V, bufp + SHM_V + SHM_K, r32, hi, qr, qrl, lane, 1);
                qkt_half<ND>(p0, bufp + SHM_V, bufp + SHM_V + SHM_K, r32, hi, qr, qrl, lane, 0);
                float tsum = carry;
#define ATT_SB_HALF(P, KOFF) do { f32x16 f; \
                    _Pragma("unroll") for (int r = 0; r < 16; ++r) { P[r] *= sc2; \
                        f[r] = fminf(-P[r], 0.f) - __builtin_amdgcn_logf(1.0f + __builtin_amdgcn_exp2f(-__builtin_fabsf(P[r]))); } \
                    if (diag) { _Pragma("unroll") for (int r = 0; r < 16; ++r) { if (kb + (KOFF) + crow(r, hi) >= tq) f[r] = 0.f; } } \
                    float gs_[4], oh_[4], ps_[4]; \
                    _Pragma("unroll") for (int i = 0; i < 4; ++i) { f[4*i+2] += f[4*i+3]; f[4*i+1] += f[4*i+2]; f[4*i] += f[4*i+1]; gs_[i] = f[4*i]; } \
                    _Pragma("unroll") for (int i = 0; i < 4; ++i) { float lo_; half_xchg(gs_[i], lo_, oh_[i]); ps_[i] = lo_ + oh_[i]; } \
                    _Pragma("unroll") for (int i = 3; i >= 0; --i) { const float Tg = tsum + hsel * oh_[i]; \
                        _Pragma("unroll") for (int e = 0; e < 4; ++e) P[4*i+e] = __builtin_amdgcn_exp2f(P[4*i+e] + f[4*i+e] + Tg); \
                        tsum += ps_[i]; } \
                    if (diag) { _Pragma("unroll") for (int r = 0; r < 16; ++r) { if (kb + (KOFF) + crow(r, hi) >= tq) P[r] = 0.f; } } } while (0)
                ATT_SB_HALF(p1, 32);
                pack_half(p1, pa2, pa3);
                ATT_SB_HALF(p0, 0);
                pack_half(p0, pa0, pa1);
#undef ATT_SB_HALF
                carry = tsum;
                pv_tile(o, (int)(uintptr_t)(bufp) + v_rd_base(lane), pa0, pa1, pa2, pa3);
                if (__all(carry < -140.f)) dead = true;
            } else {
                qkt_half<ND>(p0, bufp + SHM_V, bufp + SHM_V + SHM_K, r32, hi, qr, qrl, lane, 0);
                qkt_half<ND>(p1, bufp + SHM_V, bufp + SHM_V + SHM_K, r32, hi, qr, qrl, lane, 1);
                float pmax = p0[0];
#pragma unroll
                for (int r = 1; r < 16; ++r) pmax = fmaxf(pmax, p0[r]);
#pragma unroll
                for (int r = 0; r < 16; ++r) pmax = fmaxf(pmax, p1[r]);
                pmax = half_max(pmax);
                const float mn = fmaxf(m_reg, pmax), alpha = __builtin_amdgcn_exp2f((m_reg - mn) * sc2); m_reg = mn;
                const float mnL = -mn * sc2;
                float psum = 0.f;
#pragma unroll
                for (int r = 0; r < 16; ++r) { p0[r] = __builtin_amdgcn_exp2f(fmaf(p0[r], sc2, mnL)); psum += p0[r]; }
                pack_half(p0, pa0, pa1);
#pragma unroll
                for (int r = 0; r < 16; ++r) { p1[r] = __builtin_amdgcn_exp2f(fmaf(p1[r], sc2, mnL)); psum += p1[r]; }
                pack_half(p1, pa2, pa3);
                l_reg = l_reg * alpha + half_sum(psum);
                if (__any(alpha < 1.f))
                { if (hi == 0) scr[r32] = alpha; asm volatile("s_waitcnt lgkmcnt(0)" ::: "memory");
#pragma unroll
                    for (int r = 0; r < 16; ++r) { const float a = scr[crow(r, hi)];
#pragma unroll
                        for (int d = 0; d < 4; ++d) o[d][r] *= a; } }
#if ATT_EARLYW
                if (it + 1 < NT) { asm volatile("s_waitcnt vmcnt(0)" ::: "memory"); ATT_WRITE(cur ^ 1); staged = true; }
#endif
                pv_tile(o, (int)(uintptr_t)(bufp) + v_rd_base(lane), pa0, pa1, pa2, pa3);
            }
        }
        if (it + 1 < NT && !staged) { asm volatile("s_waitcnt vmcnt(0)" ::: "memory"); ATT_WRITE(cur ^ 1); }
        if constexpr (MODE == 0) { if (lane == 0) flags[cur * 8 + wid] = dead ? 1u : 0u; }
        __syncthreads();
        if constexpr (MODE == 0) {
            unsigned alld = 1u;
#pragma unroll
            for (int w = 0; w < 8; ++w) alld &= flags[cur * 8 + w];
            if (alld) break;
        }
    }
    if constexpr (MODE == 1) { if (hi == 0) scr[32 + r32] = l_reg; asm volatile("s_waitcnt lgkmcnt(0)" ::: "memory"); }
    bf16_t* Ow = T.O + (size_t)qw * T.ldo;
    int obase = 4 * hi * T.ldo + r32; asm volatile("" : "+v"(obase));
#pragma unroll
    for (int r = 0; r < 16; ++r) { const int orow = crow(r, hi);
        float rl = 1.f; if constexpr (MODE == 1) rl = __builtin_amdgcn_rcpf(scr[32 + orow]);
        int ro = obase + ((r & 3) + 8 * (r >> 2)) * T.ldo; asm volatile("" : "+v"(ro));
#pragma unroll
        for (int d0 = 0; d0 < 4; ++d0) { const float v = o[d0][r] * rl; const float vn = __shfl_xor(v, 1);
            if ((r32 & 1) == 0) *(unsigned*)(Ow + ro + d0 * 32) = cvtpk(v, vn); } }
    __syncthreads();
#undef ATT_LOAD
#undef ATT_WRITE
#undef ATT_TILE
}
}

constexpr int BATCH = 2, SEQ = 4096, D = 4096, M = BATCH * SEQ, DEPTH = 2;
constexpr int SBW = 2048, QRANK = 1024, KVRANK = 512, ROPE = 64, DFF = 16384;
constexpr int IN_W = 3 * SBW + QRANK + KVRANK + ROPE + 2 * D;
constexpr int C_QD = 3 * SBW, C_KVD = C_QD + QRANK, C_GATE_SRC = C_KVD + KVRANK + ROPE;
constexpr int C_GSB = 7936, C_GMLA = C_GSB + D, PROJ_W = C_GMLA + D;
constexpr int QW = 16 * 192, KVW = 16 * 256;
constexpr float EPS = 1e-6f;
static_assert(IN_W == 15936 && PROJ_W == 16128 && PROJ_W % 256 == 0 && C_GSB % 256 == 0, "projection layout");

constexpr size_t MiB = 1u << 20;
constexpr size_t WS_CTL = 0, CTL_ZERO_BYTES = 1 * MiB;
constexpr size_t WS_ADA = 1 * MiB;
constexpr size_t WS_TAB = 2 * MiB;
constexpr size_t WS_ADAP = 4 * MiB;
constexpr size_t WS_W = 32 * MiB;
constexpr size_t W_IN = 0, W_UQ = 126 * MiB, W_UKV = 132 * MiB, W_OSB = 136 * MiB, W_OMLA = 152 * MiB, W_OUT = 168 * MiB, W_UP = 200 * MiB, W_DOWN = 328 * MiB, W_LAYER = 456 * MiB;
constexpr size_t WS_ACT = WS_W + DEPTH * W_LAYER;
constexpr size_t A_H = WS_ACT, A_PROJ = A_H + 64 * MiB, A_CQ = A_PROJ + 252 * MiB, A_CKV = A_CQ + 16 * MiB, A_KR = A_CKV + 8 * MiB, A_Q = A_KR + 1 * MiB, A_KV = A_Q + 48 * MiB,
                 A_OSB = A_KV + 64 * MiB, A_OMLA = A_OSB + 32 * MiB, A_TMP = A_OMLA + 32 * MiB, A_MRG = A_TMP + 128 * MiB, A_Y = A_MRG + 64 * MiB, A_U = A_Y + 128 * MiB, WS_END = A_U + 256 * MiB;
static_assert((size_t)PROJ_W * D * 2 == 126 * MiB && (size_t)M * PROJ_W * 2 == 252 * MiB, "sizes");
constexpr int CW_TMO = 0;
constexpr int CW_BAR = 4096;

constexpr int RING_BYTES = 135168;
constexpr int LDSCTL_OFF = RING_BYTES, MISC_OFF = LDSCTL_OFF + 320;
constexpr int LDS_BYTES = RING_BYTES + 1024;
constexpr int NWAVES = 8;
static_assert(att::ATT_LDS_BYTES <= RING_BYTES && pg8::STAGE_BYTES <= RING_BYTES, "LDS map");

#define GAS __attribute__((address_space(1)))
#define LAS __attribute__((address_space(3)))
typedef unsigned short bf16;
typedef unsigned v4u __attribute__((ext_vector_type(4)));
typedef unsigned v2u __attribute__((ext_vector_type(2)));
typedef float f32x4 __attribute__((ext_vector_type(4)));
typedef GAS unsigned gu32;
#define RLX_AGENT __ATOMIC_RELAXED, __HIP_MEMORY_SCOPE_AGENT
#ifndef USE_NT
#define USE_NT 0
#endif
#if USE_NT
#define NT_LD(p) __builtin_nontemporal_load(p)
#else
#define NT_LD(p) (*(p))
#endif
#define LDS_WAIT() asm volatile("s_waitcnt lgkmcnt(0)" ::: "memory")
#define VM_WAIT() asm volatile("s_waitcnt vmcnt(0)" ::: "memory")
__device__ __forceinline__ unsigned pk2(float lo, float hi) { return pg8::cvt_pk_bf16(lo, hi); }
__device__ __forceinline__ float bflo(unsigned w) { return __builtin_bit_cast(float, w << 16); }
__device__ __forceinline__ float bfhi(unsigned w) { return __builtin_bit_cast(float, w & 0xffff0000u); }

#define XB_TMO      128
#define XB_XCNT(j)  (256  + 64 * (j))
#define XB_XSUB(j)  (1280 + 64 * (j))
#define XB_XGEN(j)  (2304 + 64 * (j))
#define XB_TOP      3328
#define XB_TOPGEN   3392
#define XCD_BAR_WORDS 3456
#define XB_SPIN_CAP (1u << 21)

__device__ __forceinline__ unsigned xb_ld(unsigned* p)              { return __hip_atomic_load(p, __ATOMIC_RELAXED, __HIP_MEMORY_SCOPE_AGENT); }
__device__ __forceinline__ unsigned xb_add(unsigned* p, unsigned v) { return __hip_atomic_fetch_add(p, v, __ATOMIC_RELAXED, __HIP_MEMORY_SCOPE_AGENT); }
__device__ __forceinline__ unsigned xb_xcc_id() { return (unsigned)__builtin_amdgcn_s_getreg((3 << 11) | 20) & 0xFu; }
#define XB_SPIN(cond, bar) do { unsigned _sp = 0; while (cond) { __builtin_amdgcn_s_sleep(1); \
    if ((++_sp & 255u) == 0u) { if (xb_ld(&(bar)[XB_TMO])) break; if (_sp > XB_SPIN_CAP) { atomicAdd(&(bar)[XB_TMO], 1u); break; } } } } while (0)

struct XcdBarrier {
    unsigned* bar; unsigned x;
    volatile LAS unsigned* st;
};

__device__ __forceinline__ XcdBarrier xcd_barrier_post(unsigned* bar, volatile LAS unsigned* st) {
    XcdBarrier b; b.bar = bar; b.x = xb_xcc_id(); b.st = st;
    if (threadIdx.x == 0) (void)xb_add(&bar[XB_XCNT(b.x)], 1u);
    return b;
}
__device__ __forceinline__ void xcd_barrier_complete(unsigned* bar, unsigned x, unsigned& nloc, unsigned& nx) {
    const unsigned G = gridDim.x * gridDim.y * gridDim.z;
    unsigned sum, cnt, mine, sp = 0u;
    for (;;) {
        sum = 0u; cnt = 0u; mine = 0u;
#pragma unroll
        for (unsigned j = 0; j < 16; ++j) { const unsigned c = xb_ld(&bar[XB_XCNT(j)]); sum += c; cnt += (c > 0u) ? 1u : 0u; mine = (j == x) ? c : mine; }
        if (sum == G) break;
        __builtin_amdgcn_s_sleep(1);
        if ((++sp & 255u) == 0u) { if (xb_ld(&bar[XB_TMO])) break; if (sp > XB_SPIN_CAP) { atomicAdd(&bar[XB_TMO], 1u); break; } }
    }
    nloc = mine > 0u ? mine : 1u; nx = cnt > 0u ? cnt : 1u;
}

__device__ __forceinline__ void xcd_barrier(const XcdBarrier& b) {
    asm volatile("s_waitcnt vmcnt(0)" ::: "memory");
    __syncthreads();
    if (threadIdx.x == 0) {
        unsigned* bar = b.bar; unsigned bx_ = b.x; asm volatile("" : "+s"(bar), "+s"(bx_));
        __builtin_amdgcn_s_waitcnt(0);
        unsigned nloc = b.st[0], nx = b.st[1];
        if (nloc == 0u) { xcd_barrier_complete(bar, bx_, nloc, nx); b.st[0] = nloc; b.st[1] = nx; }
        const unsigned old = xb_add(&bar[XB_XSUB(bx_)], 1u);
        const unsigned gen = old / nloc;
        if (old + 1u == (gen + 1u) * nloc) {
            __builtin_amdgcn_fence(__ATOMIC_RELEASE, "agent");
            asm volatile("s_waitcnt vmcnt(0)" ::: "memory");
            const unsigned og = xb_add(&bar[XB_TOP], 1u);
            const unsigned tg = og / nx;
            if (og + 1u == (tg + 1u) * nx) xb_add(&bar[XB_TOPGEN], 1u);
            else XB_SPIN(xb_ld(&bar[XB_TOPGEN]) == tg, bar);
            __builtin_amdgcn_fence(__ATOMIC_ACQUIRE, "agent");
            xb_add(&bar[XB_XGEN(bx_)], 1u);
            asm volatile("s_waitcnt vmcnt(0)" ::: "memory");
        } else {
            XB_SPIN(xb_ld(&bar[XB_XGEN(bx_)]) == gen, bar);
            __builtin_amdgcn_fence(__ATOMIC_ACQUIRE, "agent");
            asm volatile("s_waitcnt vmcnt(0)" ::: "memory");
        }
    }
    __syncthreads();
}


struct Frame {
    LAS unsigned char* lds;
    int tid, lane, wave, G, gw, NGW;
};
__device__ __forceinline__ float wave_sum(float v) {
#pragma unroll
    for (int o = 1; o < 64; o <<= 1) v += __shfl_xor(v, o);
    return v;
}

__device__ __forceinline__ void transpose_item(const float* W, int N, bf16* WT, int ldt, int kb, int nb, int rowbase, bool ropeperm, LAS float* scr, int lane) {
    const int k0 = 64 * kb, n0 = 64 * nb;
    const float* src = W + (size_t)(k0 + (lane >> 4)) * N + n0 + 4 * (lane & 15);
#pragma unroll 4
    for (int i = 0; i < 16; ++i) { const f32x4 v = NT_LD((const f32x4*)(src + (size_t)(4 * i) * N)); LAS float* d = scr + (4 * i + (lane >> 4)) * 65 + 4 * (lane & 15);
        d[0] = v[0]; d[1] = v[1]; d[2] = v[2]; d[3] = v[3]; }
    LDS_WAIT(); asm volatile("" ::: "memory");
    const int c = lane & 7;
#pragma unroll
    for (int j = 0; j < 8; ++j) { const int nn = (lane >> 3) + 8 * j; const LAS float* s = scr + (8 * c) * 65 + nn;
        v4u o; o.x = pk2(s[0 * 65], s[1 * 65]); o.y = pk2(s[2 * 65], s[3 * 65]); o.z = pk2(s[4 * 65], s[5 * 65]); o.w = pk2(s[6 * 65], s[7 * 65]);
        const int orow = rowbase + (ropeperm ? (2 * (nn & 31) + (nn >> 5)) : nn);
        *(GAS v4u*)(WT + (size_t)orow * ldt + k0 + 8 * c) = o; }
    LDS_WAIT(); asm volatile("" ::: "memory");
}

__device__ __forceinline__ void norm_mod_row(const f32x4 (&v)[16], float ssq, const float* g, const float* scv, const float* shv, bf16* orow, int lane) {
    const float r = 1.0f / sqrtf(ssq * (1.0f / D) + EPS);
#pragma unroll
    for (int j = 0; j < 16; ++j) { int c = 4 * lane + 256 * j; asm volatile("" : "+v"(c));
        const f32x4 gg = *(const f32x4*)(g + c), ss = *(const f32x4*)(scv + c), hh = *(const f32x4*)(shv + c);
        f32x4 o;
#pragma unroll
        for (int e = 0; e < 4; ++e) o[e] = v[j][e] * r * gg[e] * (1.0f + ss[e]) + hh[e];
        v2u w; w.x = pk2(o[0], o[1]); w.y = pk2(o[2], o[3]);
        *(GAS v2u*)(orow + c) = w; }
}


template <bool HAS_Y, bool HAS_H, bool XIN_BF = false, bool XOUT_BF = false>
__device__ __forceinline__ void thin_phase(Frame& F, const void* xin_, void* xout_, const bf16* Yb, bf16* Hout,
                                           const float* gpost, const float* gate0, const float* gpre, const float* sc0, const float* sh0) {
    LAS float* cA1 = (LAS float*)F.lds; LAS float* cA2 = cA1 + D; LAS float* cB2 = cA2 + D;
    for (int chunk = blockIdx.x; chunk < M / 32; chunk += F.G) {
        int tid = F.tid; asm volatile("" : "+v"(tid));
        const int b = (chunk * 32) / SEQ;
        __syncthreads();
#pragma unroll
        for (int i = 0; i < 2; ++i) { const int c = 4 * tid + 2048 * i;
            if constexpr (HAS_Y) { const f32x4 g = *(const f32x4*)(gpost + c), t = *(const f32x4*)(gate0 + (size_t)b * 6 * D + c); *(LAS f32x4*)(cA1 + c) = g * t; }
            if constexpr (HAS_H) { const f32x4 g = *(const f32x4*)(gpre + c), s = *(const f32x4*)(sc0 + (size_t)b * 6 * D + c), h = *(const f32x4*)(sh0 + (size_t)b * 6 * D + c);
                *(LAS f32x4*)(cA2 + c) = g * (s + 1.0f); *(LAS f32x4*)(cB2 + c) = h; } }
        __syncthreads();
        const int LN = tid & 63;
#pragma unroll 1
        for (int i = 0; i < 4; ++i) {
            const size_t m = (size_t)chunk * 32 + F.wave * 4 + i;
            v4u yv[8]; f32x4 xv[16];
#pragma unroll
            for (int j = 0; j < 8; ++j) { const int c = 8 * LN + 512 * j;
                if constexpr (HAS_Y) yv[j] = *(const GAS v4u*)(Yb + m * D + c);
                if constexpr (XIN_BF) { const v4u xb = *(const GAS v4u*)((const bf16*)xin_ + m * D + c);
                    xv[2 * j] = (f32x4){bflo(xb.x), bfhi(xb.x), bflo(xb.y), bfhi(xb.y)}; xv[2 * j + 1] = (f32x4){bflo(xb.z), bfhi(xb.z), bflo(xb.w), bfhi(xb.w)}; }
                else { xv[2 * j] = *(const f32x4*)((const float*)xin_ + m * D + c); xv[2 * j + 1] = *(const f32x4*)((const float*)xin_ + m * D + c + 4); } }
            float ssq2 = 0.f;
            if constexpr (HAS_Y) {
                float ssq = 0.f;
#pragma unroll
                for (int j = 0; j < 8; ++j) { const unsigned w[4] = {yv[j].x, yv[j].y, yv[j].z, yv[j].w};
#pragma unroll
                    for (int q = 0; q < 4; ++q) { const float a = bflo(w[q]), c2 = bfhi(w[q]); ssq += a * a + c2 * c2; } }
                ssq = wave_sum(ssq); const float r = 1.0f / sqrtf(ssq * (1.0f / D) + EPS);
#pragma unroll
                for (int j = 0; j < 8; ++j) { const int c = 8 * LN + 512 * j; const unsigned w[4] = {yv[j].x, yv[j].y, yv[j].z, yv[j].w};
                    const f32x4 a0 = *(const LAS f32x4*)(cA1 + c), a1 = *(const LAS f32x4*)(cA1 + c + 4);
                    f32x4 y0 = {bflo(w[0]), bfhi(w[0]), bflo(w[1]), bfhi(w[1])}, y1 = {bflo(w[2]), bfhi(w[2]), bflo(w[3]), bfhi(w[3])};
                    xv[2 * j] = xv[2 * j] + a0 * (y0 * r); xv[2 * j + 1] = xv[2 * j + 1] + a1 * (y1 * r);
                    if constexpr (XOUT_BF) { v4u xw; xw.x = pk2(xv[2 * j][0], xv[2 * j][1]); xw.y = pk2(xv[2 * j][2], xv[2 * j][3]); xw.z = pk2(xv[2 * j + 1][0], xv[2 * j + 1][1]); xw.w = pk2(xv[2 * j + 1][2], xv[2 * j + 1][3]);
                        *(GAS v4u*)((bf16*)xout_ + m * D + c) = xw; }
                    else { *(f32x4*)((float*)xout_ + m * D + c) = xv[2 * j]; *(f32x4*)((float*)xout_ + m * D + c + 4) = xv[2 * j + 1]; } } }
            if constexpr (HAS_H) {
#pragma unroll
                for (int j = 0; j < 16; ++j) ssq2 += (xv[j][0] * xv[j][0] + xv[j][1] * xv[j][1]) + (xv[j][2] * xv[j][2] + xv[j][3] * xv[j][3]);
                ssq2 = wave_sum(ssq2); const float r2 = 1.0f / sqrtf(ssq2 * (1.0f / D) + EPS);
#pragma unroll
                for (int j = 0; j < 8; ++j) { const int c = 8 * LN + 512 * j;
                    const f32x4 a0 = *(const LAS f32x4*)(cA2 + c), a1 = *(const LAS f32x4*)(cA2 + c + 4), b0 = *(const LAS f32x4*)(cB2 + c), b1 = *(const LAS f32x4*)(cB2 + c + 4);
                    const f32x4 h0 = (xv[2 * j] * r2) * a0 + b0, h1 = (xv[2 * j + 1] * r2) * a1 + b1;
                    v4u w; w.x = pk2(h0[0], h0[1]); w.y = pk2(h0[2], h0[3]); w.z = pk2(h1[0], h1[1]); w.w = pk2(h1[2], h1[3]);
                    *(GAS v4u*)(Hout + m * D + c) = w; } }
        }
    }
    __syncthreads();
}

constexpr int NB_IN = IN_W / 64, I_IN = (D / 64) * NB_IN, I_UQ = (QRANK / 64) * (QW / 64), I_UKV = (KVRANK / 64) * (KVW / 64), I_OSB = (SBW / 64) * (D / 64), I_OMLA = I_OSB,
              I_OUT = (D / 64) * (D / 64), I_UP = (D / 64) * (DFF / 64), I_DOWN = (DFF / 64) * (D / 64), I_LAYER = I_IN + I_UQ + I_UKV + I_OSB + I_OMLA + I_OUT + I_UP + I_DOWN;
#define CONVERT_ITEMS(lo, hi, start, stride) do { int cl_ = F.lane; asm volatile("" : "+v"(cl_));     \
        for (int it = (lo) + (start); it < (hi); it += (stride)) { \
            const int l = it / I_LAYER; int r = it % I_LAYER; \
            if (r < I_IN) { const int kb = r / NB_IN, nb = r % NB_IN, n0 = nb * 64; transpose_item(KIN(I_WIN) + (size_t)l * D * IN_W, IN_W, (bf16*)(wl + W_IN), D, kb, nb, n0 < C_GATE_SRC ? n0 : n0 + (C_GSB - C_GATE_SRC), false, scr, cl_); continue; } r -= I_IN; \
            if (r < I_UQ) { const int kb = r / (QW / 64), nb = r % (QW / 64); transpose_item(KIN(I_WUQ) + (size_t)l * QRANK * QW, QW, (bf16*)(wl + W_UQ), QRANK, kb, nb, nb * 64, (nb % 3) == 2, scr, cl_); continue; } r -= I_UQ; \
            if (r < I_UKV) { const int kb = r / (KVW / 64), nb = r % (KVW / 64); transpose_item(KIN(I_WUKV) + (size_t)l * KVRANK * KVW, KVW, (bf16*)(wl + W_UKV), KVRANK, kb, nb, nb * 64, false, scr, cl_); continue; } r -= I_UKV; \
            if (r < I_OSB) { const int kb = r / (D / 64), nb = r % (D / 64); transpose_item(KIN(I_WOSB) + (size_t)l * SBW * D, D, (bf16*)(wl + W_OSB), 2 * SBW, kb, nb, nb * 64, false, scr, cl_); continue; } r -= I_OSB; \
            if (r < I_OMLA) { const int kb = r / (D / 64), nb = r % (D / 64); transpose_item(KIN(I_WOMLA) + (size_t)l * SBW * D, D, (bf16*)(wl + W_OSB) + SBW, 2 * SBW, kb, nb, nb * 64, false, scr, cl_); continue; } r -= I_OMLA; \
            if (r < I_OUT) { const int kb = r / (D / 64), nb = r % (D / 64); transpose_item(KIN(I_WOUT) + (size_t)l * D * D, D, (bf16*)(wl + W_OUT), D, kb, nb, nb * 64, false, scr, cl_); continue; } r -= I_OUT; \
            if (r < I_UP) { const int kb = r / (DFF / 64), nb = r % (DFF / 64); transpose_item(KIN(I_WUP) + (size_t)l * D * DFF, DFF, (bf16*)(wl + W_UP), D, kb, nb, nb * 64, false, scr, cl_); continue; } r -= I_UP; \
            { const int kb = r / (D / 64), nb = r % (D / 64); transpose_item(KIN(I_WDOWN) + (size_t)l * DFF * D, D, (bf16*)(wl + W_DOWN), DFF, kb, nb, nb * 64, false, scr, cl_); } \
        } } while (0)

#ifndef XRES_BF16
#define XRES_BF16 1
#endif
#ifndef PG8_SP2
#define PG8_SP2 true
#endif
#ifndef PG8_ALIGN
#define PG8_ALIGN false
#endif
#ifndef PH_MASK
#define PH_MASK 0xFFFFFFFFu
#endif
#define PH(k) ((PH_MASK >> (k)) & 1u)
struct Args { const float* in[19]; float* out; unsigned char* ws; };
enum { I_X = 0, I_C, I_POS, I_WADA, I_BADA, I_GPREMIX, I_GPOSTMIX, I_GPREMLP, I_GPOSTMLP, I_WIN, I_GQ, I_WUQ, I_GKV, I_WUKV, I_WOSB, I_WOMLA, I_WOUT, I_WUP, I_WDOWN };

typedef __attribute__((address_space(4))) const unsigned char* kargp_t;
__device__ __forceinline__ __attribute__((address_space(1))) unsigned char* lw_(unsigned char* p) { __attribute__((address_space(1))) unsigned char* q = (__attribute__((address_space(1))) unsigned char*)p; asm volatile("" : "+s"(q)); return q; }
__device__ __forceinline__ kargp_t lwk_() { kargp_t p = (kargp_t)__builtin_amdgcn_kernarg_segment_ptr(); asm volatile("" : "+s"(p)); return p; }
#define KIN(k) ((const float*)(*(const __attribute__((address_space(1))) float* const __attribute__((address_space(4)))*)(lwk_() + 8 * (k))))
__global__ void __launch_bounds__(NWAVES * 64, 2) hybrid_fwd(Args args) {
    extern __shared__ __attribute__((aligned(16))) unsigned char lds_raw[];
    Frame F;
    F.lds = (LAS unsigned char*)lds_raw;
    F.tid = threadIdx.x; F.lane = F.tid & 63; F.wave = __builtin_amdgcn_readfirstlane(F.tid >> 6);
    F.G = gridDim.x; F.gw = blockIdx.x * NWAVES + F.wave; F.NGW = F.G * NWAVES;
    unsigned char* ws = args.ws;
    gu32* ctl = (gu32*)(ws + WS_CTL);
    for (int u = F.tid; u < (LDS_BYTES - LDSCTL_OFF) / 4; u += NWAVES * 64) ((LAS unsigned*)(F.lds + LDSCTL_OFF))[u] = 0u;
    __syncthreads();
    XcdBarrier bar = xcd_barrier_post((unsigned*)(ctl + CW_BAR), (volatile LAS unsigned*)(F.lds + MISC_OFF) + 8);
#define GRID_BAR() xcd_barrier(bar)

#define ada ((float*)(lw_(ws) + WS_ADA))
#define tab ((float*)(lw_(ws) + WS_TAB))
#define adap ((float*)(lw_(ws) + WS_ADAP))
#define Hb ((bf16*)(lw_(ws) + A_H))
#define PROJ ((bf16*)(lw_(ws) + A_PROJ))
#define CQ ((bf16*)(lw_(ws) + A_CQ))
#define CKV ((bf16*)(lw_(ws) + A_CKV))
#define KR ((bf16*)(lw_(ws) + A_KR))
#define QF ((bf16*)(lw_(ws) + A_Q))
#define KVF ((bf16*)(lw_(ws) + A_KV))
#define OSB ((bf16*)(lw_(ws) + A_OSB))
#define MRG ((bf16*)(lw_(ws) + A_MRG))
#define Yb ((bf16*)(lw_(ws) + A_Y))
#define XB ((bf16*)(lw_(ws) + A_TMP))
#define U ((bf16*)(lw_(ws) + A_U))
#define x_in KIN(I_X)
#define wl (lw_(ws) + WS_W + (size_t)l * W_LAYER)
#define adl (ada + (size_t)l * BATCH * 6 * D)
    float* xo = args.out;


    if (PH(0)) {
        LAS float* cact = (LAS float*)F.lds;
        for (int i = F.tid; i < BATCH * D; i += NWAVES * 64) { const float cv = KIN(I_C)[i]; cact[i] = cv / (1.0f + __expf(-cv)); }
        __syncthreads();
        for (int task = blockIdx.x; task < DEPTH * 32 * 12; task += F.G) {
            const int l = task / (32 * 12), s = (task / 12) % 32, cb = task % 12;
            const int col = cb * 2048 + F.tid * 4;
            const float* wp = KIN(I_WADA) + ((size_t)l * D + s * 128) * (6 * D) + col;
            f32x4 a0 = {0.f, 0.f, 0.f, 0.f}, a1 = {0.f, 0.f, 0.f, 0.f};
#pragma unroll 8
            for (int k = 0; k < 128; ++k) { const f32x4 w = NT_LD((const f32x4*)(wp + (size_t)k * (6 * D))); const float c0 = cact[s * 128 + k], c1 = cact[D + s * 128 + k];
                a0 += w * c0; a1 += w * c1; }
            *(f32x4*)(adap + (((size_t)s * DEPTH + l) * BATCH + 0) * (6 * D) + col) = a0;
            *(f32x4*)(adap + (((size_t)s * DEPTH + l) * BATCH + 1) * (6 * D) + col) = a1;
        }
        __syncthreads();
        for (int e = blockIdx.x * (NWAVES * 64) + F.tid; e < M * 32; e += F.G * NWAVES * 64) {
            const int m = e >> 5, i = e & 31;
            const float inv = powf(10000.0f, -(float)i / 32.0f);
            const float ang = (float)(((const int*)KIN(I_POS))[m]) * inv;
            const double rev = (double)ang * 0.15915494309189533577; const float fr = (float)(rev - rint(rev));
            tab[2 * e] = __builtin_amdgcn_cosf(fr); tab[2 * e + 1] = __builtin_amdgcn_sinf(fr);
        }
        for (int l = 0; l < DEPTH; ++l) { v4u* z = (v4u*)(ws + WS_W + l * W_LAYER + W_IN + (size_t)C_GATE_SRC * D * 2);
            for (int i = blockIdx.x * (NWAVES * 64) + F.tid; i < 192 * D * 2 / 16; i += F.G * NWAVES * 64) z[i] = (v4u){0u, 0u, 0u, 0u}; }
        LAS float* scr = (LAS float*)(F.lds) + F.wave * (64 * 65);
        CONVERT_ITEMS(0, DEPTH * I_LAYER, F.gw, F.NGW);
    }
    GRID_BAR();
    if (PH(1)) for (int e = blockIdx.x * (NWAVES * 64) + F.tid; e < DEPTH * BATCH * 6 * D; e += F.G * NWAVES * 64) {
        const int l = e / (BATCH * 6 * D), n = e % (6 * D);
        float s = KIN(I_BADA)[(size_t)l * 6 * D + n];
#pragma unroll 8
        for (int k = 0; k < 32; ++k) s += adap[(size_t)k * (DEPTH * BATCH * 6 * D) + e];
        ada[e] = s;
    }
    GRID_BAR();
    if (PH(2)) thin_phase<false, true>(F, x_in, nullptr, nullptr, Hb, nullptr, nullptr, KIN(I_GPREMIX), ada + D, ada);
    GRID_BAR();

    for (int l = 0; l < DEPTH; ++l) {
        if (PH(3)) { pg8::Gemm g{Hb, (const bf16*)(wl + W_IN), M, PROJ_W, D}; pg8::StaticOrder S; S.init(M, PROJ_W, F.G, (int)blockIdx.x);
          pg8::EpiBf16<0> E{PROJ, PROJ_W};
          pg8::gemm_phase<pg8::EpiBf16<0>, pg8::StaticOrder, PG8_ALIGN, PG8_SP2>(F.lds, g, S, E); }
        GRID_BAR();
        if (PH(4)) for (int m = F.gw; m < M; m += F.NGW) {
            int LN = F.lane; asm volatile("" : "+v"(LN));
            const bf16* pr = PROJ + (size_t)m * PROJ_W;
            { const v4u a = *(const GAS v4u*)(pr + C_QD + 16 * LN), b2 = *(const GAS v4u*)(pr + C_QD + 16 * LN + 8);
              float f[16] = {bflo(a.x), bfhi(a.x), bflo(a.y), bfhi(a.y), bflo(a.z), bfhi(a.z), bflo(a.w), bfhi(a.w), bflo(b2.x), bfhi(b2.x), bflo(b2.y), bfhi(b2.y), bflo(b2.z), bfhi(b2.z), bflo(b2.w), bfhi(b2.w)};
              float ssq = 0.f;
#pragma unroll
              for (int e = 0; e < 16; ++e) ssq += f[e] * f[e];
              ssq = wave_sum(ssq); const float r = 1.0f / sqrtf(ssq * (1.0f / QRANK) + EPS);
              const float* gq = KIN(I_GQ) + (size_t)l * QRANK + 16 * LN;
              v4u o0, o1;
              o0.x = pk2(f[0] * r * gq[0], f[1] * r * gq[1]); o0.y = pk2(f[2] * r * gq[2], f[3] * r * gq[3]); o0.z = pk2(f[4] * r * gq[4], f[5] * r * gq[5]); o0.w = pk2(f[6] * r * gq[6], f[7] * r * gq[7]);
              o1.x = pk2(f[8] * r * gq[8], f[9] * r * gq[9]); o1.y = pk2(f[10] * r * gq[10], f[11] * r * gq[11]); o1.z = pk2(f[12] * r * gq[12], f[13] * r * gq[13]); o1.w = pk2(f[14] * r * gq[14], f[15] * r * gq[15]);
              *(GAS v4u*)(CQ + (size_t)m * QRANK + 16 * LN) = o0; *(GAS v4u*)(CQ + (size_t)m * QRANK + 16 * LN + 8) = o1; }
            { const v4u a = *(const GAS v4u*)(pr + C_KVD + 8 * LN);
              float f[8] = {bflo(a.x), bfhi(a.x), bflo(a.y), bfhi(a.y), bflo(a.z), bfhi(a.z), bflo(a.w), bfhi(a.w)};
              float ssq = 0.f;
#pragma unroll
              for (int e = 0; e < 8; ++e) ssq += f[e] * f[e];
              ssq = wave_sum(ssq); const float r = 1.0f / sqrtf(ssq * (1.0f / KVRANK) + EPS);
              const float* gk = KIN(I_GKV) + (size_t)l * KVRANK + 8 * LN;
              v4u o0; o0.x = pk2(f[0] * r * gk[0], f[1] * r * gk[1]); o0.y = pk2(f[2] * r * gk[2], f[3] * r * gk[3]); o0.z = pk2(f[4] * r * gk[4], f[5] * r * gk[5]); o0.w = pk2(f[6] * r * gk[6], f[7] * r * gk[7]);
              *(GAS v4u*)(CKV + (size_t)m * KVRANK + 8 * LN) = o0; }
            if (LN < 32) { const int i = LN; const bf16* kp = pr + C_KVD + KVRANK;
              const float x1 = bflo((unsigned)kp[i]), x2 = bflo((unsigned)kp[32 + i]); const float cs = tab[((size_t)m * 32 + i) * 2], sn = tab[((size_t)m * 32 + i) * 2 + 1];
              *(GAS unsigned*)(KR + (size_t)m * ROPE + 2 * i) = pk2(x1 * cs - x2 * sn, x2 * cs + x1 * sn); }
        }
        GRID_BAR();
        if (PH(5)) { pg8::Gemm g{CQ, (const bf16*)(wl + W_UQ), M, QW, QRANK}; pg8::StaticOrder S; S.init(M, QW, F.G, (int)blockIdx.x);
          pg8::EpiRope E{QF, QW, tab};
          pg8::gemm_phase<pg8::EpiRope, pg8::StaticOrder, PG8_ALIGN, PG8_SP2>(F.lds, g, S, E); }
        if (PH(5)) { pg8::Gemm g{CKV, (const bf16*)(wl + W_UKV), M, KVW, KVRANK}; pg8::EpiBf16<0> E{KVF, KVW};
          if (F.G == 256) { pg8::UnevenOrder S; S.init(M, KVW, F.G, (int)blockIdx.x);
            pg8::gemm_phase<pg8::EpiBf16<0>, pg8::UnevenOrder, PG8_ALIGN, PG8_SP2>(F.lds, g, S, E); }
          else { pg8::StaticOrder S; S.init(M, KVW, F.G, (int)blockIdx.x);
            pg8::gemm_phase<pg8::EpiBf16<0>, pg8::StaticOrder, PG8_ALIGN, PG8_SP2>(F.lds, g, S, E); } }
        GRID_BAR();
        if (PH(6)) for (int item = blockIdx.x; item < 512; item += F.G) {
            const int kind = item >> 8, c = item & 255, bh = (c & 7) * 4 + ((c >> 3) >> 3), y = (c >> 3) & 7, b = bh >> 4, h = bh & 15;
            const size_t rb = (size_t)b * SEQ;
            if (kind == 0) { if (PH(14)) {
                att::Tensors T{PROJ + rb * PROJ_W + h * 128, PROJ_W, PROJ + rb * PROJ_W + SBW + h * 128, PROJ_W, PROJ + rb * PROJ_W + 2 * SBW + h * 128, PROJ_W, nullptr, OSB + rb * (2 * SBW) + h * 128, 2 * SBW};
                att::attn_unit<0>(T, 15 - y, 0.08838834764831845f * 1.4426950408889634f, (LAS char*)F.lds);
                att::attn_unit<0>(T, y, 0.08838834764831845f * 1.4426950408889634f, (LAS char*)F.lds); }
            } else if (PH(15)) {
                att::Tensors T{QF + rb * QW + h * 192, QW, KVF + rb * KVW + h * 256, KVW, KVF + rb * KVW + h * 256 + 128, KVW, KR + rb * ROPE, OSB + rb * (2 * SBW) + SBW + h * 128, 2 * SBW};
                att::attn_unit<1>(T, 15 - y, 0.07216878364870323f * 1.4426950408889634f, (LAS char*)F.lds);
                att::attn_unit<1>(T, y, 0.07216878364870323f * 1.4426950408889634f, (LAS char*)F.lds);
            }
        }
        GRID_BAR();
        if (PH(7)) { pg8::Gemm g{OSB, (const bf16*)(wl + W_OSB), M, D, 2 * SBW}; pg8::StaticOrder S; S.init(M, D, F.G, (int)blockIdx.x);
          pg8::EpiGateMerge E{MRG, D, PROJ + C_GSB, PROJ + C_GMLA, PROJ_W};
          pg8::gemm_phase<pg8::EpiGateMerge, pg8::StaticOrder, PG8_ALIGN, PG8_SP2>(F.lds, g, S, E); }
        GRID_BAR();
        if (PH(9)) { pg8::Gemm g{MRG, (const bf16*)(wl + W_OUT), M, D, D}; pg8::StaticOrder S; S.init(M, D, F.G, (int)blockIdx.x);
          pg8::EpiBf16<0> E{Yb, D};
          pg8::gemm_phase<pg8::EpiBf16<0>, pg8::StaticOrder, PG8_ALIGN, PG8_SP2>(F.lds, g, S, E); }
        GRID_BAR();
#if XRES_BF16
        if (PH(10)) { if (l == 0) thin_phase<true, true, false, true>(F, x_in, XB, Yb, Hb, KIN(I_GPOSTMIX) + (size_t)l * D, adl + 2 * D, KIN(I_GPREMLP) + (size_t)l * D, adl + 4 * D, adl + 3 * D);
            else thin_phase<true, true, true, true>(F, XB, XB, Yb, Hb, KIN(I_GPOSTMIX) + (size_t)l * D, adl + 2 * D, KIN(I_GPREMLP) + (size_t)l * D, adl + 4 * D, adl + 3 * D); }
#else
        if (PH(10)) thin_phase<true, true>(F, l == 0 ? x_in : (const float*)xo, xo, Yb, Hb, KIN(I_GPOSTMIX) + (size_t)l * D, adl + 2 * D, KIN(I_GPREMLP) + (size_t)l * D, adl + 4 * D, adl + 3 * D);
#endif
        GRID_BAR();
        if (PH(11)) { pg8::Gemm g{Hb, (const bf16*)(wl + W_UP), M, DFF, D}; pg8::StaticOrder S; S.init(M, DFF, F.G, (int)blockIdx.x);
          pg8::EpiBf16<1> E{U, DFF};
          pg8::gemm_phase<pg8::EpiBf16<1>, pg8::StaticOrder, PG8_ALIGN, PG8_SP2>(F.lds, g, S, E); }
        GRID_BAR();
        if (PH(12)) { pg8::Gemm g{U, (const bf16*)(wl + W_DOWN), M, D, DFF}; pg8::StaticOrder S; S.init(M, D, F.G, (int)blockIdx.x);
          pg8::EpiBf16<0> E{Yb, D};
          pg8::gemm_phase<pg8::EpiBf16<0>, pg8::StaticOrder, PG8_ALIGN, PG8_SP2>(F.lds, g, S, E); }
        GRID_BAR();
#if XRES_BF16
        if (PH(13)) { if (l + 1 < DEPTH) { const float* adn = ada + (size_t)(l + 1) * BATCH * 6 * D;
                thin_phase<true, true, true, true>(F, XB, XB, Yb, Hb, KIN(I_GPOSTMLP) + (size_t)l * D, adl + 5 * D, KIN(I_GPREMIX) + (size_t)(l + 1) * D, adn + D, adn); }
            else thin_phase<true, false, true, false>(F, XB, xo, Yb, nullptr, KIN(I_GPOSTMLP) + (size_t)l * D, adl + 5 * D, nullptr, nullptr, nullptr); }
#else
        if (PH(13)) { if (l + 1 < DEPTH) { const float* adn = ada + (size_t)(l + 1) * BATCH * 6 * D;
                thin_phase<true, true>(F, xo, xo, Yb, Hb, KIN(I_GPOSTMLP) + (size_t)l * D, adl + 5 * D, KIN(I_GPREMIX) + (size_t)(l + 1) * D, adn + D, adn); }
            else thin_phase<true, false>(F, xo, xo, Yb, nullptr, KIN(I_GPOSTMLP) + (size_t)l * D, adl + 5 * D, nullptr, nullptr, nullptr); }
#endif
        if (l + 1 < DEPTH) GRID_BAR();
    }
    if (blockIdx.x == 0 && F.tid == 0 && __hip_atomic_load((unsigned*)(ctl + CW_BAR) + XB_TMO, RLX_AGENT) != 0u) xo[0] = __builtin_nanf("");
}
#undef ada
#undef tab
#undef adap
#undef Hb
#undef PROJ
#undef CQ
#undef CKV
#undef KR
#undef QF
#undef KVF
#undef OSB
#undef MRG
#undef Yb
#undef XB
#undef U
#undef x_in
#undef wl
#undef adl


extern "C" void kernel_launch(void* const* d_in, const int* in_sizes, int n_in, void* d_out, int out_size, void* d_ws, size_t ws_size, hipStream_t stream) {
    static int grid = 0;
    if (grid == 0) {
        if (n_in != 19 || out_size != M * D || ws_size < WS_END) { fprintf(stderr, "kernel_launch: unexpected shapes (n_in %d, out %d, ws %zu < %zu)\n", n_in, out_size, ws_size, (size_t)WS_END); grid = -1; return; }
        int dev = 0, cus = 0, per_cu = 0;
        if (hipGetDevice(&dev) != hipSuccess || hipDeviceGetAttribute(&cus, hipDeviceAttributeMultiprocessorCount, dev) != hipSuccess) { grid = -1; return; }
        if (hipFuncSetAttribute((const void*)hybrid_fwd, hipFuncAttributeMaxDynamicSharedMemorySize, LDS_BYTES) != hipSuccess) { fprintf(stderr, "kernel_launch: hipFuncSetAttribute failed\n"); grid = -1; return; }
        if (hipOccupancyMaxActiveBlocksPerMultiprocessor(&per_cu, (const void*)hybrid_fwd, NWAVES * 64, LDS_BYTES) != hipSuccess || per_cu < 1) { fprintf(stderr, "kernel_launch: occupancy query says %d\n", per_cu); (void)hipGetLastError(); }
        grid = cus;
    }
    if (grid < 0) return;
    if (hipMemsetAsync((char*)d_ws + WS_CTL, 0, CTL_ZERO_BYTES, stream) != hipSuccess) return;
    Args a{};
    for (int i = 0; i < 19; ++i) a.in[i] = (const float*)d_in[i];
    a.out = (float*)d_out; a.ws = (unsigned char*)d_ws;
    hipLaunchKernelGGL(hybrid_fwd, dim3(grid), dim3(NWAVES * 64), LDS_BYTES, stream, a);
#ifdef DBG_CHECK
    hipLaunchKernelGGL(dbg_check, dim3(DBG_NCHK), dim3(256), 0, stream, a, (unsigned*)((char*)d_ws + 4096));
    hipLaunchKernelGGL(dbg_report, dim3(1), dim3(64), 0, stream, (float*)d_out, (const unsigned*)((char*)d_ws + 4096));
#endif
}
```

```cpp
#include <hip/hip_runtime.h>
#include <cstdio>
#include <cstdint>
#include <cmath>
#ifndef PG8_WGM
#define PG8_WGM 8
#endif
namespace pg8 {
#define PG8_LAS __attribute__((address_space(3)))
typedef unsigned short bf16_t;
typedef short bf16x8 __attribute__((ext_vector_type(8)));
typedef float f32x4 __attribute__((ext_vector_type(4)));
typedef unsigned u32x4 __attribute__((ext_vector_type(4)));
constexpr int BM = 256, BK = 64, HALF = 128, HTB = HALF * BK * 2  , STAGE_BYTES = 8 * HTB, NXCD = 8, WGM = PG8_WGM;

__host__ __device__ __forceinline__ int lds_byte(int r, int c) { const int st = (r >> 4) * 2 + (c >> 5), rr = r & 15, cc = c & 31, ob = rr * 64 + cc * 2; return st * 1024 + (ob ^ (((ob >> 9) & 1) << 5)); }
__host__ __device__ __forceinline__ void stage_rc(int b, int& R, int& C) { const int st = b / 1024, sb = b % 1024, swz = sb ^ (((sb >> 9) & 1) << 5); R = (st >> 1) * 16 + swz / 64; C = (st & 1) * 32 + (swz % 64) / 2; }
__host__ __device__ __forceinline__ int perm32(int rho) { const int n = rho >> 4, i = rho & 15; return 8 * (i >> 2) + 4 * n + (i & 3); }

struct Unit { int pm, pn; };
struct Gemm { const bf16_t* A; const bf16_t* Bt; int M, N, K; int lda = 0; };

struct StaticOrder {
    int nM, nN, nwg, G, c;
    __host__ __device__ void init(int M, int N, int G_, int c_) { nM = M / BM; nN = N / BM; nwg = nM * nN; G = G_; c = c_; }
    __host__ __device__ bool next(int i, Unit& u) const {
        const long L = (long)i * G + c; if (L >= nwg) return false;
        int wgid = (int)L; { const int q = nwg / NXCD, r = nwg % NXCD, xcd = wgid % NXCD, off = wgid / NXCD; wgid = (xcd < r ? xcd * (q + 1) : r * (q + 1) + (xcd - r) * q) + off; }
        const int nig = WGM * nN, gid = wgid / nig, fm = gid * WGM, gsz = (nM - fm) < WGM ? (nM - fm) : WGM;
        u.pm = fm + ((wgid % nig) % gsz); u.pn = (wgid % nig) / gsz; return true;
    }
    __device__ __forceinline__ void a_ready(const Unit&) const {}
    __device__ __forceinline__ void done(const Unit&) const {}
};

struct UnevenOrder : StaticOrder {
    __host__ __device__ bool next(int i, Unit& u) const {
        long L; const int h = G / 2;
        if (c < h) { if (i > 0) return false; L = c; } else { if (i > 2) return false; L = h + (long)h * i + (c - h); }
        if (L >= nwg) return false;
        int wgid = (int)L; { const int q = nwg / NXCD, r = nwg % NXCD, xcd = wgid % NXCD, off = wgid / NXCD; wgid = (xcd < r ? xcd * (q + 1) : r * (q + 1) + (xcd - r) * q) + off; }
        const int nig = WGM * nN, gid = wgid / nig, fm = gid * WGM, gsz = (nM - fm) < WGM ? (nM - fm) : WGM;
        u.pm = fm + ((wgid % nig) % gsz); u.pn = (wgid % nig) / gsz; return true;
    }
};

struct RepOrder : StaticOrder {
    int reps;
    __host__ __device__ bool next(int i, Unit& u) const { const int per = (nwg + G - 1) / G; if (i >= per * reps) return false; return StaticOrder::next(i % per, u); }
};
__device__ __forceinline__ unsigned cvt_pk_bf16(float lo, float hi) { unsigned r; asm volatile("v_cvt_pk_bf16_f32 %0, %1, %2" : "=v"(r) : "v"(lo), "v"(hi)); return r; }
typedef float f32x2 __attribute__((ext_vector_type(2)));

__device__ __forceinline__ float bf_lo(unsigned w) { return __builtin_bit_cast(float, w << 16); }
__device__ __forceinline__ float bf_hi(unsigned w) { return __builtin_bit_cast(float, w & 0xffff0000u); }
__device__ __forceinline__ float sigmoidf_fast(float x) { return __builtin_amdgcn_rcpf(1.0f + __builtin_amdgcn_exp2f(-1.4426950408889634f * x)); }

#ifndef EPI_WT
#define EPI_WT 0
#endif
__device__ __forceinline__ void st16_out(bf16_t* p, u32x4 w) {
#if EPI_WT
    asm volatile("global_store_dwordx4 %0, %1, off sc1" :: "v"((__attribute__((address_space(1))) u32x4*)p), "v"(w) : "memory");
#else
    *(u32x4*)p = w;
#endif
}
template <int ACT  > struct EpiBf16 {
    static constexpr bool PERM = true, AFTER_DRAIN = false, MID = false;
    bf16_t* O; int ldc;
    __device__ __forceinline__ void operator()(const f32x4 (&acc)[2][2][4][2], const Unit& u, int wr, int wc, int fr, int fq) const {
        const int row0 = u.pm * BM + wr * 64 + fr, col0 = u.pn * BM + wc * 32 + 8 * fq;
#pragma unroll
        for (int ai = 0; ai < 2; ++ai)
#pragma unroll
            for (int m = 0; m < 4; ++m) { bf16_t* rowp = O + (size_t)(row0 + ai * HALF + m * 16) * ldc + col0;
#pragma unroll
                for (int bj = 0; bj < 2; ++bj) { f32x4 v0 = acc[ai][bj][m][0], v1 = acc[ai][bj][m][1];
                    if (ACT == 1) {
#pragma unroll
                        for (int j = 0; j < 4; ++j) { const float a = fmaxf(v0[j], 0.f), b = fmaxf(v1[j], 0.f); v0[j] = a * a; v1[j] = b * b; } }
                    u32x4 w; w.x = cvt_pk_bf16(v0[0], v0[1]); w.y = cvt_pk_bf16(v0[2], v0[3]); w.z = cvt_pk_bf16(v1[0], v1[1]); w.w = cvt_pk_bf16(v1[2], v1[3]);
                    st16_out(rowp + bj * HALF, w);
                    } }
    }
};
struct EpiProj {
    static constexpr bool PERM = true, AFTER_DRAIN = false, MID = false;
    static constexpr int SSQ_T0 = 24, ROPE_T = 30;
    bf16_t* O; int ldc; float* SSQ; bf16_t* KRo; const float* tab;
    __device__ __forceinline__ void operator()(const f32x4 (&acc)[2][2][4][2], const Unit& u, int wr, int wc, int fr, int fq) const {
        const int row0 = u.pm * BM + wr * 64 + fr, col0 = u.pn * BM + wc * 32 + 8 * fq;
        const bool do_ssq = (u.pn >= SSQ_T0) && (u.pn < SSQ_T0 + 6), do_rope = (u.pn == ROPE_T) && (wc < 2);
#pragma unroll
        for (int ai = 0; ai < 2; ++ai)
#pragma unroll
            for (int m = 0; m < 4; ++m) { const int row = row0 + ai * HALF + m * 16; bf16_t* rowp = O + (size_t)row * ldc + col0;
                float ss = 0.f;
#pragma unroll
                for (int bj = 0; bj < 2; ++bj) { const f32x4 v0 = acc[ai][bj][m][0], v1 = acc[ai][bj][m][1];
                    u32x4 w; w.x = cvt_pk_bf16(v0[0], v0[1]); w.y = cvt_pk_bf16(v0[2], v0[3]); w.z = cvt_pk_bf16(v1[0], v1[1]); w.w = cvt_pk_bf16(v1[2], v1[3]);
                    st16_out(rowp + bj * HALF, w);
                    if (do_ssq) { const unsigned ww[4] = {w.x, w.y, w.z, w.w};
#pragma unroll
                        for (int q = 0; q < 4; ++q) { const float a = bf_lo(ww[q]), b = bf_hi(ww[q]); ss += a * a + b * b; } }
                    if (bj == 0 && do_rope) { const int co = wc * 32 + 8 * fq; const float* tp = tab + (size_t)row * 64 + co;
                        const f32x4 t0 = *(const f32x4*)tp, t1 = *(const f32x4*)(tp + 4);
                        f32x4 r0, r1;
                        r0[0] = v0[0] * t0[0] - v0[1] * t0[1]; r0[1] = v0[1] * t0[0] + v0[0] * t0[1];
                        r0[2] = v0[2] * t0[2] - v0[3] * t0[3]; r0[3] = v0[3] * t0[2] + v0[2] * t0[3];
                        r1[0] = v1[0] * t1[0] - v1[1] * t1[1]; r1[1] = v1[1] * t1[0] + v1[0] * t1[1];
                        r1[2] = v1[2] * t1[2] - v1[3] * t1[3]; r1[3] = v1[3] * t1[2] + v1[2] * t1[3];
                        u32x4 k; k.x = cvt_pk_bf16(r0[0], r0[1]); k.y = cvt_pk_bf16(r0[2], r0[3]); k.z = cvt_pk_bf16(r1[0], r1[1]); k.w = cvt_pk_bf16(r1[2], r1[3]);
                        *(u32x4*)(KRo + (size_t)row * 64 + co) = k; } }
                if (do_ssq) { ss += __shfl_xor(ss, 16); ss += __shfl_xor(ss, 32);
                    if (fq == 0) SSQ[(size_t)row * 32 + 4 * (u.pn - SSQ_T0) + wc] = ss; } }
    }
};
template <int S0, int NS> __device__ __forceinline__ void row_rms_scales(float (&rs)[2][4], const float* SSQ, int row0, int fq, float inv_dim) {
    float part[2][4];
#pragma unroll
    for (int ai = 0; ai < 2; ++ai)
#pragma unroll
        for (int m = 0; m < 4; ++m) { const float* p = SSQ + (size_t)(row0 + ai * HALF + m * 16) * 32 + S0 + (NS / 4) * fq;
            if constexpr (NS == 16) { const f32x4 v = *(const f32x4*)p; part[ai][m] = (v[0] + v[1]) + (v[2] + v[3]); }
            else { const f32x2 v = *(const f32x2*)p; part[ai][m] = v[0] + v[1]; } }
#pragma unroll
    for (int ai = 0; ai < 2; ++ai)
#pragma unroll
        for (int m = 0; m < 4; ++m) { float t = part[ai][m]; t += __shfl_xor(t, 16); t += __shfl_xor(t, 32); rs[ai][m] = 1.0f / sqrtf(t * inv_dim + 1e-6f); }
}
struct EpiScale {
    static constexpr bool PERM = true, AFTER_DRAIN = false, MID = false;
    bf16_t* O; int ldc; const float* SSQ;
    __device__ __forceinline__ void operator()(const f32x4 (&acc)[2][2][4][2], const Unit& u, int wr, int wc, int fr, int fq) const {
        const int row0 = u.pm * BM + wr * 64 + fr, col0 = u.pn * BM + wc * 32 + 8 * fq;
        float rs[2][4]; row_rms_scales<16, 8>(rs, SSQ, row0, fq, 1.0f / 512.0f);
#pragma unroll
        for (int ai = 0; ai < 2; ++ai)
#pragma unroll
            for (int m = 0; m < 4; ++m) { bf16_t* rowp = O + (size_t)(row0 + ai * HALF + m * 16) * ldc + col0; const float r = rs[ai][m];
#pragma unroll
                for (int bj = 0; bj < 2; ++bj) { const f32x4 v0 = acc[ai][bj][m][0] * r, v1 = acc[ai][bj][m][1] * r;
                    u32x4 w; w.x = cvt_pk_bf16(v0[0], v0[1]); w.y = cvt_pk_bf16(v0[2], v0[3]); w.z = cvt_pk_bf16(v1[0], v1[1]); w.w = cvt_pk_bf16(v1[2], v1[3]);
                    st16_out(rowp + bj * HALF, w); } }
    }
};
struct EpiRope {
    static constexpr bool PERM = true, AFTER_DRAIN = false, MID = false;
    bf16_t* O; int ldc; const float* tab; const float* SSQ;
    __device__ __forceinline__ void operator()(const f32x4 (&acc)[2][2][4][2], const Unit& u, int wr, int wc, int fr, int fq) const {
        const int row0 = u.pm * BM + wr * 64 + fr, col0 = u.pn * BM + wc * 32 + 8 * fq;
        float rs[2][4]; row_rms_scales<0, 16>(rs, SSQ, row0, fq, 1.0f / 1024.0f);
        const int j0 = col0 % 192, j1 = (col0 + HALF) % 192, rbj = (j0 >= 128) ? 0 : (j1 >= 128) ? 1 : -1, jr = (rbj == 0 ? j0 : j1) - 128;
#pragma unroll
        for (int ai = 0; ai < 2; ++ai) {
            f32x4 t0[4], t1[4];
            if (rbj >= 0) {
#pragma unroll
                for (int m = 0; m < 4; ++m) { const float* tp = tab + (size_t)(row0 + ai * HALF + m * 16) * 64 + jr;
                    t0[m] = *(const f32x4*)tp; t1[m] = *(const f32x4*)(tp + 4); }
            }
#pragma unroll
            for (int m = 0; m < 4; ++m) { const int row = row0 + ai * HALF + m * 16; bf16_t* rowp = O + (size_t)row * ldc + col0;
#pragma unroll
                for (int bj = 0; bj < 2; ++bj) { f32x4 v0 = acc[ai][bj][m][0] * rs[ai][m], v1 = acc[ai][bj][m][1] * rs[ai][m];
                    if (bj == rbj) { const f32x4 a0 = t0[m], a1 = t1[m];
                        f32x4 r0, r1;
                        r0[0] = v0[0] * a0[0] - v0[1] * a0[1]; r0[1] = v0[1] * a0[0] + v0[0] * a0[1];
                        r0[2] = v0[2] * a0[2] - v0[3] * a0[3]; r0[3] = v0[3] * a0[2] + v0[2] * a0[3];
                        r1[0] = v1[0] * a1[0] - v1[1] * a1[1]; r1[1] = v1[1] * a1[0] + v1[0] * a1[1];
                        r1[2] = v1[2] * a1[2] - v1[3] * a1[3]; r1[3] = v1[3] * a1[2] + v1[2] * a1[3];
                        v0 = r0; v1 = r1; }
                    u32x4 w; w.x = cvt_pk_bf16(v0[0], v0[1]); w.y = cvt_pk_bf16(v0[2], v0[3]); w.z = cvt_pk_bf16(v1[0], v1[1]); w.w = cvt_pk_bf16(v1[2], v1[3]);
                    st16_out(rowp + bj * HALF, w); } }
            asm volatile("" ::: "memory"); }
    }
};
struct EpiGateMerge {
    static constexpr bool PERM = true, AFTER_DRAIN = false, MID = true;
    bf16_t* O; int ldo; const bf16_t* G1; const bf16_t* G2; int ldg;
    __device__ __forceinline__ void mid(f32x4 (&acc)[2][2][4][2], const Unit& u, int wr, int wc, int fr, int fq) const {
        int fr_ = fr, fq_ = fq; asm volatile("" : "+v"(fr_), "+v"(fq_));
        const int row0 = u.pm * BM + wr * 64 + fr_, col0 = u.pn * BM + wc * 32 + 8 * fq_;
#pragma unroll
        for (int ai = 0; ai < 2; ++ai) {
            u32x4 ga[4][2], gb[4][2];
#pragma unroll
            for (int m = 0; m < 4; ++m) { const int row = row0 + ai * HALF + m * 16; const bf16_t* g1p = G1 + (size_t)row * ldg + col0; const bf16_t* g2p = G2 + (size_t)row * ldg + col0;
#pragma unroll
                for (int bj = 0; bj < 2; ++bj) { ga[m][bj] = *(const u32x4*)(g1p + bj * HALF); gb[m][bj] = *(const u32x4*)(g2p + bj * HALF); } }
#pragma unroll
            for (int m = 0; m < 4; ++m)
#pragma unroll
                for (int bj = 0; bj < 2; ++bj) { const u32x4 a = ga[m][bj], b = gb[m][bj];
                    const unsigned aw[4] = {a.x, a.y, a.z, a.w}, bw[4] = {b.x, b.y, b.z, b.w};
#pragma unroll
                    for (int q = 0; q < 4; ++q) {
                        const float r0 = (1.0f + __builtin_amdgcn_exp2f(-1.4426950408889634f * bf_lo(bw[q]))) * __builtin_amdgcn_rcpf(1.0f + __builtin_amdgcn_exp2f(-1.4426950408889634f * bf_lo(aw[q])));
                        const float r1 = (1.0f + __builtin_amdgcn_exp2f(-1.4426950408889634f * bf_hi(bw[q]))) * __builtin_amdgcn_rcpf(1.0f + __builtin_amdgcn_exp2f(-1.4426950408889634f * bf_hi(aw[q])));
                        acc[ai][bj][m][q >> 1][2 * (q & 1)] *= r0; acc[ai][bj][m][q >> 1][2 * (q & 1) + 1] *= r1; } }
            asm volatile("" ::: "memory"); }
    }
    __device__ __forceinline__ void operator()(const f32x4 (&acc)[2][2][4][2], const Unit& u, int wr, int wc, int fr, int fq) const {
        const int row0 = u.pm * BM + wr * 64 + fr, col0 = u.pn * BM + wc * 32 + 8 * fq;
#ifndef EPI_GBATCH
#define EPI_GBATCH 2
#endif
#pragma unroll
        for (int a0 = 0; a0 < 2; a0 += EPI_GBATCH) {
            u32x4 gg[EPI_GBATCH][4][2];
#pragma unroll
            for (int ai = a0; ai < a0 + EPI_GBATCH; ++ai)
#pragma unroll
                for (int m = 0; m < 4; ++m) { const int row = row0 + ai * HALF + m * 16; const bf16_t* gp = G2 + (size_t)row * ldg + col0;
#pragma unroll
                    for (int bj = 0; bj < 2; ++bj) gg[ai - a0][m][bj] = *(const u32x4*)(gp + bj * HALF); }
#pragma unroll
            for (int ai = a0; ai < a0 + EPI_GBATCH; ++ai)
#pragma unroll
                for (int m = 0; m < 4; ++m) { const int row = row0 + ai * HALF + m * 16; bf16_t* op = O + (size_t)row * ldo + col0;
#pragma unroll
                    for (int bj = 0; bj < 2; ++bj) { const f32x4 v0 = acc[ai][bj][m][0], v1 = acc[ai][bj][m][1];
                        const u32x4 g = gg[ai - a0][m][bj];
                        u32x4 w; w.x = cvt_pk_bf16(v0[0] * sigmoidf_fast(bf_lo(g.x)), v0[1] * sigmoidf_fast(bf_hi(g.x))); w.y = cvt_pk_bf16(v0[2] * sigmoidf_fast(bf_lo(g.y)), v0[3] * sigmoidf_fast(bf_hi(g.y)));
                        w.z = cvt_pk_bf16(v1[0] * sigmoidf_fast(bf_lo(g.z)), v1[1] * sigmoidf_fast(bf_hi(g.z))); w.w = cvt_pk_bf16(v1[2] * sigmoidf_fast(bf_lo(g.w)), v1[3] * sigmoidf_fast(bf_hi(g.w)));
                        st16_out(op + bj * HALF, w); } }
            asm volatile("" ::: "memory"); }
    }
};

template <class Epi, class Sched, bool ALIGN_EPI = false, bool SP2 = false>
__device__ __forceinline__ void gemm_phase(PG8_LAS unsigned char* lds, const Gemm g, const Sched& S, const Epi& E) {
    int tid_ = threadIdx.x; asm volatile("" : "+v"(tid_));
    const int tid = tid_, wid = __builtin_amdgcn_readfirstlane(tid >> 6), lane = tid & 63, wr = wid >> 2, wc = wid & 3, fr = lane & 15, fq = lane >> 4;
    const int K = g.K, nt = K / BK, lda = g.lda ? g.lda : K;
#ifndef PG8_KROT
#define PG8_KROT 0
#endif
#if PG8_KROT
    const int ktm = nt - 1, kt0 = Epi::MID ? 0 : ((int)((blockIdx.x & 7u) * (unsigned)(nt >> 3)) * PG8_KROT) & ktm;
#define PG8_KP(base, t) ((base) + (size_t)(((t) + kt0) & ktm) * kstep)
#else
#define PG8_KP(base, t) ((base) + (size_t)(t) * kstep)
#endif
    unsigned voffA[2], voffB[2];
#pragma unroll
    for (int i = 0; i < 2; ++i) { int R, C; stage_rc(tid * 16 + i * 8192, R, C); const int Rb = Epi::PERM ? ((R & ~31) + perm32(R & 31)) : R;
        voffA[i] = (unsigned)(R * lda + C) * 2u; voffB[i] = (unsigned)(Rb * K + C) * 2u; }
    const size_t kstep = (size_t)(BK * 2);
    const size_t hstepA = (size_t)HALF * lda * 2, hstepB = (size_t)HALF * K * 2;
    const size_t tstepA = 2 * hstepA, tstepB = 2 * hstepB;
    const unsigned ldsw = (unsigned)wid * 1024u;
    const int aoff = lds_byte(wr * 64 + fr, fq * 8), boff = lds_byte(wc * 32 + fr, fq * 8);
#define PG8_SA(b, h) (((b) * 2 + (h)) * HTB)
#define PG8_SB(b, h) ((4 + (b) * 2 + (h)) * HTB)
#define PG8_STAGE(bufoff, gbase, voff) do { _Pragma("unroll") for (int _i = 0; _i < 2; ++_i) \
        __builtin_amdgcn_global_load_lds((const unsigned*)((const char*)(gbase) + (voff)[_i]), (PG8_LAS unsigned*)(lds + (bufoff) + ldsw + _i * 8192), 16, 0, 0); } while (0)
#define PG8_LDA(dst, b, h) do { _Pragma("unroll") for (int m = 0; m < 4; ++m) _Pragma("unroll") for (int k = 0; k < 2; ++k) dst[m][k] = *(const PG8_LAS bf16x8*)(lds + PG8_SA(b, h) + aoff + m * 2048 + k * 1024); } while (0)
#define PG8_LDB(dst, b, h) do { _Pragma("unroll") for (int n = 0; n < 2; ++n) _Pragma("unroll") for (int k = 0; k < 2; ++k) dst[n][k] = *(const PG8_LAS bf16x8*)(lds + PG8_SB(b, h) + boff + n * 2048 + k * 1024); } while (0)
#ifndef PG8_PRIO
#define PG8_PRIO 1
#endif
#define PG8_MMA(ai, bj, At, Bt) do { if (PG8_PRIO) __builtin_amdgcn_s_setprio(PG8_PRIO); _Pragma("unroll") for (int m = 0; m < 4; ++m) _Pragma("unroll") for (int n = 0; n < 2; ++n) _Pragma("unroll") for (int k = 0; k < 2; ++k) \
        acc[ai][bj][m][n] = __builtin_amdgcn_mfma_f32_16x16x32_bf16(Bt[n][k], At[m][k], acc[ai][bj][m][n], 0, 0, 0); if (PG8_PRIO) __builtin_amdgcn_s_setprio(0); } while (0)
#define PG8_WAIT_V(n) asm volatile("s_waitcnt vmcnt(" #n ")" ::: "memory")
#define PG8_WAIT_L(n) asm volatile("s_waitcnt lgkmcnt(" #n ")" ::: "memory")
#define PG8_BAR __builtin_amdgcn_s_barrier()
#define PG8_SCHED __builtin_amdgcn_sched_barrier(0)
    Unit cur, nxt; int ui = 0;
    if (!S.next(0, cur)) return;
    f32x4 acc[2][2][4][2];
#pragma unroll
    for (int a = 0; a < 2; ++a)
#pragma unroll
        for (int b = 0; b < 2; ++b)
#pragma unroll
            for (int m = 0; m < 4; ++m)
#pragma unroll
                for (int n = 0; n < 2; ++n) acc[a][b][m][n] = (f32x4){0.f, 0.f, 0.f, 0.f};
    bf16x8 At[4][2], B0[2][2], B1[2][2];
    const char* cA = (const char*)g.A + (size_t)cur.pm * tstepA; const char* cB = (const char*)g.Bt + (size_t)cur.pn * tstepB;
    S.a_ready(cur);
    if constexpr (SP2) {
        PG8_STAGE(PG8_SB(0, 0), PG8_KP(cB, 0), voffB); PG8_STAGE(PG8_SB(0, 1), PG8_KP(cB, 0) + hstepB, voffB); PG8_STAGE(PG8_SA(0, 0), PG8_KP(cA, 0), voffA); PG8_STAGE(PG8_SA(0, 1), PG8_KP(cA, 0) + hstepA, voffA);
        if (wr == 1) PG8_BAR;
        PG8_WAIT_V(2); PG8_BAR;
        PG8_STAGE(PG8_SB(1, 0), PG8_KP(cB, 1), voffB); PG8_STAGE(PG8_SA(1, 0), PG8_KP(cA, 1), voffA); PG8_STAGE(PG8_SB(1, 1), PG8_KP(cB, 1) + hstepB, voffB);
        PG8_WAIT_V(6); PG8_BAR;
    } else {
        PG8_STAGE(PG8_SB(0, 0), cB, voffB); PG8_STAGE(PG8_SA(0, 0), cA, voffA); PG8_STAGE(PG8_SB(0, 1), cB + hstepB, voffB); PG8_STAGE(PG8_SA(0, 1), cA + hstepA, voffA);
        if (wr == 1) PG8_BAR;
        PG8_WAIT_V(4); PG8_BAR;
        PG8_STAGE(PG8_SB(1, 0), cB + kstep, voffB); PG8_STAGE(PG8_SA(1, 0), cA + kstep, voffA); PG8_STAGE(PG8_SB(1, 1), cB + hstepB + kstep, voffB);
        PG8_WAIT_V(6); PG8_BAR;
    }
    for (;;) {
        const bool has_next = S.next(ui + 1, nxt);
        const char* nA = has_next ? (const char*)g.A + (size_t)nxt.pm * tstepA : cA; const char* nB = has_next ? (const char*)g.Bt + (size_t)nxt.pn * tstepB : cB;
        for (int t = 0; t < nt; t += 2) {
            const bool last = (t == nt - 2);
            const char* a1 = PG8_KP(cA, t + 1);
            const char* a2 = last ? PG8_KP(nA, 0) : PG8_KP(cA, t + 2); const char* b2 = last ? PG8_KP(nB, 0) : PG8_KP(cB, t + 2);
            const char* a3 = last ? PG8_KP(nA, 1) : PG8_KP(cA, t + 3); const char* b3 = last ? PG8_KP(nB, 1) : PG8_KP(cB, t + 3);
            if (last && has_next) S.a_ready(nxt);
            if constexpr (Epi::MID) { if (t == (nt >> 1)) E.mid(acc, cur, wr, wc, fr, fq); }
            if constexpr (SP2) {
            PG8_LDB(B0, 0, 0); PG8_LDB(B1, 0, 1); PG8_SCHED; PG8_LDA(At, 0, 0); PG8_STAGE(PG8_SA(1, 1), a1 + hstepA, voffA);
            PG8_WAIT_V(8); PG8_WAIT_L(0); PG8_BAR; PG8_MMA(0, 0, At, B0); PG8_MMA(0, 1, At, B1); PG8_BAR; PG8_SCHED;
            PG8_LDA(At, 0, 1); PG8_STAGE(PG8_SB(0, 0), b2, voffB); PG8_STAGE(PG8_SB(0, 1), b2 + hstepB, voffB); PG8_STAGE(PG8_SA(0, 0), a2, voffA);
            PG8_WAIT_V(8); PG8_WAIT_L(0); PG8_BAR; PG8_MMA(1, 0, At, B0); PG8_MMA(1, 1, At, B1); PG8_BAR; PG8_SCHED;
            PG8_LDB(B0, 1, 0); PG8_LDB(B1, 1, 1); PG8_SCHED; PG8_LDA(At, 1, 0); PG8_STAGE(PG8_SA(0, 1), a2 + hstepA, voffA);
            PG8_WAIT_V(8); PG8_WAIT_L(0); PG8_BAR; PG8_MMA(0, 0, At, B0); PG8_MMA(0, 1, At, B1); PG8_BAR; PG8_SCHED;
            PG8_LDA(At, 1, 1); PG8_STAGE(PG8_SB(1, 0), b3, voffB); PG8_STAGE(PG8_SB(1, 1), b3 + hstepB, voffB); PG8_STAGE(PG8_SA(1, 0), a3, voffA);
            PG8_WAIT_V(8); PG8_WAIT_L(0); PG8_BAR; PG8_MMA(1, 0, At, B0); PG8_MMA(1, 1, At, B1); PG8_BAR; PG8_SCHED;
            } else {
            PG8_LDB(B0, 0, 0); PG8_SCHED; PG8_LDA(At, 0, 0); PG8_STAGE(PG8_SA(1, 1), a1 + hstepA, voffA);
            PG8_WAIT_L(8); PG8_BAR; PG8_WAIT_L(0); PG8_MMA(0, 0, At, B0); PG8_BAR; PG8_SCHED;
            PG8_LDB(B1, 0, 1); PG8_STAGE(PG8_SB(0, 0), b2, voffB);
            PG8_BAR; PG8_WAIT_L(0); PG8_MMA(0, 1, At, B1); PG8_BAR;
            PG8_LDA(At, 0, 1); PG8_STAGE(PG8_SA(0, 0), a2, voffA);
            PG8_BAR; PG8_WAIT_L(0); PG8_MMA(1, 0, At, B0); PG8_BAR; PG8_SCHED;
            PG8_STAGE(PG8_SB(0, 1), b2 + hstepB, voffB);
            PG8_WAIT_V(6); PG8_BAR; PG8_MMA(1, 1, At, B1); PG8_BAR;
            PG8_LDB(B0, 1, 0); PG8_SCHED; PG8_LDA(At, 1, 0); PG8_STAGE(PG8_SA(0, 1), a2 + hstepA, voffA);
            PG8_WAIT_L(8); PG8_BAR; PG8_WAIT_L(0); PG8_MMA(0, 0, At, B0); PG8_BAR; PG8_SCHED;
            PG8_LDB(B1, 1, 1); PG8_STAGE(PG8_SB(1, 0), b3, voffB);
            PG8_BAR; PG8_WAIT_L(0); PG8_MMA(0, 1, At, B1); PG8_BAR;
            PG8_LDA(At, 1, 1); PG8_STAGE(PG8_SA(1, 0), a3, voffA);
            PG8_BAR; PG8_WAIT_L(0); PG8_MMA(1, 0, At, B0); PG8_BAR; PG8_SCHED;
            PG8_STAGE(PG8_SB(1, 1), b3 + hstepB, voffB);
            PG8_WAIT_V(6); PG8_BAR; PG8_MMA(1, 1, At, B1); PG8_BAR;
            }
        }
        if constexpr (ALIGN_EPI) { if (wr == 0) PG8_BAR; }
        if constexpr (!Epi::AFTER_DRAIN) { E(acc, cur, wr, wc, fr, fq); S.done(cur); }
        if (!has_next) break;
#pragma unroll
        for (int a = 0; a < 2; ++a)
#pragma unroll
            for (int b = 0; b < 2; ++b)
#pragma unroll
                for (int m = 0; m < 4; ++m)
#pragma unroll
                    for (int n = 0; n < 2; ++n) acc[a][b][m][n] = (f32x4){0.f, 0.f, 0.f, 0.f};
        cur = nxt; cA = nA; cB = nB; ++ui;
        if constexpr (ALIGN_EPI) { if (wr == 1) PG8_BAR; }
    }
    PG8_WAIT_V(0);
    if constexpr (!ALIGN_EPI) { if (wr == 0) PG8_BAR; }
    PG8_BAR;
    if constexpr (Epi::AFTER_DRAIN) { E.fused(acc, cur, wr, wc, fr, fq, lds, wid, lane); S.done(cur); }
#undef PG8_SA
#undef PG8_KP
#undef PG8_SB
#undef PG8_STAGE
#undef PG8_LDA
#undef PG8_LDB
#undef PG8_MMA
#undef PG8_WAIT_V
#undef PG8_WAIT_L
#undef PG8_BAR
#undef PG8_SCHED
}
}

namespace att {
#define ATT_LAS __attribute__((address_space(3)))
typedef unsigned short bf16_t;
typedef short bf16x8 __attribute__((ext_vector_type(8)));
typedef short s16x4 __attribute__((ext_vector_type(4)));
typedef float f32x16 __attribute__((ext_vector_type(16)));
typedef unsigned u32x4 __attribute__((ext_vector_type(4)));
constexpr int SHM_V = 16384, SHM_K = 16384, SHM_R = 8192, BUFB = SHM_V + SHM_K + SHM_R;
constexpr int LDS_SCR = 2 * BUFB;
constexpr int LDS_FLAGS = LDS_SCR + 8 * 256;
constexpr int LDS_QR = LDS_FLAGS + 64;
constexpr int ATT_LDS_BYTES = LDS_QR + 8 * 4096;
#define KSWZ(row, colB) ((row) * 256 + ((colB) ^ (((row) & 7) << 4)))
#define RSWZ(row, colB) ((row) * 128 + ((colB) ^ ((((row) >> 1) & 7) << 4)))
__device__ __forceinline__ int v_st(int k, int c) { const int kk = (k & ~0xC) | ((k & 4) << 1) | ((k & 8) >> 1); return ((kk >> 3) * 4 + (c >> 5)) * 512 + ((kk & 7) * 32 + (c & 31)) * 2; }
__device__ __forceinline__ int v_rd_base(int lane) { return ((lane & 3) << 3) | (((lane >> 2) & 3) << 6) | (((lane >> 4) & 1) << 5) | (((lane >> 5) & 1) << 8); }
constexpr int v_rd_off(int d0, int ks, int half) { return d0 * 512 + ks * 4096 + half * 2048; }
__device__ __forceinline__ int crow(int r, int hi) { return (r & 3) + 8 * (r >> 2) + 4 * hi; }
__device__ __forceinline__ unsigned cvtpk(float lo, float hi) { unsigned r; asm volatile("v_cvt_pk_bf16_f32 %0, %1, %2" : "=v"(r) : "v"(lo), "v"(hi)); return r; }
#define ATT_SBAR() __builtin_amdgcn_sched_barrier(0)
#ifndef ATT_PRIO
#define ATT_PRIO 0
#endif
#ifndef ATT_EARLYW
#define ATT_EARLYW 0
#endif

template <int ND>
__device__ __forceinline__ void qkt_half(f32x16& p, const ATT_LAS char* Kb, const ATT_LAS char* Rb, int r32, int hi, const bf16x8* qr, const ATT_LAS char* qrl, int lane, int half) {
    bf16x8 kf[8];
#pragma unroll
    for (int d0 = 0; d0 < 8; ++d0) kf[d0] = *(const ATT_LAS bf16x8*)(Kb + KSWZ(r32, ((d0 & 3) * 16 + hi * 8) * 2) + (d0 >> 2) * 128 + half * (32 * 256));
    ATT_SBAR();
    p = f32x16{};
    if constexpr (ND == 12) {
        bf16x8 rf[4], qf[4];
#pragma unroll
        for (int d0 = 0; d0 < 4; ++d0) p = __builtin_amdgcn_mfma_f32_32x32x16_bf16(kf[d0], qr[d0], p, 0, 0, 0);
        ATT_SBAR();
#pragma unroll
        for (int dr = 0; dr < 4; ++dr) { rf[dr] = *(const ATT_LAS bf16x8*)(Rb + RSWZ(r32, (dr * 16 + hi * 8) * 2) + half * (32 * 128)); qf[dr] = *(const ATT_LAS bf16x8*)(qrl + dr * 1024 + lane * 16); }
        ATT_SBAR();
#pragma unroll
        for (int d0 = 4; d0 < 8; ++d0) p = __builtin_amdgcn_mfma_f32_32x32x16_bf16(kf[d0], qr[d0], p, 0, 0, 0);
#pragma unroll
        for (int dr = 0; dr < 4; ++dr) p = __builtin_amdgcn_mfma_f32_32x32x16_bf16(rf[dr], qf[dr], p, 0, 0, 0);
    } else {
#pragma unroll
        for (int d0 = 0; d0 < 8; ++d0) p = __builtin_amdgcn_mfma_f32_32x32x16_bf16(kf[d0], qr[d0], p, 0, 0, 0);
    }
}
__device__ __forceinline__ void pv_tile(f32x16* o, int vb, bf16x8 pa0, bf16x8 pa1, bf16x8 pa2, bf16x8 pa3) {
#define ATT_TRRD(dst, off) asm volatile("ds_read_b64_tr_b16 %0, %1 offset:%2" : "=&v"(dst) : "v"(vb), "i"(off) : "memory")
#define ATT_PV_D0(d0) do { s16x4 l0, l1, l2, l3, h0, h1, h2, h3; constexpr int b_ = v_rd_off(d0, 0, 0); \
        ATT_TRRD(l0, b_); ATT_TRRD(h0, b_ + 2048); ATT_TRRD(l1, b_ + 4096); ATT_TRRD(h1, b_ + 6144); ATT_TRRD(l2, b_ + 8192); ATT_TRRD(h2, b_ + 10240); ATT_TRRD(l3, b_ + 12288); ATT_TRRD(h3, b_ + 14336); \
        asm volatile("s_waitcnt lgkmcnt(0)" ::: "memory"); ATT_SBAR(); \
        o[d0] = __builtin_amdgcn_mfma_f32_32x32x16_bf16(pa0, (bf16x8){l0[0], l0[1], l0[2], l0[3], h0[0], h0[1], h0[2], h0[3]}, o[d0], 0, 0, 0); \
        o[d0] = __builtin_amdgcn_mfma_f32_32x32x16_bf16(pa1, (bf16x8){l1[0], l1[1], l1[2], l1[3], h1[0], h1[1], h1[2], h1[3]}, o[d0], 0, 0, 0); \
        o[d0] = __builtin_amdgcn_mfma_f32_32x32x16_bf16(pa2, (bf16x8){l2[0], l2[1], l2[2], l2[3], h2[0], h2[1], h2[2], h2[3]}, o[d0], 0, 0, 0); \
        o[d0] = __builtin_amdgcn_mfma_f32_32x32x16_bf16(pa3, (bf16x8){l3[0], l3[1], l3[2], l3[3], h3[0], h3[1], h3[2], h3[3]}, o[d0], 0, 0, 0); } while (0)
    if (ATT_PRIO) __builtin_amdgcn_s_setprio(1);
    ATT_PV_D0(0); ATT_PV_D0(1); ATT_PV_D0(2); ATT_PV_D0(3);
    if (ATT_PRIO) __builtin_amdgcn_s_setprio(0);
#undef ATT_PV_D0
#undef ATT_TRRD
}
__device__ __forceinline__ void pack_half(const f32x16& p, bf16x8& pa0, bf16x8& pa1) {
#define ATT_PK4(P, B_, OUT) do { unsigned a0 = cvtpk(P[B_+0], P[B_+1]), a1 = cvtpk(P[B_+2], P[B_+3]); \
        unsigned b0 = cvtpk(P[B_+4], P[B_+5]), b1 = cvtpk(P[B_+6], P[B_+7]); \
        auto r0 = __builtin_amdgcn_permlane32_swap(a0, b0, false, false); auto r1 = __builtin_amdgcn_permlane32_swap(a1, b1, false, false); \
        u32x4 w = {r0[0], r1[0], r0[1], r1[1]}; OUT = __builtin_bit_cast(bf16x8, w); } while (0)
    ATT_PK4(p, 0, pa0); ATT_PK4(p, 8, pa1);
#undef ATT_PK4
}
__device__ __forceinline__ void half_xchg(float x, float& lo, float& hi) {
    unsigned a = __builtin_bit_cast(unsigned, x), b;
    asm volatile("s_nop 1\n\tv_mov_b32 %1, %0\n\ts_nop 1\n\tv_permlane32_swap_b32 %0, %1" : "+v"(a), "=&v"(b));
    lo = __builtin_bit_cast(float, a); hi = __builtin_bit_cast(float, b);
}
__device__ __forceinline__ float half_sum(float v) { float lo, hi; half_xchg(v, lo, hi); return lo + hi; }
__device__ __forceinline__ float half_max(float v) { float lo, hi; half_xchg(v, lo, hi); return fmaxf(lo, hi); }

struct Tensors { const bf16_t* Q; int ldq; const bf16_t* K; int ldk; const bf16_t* V; int ldv; const bf16_t* R; bf16_t* O; int ldo; };

template <int MODE>
__device__ __forceinline__ void attn_unit(const Tensors& T, int qb, float sc2, ATT_LAS char* lds) {
    constexpr int ND = MODE == 1 ? 12 : 8;
    int tid_ = threadIdx.x; asm volatile("" : "+v"(tid_));
    const int tid = tid_, wid = __builtin_amdgcn_readfirstlane(tid >> 6), lane = tid & 63, r32 = lane & 31, hi = lane >> 5;
    const int q0 = qb * 256, qw = q0 + wid * 32;
    const int NT = 4 * (qb + 1);
    const int wlast = 4 * qb + (wid >> 1);
    const int tq = qw + r32;
    ATT_LAS float* scr = (ATT_LAS float*)(lds + LDS_SCR) + wid * 64;
    volatile ATT_LAS unsigned* flags = (volatile ATT_LAS unsigned*)(lds + LDS_FLAGS);
    const ATT_LAS char* qrl = lds + LDS_QR + wid * 4096;
    bf16x8 qr[8];
    { const bf16_t* qp = T.Q + (size_t)tq * T.ldq + hi * 8;
#pragma unroll
      for (int d0 = 0; d0 < 8; ++d0) qr[d0] = *(const bf16x8*)(qp + d0 * 16);
      if constexpr (MODE == 1) {
#pragma unroll
          for (int dr = 0; dr < 4; ++dr) *(ATT_LAS bf16x8*)(lds + LDS_QR + wid * 4096 + dr * 1024 + lane * 16) = *(const bf16x8*)(qp + 128 + dr * 16); } }
    const int sr = tid >> 4, sc = (tid & 15) * 8, kws = KSWZ(sr, sc * 2), vst0 = v_st(sr, sc), vst1 = v_st(32 + sr, sc);
    const int rr_ = tid >> 3, rc = (tid & 7) * 8, rws = RSWZ(rr_, rc * 2);
    bf16x8 sk0, sk1, sv0, sv1, srp;
#define ATT_LOAD(kt) do { const size_t k0_ = (size_t)(kt) * 64; \
        sk0 = *(const bf16x8*)(T.K + (k0_ + sr) * T.ldk + sc); sk1 = *(const bf16x8*)(T.K + (k0_ + 32 + sr) * T.ldk + sc); \
        sv0 = *(const bf16x8*)(T.V + (k0_ + sr) * T.ldv + sc); sv1 = *(const bf16x8*)(T.V + (k0_ + 32 + sr) * T.ldv + sc); \
        if constexpr (MODE == 1) srp = *(const bf16x8*)(T.R + (k0_ + rr_) * 64 + rc); } while (0)
#define ATT_WRITE(bf) do { ATT_LAS char* b_ = lds + (bf) * BUFB; \
        *(ATT_LAS bf16x8*)(b_ + vst0) = sv0; *(ATT_LAS bf16x8*)(b_ + vst1) = sv1; \
        *(ATT_LAS bf16x8*)(b_ + SHM_V + kws) = sk0; *(ATT_LAS bf16x8*)(b_ + SHM_V + kws + 32 * 256) = sk1; \
        if constexpr (MODE == 1) *(ATT_LAS bf16x8*)(b_ + SHM_V + SHM_K + rws) = srp; } while (0)
#define ATT_TILE(it) (MODE == 0 ? (NT - 1 - (it)) : (it))
    f32x16 o[4] = {};
    float carry = 0.f;
    float m_reg = -1e30f, l_reg = 0.f;
    bool dead = false;
    const float hsel = hi ? 0.f : 1.f;
    ATT_LOAD(ATT_TILE(0)); asm volatile("s_waitcnt vmcnt(0)" ::: "memory"); ATT_WRITE(0);
    __syncthreads();
    for (int it = 0; it < NT; ++it) {
        const int cur = it & 1, kt = ATT_TILE(it), kb = kt * 64;
        if (it + 1 < NT) ATT_LOAD(ATT_TILE(it + 1));
        const ATT_LAS char* bufp = lds + cur * BUFB;
        bool staged = false;
        if (kt <= wlast && !dead) {
            f32x16 p0, p1;
            bf16x8 pa0, pa1, pa2, pa3;
            if constexpr (MODE == 0) {
                const bool diag = (kb + 63 >= qw);
                qkt_half<ND>(p1, bufp + SHM_V, bufp + SHM_V + SHM_K, r32, hi, qr, qrl, lane, 1);
                qkt_half<ND>(p0, bufp + SHM_V, bufp + SHM_V + SHM_K, r32, hi, qr, qrl, lane, 0);
                float tsum = carry;
#define ATT_SB_HALF(P, KOFF) do { f32x16 f; \
                    _Pragma("unroll") for (int r = 0; r < 16; ++r) { P[r] *= sc2; \
                        f[r] = fminf(-P[r], 0.f) - __builtin_amdgcn_logf(1.0f + __builtin_amdgcn_exp2f(-__builtin_fabsf(P[r]))); } \
                    if (diag) { _Pragma("unroll") for (int r = 0; r < 16; ++r) { if (kb + (KOFF) + crow(r, hi) >= tq) f[r] = 0.f; } } \
                    float gs_[4], oh_[4], ps_[4]; \
                    _Pragma("unroll") for (int i = 0; i < 4; ++i) { f[4*i+2] += f[4*i+3]; f[4*i+1] += f[4*i+2]; f[4*i] += f[4*i+1]; gs_[i] = f[4*i]; } \
                    _Pragma("unroll") for (int i = 0; i < 4; ++i) { float lo_; half_xchg(gs_[i], lo_, oh_[i]); ps_[i] = lo_ + oh_[i]; } \
                    _Pragma("unroll") for (int i = 3; i >= 0; --i) { const float Tg = tsum + hsel * oh_[i]; \
                        _Pragma("unroll") for (int e = 0; e < 4; ++e) P[4*i+e] = __builtin_amdgcn_exp2f(P[4*i+e] + f[4*i+e] + Tg); \
                        tsum += ps_[i]; } \
                    if (diag) { _Pragma("unroll") for (int r = 0; r < 16; ++r) { if (kb + (KOFF) + crow(r, hi) >= tq) P[r] = 0.f; } } } while (0)
                ATT_SB_HALF(p1, 32);
                pack_half(p1, pa2, pa3);
                ATT_SB_HALF(p0, 0);
                pack_half(p0, pa0, pa1);
#undef ATT_SB_HALF
                carry = tsum;
                pv_tile(o, (int)(uintptr_t)(bufp) + v_rd_base(lane), pa0, pa1, pa2, pa3);
                if (__all(carry < -140.f)) dead = true;
            } else {
                qkt_half<ND>(p0, bufp + SHM_V, bufp + SHM_V + SHM_K, r32, hi, qr, qrl, lane, 0);
                qkt_half<ND>(p1, bufp + SHM_V, bufp + SHM_V + SHM_K, r32, hi, qr, qrl, lane, 1);
                float pmax = p0[0];
#pragma unroll
                for (int r = 1; r < 16; ++r) pmax = fmaxf(pmax, p0[r]);
#pragma unroll
                for (int r = 0; r < 16; ++r) pmax = fmaxf(pmax, p1[r]);
                pmax = half_max(pmax);
                const float mn = fmaxf(m_reg, pmax), alpha = __builtin_amdgcn_exp2f((m_reg - mn) * sc2); m_reg = mn;
                const float mnL = -mn * sc2;
                float psum = 0.f;
#pragma unroll
                for (int r = 0; r < 16; ++r) { p0[r] = __builtin_amdgcn_exp2f(fmaf(p0[r], sc2, mnL)); psum += p0[r]; }
                pack_half(p0, pa0, pa1);
#pragma unroll
                for (int r = 0; r < 16; ++r) { p1[r] = __builtin_amdgcn_exp2f(fmaf(p1[r], sc2, mnL)); psum += p1[r]; }
                pack_half(p1, pa2, pa3);
                l_reg = l_reg * alpha + half_sum(psum);
                if (__any(alpha < 1.f))
                { if (hi == 0) scr[r32] = alpha; asm volatile("s_waitcnt lgkmcnt(0)" ::: "memory");
#pragma unroll
                    for (int r = 0; r < 16; ++r) { const float a = scr[crow(r, hi)];
#pragma unroll
                        for (int d = 0; d < 4; ++d) o[d][r] *= a; } }
#if ATT_EARLYW
                if (it + 1 < NT) { asm volatile("s_waitcnt vmcnt(0)" ::: "memory"); ATT_WRITE(cur ^ 1); staged = true; }
#endif
                pv_tile(o, (int)(uintptr_t)(bufp) + v_rd_base(lane), pa0, pa1, pa2, pa3);
            }
        }
        if (it + 1 < NT && !staged) { asm volatile("s_waitcnt vmcnt(0)" ::: "memory"); ATT_WRITE(cur ^ 1); }
        if constexpr (MODE == 0) { if (lane == 0) flags[cur * 8 + wid] = dead ? 1u : 0u; }
        __syncthreads();
        if constexpr (MODE == 0) {
            unsigned alld = 1u;
#pragma unroll
            for (int w = 0; w < 8; ++w) alld &= flags[cur * 8 + w];
            if (alld) break;
        }
    }
    if constexpr (MODE == 1) { if (hi == 0) scr[32 + r32] = l_reg; asm volatile("s_waitcnt lgkmcnt(0)" ::: "memory"); }
    bf16_t* Ow = T.O + (size_t)qw * T.ldo;
    int obase = 4 * hi * T.ldo + r32; asm volatile("" : "+v"(obase));
#pragma unroll
    for (int r = 0; r < 16; ++r) { const int orow = crow(r, hi);
        float rl = 1.f; if constexpr (MODE == 1) rl = __builtin_amdgcn_rcpf(scr[32 + orow]);
        int ro = obase + ((r & 3) + 8 * (r >> 2)) * T.ldo; asm volatile("" : "+v"(ro));
#pragma unroll
        for (int d0 = 0; d0 < 4; ++d0) { const float v = o[d0][r] * rl; const float vn = __shfl_xor(v, 1);
            if ((r32 & 1) == 0) *(unsigned*)(Ow + ro + d0 * 32) = cvtpk(v, vn); } }
    __syncthreads();
#undef ATT_LOAD
#undef ATT_WRITE
#undef ATT_TILE
}
}

constexpr int BATCH = 2, SEQ = 4096, D = 4096, M = BATCH * SEQ, DEPTH = 2;
constexpr int SBW = 2048, QRANK = 1024, KVRANK = 512, ROPE = 64, DFF = 16384;
constexpr int IN_W = 3 * SBW + QRANK + KVRANK + ROPE + 2 * D;
constexpr int C_QD = 3 * SBW, C_KVD = C_QD + QRANK, C_GATE_SRC = C_KVD + KVRANK + ROPE;
constexpr int C_GSB = 7936, C_GMLA = C_GSB + D, PROJ_W = C_GMLA + D;
constexpr int QW = 16 * 192, KVW = 16 * 256;
constexpr float EPS = 1e-6f;
static_assert(IN_W == 15936 && PROJ_W == 16128 && PROJ_W % 256 == 0 && C_GSB % 256 == 0, "projection layout");

constexpr size_t MiB = 1u << 20;
constexpr size_t WS_CTL = 0, CTL_ZERO_BYTES = 1 * MiB;
constexpr size_t WS_ADA = 1 * MiB;
constexpr size_t WS_TAB = 2 * MiB;
constexpr size_t WS_ADAP = 4 * MiB;
constexpr size_t WS_W = 32 * MiB;
constexpr size_t W_IN = 0, W_UQ = 126 * MiB, W_UKV = 132 * MiB, W_OSB = 136 * MiB, W_OMLA = 152 * MiB, W_OUT = 168 * MiB, W_UP = 200 * MiB, W_DOWN = 328 * MiB, W_LAYER = 456 * MiB;
constexpr size_t WS_ACT = WS_W + DEPTH * W_LAYER;
constexpr size_t A_H = WS_ACT, A_PROJ = A_H + 64 * MiB, A_CQ = A_PROJ + 252 * MiB, A_CKV = A_CQ + 16 * MiB, A_KR = A_CKV + 8 * MiB, A_Q = A_KR + 1 * MiB, A_KV = A_Q + 48 * MiB,
                 A_OSB = A_KV + 64 * MiB, A_OMLA = A_OSB + 32 * MiB, A_TMP = A_OMLA + 32 * MiB, A_MRG = A_TMP + 128 * MiB, A_Y = A_MRG + 64 * MiB, A_U = A_Y + 128 * MiB, WS_END = A_U + 256 * MiB;
static_assert((size_t)PROJ_W * D * 2 == 126 * MiB && (size_t)M * PROJ_W * 2 == 252 * MiB, "sizes");
constexpr int CW_TMO = 0;
constexpr int CW_BAR = 4096;

constexpr int RING_BYTES = 135168;
constexpr int LDSCTL_OFF = RING_BYTES, MISC_OFF = LDSCTL_OFF + 320;
constexpr int LDS_BYTES = RING_BYTES + 1024;
constexpr int NWAVES = 8;
static_assert(att::ATT_LDS_BYTES <= RING_BYTES && pg8::STAGE_BYTES <= RING_BYTES, "LDS map");

#define GAS __attribute__((address_space(1)))
#define LAS __attribute__((address_space(3)))
typedef unsigned short bf16;
typedef unsigned v4u __attribute__((ext_vector_type(4)));
typedef unsigned v2u __attribute__((ext_vector_type(2)));
typedef float f32x4 __attribute__((ext_vector_type(4)));
typedef GAS unsigned gu32;
#define RLX_AGENT __ATOMIC_RELAXED, __HIP_MEMORY_SCOPE_AGENT
#ifndef USE_NT
#define USE_NT 0
#endif
#if USE_NT
#define NT_LD(p) __builtin_nontemporal_load(p)
#else
#define NT_LD(p) (*(p))
#endif
#define LDS_WAIT() asm volatile("s_waitcnt lgkmcnt(0)" ::: "memory")
#define VM_WAIT() asm volatile("s_waitcnt vmcnt(0)" ::: "memory")
__device__ __forceinline__ unsigned pk2(float lo, float hi) { return pg8::cvt_pk_bf16(lo, hi); }
__device__ __forceinline__ float bflo(unsigned w) { return __builtin_bit_cast(float, w << 16); }
__device__ __forceinline__ float bfhi(unsigned w) { return __builtin_bit_cast(float, w & 0xffff0000u); }

#define XB_TMO      128
#define XB_XCNT(j)  (256  + 64 * (j))
#define XB_XSUB(j)  (1280 + 64 * (j))
#define XB_XGEN(j)  (2304 + 64 * (j))
#define XB_TOP      3328
#define XB_TOPGEN   3392
#define XCD_BAR_WORDS 3456
#define XB_SPIN_CAP (1u << 21)

__device__ __forceinline__ unsigned xb_ld(unsigned* p)              { return __hip_atomic_load(p, __ATOMIC_RELAXED, __HIP_MEMORY_SCOPE_AGENT); }
__device__ __forceinline__ unsigned xb_add(unsigned* p, unsigned v) { return __hip_atomic_fetch_add(p, v, __ATOMIC_RELAXED, __HIP_MEMORY_SCOPE_AGENT); }
__device__ __forceinline__ unsigned xb_xcc_id() { return (unsigned)__builtin_amdgcn_s_getreg((3 << 11) | 20) & 0xFu; }
#define XB_SPIN(cond, bar) do { unsigned _sp = 0; while (cond) { __builtin_amdgcn_s_sleep(1); \
    if ((++_sp & 255u) == 0u) { if (xb_ld(&(bar)[XB_TMO])) break; if (_sp > XB_SPIN_CAP) { atomicAdd(&(bar)[XB_TMO], 1u); break; } } } } while (0)

struct XcdBarrier {
    unsigned* bar; unsigned x;
    volatile LAS unsigned* st;
};

__device__ __forceinline__ XcdBarrier xcd_barrier_post(unsigned* bar, volatile LAS unsigned* st) {
    XcdBarrier b; b.bar = bar; b.x = xb_xcc_id(); b.st = st;
    if (threadIdx.x == 0) (void)xb_add(&bar[XB_XCNT(b.x)], 1u);
    return b;
}
__device__ __forceinline__ void xcd_barrier_complete(unsigned* bar, unsigned x, unsigned& nloc, unsigned& nx) {
    const unsigned G = gridDim.x * gridDim.y * gridDim.z;
    unsigned sum, cnt, mine, sp = 0u;
    for (;;) {
        sum = 0u; cnt = 0u; mine = 0u;
#pragma unroll
        for (unsigned j = 0; j < 16; ++j) { const unsigned c = xb_ld(&bar[XB_XCNT(j)]); sum += c; cnt += (c > 0u) ? 1u : 0u; mine = (j == x) ? c : mine; }
        if (sum == G) break;
        __builtin_amdgcn_s_sleep(1);
        if ((++sp & 255u) == 0u) { if (xb_ld(&bar[XB_TMO])) break; if (sp > XB_SPIN_CAP) { atomicAdd(&bar[XB_TMO], 1u); break; } }
    }
    nloc = mine > 0u ? mine : 1u; nx = cnt > 0u ? cnt : 1u;
}

__device__ __forceinline__ void xcd_barrier(const XcdBarrier& b) {
    asm volatile("s_waitcnt vmcnt(0)" ::: "memory");
    __syncthreads();
    if (threadIdx.x == 0) {
        unsigned* bar = b.bar; unsigned bx_ = b.x; asm volatile("" : "+s"(bar), "+s"(bx_));
        __builtin_amdgcn_s_waitcnt(0);
        unsigned nloc = b.st[0], nx = b.st[1];
        if (nloc == 0u) { xcd_barrier_complete(bar, bx_, nloc, nx); b.st[0] = nloc; b.st[1] = nx; }
        const unsigned old = xb_add(&bar[XB_XSUB(bx_)], 1u);
        const unsigned gen = old / nloc;
        if (old + 1u == (gen + 1u) * nloc) {
            __builtin_amdgcn_fence(__ATOMIC_RELEASE, "agent");
            asm volatile("s_waitcnt vmcnt(0)" ::: "memory");
            const unsigned og = xb_add(&bar[XB_TOP], 1u);
            const unsigned tg = og / nx;
            if (og + 1u == (tg + 1u) * nx) xb_add(&bar[XB_TOPGEN], 1u);
            else XB_SPIN(xb_ld(&bar[XB_TOPGEN]) == tg, bar);
            __builtin_amdgcn_fence(__ATOMIC_ACQUIRE, "agent");
            xb_add(&bar[XB_XGEN(bx_)], 1u);
            asm volatile("s_waitcnt vmcnt(0)" ::: "memory");
        } else {
            XB_SPIN(xb_ld(&bar[XB_XGEN(bx_)]) == gen, bar);
            __builtin_amdgcn_fence(__ATOMIC_ACQUIRE, "agent");
            asm volatile("s_waitcnt vmcnt(0)" ::: "memory");
        }
    }
    __syncthreads();
}


struct Frame {
    LAS unsigned char* lds;
    int tid, lane, wave, G, gw, NGW;
};
__device__ __forceinline__ float wave_sum(float v) {
#pragma unroll
    for (int o = 1; o < 64; o <<= 1) v += __shfl_xor(v, o);
    return v;
}

__device__ __forceinline__ void transpose_item(const float* W, int N, bf16* WT, int ldt, int kb, int nb, int rowbase, bool ropeperm, LAS float* scr, int lane, const float* kscale = nullptr) {
    const int k0 = 64 * kb, n0 = 64 * nb;
    const float* src = W + (size_t)(k0 + (lane >> 4)) * N + n0 + 4 * (lane & 15);
#pragma unroll 4
    for (int i = 0; i < 16; ++i) { const f32x4 v = NT_LD((const f32x4*)(src + (size_t)(4 * i) * N)); LAS float* d = scr + (4 * i + (lane >> 4)) * 65 + 4 * (lane & 15);
        d[0] = v[0]; d[1] = v[1]; d[2] = v[2]; d[3] = v[3]; }
    LDS_WAIT(); asm volatile("" ::: "memory");
    const int c = lane & 7;
    f32x4 ks0 = {1.f, 1.f, 1.f, 1.f}, ks1 = ks0;
    if (kscale) { ks0 = *(const f32x4*)(kscale + k0 + 8 * c); ks1 = *(const f32x4*)(kscale + k0 + 8 * c + 4); }
#pragma unroll
    for (int j = 0; j < 8; ++j) { const int nn = (lane >> 3) + 8 * j; const LAS float* s = scr + (8 * c) * 65 + nn;
        v4u o; o.x = pk2(s[0 * 65] * ks0[0], s[1 * 65] * ks0[1]); o.y = pk2(s[2 * 65] * ks0[2], s[3 * 65] * ks0[3]); o.z = pk2(s[4 * 65] * ks1[0], s[5 * 65] * ks1[1]); o.w = pk2(s[6 * 65] * ks1[2], s[7 * 65] * ks1[3]);
        const int orow = rowbase + (ropeperm ? (2 * (nn & 31) + (nn >> 5)) : nn);
        *(GAS v4u*)(WT + (size_t)orow * ldt + k0 + 8 * c) = o; }
    LDS_WAIT(); asm volatile("" ::: "memory");
}

__device__ __forceinline__ void norm_mod_row(const f32x4 (&v)[16], float ssq, const float* g, const float* scv, const float* shv, bf16* orow, int lane) {
    const float r = 1.0f / sqrtf(ssq * (1.0f / D) + EPS);
#pragma unroll
    for (int j = 0; j < 16; ++j) { int c = 4 * lane + 256 * j; asm volatile("" : "+v"(c));
        const f32x4 gg = *(const f32x4*)(g + c), ss = *(const f32x4*)(scv + c), hh = *(const f32x4*)(shv + c);
        f32x4 o;
#pragma unroll
        for (int e = 0; e < 4; ++e) o[e] = v[j][e] * r * gg[e] * (1.0f + ss[e]) + hh[e];
        v2u w; w.x = pk2(o[0], o[1]); w.y = pk2(o[2], o[3]);
        *(GAS v2u*)(orow + c) = w; }
}


template <bool HAS_Y, bool HAS_H, bool XIN_BF = false, bool XOUT_BF = false>
__device__ __forceinline__ void thin_phase(Frame& F, const void* xin_, void* xout_, const bf16* Yb, bf16* Hout,
                                           const float* gpost, const float* gate0, const float* gpre, const float* sc0, const float* sh0) {
    LAS float* cA1 = (LAS float*)F.lds; LAS float* cA2 = cA1 + D; LAS float* cB2 = cA2 + D;
    for (int chunk = blockIdx.x; chunk < M / 32; chunk += F.G) {
        int tid = F.tid; asm volatile("" : "+v"(tid));
        const int b = (chunk * 32) / SEQ;
        __syncthreads();
#pragma unroll
        for (int i = 0; i < 2; ++i) { const int c = 4 * tid + 2048 * i;
            if constexpr (HAS_Y) { const f32x4 g = *(const f32x4*)(gpost + c), t = *(const f32x4*)(gate0 + (size_t)b * 6 * D + c); *(LAS f32x4*)(cA1 + c) = g * t; }
            if constexpr (HAS_H) { const f32x4 g = *(const f32x4*)(gpre + c), s = *(const f32x4*)(sc0 + (size_t)b * 6 * D + c), h = *(const f32x4*)(sh0 + (size_t)b * 6 * D + c);
                *(LAS f32x4*)(cA2 + c) = g * (s + 1.0f); *(LAS f32x4*)(cB2 + c) = h; } }
        __syncthreads();
        const int LN = tid & 63;
#pragma unroll 1
        for (int i = 0; i < 4; ++i) {
            const size_t m = (size_t)chunk * 32 + F.wave * 4 + i;
            v4u yv[8]; f32x4 xv[16];
#pragma unroll
            for (int j = 0; j < 8; ++j) { const int c = 8 * LN + 512 * j;
                if constexpr (HAS_Y) yv[j] = *(const GAS v4u*)(Yb + m * D + c);
                if constexpr (XIN_BF) { const v4u xb = *(const GAS v4u*)((const bf16*)xin_ + m * D + c);
                    xv[2 * j] = (f32x4){bflo(xb.x), bfhi(xb.x), bflo(xb.y), bfhi(xb.y)}; xv[2 * j + 1] = (f32x4){bflo(xb.z), bfhi(xb.z), bflo(xb.w), bfhi(xb.w)}; }
                else { xv[2 * j] = *(const f32x4*)((const float*)xin_ + m * D + c); xv[2 * j + 1] = *(const f32x4*)((const float*)xin_ + m * D + c + 4); } }
            float ssq2 = 0.f;
            if constexpr (HAS_Y) {
                float ssq = 0.f;
#pragma unroll
                for (int j = 0; j < 8; ++j) { const unsigned w[4] = {yv[j].x, yv[j].y, yv[j].z, yv[j].w};
#pragma unroll
                    for (int q = 0; q < 4; ++q) { const float a = bflo(w[q]), c2 = bfhi(w[q]); ssq += a * a + c2 * c2; } }
                ssq = wave_sum(ssq); const float r = 1.0f / sqrtf(ssq * (1.0f / D) + EPS);
#pragma unroll
                for (int j = 0; j < 8; ++j) { const int c = 8 * LN + 512 * j; const unsigned w[4] = {yv[j].x, yv[j].y, yv[j].z, yv[j].w};
                    const f32x4 a0 = *(const LAS f32x4*)(cA1 + c), a1 = *(const LAS f32x4*)(cA1 + c + 4);
                    f32x4 y0 = {bflo(w[0]), bfhi(w[0]), bflo(w[1]), bfhi(w[1])}, y1 = {bflo(w[2]), bfhi(w[2]), bflo(w[3]), bfhi(w[3])};
                    xv[2 * j] = xv[2 * j] + a0 * (y0 * r); xv[2 * j + 1] = xv[2 * j + 1] + a1 * (y1 * r);
                    if constexpr (XOUT_BF) { v4u xw; xw.x = pk2(xv[2 * j][0], xv[2 * j][1]); xw.y = pk2(xv[2 * j][2], xv[2 * j][3]); xw.z = pk2(xv[2 * j + 1][0], xv[2 * j + 1][1]); xw.w = pk2(xv[2 * j + 1][2], xv[2 * j + 1][3]);
                        *(GAS v4u*)((bf16*)xout_ + m * D + c) = xw; }
                    else { *(f32x4*)((float*)xout_ + m * D + c) = xv[2 * j]; *(f32x4*)((float*)xout_ + m * D + c + 4) = xv[2 * j + 1]; } } }
            if constexpr (HAS_H) {
#pragma unroll
                for (int j = 0; j < 16; ++j) ssq2 += (xv[j][0] * xv[j][0] + xv[j][1] * xv[j][1]) + (xv[j][2] * xv[j][2] + xv[j][3] * xv[j][3]);
                ssq2 = wave_sum(ssq2); const float r2 = 1.0f / sqrtf(ssq2 * (1.0f / D) + EPS);
#pragma unroll
                for (int j = 0; j < 8; ++j) { const int c = 8 * LN + 512 * j;
                    const f32x4 a0 = *(const LAS f32x4*)(cA2 + c), a1 = *(const LAS f32x4*)(cA2 + c + 4), b0 = *(const LAS f32x4*)(cB2 + c), b1 = *(const LAS f32x4*)(cB2 + c + 4);
                    const f32x4 h0 = (xv[2 * j] * r2) * a0 + b0, h1 = (xv[2 * j + 1] * r2) * a1 + b1;
                    v4u w; w.x = pk2(h0[0], h0[1]); w.y = pk2(h0[2], h0[3]); w.z = pk2(h1[0], h1[1]); w.w = pk2(h1[2], h1[3]);
                    *(GAS v4u*)(Hout + m * D + c) = w; } }
        }
    }
    __syncthreads();
}

constexpr int NB_IN = IN_W / 64, I_IN = (D / 64) * NB_IN, I_UQ = (QRANK / 64) * (QW / 64), I_UKV = (KVRANK / 64) * (KVW / 64), I_OSB = (SBW / 64) * (D / 64), I_OMLA = I_OSB,
              I_OUT = (D / 64) * (D / 64), I_UP = (D / 64) * (DFF / 64), I_DOWN = (DFF / 64) * (D / 64), I_LAYER = I_IN + I_UQ + I_UKV + I_OSB + I_OMLA + I_OUT + I_UP + I_DOWN;
#define CONVERT_ITEMS(lo, hi, start, stride) do { int cl_ = F.lane; asm volatile("" : "+v"(cl_));     \
        for (int it = (lo) + (start); it < (hi); it += (stride)) { \
            const int l = it / I_LAYER; int r = it % I_LAYER; \
            if (r < I_IN) { const int kb = r / NB_IN, nb = r % NB_IN, n0 = nb * 64; transpose_item(KIN(I_WIN) + (size_t)l * D * IN_W, IN_W, (bf16*)(wl + W_IN), D, kb, nb, n0 < C_GATE_SRC ? n0 : n0 + (C_GSB - C_GATE_SRC), n0 == C_KVD + KVRANK  , scr, cl_); continue; } r -= I_IN; \
            if (r < I_UQ) { const int kb = r / (QW / 64), nb = r % (QW / 64); transpose_item(KIN(I_WUQ) + (size_t)l * QRANK * QW, QW, (bf16*)(wl + W_UQ), QRANK, kb, nb, nb * 64, (nb % 3) == 2, scr, cl_, KIN(I_GQ) + (size_t)l * QRANK); continue; } r -= I_UQ; \
            if (r < I_UKV) { const int kb = r / (KVW / 64), nb = r % (KVW / 64); transpose_item(KIN(I_WUKV) + (size_t)l * KVRANK * KVW, KVW, (bf16*)(wl + W_UKV), KVRANK, kb, nb, nb * 64, false, scr, cl_, KIN(I_GKV) + (size_t)l * KVRANK); continue; } r -= I_UKV; \
            if (r < I_OSB) { const int kb = r / (D / 64), nb = r % (D / 64); transpose_item(KIN(I_WOSB) + (size_t)l * SBW * D, D, (bf16*)(wl + W_OSB), 2 * SBW, kb, nb, nb * 64, false, scr, cl_); continue; } r -= I_OSB; \
            if (r < I_OMLA) { const int kb = r / (D / 64), nb = r % (D / 64); transpose_item(KIN(I_WOMLA) + (size_t)l * SBW * D, D, (bf16*)(wl + W_OSB) + SBW, 2 * SBW, kb, nb, nb * 64, false, scr, cl_); continue; } r -= I_OMLA; \
            if (r < I_OUT) { const int kb = r / (D / 64), nb = r % (D / 64); transpose_item(KIN(I_WOUT) + (size_t)l * D * D, D, (bf16*)(wl + W_OUT), D, kb, nb, nb * 64, false, scr, cl_); continue; } r -= I_OUT; \
            if (r < I_UP) { const int kb = r / (DFF / 64), nb = r % (DFF / 64); transpose_item(KIN(I_WUP) + (size_t)l * D * DFF, DFF, (bf16*)(wl + W_UP), D, kb, nb, nb * 64, false, scr, cl_); continue; } r -= I_UP; \
            { const int kb = r / (D / 64), nb = r % (D / 64); transpose_item(KIN(I_WDOWN) + (size_t)l * DFF * D, D, (bf16*)(wl + W_DOWN), DFF, kb, nb, nb * 64, false, scr, cl_); } \
        } } while (0)

#ifndef XRES_BF16
#define XRES_BF16 1
#endif
#ifndef PG8_SP2
#define PG8_SP2 true
#endif
#ifndef PG8_ALIGN
#define PG8_ALIGN false
#endif
#ifndef PH_MASK
#define PH_MASK 0xFFFFFFFFu
#endif
#define PH(k) ((PH_MASK >> (k)) & 1u)
struct Args { const float* in[19]; float* out; unsigned char* ws; };
enum { I_X = 0, I_C, I_POS, I_WADA, I_BADA, I_GPREMIX, I_GPOSTMIX, I_GPREMLP, I_GPOSTMLP, I_WIN, I_GQ, I_WUQ, I_GKV, I_WUKV, I_WOSB, I_WOMLA, I_WOUT, I_WUP, I_WDOWN };

typedef __attribute__((address_space(4))) const unsigned char* kargp_t;
__device__ __forceinline__ __attribute__((address_space(1))) unsigned char* lw_(unsigned char* p) { __attribute__((address_space(1))) unsigned char* q = (__attribute__((address_space(1))) unsigned char*)p; asm volatile("" : "+s"(q)); return q; }
__device__ __forceinline__ kargp_t lwk_() { kargp_t p = (kargp_t)__builtin_amdgcn_kernarg_segment_ptr(); asm volatile("" : "+s"(p)); return p; }
#define KIN(k) ((const float*)(*(const __attribute__((address_space(1))) float* const __attribute__((address_space(4)))*)(lwk_() + 8 * (k))))
__global__ void __launch_bounds__(NWAVES * 64, 2) hybrid_fwd(Args args) {
    extern __shared__ __attribute__((aligned(16))) unsigned char lds_raw[];
    Frame F;
    F.lds = (LAS unsigned char*)lds_raw;
    F.tid = threadIdx.x; F.lane = F.tid & 63; F.wave = __builtin_amdgcn_readfirstlane(F.tid >> 6);
    F.G = gridDim.x; F.gw = blockIdx.x * NWAVES + F.wave; F.NGW = F.G * NWAVES;
    unsigned char* ws = args.ws;
    gu32* ctl = (gu32*)(ws + WS_CTL);
    for (int u = F.tid; u < (LDS_BYTES - LDSCTL_OFF) / 4; u += NWAVES * 64) ((LAS unsigned*)(F.lds + LDSCTL_OFF))[u] = 0u;
    __syncthreads();
    XcdBarrier bar = xcd_barrier_post((unsigned*)(ctl + CW_BAR), (volatile LAS unsigned*)(F.lds + MISC_OFF) + 8);
#define GRID_BAR() xcd_barrier(bar)

#define ada ((float*)(lw_(ws) + WS_ADA))
#define tab ((float*)(lw_(ws) + WS_TAB))
#define adap ((float*)(lw_(ws) + WS_ADAP))
#define Hb ((bf16*)(lw_(ws) + A_H))
#define PROJ ((bf16*)(lw_(ws) + A_PROJ))
#define SSQ ((float*)(lw_(ws) + A_CQ))
#define KR ((bf16*)(lw_(ws) + A_KR))
#define QF ((bf16*)(lw_(ws) + A_Q))
#define KVF ((bf16*)(lw_(ws) + A_KV))
#define OSB ((bf16*)(lw_(ws) + A_OSB))
#define MRG ((bf16*)(lw_(ws) + A_MRG))
#define Yb ((bf16*)(lw_(ws) + A_Y))
#define XB ((bf16*)(lw_(ws) + A_TMP))
#define U ((bf16*)(lw_(ws) + A_U))
#define x_in KIN(I_X)
#define wl (lw_(ws) + WS_W + (size_t)l * W_LAYER)
#define adl (ada + (size_t)l * BATCH * 6 * D)
    float* xo = args.out;


    if (PH(0)) {
        LAS float* cact = (LAS float*)F.lds;
        for (int i = F.tid; i < BATCH * D; i += NWAVES * 64) { const float cv = KIN(I_C)[i]; cact[i] = cv / (1.0f + __expf(-cv)); }
        __syncthreads();
        for (int task = blockIdx.x; task < DEPTH * 32 * 12; task += F.G) {
            const int l = task / (32 * 12), s = (task / 12) % 32, cb = task % 12;
            const int col = cb * 2048 + F.tid * 4;
            const float* wp = KIN(I_WADA) + ((size_t)l * D + s * 128) * (6 * D) + col;
            f32x4 a0 = {0.f, 0.f, 0.f, 0.f}, a1 = {0.f, 0.f, 0.f, 0.f};
#pragma unroll 8
            for (int k = 0; k < 128; ++k) { const f32x4 w = NT_LD((const f32x4*)(wp + (size_t)k * (6 * D))); const float c0 = cact[s * 128 + k], c1 = cact[D + s * 128 + k];
                a0 += w * c0; a1 += w * c1; }
            *(f32x4*)(adap + (((size_t)s * DEPTH + l) * BATCH + 0) * (6 * D) + col) = a0;
            *(f32x4*)(adap + (((size_t)s * DEPTH + l) * BATCH + 1) * (6 * D) + col) = a1;
        }
        __syncthreads();
        for (int e = blockIdx.x * (NWAVES * 64) + F.tid; e < M * 32; e += F.G * NWAVES * 64) {
            const int m = e >> 5, i = e & 31;
            const float inv = powf(10000.0f, -(float)i / 32.0f);
            const float ang = (float)(((const int*)KIN(I_POS))[m]) * inv;
            const double rev = (double)ang * 0.15915494309189533577; const float fr = (float)(rev - rint(rev));
            tab[2 * e] = __builtin_amdgcn_cosf(fr); tab[2 * e + 1] = __builtin_amdgcn_sinf(fr);
        }
        for (int l = 0; l < DEPTH; ++l) { v4u* z = (v4u*)(ws + WS_W + l * W_LAYER + W_IN + (size_t)C_GATE_SRC * D * 2);
            for (int i = blockIdx.x * (NWAVES * 64) + F.tid; i < 192 * D * 2 / 16; i += F.G * NWAVES * 64) z[i] = (v4u){0u, 0u, 0u, 0u}; }
        LAS float* scr = (LAS float*)(F.lds) + F.wave * (64 * 65);
        CONVERT_ITEMS(0, DEPTH * I_LAYER, F.gw, F.NGW);
    }
    GRID_BAR();
    if (PH(1)) for (int e = blockIdx.x * (NWAVES * 64) + F.tid; e < DEPTH * BATCH * 6 * D; e += F.G * NWAVES * 64) {
        const int l = e / (BATCH * 6 * D), n = e % (6 * D);
        float s = KIN(I_BADA)[(size_t)l * 6 * D + n];
#pragma unroll 8
        for (int k = 0; k < 32; ++k) s += adap[(size_t)k * (DEPTH * BATCH * 6 * D) + e];
        ada[e] = s;
    }
    GRID_BAR();
    if (PH(2)) thin_phase<false, true>(F, x_in, nullptr, nullptr, Hb, nullptr, nullptr, KIN(I_GPREMIX), ada + D, ada);
    GRID_BAR();

    for (int l = 0; l < DEPTH; ++l) {
        if (PH(3)) { pg8::Gemm g{Hb, (const bf16*)(wl + W_IN), M, PROJ_W, D}; pg8::StaticOrder S; S.init(M, PROJ_W, F.G, (int)blockIdx.x);
          pg8::EpiProj E{PROJ, PROJ_W, SSQ, KR, tab};
          pg8::gemm_phase<pg8::EpiProj, pg8::StaticOrder, PG8_ALIGN, PG8_SP2>(F.lds, g, S, E); }
        GRID_BAR();
#ifndef P3_REP
#define P3_REP 1
#endif
#pragma unroll 1
        for (int rep3 = 0; rep3 < P3_REP; ++rep3) {
        if (PH(5)) { pg8::Gemm g{PROJ + C_QD, (const bf16*)(wl + W_UQ), M, QW, QRANK, PROJ_W}; pg8::StaticOrder S; S.init(M, QW, F.G, (int)blockIdx.x);
          pg8::EpiRope E{QF, QW, tab, SSQ};
          pg8::gemm_phase<pg8::EpiRope, pg8::StaticOrder, PG8_ALIGN, PG8_SP2>(F.lds, g, S, E); }
        if (PH(5)) { pg8::Gemm g{PROJ + C_KVD, (const bf16*)(wl + W_UKV), M, KVW, KVRANK, PROJ_W}; pg8::EpiScale E{KVF, KVW, SSQ};
          if (F.G == 256) { pg8::UnevenOrder S; S.init(M, KVW, F.G, (int)blockIdx.x);
            pg8::gemm_phase<pg8::EpiScale, pg8::UnevenOrder, PG8_ALIGN, PG8_SP2>(F.lds, g, S, E); }
          else { pg8::StaticOrder S; S.init(M, KVW, F.G, (int)blockIdx.x);
            pg8::gemm_phase<pg8::EpiScale, pg8::StaticOrder, PG8_ALIGN, PG8_SP2>(F.lds, g, S, E); } }
        }
        GRID_BAR();
        if (PH(6)) for (int item = blockIdx.x; item < 512; item += F.G) {
            const int kind = item >> 8, c = item & 255, bh = (c & 7) * 4 + ((c >> 3) >> 3), y = (c >> 3) & 7, b = bh >> 4, h = bh & 15;
            const size_t rb = (size_t)b * SEQ;
            if (kind == 0) { if (PH(14)) {
                att::Tensors T{PROJ + rb * PROJ_W + h * 128, PROJ_W, PROJ + rb * PROJ_W + SBW + h * 128, PROJ_W, PROJ + rb * PROJ_W + 2 * SBW + h * 128, PROJ_W, nullptr, OSB + rb * (2 * SBW) + h * 128, 2 * SBW};
                att::attn_unit<0>(T, 15 - y, 0.08838834764831845f * 1.4426950408889634f, (LAS char*)F.lds);
                att::attn_unit<0>(T, y, 0.08838834764831845f * 1.4426950408889634f, (LAS char*)F.lds); }
            } else if (PH(15)) {
                att::Tensors T{QF + rb * QW + h * 192, QW, KVF + rb * KVW + h * 256, KVW, KVF + rb * KVW + h * 256 + 128, KVW, KR + rb * ROPE, OSB + rb * (2 * SBW) + SBW + h * 128, 2 * SBW};
                att::attn_unit<1>(T, 15 - y, 0.07216878364870323f * 1.4426950408889634f, (LAS char*)F.lds);
                att::attn_unit<1>(T, y, 0.07216878364870323f * 1.4426950408889634f, (LAS char*)F.lds);
            }
        }
        GRID_BAR();
#ifndef P5_REP
#define P5_REP 1
#endif
#pragma unroll 1
        for (int rep5 = 0; rep5 < P5_REP; ++rep5)
        if (PH(7)) { pg8::Gemm g{OSB, (const bf16*)(wl + W_OSB), M, D, 2 * SBW}; pg8::StaticOrder S; S.init(M, D, F.G, (int)blockIdx.x);
          pg8::EpiGateMerge E{MRG, D, PROJ + C_GSB, PROJ + C_GMLA, PROJ_W};
          pg8::gemm_phase<pg8::EpiGateMerge, pg8::StaticOrder, PG8_ALIGN, PG8_SP2>(F.lds, g, S, E); }
        GRID_BAR();
#ifndef P7_REP
#define P7_REP 1
#endif
#pragma unroll 1
        for (int rep7 = 0; rep7 < P7_REP; ++rep7)
#ifdef P7_MREP
        if (PH(9)) { pg8::Gemm g{MRG, (const bf16*)(wl + W_OUT), M, D, D}; pg8::RepOrder S; S.init(M, D, F.G, (int)blockIdx.x); S.reps = P7_MREP;
          pg8::EpiBf16<0> E{Yb, D};
          pg8::gemm_phase<pg8::EpiBf16<0>, pg8::RepOrder, PG8_ALIGN, PG8_SP2>(F.lds, g, S, E); }
#else
        if (PH(9)) { pg8::Gemm g{MRG, (const bf16*)(wl + W_OUT), M, D, D}; pg8::StaticOrder S; S.init(M, D, F.G, (int)blockIdx.x);
          pg8::EpiBf16<0> E{Yb, D};
          pg8::gemm_phase<pg8::EpiBf16<0>, pg8::StaticOrder, PG8_ALIGN, PG8_SP2>(F.lds, g, S, E); }
#endif
        GRID_BAR();
#if XRES_BF16
        if (PH(10)) { if (l == 0) thin_phase<true, true, false, true>(F, x_in, XB, Yb, Hb, KIN(I_GPOSTMIX) + (size_t)l * D, adl + 2 * D, KIN(I_GPREMLP) + (size_t)l * D, adl + 4 * D, adl + 3 * D);
            else thin_phase<true, true, true, true>(F, XB, XB, Yb, Hb, KIN(I_GPOSTMIX) + (size_t)l * D, adl + 2 * D, KIN(I_GPREMLP) + (size_t)l * D, adl + 4 * D, adl + 3 * D); }
#else
        if (PH(10)) thin_phase<true, true>(F, l == 0 ? x_in : (const float*)xo, xo, Yb, Hb, KIN(I_GPOSTMIX) + (size_t)l * D, adl + 2 * D, KIN(I_GPREMLP) + (size_t)l * D, adl + 4 * D, adl + 3 * D);
#endif
        GRID_BAR();
        if (PH(11)) { pg8::Gemm g{Hb, (const bf16*)(wl + W_UP), M, DFF, D}; pg8::StaticOrder S; S.init(M, DFF, F.G, (int)blockIdx.x);
          pg8::EpiBf16<1> E{U, DFF};
          pg8::gemm_phase<pg8::EpiBf16<1>, pg8::StaticOrder, PG8_ALIGN, PG8_SP2>(F.lds, g, S, E); }
        GRID_BAR();
        if (PH(12)) { pg8::Gemm g{U, (const bf16*)(wl + W_DOWN), M, D, DFF}; pg8::StaticOrder S; S.init(M, D, F.G, (int)blockIdx.x);
          pg8::EpiBf16<0> E{Yb, D};
          pg8::gemm_phase<pg8::EpiBf16<0>, pg8::StaticOrder, PG8_ALIGN, PG8_SP2>(F.lds, g, S, E); }
        GRID_BAR();
#if XRES_BF16
        if (PH(13)) { if (l + 1 < DEPTH) { const float* adn = ada + (size_t)(l + 1) * BATCH * 6 * D;
                thin_phase<true, true, true, true>(F, XB, XB, Yb, Hb, KIN(I_GPOSTMLP) + (size_t)l * D, adl + 5 * D, KIN(I_GPREMIX) + (size_t)(l + 1) * D, adn + D, adn); }
            else thin_phase<true, false, true, false>(F, XB, xo, Yb, nullptr, KIN(I_GPOSTMLP) + (size_t)l * D, adl + 5 * D, nullptr, nullptr, nullptr); }
#else
        if (PH(13)) { if (l + 1 < DEPTH) { const float* adn = ada + (size_t)(l + 1) * BATCH * 6 * D;
                thin_phase<true, true>(F, xo, xo, Yb, Hb, KIN(I_GPOSTMLP) + (size_t)l * D, adl + 5 * D, KIN(I_GPREMIX) + (size_t)(l + 1) * D, adn + D, adn); }
            else thin_phase<true, false>(F, xo, xo, Yb, nullptr, KIN(I_GPOSTMLP) + (size_t)l * D, adl + 5 * D, nullptr, nullptr, nullptr); }
#endif
        if (l + 1 < DEPTH) GRID_BAR();
    }
    if (blockIdx.x == 0 && F.tid == 0 && __hip_atomic_load((unsigned*)(ctl + CW_BAR) + XB_TMO, RLX_AGENT) != 0u) xo[0] = __builtin_nanf("");
}
#undef ada
#undef tab
#undef adap
#undef Hb
#undef PROJ
#undef SSQ
#undef KR
#undef QF
#undef KVF
#undef OSB
#undef MRG
#undef Yb
#undef XB
#undef U
#undef x_in
#undef wl
#undef adl


extern "C" void kernel_launch(void* const* d_in, const int* in_sizes, int n_in, void* d_out, int out_size, void* d_ws, size_t ws_size, hipStream_t stream) {
    static int grid = 0;
    if (grid == 0) {
        if (n_in != 19 || out_size != M * D || ws_size < WS_END) { fprintf(stderr, "kernel_launch: unexpected shapes (n_in %d, out %d, ws %zu < %zu)\n", n_in, out_size, ws_size, (size_t)WS_END); grid = -1; return; }
        int dev = 0, cus = 0, per_cu = 0;
        if (hipGetDevice(&dev) != hipSuccess || hipDeviceGetAttribute(&cus, hipDeviceAttributeMultiprocessorCount, dev) != hipSuccess) { grid = -1; return; }
        if (hipFuncSetAttribute((const void*)hybrid_fwd, hipFuncAttributeMaxDynamicSharedMemorySize, LDS_BYTES) != hipSuccess) { fprintf(stderr, "kernel_launch: hipFuncSetAttribute failed\n"); grid = -1; return; }
        if (hipOccupancyMaxActiveBlocksPerMultiprocessor(&per_cu, (const void*)hybrid_fwd, NWAVES * 64, LDS_BYTES) != hipSuccess || per_cu < 1) { fprintf(stderr, "kernel_launch: occupancy query says %d\n", per_cu); (void)hipGetLastError(); }
        grid = cus;
    }
    if (grid < 0) return;
    if (hipMemsetAsync((char*)d_ws + WS_CTL, 0, CTL_ZERO_BYTES, stream) != hipSuccess) return;
    Args a{};
    for (int i = 0; i < 19; ++i) a.in[i] = (const float*)d_in[i];
    a.out = (float*)d_out; a.ws = (unsigned char*)d_ws;
    hipLaunchKernelGGL(hybrid_fwd, dim3(grid), dim3(NWAVES * 64), LDS_BYTES, stream, a);
#ifdef DBG_CHECK
    hipLaunchKernelGGL(dbg_check, dim3(DBG_NCHK), dim3(256), 0, stream, a, (unsigned*)((char*)d_ws + 4096));
    hipLaunchKernelGGL(dbg_report, dim3(1), dim3(64), 0, stream, (float*)d_out, (const unsigned*)((char*)d_ws + 4096));
#endif
}
```

```cpp
#include <hip/hip_runtime.h>
#include <cstdio>
#include <cstdint>
#include <cmath>
#ifndef PG8_WGM
#define PG8_WGM 8
#endif
namespace pg8 {
#define PG8_LAS __attribute__((address_space(3)))
typedef unsigned short bf16_t;
typedef short bf16x8 __attribute__((ext_vector_type(8)));
typedef float f32x4 __attribute__((ext_vector_type(4)));
typedef unsigned u32x4 __attribute__((ext_vector_type(4)));
constexpr int BM = 256, BK = 64, HALF = 128, HTB = HALF * BK * 2  , STAGE_BYTES = 8 * HTB, NXCD = 8, WGM = PG8_WGM;

__host__ __device__ __forceinline__ int lds_byte(int r, int c) { const int st = (r >> 4) * 2 + (c >> 5), rr = r & 15, cc = c & 31, ob = rr * 64 + cc * 2; return st * 1024 + (ob ^ (((ob >> 9) & 1) << 5)); }
__host__ __device__ __forceinline__ void stage_rc(int b, int& R, int& C) { const int st = b / 1024, sb = b % 1024, swz = sb ^ (((sb >> 9) & 1) << 5); R = (st >> 1) * 16 + swz / 64; C = (st & 1) * 32 + (swz % 64) / 2; }
__host__ __device__ __forceinline__ int perm32(int rho) { const int n = rho >> 4, i = rho & 15; return 8 * (i >> 2) + 4 * n + (i & 3); }

struct Unit { int pm, pn; };
struct Gemm { const bf16_t* A; const bf16_t* Bt; int M, N, K; int lda = 0; };

struct StaticOrder {
    int nM, nN, nwg, G, c;
    __host__ __device__ void init(int M, int N, int G_, int c_) { nM = M / BM; nN = N / BM; nwg = nM * nN; G = G_; c = c_; }
    __host__ __device__ bool next(int i, Unit& u) const {
        const long L = (long)i * G + c; if (L >= nwg) return false;
        int wgid = (int)L; { const int q = nwg / NXCD, r = nwg % NXCD, xcd = wgid % NXCD, off = wgid / NXCD; wgid = (xcd < r ? xcd * (q + 1) : r * (q + 1) + (xcd - r) * q) + off; }
        const int nig = WGM * nN, gid = wgid / nig, fm = gid * WGM, gsz = (nM - fm) < WGM ? (nM - fm) : WGM;
        u.pm = fm + ((wgid % nig) % gsz); u.pn = (wgid % nig) / gsz; return true;
    }
    __device__ __forceinline__ void a_ready(const Unit&) const {}
    __device__ __forceinline__ void done(const Unit&) const {}
};

struct UnevenOrder : StaticOrder {
    __host__ __device__ bool next(int i, Unit& u) const {
        long L; const int h = G / 2;
        if (c < h) { if (i > 0) return false; L = c; } else { if (i > 2) return false; L = h + (long)h * i + (c - h); }
        if (L >= nwg) return false;
        int wgid = (int)L; { const int q = nwg / NXCD, r = nwg % NXCD, xcd = wgid % NXCD, off = wgid / NXCD; wgid = (xcd < r ? xcd * (q + 1) : r * (q + 1) + (xcd - r) * q) + off; }
        const int nig = WGM * nN, gid = wgid / nig, fm = gid * WGM, gsz = (nM - fm) < WGM ? (nM - fm) : WGM;
        u.pm = fm + ((wgid % nig) % gsz); u.pn = (wgid % nig) / gsz; return true;
    }
};

struct RepOrder : StaticOrder {
    int reps;
    __host__ __device__ bool next(int i, Unit& u) const { const int per = (nwg + G - 1) / G; if (i >= per * reps) return false; return StaticOrder::next(i % per, u); }
};
__device__ __forceinline__ unsigned cvt_pk_bf16(float lo, float hi) { unsigned r; asm volatile("v_cvt_pk_bf16_f32 %0, %1, %2" : "=v"(r) : "v"(lo), "v"(hi)); return r; }
typedef float f32x2 __attribute__((ext_vector_type(2)));

__device__ __forceinline__ float bf_lo(unsigned w) { return __builtin_bit_cast(float, w << 16); }
__device__ __forceinline__ float bf_hi(unsigned w) { return __builtin_bit_cast(float, w & 0xffff0000u); }
__device__ __forceinline__ float sigmoidf_fast(float x) { return __builtin_amdgcn_rcpf(1.0f + __builtin_amdgcn_exp2f(-1.4426950408889634f * x)); }

#ifndef EPI_WT
#define EPI_WT 0
#endif
__device__ __forceinline__ void st16_out(bf16_t* p, u32x4 w) {
#if EPI_WT
    asm volatile("global_store_dwordx4 %0, %1, off sc1" :: "v"((__attribute__((address_space(1))) u32x4*)p), "v"(w) : "memory");
#else
    *(u32x4*)p = w;
#endif
}
template <int ACT  > struct EpiBf16 {
    static constexpr bool PERM = true, AFTER_DRAIN = false, MID = false;
    bf16_t* O; int ldc;
    __device__ __forceinline__ void operator()(const f32x4 (&acc)[2][2][4][2], const Unit& u, int wr, int wc, int fr, int fq) const {
        const int row0 = u.pm * BM + wr * 64 + fr, col0 = u.pn * BM + wc * 32 + 8 * fq;
#pragma unroll
        for (int ai = 0; ai < 2; ++ai)
#pragma unroll
            for (int m = 0; m < 4; ++m) { bf16_t* rowp = O + (size_t)(row0 + ai * HALF + m * 16) * ldc + col0;
#pragma unroll
                for (int bj = 0; bj < 2; ++bj) { f32x4 v0 = acc[ai][bj][m][0], v1 = acc[ai][bj][m][1];
                    if (ACT == 1) {
#pragma unroll
                        for (int j = 0; j < 4; ++j) { const float a = fmaxf(v0[j], 0.f), b = fmaxf(v1[j], 0.f); v0[j] = a * a; v1[j] = b * b; } }
                    u32x4 w; w.x = cvt_pk_bf16(v0[0], v0[1]); w.y = cvt_pk_bf16(v0[2], v0[3]); w.z = cvt_pk_bf16(v1[0], v1[1]); w.w = cvt_pk_bf16(v1[2], v1[3]);
                    st16_out(rowp + bj * HALF, w);
                    } }
    }
};
struct EpiProj {
    static constexpr bool PERM = true, AFTER_DRAIN = false, MID = false;
    static constexpr int SSQ_T0 = 24, ROPE_T = 30, GATE_T0 = 31;
    bf16_t* O; int ldc; float* SSQ; bf16_t* KRo; const float* tab; u32x4* GR; u32x4* GS;
    __device__ __forceinline__ void operator()(const f32x4 (&acc)[2][2][4][2], const Unit& u, int wr, int wc, int fr, int fq) const {
        const int row0 = u.pm * BM + wr * 64 + fr, col0 = u.pn * BM + wc * 32 + 8 * fq;
        const bool do_ssq = (u.pn >= SSQ_T0) && (u.pn < SSQ_T0 + 6), do_rope = (u.pn == ROPE_T) && (wc < 2);
        if (u.pn >= GATE_T0) {
            const int t = u.pn - GATE_T0; const size_t e0 = ((size_t)((u.pm * 16 + (t >> 1)) * 16 + (t & 1))) * 512 + (size_t)((wr * 4 + wc) * 64 + fr + 16 * fq);
#pragma unroll
            for (int ai = 0; ai < 2; ++ai)
#pragma unroll
                for (int m = 0; m < 4; ++m) { float r[8], sg[8];
#pragma unroll
                    for (int n = 0; n < 2; ++n)
#pragma unroll
                        for (int j = 0; j < 4; ++j) { const float e1 = __builtin_amdgcn_exp2f(-1.4426950408889634f * acc[ai][0][m][n][j]), e2 = __builtin_amdgcn_exp2f(-1.4426950408889634f * acc[ai][1][m][n][j]);
                            sg[4 * n + j] = __builtin_amdgcn_rcpf(1.0f + e2); r[4 * n + j] = (1.0f + e2) * __builtin_amdgcn_rcpf(1.0f + e1); }
                    u32x4 rw, sw; rw.x = cvt_pk_bf16(r[0], r[1]); rw.y = cvt_pk_bf16(r[2], r[3]); rw.z = cvt_pk_bf16(r[4], r[5]); rw.w = cvt_pk_bf16(r[6], r[7]);
                    sw.x = cvt_pk_bf16(sg[0], sg[1]); sw.y = cvt_pk_bf16(sg[2], sg[3]); sw.z = cvt_pk_bf16(sg[4], sg[5]); sw.w = cvt_pk_bf16(sg[6], sg[7]);
                    GR[e0 + (size_t)(ai * 8 + m * 2) * 512] = rw; GS[e0 + (size_t)(ai * 8 + m * 2) * 512] = sw; }
            return;
        }
#pragma unroll
        for (int ai = 0; ai < 2; ++ai)
#pragma unroll
            for (int m = 0; m < 4; ++m) { const int row = row0 + ai * HALF + m * 16; bf16_t* rowp = O + (size_t)row * ldc + col0;
                float ss = 0.f;
#pragma unroll
                for (int bj = 0; bj < 2; ++bj) { const f32x4 v0 = acc[ai][bj][m][0], v1 = acc[ai][bj][m][1];
                    u32x4 w; w.x = cvt_pk_bf16(v0[0], v0[1]); w.y = cvt_pk_bf16(v0[2], v0[3]); w.z = cvt_pk_bf16(v1[0], v1[1]); w.w = cvt_pk_bf16(v1[2], v1[3]);
                    st16_out(rowp + bj * HALF, w);
                    if (do_ssq) { const unsigned ww[4] = {w.x, w.y, w.z, w.w};
#pragma unroll
                        for (int q = 0; q < 4; ++q) { const float a = bf_lo(ww[q]), b = bf_hi(ww[q]); ss += a * a + b * b; } }
                    if (bj == 0 && do_rope) { const int co = wc * 32 + 8 * fq; const float* tp = tab + (size_t)row * 64 + co;
                        const f32x4 t0 = *(const f32x4*)tp, t1 = *(const f32x4*)(tp + 4);
                        f32x4 r0, r1;
                        r0[0] = v0[0] * t0[0] - v0[1] * t0[1]; r0[1] = v0[1] * t0[0] + v0[0] * t0[1];
                        r0[2] = v0[2] * t0[2] - v0[3] * t0[3]; r0[3] = v0[3] * t0[2] + v0[2] * t0[3];
                        r1[0] = v1[0] * t1[0] - v1[1] * t1[1]; r1[1] = v1[1] * t1[0] + v1[0] * t1[1];
                        r1[2] = v1[2] * t1[2] - v1[3] * t1[3]; r1[3] = v1[3] * t1[2] + v1[2] * t1[3];
                        u32x4 k; k.x = cvt_pk_bf16(r0[0], r0[1]); k.y = cvt_pk_bf16(r0[2], r0[3]); k.z = cvt_pk_bf16(r1[0], r1[1]); k.w = cvt_pk_bf16(r1[2], r1[3]);
                        *(u32x4*)(KRo + (size_t)row * 64 + co) = k; } }
                if (do_ssq) { ss += __shfl_xor(ss, 16); ss += __shfl_xor(ss, 32);
                    if (fq == 0) SSQ[(size_t)row * 32 + 4 * (u.pn - SSQ_T0) + wc] = ss; } }
    }
};
template <int S0, int NS> __device__ __forceinline__ void row_rms_scales(float (&rs)[2][4], const float* SSQ, int row0, int fq, float inv_dim) {
    float part[2][4];
#pragma unroll
    for (int ai = 0; ai < 2; ++ai)
#pragma unroll
        for (int m = 0; m < 4; ++m) { const float* p = SSQ + (size_t)(row0 + ai * HALF + m * 16) * 32 + S0 + (NS / 4) * fq;
            if constexpr (NS == 16) { const f32x4 v = *(const f32x4*)p; part[ai][m] = (v[0] + v[1]) + (v[2] + v[3]); }
            else { const f32x2 v = *(const f32x2*)p; part[ai][m] = v[0] + v[1]; } }
#pragma unroll
    for (int ai = 0; ai < 2; ++ai)
#pragma unroll
        for (int m = 0; m < 4; ++m) { float t = part[ai][m]; t += __shfl_xor(t, 16); t += __shfl_xor(t, 32); rs[ai][m] = 1.0f / sqrtf(t * inv_dim + 1e-6f); }
}
struct EpiScale {
    static constexpr bool PERM = true, AFTER_DRAIN = false, MID = false;
    bf16_t* O; int ldc; const float* SSQ;
    __device__ __forceinline__ void operator()(const f32x4 (&acc)[2][2][4][2], const Unit& u, int wr, int wc, int fr, int fq) const {
        const int row0 = u.pm * BM + wr * 64 + fr, col0 = u.pn * BM + wc * 32 + 8 * fq;
        float rs[2][4]; row_rms_scales<16, 8>(rs, SSQ, row0, fq, 1.0f / 512.0f);
#pragma unroll
        for (int ai = 0; ai < 2; ++ai)
#pragma unroll
            for (int m = 0; m < 4; ++m) { bf16_t* rowp = O + (size_t)(row0 + ai * HALF + m * 16) * ldc + col0; const float r = rs[ai][m];
#pragma unroll
                for (int bj = 0; bj < 2; ++bj) { const f32x4 v0 = acc[ai][bj][m][0] * r, v1 = acc[ai][bj][m][1] * r;
                    u32x4 w; w.x = cvt_pk_bf16(v0[0], v0[1]); w.y = cvt_pk_bf16(v0[2], v0[3]); w.z = cvt_pk_bf16(v1[0], v1[1]); w.w = cvt_pk_bf16(v1[2], v1[3]);
                    st16_out(rowp + bj * HALF, w); } }
    }
};
struct EpiRope {
    static constexpr bool PERM = true, AFTER_DRAIN = false, MID = false;
    bf16_t* O; int ldc; const float* tab; const float* SSQ;
    __device__ __forceinline__ void operator()(const f32x4 (&acc)[2][2][4][2], const Unit& u, int wr, int wc, int fr, int fq) const {
        const int row0 = u.pm * BM + wr * 64 + fr, col0 = u.pn * BM + wc * 32 + 8 * fq;
        float rs[2][4]; row_rms_scales<0, 16>(rs, SSQ, row0, fq, 1.0f / 1024.0f);
        const int j0 = col0 % 192, j1 = (col0 + HALF) % 192, rbj = (j0 >= 128) ? 0 : (j1 >= 128) ? 1 : -1, jr = (rbj == 0 ? j0 : j1) - 128;
#pragma unroll
        for (int ai = 0; ai < 2; ++ai) {
            f32x4 t0[4], t1[4];
            if (rbj >= 0) {
#pragma unroll
                for (int m = 0; m < 4; ++m) { const float* tp = tab + (size_t)(row0 + ai * HALF + m * 16) * 64 + jr;
                    t0[m] = *(const f32x4*)tp; t1[m] = *(const f32x4*)(tp + 4); }
            }
#pragma unroll
            for (int m = 0; m < 4; ++m) { const int row = row0 + ai * HALF + m * 16; bf16_t* rowp = O + (size_t)row * ldc + col0;
#pragma unroll
                for (int bj = 0; bj < 2; ++bj) { f32x4 v0 = acc[ai][bj][m][0] * rs[ai][m], v1 = acc[ai][bj][m][1] * rs[ai][m];
                    if (bj == rbj) { const f32x4 a0 = t0[m], a1 = t1[m];
                        f32x4 r0, r1;
                        r0[0] = v0[0] * a0[0] - v0[1] * a0[1]; r0[1] = v0[1] * a0[0] + v0[0] * a0[1];
                        r0[2] = v0[2] * a0[2] - v0[3] * a0[3]; r0[3] = v0[3] * a0[2] + v0[2] * a0[3];
                        r1[0] = v1[0] * a1[0] - v1[1] * a1[1]; r1[1] = v1[1] * a1[0] + v1[0] * a1[1];
                        r1[2] = v1[2] * a1[2] - v1[3] * a1[3]; r1[3] = v1[3] * a1[2] + v1[2] * a1[3];
                        v0 = r0; v1 = r1; }
                    u32x4 w; w.x = cvt_pk_bf16(v0[0], v0[1]); w.y = cvt_pk_bf16(v0[2], v0[3]); w.z = cvt_pk_bf16(v1[0], v1[1]); w.w = cvt_pk_bf16(v1[2], v1[3]);
                    st16_out(rowp + bj * HALF, w); } }
            asm volatile("" ::: "memory"); }
    }
};
struct EpiGateMerge {
    static constexpr bool PERM = true, AFTER_DRAIN = false, MID = true;
    bf16_t* O; int ldo; const u32x4* GR; const u32x4* GS;
    __device__ __forceinline__ void mid(f32x4 (&acc)[2][2][4][2], const Unit& u, int wr, int wc, int fr, int fq) const {
        int fr_ = fr, fq_ = fq; asm volatile("" : "+v"(fr_), "+v"(fq_));
        const u32x4* p = GR + (size_t)((u.pm * 16 + u.pn) * 16) * 512 + (size_t)((wr * 4 + wc) * 64 + fr_ + 16 * fq_);
        u32x4 g[2][4][2];
#pragma unroll
        for (int ai = 0; ai < 2; ++ai)
#pragma unroll
            for (int m = 0; m < 4; ++m)
#pragma unroll
                for (int bj = 0; bj < 2; ++bj) g[ai][m][bj] = p[(ai * 8 + m * 2 + bj) * 512];
#pragma unroll
        for (int ai = 0; ai < 2; ++ai)
#pragma unroll
            for (int m = 0; m < 4; ++m)
#pragma unroll
                for (int bj = 0; bj < 2; ++bj) { const u32x4 a = g[ai][m][bj]; const unsigned aw[4] = {a.x, a.y, a.z, a.w};
#pragma unroll
                    for (int q = 0; q < 4; ++q) { acc[ai][bj][m][q >> 1][2 * (q & 1)] *= bf_lo(aw[q]); acc[ai][bj][m][q >> 1][2 * (q & 1) + 1] *= bf_hi(aw[q]); } }
    }
    __device__ __forceinline__ void operator()(const f32x4 (&acc)[2][2][4][2], const Unit& u, int wr, int wc, int fr, int fq) const {
        const int row0 = u.pm * BM + wr * 64 + fr, col0 = u.pn * BM + wc * 32 + 8 * fq;
        const u32x4* p = GS + (size_t)((u.pm * 16 + u.pn) * 16) * 512 + (size_t)((wr * 4 + wc) * 64 + fr + 16 * fq);
        u32x4 g[2][4][2];
#pragma unroll
        for (int ai = 0; ai < 2; ++ai)
#pragma unroll
            for (int m = 0; m < 4; ++m)
#pragma unroll
                for (int bj = 0; bj < 2; ++bj) g[ai][m][bj] = p[(ai * 8 + m * 2 + bj) * 512];
#pragma unroll
        for (int ai = 0; ai < 2; ++ai)
#pragma unroll
            for (int m = 0; m < 4; ++m) { bf16_t* op = O + (size_t)(row0 + ai * HALF + m * 16) * ldo + col0;
#pragma unroll
                for (int bj = 0; bj < 2; ++bj) { const f32x4 v0 = acc[ai][bj][m][0], v1 = acc[ai][bj][m][1]; const u32x4 s = g[ai][m][bj];
                    u32x4 w; w.x = cvt_pk_bf16(v0[0] * bf_lo(s.x), v0[1] * bf_hi(s.x)); w.y = cvt_pk_bf16(v0[2] * bf_lo(s.y), v0[3] * bf_hi(s.y));
                    w.z = cvt_pk_bf16(v1[0] * bf_lo(s.z), v1[1] * bf_hi(s.z)); w.w = cvt_pk_bf16(v1[2] * bf_lo(s.w), v1[3] * bf_hi(s.w));
                    st16_out(op + bj * HALF, w); } }
    }
};

template <class Epi, class Sched, bool ALIGN_EPI = false, bool SP2 = false>
__device__ __forceinline__ void gemm_phase(PG8_LAS unsigned char* lds, const Gemm g, const Sched& S, const Epi& E) {
    int tid_ = threadIdx.x; asm volatile("" : "+v"(tid_));
    const int tid = tid_, wid = __builtin_amdgcn_readfirstlane(tid >> 6), lane = tid & 63, wr = wid >> 2, wc = wid & 3, fr = lane & 15, fq = lane >> 4;
    const int K = g.K, nt = K / BK, lda = g.lda ? g.lda : K;
#ifndef PG8_KROT
#define PG8_KROT 0
#endif
#if PG8_KROT
    const int ktm = nt - 1, kt0 = Epi::MID ? 0 : ((int)((blockIdx.x & 7u) * (unsigned)(nt >> 3)) * PG8_KROT) & ktm;
#define PG8_KP(base, t) ((base) + (size_t)(((t) + kt0) & ktm) * kstep)
#else
#define PG8_KP(base, t) ((base) + (size_t)(t) * kstep)
#endif
    unsigned voffA[2], voffB[2];
#pragma unroll
    for (int i = 0; i < 2; ++i) { int R, C; stage_rc(tid * 16 + i * 8192, R, C); const int Rb = Epi::PERM ? ((R & ~31) + perm32(R & 31)) : R;
        voffA[i] = (unsigned)(R * lda + C) * 2u; voffB[i] = (unsigned)(Rb * K + C) * 2u; }
    const size_t kstep = (size_t)(BK * 2);
    const size_t hstepA = (size_t)HALF * lda * 2, hstepB = (size_t)HALF * K * 2;
    const size_t tstepA = 2 * hstepA, tstepB = 2 * hstepB;
    const unsigned ldsw = (unsigned)wid * 1024u;
    const int aoff = lds_byte(wr * 64 + fr, fq * 8), boff = lds_byte(wc * 32 + fr, fq * 8);
#define PG8_SA(b, h) (((b) * 2 + (h)) * HTB)
#define PG8_SB(b, h) ((4 + (b) * 2 + (h)) * HTB)
#define PG8_STAGE(bufoff, gbase, voff) do { _Pragma("unroll") for (int _i = 0; _i < 2; ++_i) \
        __builtin_amdgcn_global_load_lds((const unsigned*)((const char*)(gbase) + (voff)[_i]), (PG8_LAS unsigned*)(lds + (bufoff) + ldsw + _i * 8192), 16, 0, 0); } while (0)
#define PG8_LDA(dst, b, h) do { _Pragma("unroll") for (int m = 0; m < 4; ++m) _Pragma("unroll") for (int k = 0; k < 2; ++k) dst[m][k] = *(const PG8_LAS bf16x8*)(lds + PG8_SA(b, h) + aoff + m * 2048 + k * 1024); } while (0)
#define PG8_LDB(dst, b, h) do { _Pragma("unroll") for (int n = 0; n < 2; ++n) _Pragma("unroll") for (int k = 0; k < 2; ++k) dst[n][k] = *(const PG8_LAS bf16x8*)(lds + PG8_SB(b, h) + boff + n * 2048 + k * 1024); } while (0)
#ifndef PG8_PRIO
#define PG8_PRIO 1
#endif
#define PG8_MMA(ai, bj, At, Bt) do { if (PG8_PRIO) __builtin_amdgcn_s_setprio(PG8_PRIO); _Pragma("unroll") for (int m = 0; m < 4; ++m) _Pragma("unroll") for (int n = 0; n < 2; ++n) _Pragma("unroll") for (int k = 0; k < 2; ++k) \
        acc[ai][bj][m][n] = __builtin_amdgcn_mfma_f32_16x16x32_bf16(Bt[n][k], At[m][k], acc[ai][bj][m][n], 0, 0, 0); if (PG8_PRIO) __builtin_amdgcn_s_setprio(0); } while (0)
#define PG8_WAIT_V(n) asm volatile("s_waitcnt vmcnt(" #n ")" ::: "memory")
#define PG8_WAIT_L(n) asm volatile("s_waitcnt lgkmcnt(" #n ")" ::: "memory")
#define PG8_BAR __builtin_amdgcn_s_barrier()
#define PG8_SCHED __builtin_amdgcn_sched_barrier(0)
    Unit cur, nxt; int ui = 0;
    if (!S.next(0, cur)) return;
    f32x4 acc[2][2][4][2];
#pragma unroll
    for (int a = 0; a < 2; ++a)
#pragma unroll
        for (int b = 0; b < 2; ++b)
#pragma unroll
            for (int m = 0; m < 4; ++m)
#pragma unroll
                for (int n = 0; n < 2; ++n) acc[a][b][m][n] = (f32x4){0.f, 0.f, 0.f, 0.f};
    bf16x8 At[4][2], B0[2][2], B1[2][2];
    const char* cA = (const char*)g.A + (size_t)cur.pm * tstepA; const char* cB = (const char*)g.Bt + (size_t)cur.pn * tstepB;
    S.a_ready(cur);
    if constexpr (SP2) {
        PG8_STAGE(PG8_SB(0, 0), PG8_KP(cB, 0), voffB); PG8_STAGE(PG8_SB(0, 1), PG8_KP(cB, 0) + hstepB, voffB); PG8_STAGE(PG8_SA(0, 0), PG8_KP(cA, 0), voffA); PG8_STAGE(PG8_SA(0, 1), PG8_KP(cA, 0) + hstepA, voffA);
        if (wr == 1) PG8_BAR;
        PG8_WAIT_V(2); PG8_BAR;
        PG8_STAGE(PG8_SB(1, 0), PG8_KP(cB, 1), voffB); PG8_STAGE(PG8_SA(1, 0), PG8_KP(cA, 1), voffA); PG8_STAGE(PG8_SB(1, 1), PG8_KP(cB, 1) + hstepB, voffB);
        PG8_WAIT_V(6); PG8_BAR;
    } else {
        PG8_STAGE(PG8_SB(0, 0), cB, voffB); PG8_STAGE(PG8_SA(0, 0), cA, voffA); PG8_STAGE(PG8_SB(0, 1), cB + hstepB, voffB); PG8_STAGE(PG8_SA(0, 1), cA + hstepA, voffA);
        if (wr == 1) PG8_BAR;
        PG8_WAIT_V(4); PG8_BAR;
        PG8_STAGE(PG8_SB(1, 0), cB + kstep, voffB); PG8_STAGE(PG8_SA(1, 0), cA + kstep, voffA); PG8_STAGE(PG8_SB(1, 1), cB + hstepB + kstep, voffB);
        PG8_WAIT_V(6); PG8_BAR;
    }
    for (;;) {
        const bool has_next = S.next(ui + 1, nxt);
        const char* nA = has_next ? (const char*)g.A + (size_t)nxt.pm * tstepA : cA; const char* nB = has_next ? (const char*)g.Bt + (size_t)nxt.pn * tstepB : cB;
        for (int t = 0; t < nt; t += 2) {
            const bool last = (t == nt - 2);
            const char* a1 = PG8_KP(cA, t + 1);
            const char* a2 = last ? PG8_KP(nA, 0) : PG8_KP(cA, t + 2); const char* b2 = last ? PG8_KP(nB, 0) : PG8_KP(cB, t + 2);
            const char* a3 = last ? PG8_KP(nA, 1) : PG8_KP(cA, t + 3); const char* b3 = last ? PG8_KP(nB, 1) : PG8_KP(cB, t + 3);
            if (last && has_next) S.a_ready(nxt);
            if constexpr (Epi::MID) { if (t == (nt >> 1)) E.mid(acc, cur, wr, wc, fr, fq); }
            if constexpr (SP2) {
            PG8_LDB(B0, 0, 0); PG8_LDB(B1, 0, 1); PG8_SCHED; PG8_LDA(At, 0, 0); PG8_STAGE(PG8_SA(1, 1), a1 + hstepA, voffA);
            PG8_WAIT_V(8); PG8_WAIT_L(0); PG8_BAR; PG8_MMA(0, 0, At, B0); PG8_MMA(0, 1, At, B1); PG8_BAR; PG8_SCHED;
            PG8_LDA(At, 0, 1); PG8_STAGE(PG8_SB(0, 0), b2, voffB); PG8_STAGE(PG8_SB(0, 1), b2 + hstepB, voffB); PG8_STAGE(PG8_SA(0, 0), a2, voffA);
            PG8_WAIT_V(8); PG8_WAIT_L(0); PG8_BAR; PG8_MMA(1, 0, At, B0); PG8_MMA(1, 1, At, B1); PG8_BAR; PG8_SCHED;
            PG8_LDB(B0, 1, 0); PG8_LDB(B1, 1, 1); PG8_SCHED; PG8_LDA(At, 1, 0); PG8_STAGE(PG8_SA(0, 1), a2 + hstepA, voffA);
            PG8_WAIT_V(8); PG8_WAIT_L(0); PG8_BAR; PG8_MMA(0, 0, At, B0); PG8_MMA(0, 1, At, B1); PG8_BAR; PG8_SCHED;
            PG8_LDA(At, 1, 1); PG8_STAGE(PG8_SB(1, 0), b3, voffB); PG8_STAGE(PG8_SB(1, 1), b3 + hstepB, voffB); PG8_STAGE(PG8_SA(1, 0), a3, voffA);
            PG8_WAIT_V(8); PG8_WAIT_L(0); PG8_BAR; PG8_MMA(1, 0, At, B0); PG8_MMA(1, 1, At, B1); PG8_BAR; PG8_SCHED;
            } else {
            PG8_LDB(B0, 0, 0); PG8_SCHED; PG8_LDA(At, 0, 0); PG8_STAGE(PG8_SA(1, 1), a1 + hstepA, voffA);
            PG8_WAIT_L(8); PG8_BAR; PG8_WAIT_L(0); PG8_MMA(0, 0, At, B0); PG8_BAR; PG8_SCHED;
            PG8_LDB(B1, 0, 1); PG8_STAGE(PG8_SB(0, 0), b2, voffB);
            PG8_BAR; PG8_WAIT_L(0); PG8_MMA(0, 1, At, B1); PG8_BAR;
            PG8_LDA(At, 0, 1); PG8_STAGE(PG8_SA(0, 0), a2, voffA);
            PG8_BAR; PG8_WAIT_L(0); PG8_MMA(1, 0, At, B0); PG8_BAR; PG8_SCHED;
            PG8_STAGE(PG8_SB(0, 1), b2 + hstepB, voffB);
            PG8_WAIT_V(6); PG8_BAR; PG8_MMA(1, 1, At, B1); PG8_BAR;
            PG8_LDB(B0, 1, 0); PG8_SCHED; PG8_LDA(At, 1, 0); PG8_STAGE(PG8_SA(0, 1), a2 + hstepA, voffA);
            PG8_WAIT_L(8); PG8_BAR; PG8_WAIT_L(0); PG8_MMA(0, 0, At, B0); PG8_BAR; PG8_SCHED;
            PG8_LDB(B1, 1, 1); PG8_STAGE(PG8_SB(1, 0), b3, voffB);
            PG8_BAR; PG8_WAIT_L(0); PG8_MMA(0, 1, At, B1); PG8_BAR;
            PG8_LDA(At, 1, 1); PG8_STAGE(PG8_SA(1, 0), a3, voffA);
            PG8_BAR; PG8_WAIT_L(0); PG8_MMA(1, 0, At, B0); PG8_BAR; PG8_SCHED;
            PG8_STAGE(PG8_SB(1, 1), b3 + hstepB, voffB);
            PG8_WAIT_V(6); PG8_BAR; PG8_MMA(1, 1, At, B1); PG8_BAR;
            }
        }
        if constexpr (ALIGN_EPI) { if (wr == 0) PG8_BAR; }
        if constexpr (!Epi::AFTER_DRAIN) { E(acc, cur, wr, wc, fr, fq); S.done(cur); }
        if (!has_next) break;
#pragma unroll
        for (int a = 0; a < 2; ++a)
#pragma unroll
            for (int b = 0; b < 2; ++b)
#pragma unroll
                for (int m = 0; m < 4; ++m)
#pragma unroll
                    for (int n = 0; n < 2; ++n) acc[a][b][m][n] = (f32x4){0.f, 0.f, 0.f, 0.f};
        cur = nxt; cA = nA; cB = nB; ++ui;
        if constexpr (ALIGN_EPI) { if (wr == 1) PG8_BAR; }
    }
    PG8_WAIT_V(0);
    if constexpr (!ALIGN_EPI) { if (wr == 0) PG8_BAR; }
    PG8_BAR;
    if constexpr (Epi::AFTER_DRAIN) { E.fused(acc, cur, wr, wc, fr, fq, lds, wid, lane); S.done(cur); }
#undef PG8_SA
#undef PG8_KP
#undef PG8_SB
#undef PG8_STAGE
#undef PG8_LDA
#undef PG8_LDB
#undef PG8_MMA
#undef PG8_WAIT_V
#undef PG8_WAIT_L
#undef PG8_BAR
#undef PG8_SCHED
}
}

namespace att {
#define ATT_LAS __attribute__((address_space(3)))
typedef unsigned short bf16_t;
typedef short bf16x8 __attribute__((ext_vector_type(8)));
typedef short s16x4 __attribute__((ext_vector_type(4)));
typedef float f32x16 __attribute__((ext_vector_type(16)));
typedef unsigned u32x4 __attribute__((ext_vector_type(4)));
constexpr int SHM_V = 16384, SHM_K = 16384, SHM_R = 8192, BUFB = SHM_V + SHM_K + SHM_R;
constexpr int LDS_SCR = 2 * BUFB;
constexpr int LDS_FLAGS = LDS_SCR + 8 * 256;
constexpr int LDS_QR = LDS_FLAGS + 64;
constexpr int ATT_LDS_BYTES = LDS_QR + 8 * 4096;
#define KSWZ(row, colB) ((row) * 256 + ((colB) ^ (((row) & 7) << 4)))
#define RSWZ(row, colB) ((row) * 128 + ((colB) ^ ((((row) >> 1) & 7) << 4)))
__device__ __forceinline__ int v_st(int k, int c) { const int kk = (k & ~0xC) | ((k & 4) << 1) | ((k & 8) >> 1); return ((kk >> 3) * 4 + (c >> 5)) * 512 + ((kk & 7) * 32 + (c & 31)) * 2; }
__device__ __forceinline__ int v_rd_base(int lane) { return ((lane & 3) << 3) | (((lane >> 2) & 3) << 6) | (((lane >> 4) & 1) << 5) | (((lane >> 5) & 1) << 8); }
constexpr int v_rd_off(int d0, int ks, int half) { return d0 * 512 + ks * 4096 + half * 2048; }
__device__ __forceinline__ int crow(int r, int hi) { return (r & 3) + 8 * (r >> 2) + 4 * hi; }
__device__ __forceinline__ unsigned cvtpk(float lo, float hi) { unsigned r; asm volatile("v_cvt_pk_bf16_f32 %0, %1, %2" : "=v"(r) : "v"(lo), "v"(hi)); return r; }
#define ATT_SBAR() __builtin_amdgcn_sched_barrier(0)
#ifndef ATT_PRIO
#define ATT_PRIO 0
#endif
#ifndef ATT_EARLYW
#define ATT_EARLYW 0
#endif

template <int ND>
__device__ __forceinline__ void qkt_half(f32x16& p, const ATT_LAS char* Kb, const ATT_LAS char* Rb, int r32, int hi, const bf16x8* qr, const ATT_LAS char* qrl, int lane, int half) {
    bf16x8 kf[8];
#pragma unroll
    for (int d0 = 0; d0 < 8; ++d0) kf[d0] = *(const ATT_LAS bf16x8*)(Kb + KSWZ(r32, ((d0 & 3) * 16 + hi * 8) * 2) + (d0 >> 2) * 128 + half * (32 * 256));
    ATT_SBAR();
    p = f32x16{};
    if constexpr (ND == 12) {
        bf16x8 rf[4], qf[4];
#pragma unroll
        for (int d0 = 0; d0 < 4; ++d0) p = __builtin_amdgcn_mfma_f32_32x32x16_bf16(kf[d0], qr[d0], p, 0, 0, 0);
        ATT_SBAR();
#pragma unroll
        for (int dr = 0; dr < 4; ++dr) { rf[dr] = *(const ATT_LAS bf16x8*)(Rb + RSWZ(r32, (dr * 16 + hi * 8) * 2) + half * (32 * 128)); qf[dr] = *(const ATT_LAS bf16x8*)(qrl + dr * 1024 + lane * 16); }
        ATT_SBAR();
#pragma unroll
        for (int d0 = 4; d0 < 8; ++d0) p = __builtin_amdgcn_mfma_f32_32x32x16_bf16(kf[d0], qr[d0], p, 0, 0, 0);
#pragma unroll
        for (int dr = 0; dr < 4; ++dr) p = __builtin_amdgcn_mfma_f32_32x32x16_bf16(rf[dr], qf[dr], p, 0, 0, 0);
    } else {
#pragma unroll
        for (int d0 = 0; d0 < 8; ++d0) p = __builtin_amdgcn_mfma_f32_32x32x16_bf16(kf[d0], qr[d0], p, 0, 0, 0);
    }
}
__device__ __forceinline__ void pv_tile(f32x16* o, int vb, bf16x8 pa0, bf16x8 pa1, bf16x8 pa2, bf16x8 pa3) {
#define ATT_TRRD(dst, off) asm volatile("ds_read_b64_tr_b16 %0, %1 offset:%2" : "=&v"(dst) : "v"(vb), "i"(off) : "memory")
#define ATT_PV_D0(d0) do { s16x4 l0, l1, l2, l3, h0, h1, h2, h3; constexpr int b_ = v_rd_off(d0, 0, 0); \
        ATT_TRRD(l0, b_); ATT_TRRD(h0, b_ + 2048); ATT_TRRD(l1, b_ + 4096); ATT_TRRD(h1, b_ + 6144); ATT_TRRD(l2, b_ + 8192); ATT_TRRD(h2, b_ + 10240); ATT_TRRD(l3, b_ + 12288); ATT_TRRD(h3, b_ + 14336); \
        asm volatile("s_waitcnt lgkmcnt(0)" ::: "memory"); ATT_SBAR(); \
        o[d0] = __builtin_amdgcn_mfma_f32_32x32x16_bf16(pa0, (bf16x8){l0[0], l0[1], l0[2], l0[3], h0[0], h0[1], h0[2], h0[3]}, o[d0], 0, 0, 0); \
        o[d0] = __builtin_amdgcn_mfma_f32_32x32x16_bf16(pa1, (bf16x8){l1[0], l1[1], l1[2], l1[3], h1[0], h1[1], h1[2], h1[3]}, o[d0], 0, 0, 0); \
        o[d0] = __builtin_amdgcn_mfma_f32_32x32x16_bf16(pa2, (bf16x8){l2[0], l2[1], l2[2], l2[3], h2[0], h2[1], h2[2], h2[3]}, o[d0], 0, 0, 0); \
        o[d0] = __builtin_amdgcn_mfma_f32_32x32x16_bf16(pa3, (bf16x8){l3[0], l3[1], l3[2], l3[3], h3[0], h3[1], h3[2], h3[3]}, o[d0], 0, 0, 0); } while (0)
    if (ATT_PRIO) __builtin_amdgcn_s_setprio(1);
    ATT_PV_D0(0); ATT_PV_D0(1); ATT_PV_D0(2); ATT_PV_D0(3);
    if (ATT_PRIO) __builtin_amdgcn_s_setprio(0);
#undef ATT_PV_D0
#undef ATT_TRRD
}
__device__ __forceinline__ void pack_half(const f32x16& p, bf16x8& pa0, bf16x8& pa1) {
#define ATT_PK4(P, B_, OUT) do { unsigned a0 = cvtpk(P[B_+0], P[B_+1]), a1 = cvtpk(P[B_+2], P[B_+3]); \
        unsigned b0 = cvtpk(P[B_+4], P[B_+5]), b1 = cvtpk(P[B_+6], P[B_+7]); \
        auto r0 = __builtin_amdgcn_permlane32_swap(a0, b0, false, false); auto r1 = __builtin_amdgcn_permlane32_swap(a1, b1, false, false); \
        u32x4 w = {r0[0], r1[0], r0[1], r1[1]}; OUT = __builtin_bit_cast(bf16x8, w); } while (0)
    ATT_PK4(p, 0, pa0); ATT_PK4(p, 8, pa1);
#undef ATT_PK4
}
__device__ __forceinline__ void half_xchg(float x, float& lo, float& hi) {
    unsigned a = __builtin_bit_cast(unsigned, x), b;
    asm volatile("s_nop 1\n\tv_mov_b32 %1, %0\n\ts_nop 1\n\tv_permlane32_swap_b32 %0, %1" : "+v"(a), "=&v"(b));
    lo = __builtin_bit_cast(float, a); hi = __builtin_bit_cast(float, b);
}
__device__ __forceinline__ float half_sum(float v) { float lo, hi; half_xchg(v, lo, hi); return lo + hi; }
__device__ __forceinline__ float half_max(float v) { float lo, hi; half_xchg(v, lo, hi); return fmaxf(lo, hi); }

struct Tensors { const bf16_t* Q; int ldq; const bf16_t* K; int ldk; const bf16_t* V; int ldv; const bf16_t* R; bf16_t* O; int ldo; };

template <int MODE>
__device__ __forceinline__ void attn_unit(const Tensors& T, int qb, float sc2, ATT_LAS char* lds) {
    constexpr int ND = MODE == 1 ? 12 : 8;
    int tid_ = threadIdx.x; asm volatile("" : "+v"(tid_));
    const int tid = tid_, wid = __builtin_amdgcn_readfirstlane(tid >> 6), lane = tid & 63, r32 = lane & 31, hi = lane >> 5;
    const int q0 = qb * 256, qw = q0 + wid * 32;
    const int NT = 4 * (qb + 1);
    const int wlast = 4 * qb + (wid >> 1);
    const int tq = qw + r32;
    ATT_LAS float* scr = (ATT_LAS float*)(lds + LDS_SCR) + wid * 64;
    volatile ATT_LAS unsigned* flags = (volatile ATT_LAS unsigned*)(lds + LDS_FLAGS);
    const ATT_LAS char* qrl = lds + LDS_QR + wid * 4096;
    bf16x8 qr[8];
    { const bf16_t* qp = T.Q + (size_t)tq * T.ldq + hi * 8;
#pragma unroll
      for (int d0 = 0; d0 < 8; ++d0) qr[d0] = *(const bf16x8*)(qp + d0 * 16);
      if constexpr (MODE == 1) {
#pragma unroll
          for (int dr = 0; dr < 4; ++dr) *(ATT_LAS bf16x8*)(lds + LDS_QR + wid * 4096 + dr * 1024 + lane * 16) = *(const bf16x8*)(qp + 128 + dr * 16); } }
    const int sr = tid >> 4, sc = (tid & 15) * 8, kws = KSWZ(sr, sc * 2), vst0 = v_st(sr, sc), vst1 = v_st(32 + sr, sc);
    const int rr_ = tid >> 3, rc = (tid & 7) * 8, rws = RSWZ(rr_, rc * 2);
    bf16x8 sk0, sk1, sv0, sv1, srp;
#define ATT_LOAD(kt) do { const size_t k0_ = (size_t)(kt) * 64; \
        sk0 = *(const bf16x8*)(T.K + (k0_ + sr) * T.ldk + sc); sk1 = *(const bf16x8*)(T.K + (k0_ + 32 + sr) * T.ldk + sc); \
        sv0 = *(const bf16x8*)(T.V + (k0_ + sr) * T.ldv + sc); sv1 = *(const bf16x8*)(T.V + (k0_ + 32 + sr) * T.ldv + sc); \
        if constexpr (MODE == 1) srp = *(const bf16x8*)(T.R + (k0_ + rr_) * 64 + rc); } while (0)
#define ATT_WRITE(bf) do { ATT_LAS char* b_ = lds + (bf) * BUFB; \
        *(ATT_LAS bf16x8*)(b_ + vst0) = sv0; *(ATT_LAS bf16x8*)(b_ + vst1) = sv1; \
        *(ATT_LAS bf16x8*)(b_ + SHM_V + kws) = sk0; *(ATT_LAS bf16x8*)(b_ + SHM_V + kws + 32 * 256) = sk1; \
        if constexpr (MODE == 1) *(ATT_LAS bf16x8*)(b_ + SHM_V + SHM_K + rws) = srp; } while (0)
#define ATT_TILE(it) (MODE == 0 ? (NT - 1 - (it)) : (it))
    f32x16 o[4] = {};
    float carry = 0.f;
    float m_reg = -1e30f, l_reg = 0.f;
    bool dead = false;
    const float hsel = hi ? 0.f : 1.f;
    ATT_LOAD(ATT_TILE(0)); asm volatile("s_waitcnt vmcnt(0)" ::: "memory"); ATT_WRITE(0);
    __syncthreads();
    for (int it = 0; it < NT; ++it) {
        const int cur = it & 1, kt = ATT_TILE(it), kb = kt * 64;
        if (it + 1 < NT) ATT_LOAD(ATT_TILE(it + 1));
        const ATT_LAS char* bufp = lds + cur * BUFB;
        bool staged = false;
        if (kt <= wlast && !dead) {
            f32x16 p0, p1;
            bf16x8 pa0, pa1, pa2, pa3;
            if constexpr (MODE == 0) {
                const bool diag = (kb + 63 >= qw);
                qkt_half<ND>(p1, bufp + SHM_V, bufp + SHM_V + SHM_K, r32, hi, qr, qrl, lane, 1);
                qkt_half<ND>(p0, bufp + SHM_V, bufp + SHM_V + SHM_K, r32, hi, qr, qrl, lane, 0);
                float tsum = carry;
#define ATT_SB_HALF(P, KOFF) do { f32x16 f; \
                    _Pragma("unroll") for (int r = 0; r < 16; ++r) { P[r] *= sc2; \
                        f[r] = fminf(-P[r], 0.f) - __builtin_amdgcn_logf(1.0f + __builtin_amdgcn_exp2f(-__builtin_fabsf(P[r]))); } \
                    if (diag) { _Pragma("unroll") for (int r = 0; r < 16; ++r) { if (kb + (KOFF) + crow(r, hi) >= tq) f[r] = 0.f; } } \
                    float gs_[4], oh_[4], ps_[4]; \
                    _Pragma("unroll") for (int i = 0; i < 4; ++i) { f[4*i+2] += f[4*i+3]; f[4*i+1] += f[4*i+2]; f[4*i] += f[4*i+1]; gs_[i] = f[4*i]; } \
                    _Pragma("unroll") for (int i = 0; i < 4; ++i) { float lo_; half_xchg(gs_[i], lo_, oh_[i]); ps_[i] = lo_ + oh_[i]; } \
                    _Pragma("unroll") for (int i = 3; i >= 0; --i) { const float Tg = tsum + hsel * oh_[i]; \
                        _Pragma("unroll") for (int e = 0; e < 4; ++e) P[4*i+e] = __builtin_amdgcn_exp2f(P[4*i+e] + f[4*i+e] + Tg); \
                        tsum += ps_[i]; } \
                    if (diag) { _Pragma("unroll") for (int r = 0; r < 16; ++r) { if (kb + (KOFF) + crow(r, hi) >= tq) P[r] = 0.f; } } } while (0)
                ATT_SB_HALF(p1, 32);
                pack_half(p1, pa2, pa3);
                ATT_SB_HALF(p0, 0);
                pack_half(p0, pa0, pa1);
#undef ATT_SB_HALF
                carry = tsum;
                pv_tile(o, (int)(uintptr_t)(bufp) + v_rd_base(lane), pa0, pa1, pa2, pa3);
                if (__all(carry < -140.f)) dead = true;
            } else {
                qkt_half<ND>(p0, bufp + SHM_V, bufp + SHM_V + SHM_K, r32, hi, qr, qrl, lane, 0);
                qkt_half<ND>(p1, bufp + SHM_V, bufp + SHM_V + SHM_K, r32, hi, qr, qrl, lane, 1);
                float pmax = p0[0];
#pragma unroll
                for (int r = 1; r < 16; ++r) pmax = fmaxf(pmax, p0[r]);
#pragma unroll
                for (int r = 0; r < 16; ++r) pmax = fmaxf(pmax, p1[r]);
                pmax = half_max(pmax);
                const float mn = fmaxf(m_reg, pmax), alpha = __builtin_amdgcn_exp2f((m_reg - mn) * sc2); m_reg = mn;
                const float mnL = -mn * sc2;
                float psum = 0.f;
#pragma unroll
                for (int r = 0; r < 16; ++r) { p0[r] = __builtin_amdgcn_exp2f(fmaf(p0[r], sc2, mnL)); psum += p0[r]; }
                pack_half(p0, pa0, pa1);
#pragma unroll
                for (int r = 0; r < 16; ++r) { p1[r] = __builtin_amdgcn_exp2f(fmaf(p1[r], sc2, mnL)); psum += p1[r]; }
                pack_half(p1, pa2, pa3);
                l_reg = l_reg * alpha + half_sum(psum);
                if (__any(alpha < 1.f))
                { if (hi == 0) scr[r32] = alpha; asm volatile("s_waitcnt lgkmcnt(0)" ::: "memory");
#pragma unroll
                    for (int r = 0; r < 16; ++r) { const float a = scr[crow(r, hi)];
#pragma unroll
                        for (int d = 0; d < 4; ++d) o[d][r] *= a; } }
#if ATT_EARLYW
                if (it + 1 < NT) { asm volatile("s_waitcnt vmcnt(0)" ::: "memory"); ATT_WRITE(cur ^ 1); staged = true; }
#endif
                pv_tile(o, (int)(uintptr_t)(bufp) + v_rd_base(lane), pa0, pa1, pa2, pa3);
            }
        }
        if (it + 1 < NT && !staged) { asm volatile("s_waitcnt vmcnt(0)" ::: "memory"); ATT_WRITE(cur ^ 1); }
        if constexpr (MODE == 0) { if (lane == 0) flags[cur * 8 + wid] = dead ? 1u : 0u; }
        __syncthreads();
        if constexpr (MODE == 0) {
            unsigned alld = 1u;
#pragma unroll
            for (int w = 0; w < 8; ++w) alld &= flags[cur * 8 + w];
            if (alld) break;
        }
    }
    if constexpr (MODE == 1) { if (hi == 0) scr[32 + r32] = l_reg; asm volatile("s_waitcnt lgkmcnt(0)" ::: "memory"); }
    bf16_t* Ow = T.O + (size_t)qw * T.ldo;
    int obase = 4 * hi * T.ldo + r32; asm volatile("" : "+v"(obase));
#pragma unroll
    for (int r = 0; r < 16; ++r) { const int orow = crow(r, hi);
        float rl = 1.f; if constexpr (MODE == 1) rl = __builtin_amdgcn_rcpf(scr[32 + orow]);
        int ro = obase + ((r & 3) + 8 * (r >> 2)) * T.ldo; asm volatile("" : "+v"(ro));
#pragma unroll
        for (int d0 = 0; d0 < 4; ++d0) { const float v = o[d0][r] * rl; const float vn = __shfl_xor(v, 1);
            if ((r32 & 1) == 0) *(unsigned*)(Ow + ro + d0 * 32) = cvtpk(v, vn); } }
    __syncthreads();
#undef ATT_LOAD
#undef ATT_WRITE
#undef ATT_TILE
}
}

constexpr int BATCH = 2, SEQ = 4096, D = 4096, M = BATCH * SEQ, DEPTH = 2;
constexpr int SBW = 2048, QRANK = 1024, KVRANK = 512, ROPE = 64, DFF = 16384;
constexpr int IN_W = 3 * SBW + QRANK + KVRANK + ROPE + 2 * D;
constexpr int C_QD = 3 * SBW, C_KVD = C_QD + QRANK, C_GATE_SRC = C_KVD + KVRANK + ROPE;
constexpr int C_GSB = 7936, C_GMLA = C_GSB + D, PROJ_W = C_GMLA + D;
constexpr int QW = 16 * 192, KVW = 16 * 256;
constexpr float EPS = 1e-6f;
static_assert(IN_W == 15936 && PROJ_W == 16128 && PROJ_W % 256 == 0 && C_GSB % 256 == 0, "projection layout");

constexpr size_t MiB = 1u << 20;
constexpr size_t WS_CTL = 0, CTL_ZERO_BYTES = 1 * MiB;
constexpr size_t WS_ADA = 1 * MiB;
constexpr size_t WS_TAB = 2 * MiB;
constexpr size_t WS_ADAP = 4 * MiB;
constexpr size_t WS_W = 32 * MiB;
constexpr size_t W_IN = 0, W_UQ = 126 * MiB, W_UKV = 132 * MiB, W_OSB = 136 * MiB, W_OMLA = 152 * MiB, W_OUT = 168 * MiB, W_UP = 200 * MiB, W_DOWN = 328 * MiB, W_LAYER = 456 * MiB;
constexpr size_t WS_ACT = WS_W + DEPTH * W_LAYER;
constexpr size_t A_H = WS_ACT, A_PROJ = A_H + 64 * MiB, A_CQ = A_PROJ + 252 * MiB, A_CKV = A_CQ + 16 * MiB, A_KR = A_CKV + 8 * MiB, A_Q = A_KR + 1 * MiB, A_KV = A_Q + 48 * MiB,
                 A_OSB = A_KV + 64 * MiB, A_OMLA = A_OSB + 32 * MiB, A_TMP = A_OMLA + 32 * MiB, A_MRG = A_TMP + 128 * MiB, A_Y = A_MRG + 64 * MiB, A_U = A_Y + 128 * MiB, WS_END = A_U + 256 * MiB;
static_assert((size_t)PROJ_W * D * 2 == 126 * MiB && (size_t)M * PROJ_W * 2 == 252 * MiB, "sizes");
constexpr int CW_TMO = 0;
constexpr int CW_BAR = 4096;

constexpr int RING_BYTES = 135168;
constexpr int LDSCTL_OFF = RING_BYTES, MISC_OFF = LDSCTL_OFF + 320;
constexpr int LDS_BYTES = RING_BYTES + 1024;
constexpr int NWAVES = 8;
static_assert(att::ATT_LDS_BYTES <= RING_BYTES && pg8::STAGE_BYTES <= RING_BYTES, "LDS map");

#define GAS __attribute__((address_space(1)))
#define LAS __attribute__((address_space(3)))
typedef unsigned short bf16;
typedef unsigned v4u __attribute__((ext_vector_type(4)));
typedef unsigned v2u __attribute__((ext_vector_type(2)));
typedef float f32x4 __attribute__((ext_vector_type(4)));
typedef GAS unsigned gu32;
#define RLX_AGENT __ATOMIC_RELAXED, __HIP_MEMORY_SCOPE_AGENT
#ifndef USE_NT
#define USE_NT 0
#endif
#if USE_NT
#define NT_LD(p) __builtin_nontemporal_load(p)
#else
#define NT_LD(p) (*(p))
#endif
#define LDS_WAIT() asm volatile("s_waitcnt lgkmcnt(0)" ::: "memory")
#define VM_WAIT() asm volatile("s_waitcnt vmcnt(0)" ::: "memory")
__device__ __forceinline__ unsigned pk2(float lo, float hi) { return pg8::cvt_pk_bf16(lo, hi); }
__device__ __forceinline__ float bflo(unsigned w) { return __builtin_bit_cast(float, w << 16); }
__device__ __forceinline__ float bfhi(unsigned w) { return __builtin_bit_cast(float, w & 0xffff0000u); }

#define XB_TMO      128
#define XB_XCNT(j)  (256  + 64 * (j))
#define XB_XSUB(j)  (1280 + 64 * (j))
#define XB_XGEN(j)  (2304 + 64 * (j))
#define XB_TOP      3328
#define XB_TOPGEN   3392
#define XCD_BAR_WORDS 3456
#define XB_SPIN_CAP (1u << 21)

__device__ __forceinline__ unsigned xb_ld(unsigned* p)              { return __hip_atomic_load(p, __ATOMIC_RELAXED, __HIP_MEMORY_SCOPE_AGENT); }
__device__ __forceinline__ unsigned xb_add(unsigned* p, unsigned v) { return __hip_atomic_fetch_add(p, v, __ATOMIC_RELAXED, __HIP_MEMORY_SCOPE_AGENT); }
__device__ __forceinline__ unsigned xb_xcc_id() { return (unsigned)__builtin_amdgcn_s_getreg((3 << 11) | 20) & 0xFu; }
#define XB_SPIN(cond, bar) do { unsigned _sp = 0; while (cond) { __builtin_amdgcn_s_sleep(1); \
    if ((++_sp & 255u) == 0u) { if (xb_ld(&(bar)[XB_TMO])) break; if (_sp > XB_SPIN_CAP) { atomicAdd(&(bar)[XB_TMO], 1u); break; } } } } while (0)

struct XcdBarrier {
    unsigned* bar; unsigned x;
    volatile LAS unsigned* st;
};

__device__ __forceinline__ XcdBarrier xcd_barrier_post(unsigned* bar, volatile LAS unsigned* st) {
    XcdBarrier b; b.bar = bar; b.x = xb_xcc_id(); b.st = st;
    if (threadIdx.x == 0) (void)xb_add(&bar[XB_XCNT(b.x)], 1u);
    return b;
}
__device__ __forceinline__ void xcd_barrier_complete(unsigned* bar, unsigned x, unsigned& nloc, unsigned& nx) {
    const unsigned G = gridDim.x * gridDim.y * gridDim.z;
    unsigned sum, cnt, mine, sp = 0u;
    for (;;) {
        sum = 0u; cnt = 0u; mine = 0u;
#pragma unroll
        for (unsigned j = 0; j < 16; ++j) { const unsigned c = xb_ld(&bar[XB_XCNT(j)]); sum += c; cnt += (c > 0u) ? 1u : 0u; mine = (j == x) ? c : mine; }
        if (sum == G) break;
        __builtin_amdgcn_s_sleep(1);
        if ((++sp & 255u) == 0u) { if (xb_ld(&bar[XB_TMO])) break; if (sp > XB_SPIN_CAP) { atomicAdd(&bar[XB_TMO], 1u); break; } }
    }
    nloc = mine > 0u ? mine : 1u; nx = cnt > 0u ? cnt : 1u;
}

__device__ __forceinline__ void xcd_barrier(const XcdBarrier& b) {
    asm volatile("s_waitcnt vmcnt(0)" ::: "memory");
    __syncthreads();
    if (threadIdx.x == 0) {
        unsigned* bar = b.bar; unsigned bx_ = b.x; asm volatile("" : "+s"(bar), "+s"(bx_));
        __builtin_amdgcn_s_waitcnt(0);
        unsigned nloc = b.st[0], nx = b.st[1];
        if (nloc == 0u) { xcd_barrier_complete(bar, bx_, nloc, nx); b.st[0] = nloc; b.st[1] = nx; }
        const unsigned old = xb_add(&bar[XB_XSUB(bx_)], 1u);
        const unsigned gen = old / nloc;
        if (old + 1u == (gen + 1u) * nloc) {
            __builtin_amdgcn_fence(__ATOMIC_RELEASE, "agent");
            asm volatile("s_waitcnt vmcnt(0)" ::: "memory");
            const unsigned og = xb_add(&bar[XB_TOP], 1u);
            const unsigned tg = og / nx;
            if (og + 1u == (tg + 1u) * nx) xb_add(&bar[XB_TOPGEN], 1u);
            else XB_SPIN(xb_ld(&bar[XB_TOPGEN]) == tg, bar);
            __builtin_amdgcn_fence(__ATOMIC_ACQUIRE, "agent");
            xb_add(&bar[XB_XGEN(bx_)], 1u);
            asm volatile("s_waitcnt vmcnt(0)" ::: "memory");
        } else {
            XB_SPIN(xb_ld(&bar[XB_XGEN(bx_)]) == gen, bar);
            __builtin_amdgcn_fence(__ATOMIC_ACQUIRE, "agent");
            asm volatile("s_waitcnt vmcnt(0)" ::: "memory");
        }
    }
    __syncthreads();
}


struct Frame {
    LAS unsigned char* lds;
    int tid, lane, wave, G, gw, NGW;
};
__device__ __forceinline__ float wave_sum(float v) {
#pragma unroll
    for (int o = 1; o < 64; o <<= 1) v += __shfl_xor(v, o);
    return v;
}

__device__ __forceinline__ void transpose_item(const float* W, int N, bf16* WT, int ldt, int kb, int nb, int rowbase, bool ropeperm, LAS float* scr, int lane, const float* kscale = nullptr) {
    const int k0 = 64 * kb, n0 = 64 * nb;
    const float* src = W + (size_t)(k0 + (lane >> 4)) * N + n0 + 4 * (lane & 15);
#pragma unroll 4
    for (int i = 0; i < 16; ++i) { const f32x4 v = NT_LD((const f32x4*)(src + (size_t)(4 * i) * N)); LAS float* d = scr + (4 * i + (lane >> 4)) * 65 + 4 * (lane & 15);
        d[0] = v[0]; d[1] = v[1]; d[2] = v[2]; d[3] = v[3]; }
    LDS_WAIT(); asm volatile("" ::: "memory");
    const int c = lane & 7;
    f32x4 ks0 = {1.f, 1.f, 1.f, 1.f}, ks1 = ks0;
    if (kscale) { ks0 = *(const f32x4*)(kscale + k0 + 8 * c); ks1 = *(const f32x4*)(kscale + k0 + 8 * c + 4); }
#pragma unroll
    for (int j = 0; j < 8; ++j) { const int nn = (lane >> 3) + 8 * j; const LAS float* s = scr + (8 * c) * 65 + nn;
        v4u o; o.x = pk2(s[0 * 65] * ks0[0], s[1 * 65] * ks0[1]); o.y = pk2(s[2 * 65] * ks0[2], s[3 * 65] * ks0[3]); o.z = pk2(s[4 * 65] * ks1[0], s[5 * 65] * ks1[1]); o.w = pk2(s[6 * 65] * ks1[2], s[7 * 65] * ks1[3]);
        const int orow = rowbase + (ropeperm ? (2 * (nn & 31) + (nn >> 5)) : nn);
        *(GAS v4u*)(WT + (size_t)orow * ldt + k0 + 8 * c) = o; }
    LDS_WAIT(); asm volatile("" ::: "memory");
}

__device__ __forceinline__ void norm_mod_row(const f32x4 (&v)[16], float ssq, const float* g, const float* scv, const float* shv, bf16* orow, int lane) {
    const float r = 1.0f / sqrtf(ssq * (1.0f / D) + EPS);
#pragma unroll
    for (int j = 0; j < 16; ++j) { int c = 4 * lane + 256 * j; asm volatile("" : "+v"(c));
        const f32x4 gg = *(const f32x4*)(g + c), ss = *(const f32x4*)(scv + c), hh = *(const f32x4*)(shv + c);
        f32x4 o;
#pragma unroll
        for (int e = 0; e < 4; ++e) o[e] = v[j][e] * r * gg[e] * (1.0f + ss[e]) + hh[e];
        v2u w; w.x = pk2(o[0], o[1]); w.y = pk2(o[2], o[3]);
        *(GAS v2u*)(orow + c) = w; }
}


template <bool HAS_Y, bool HAS_H, bool XIN_BF = false, bool XOUT_BF = false>
__device__ __forceinline__ void thin_phase(Frame& F, const void* xin_, void* xout_, const bf16* Yb, bf16* Hout,
                                           const float* gpost, const float* gate0, const float* gpre, const float* sc0, const float* sh0) {
    LAS float* cA1 = (LAS float*)F.lds; LAS float* cA2 = cA1 + D; LAS float* cB2 = cA2 + D;
    for (int chunk = blockIdx.x; chunk < M / 32; chunk += F.G) {
        int tid = F.tid; asm volatile("" : "+v"(tid));
        const int b = (chunk * 32) / SEQ;
        __syncthreads();
#pragma unroll
        for (int i = 0; i < 2; ++i) { const int c = 4 * tid + 2048 * i;
            if constexpr (HAS_Y) { const f32x4 g = *(const f32x4*)(gpost + c), t = *(const f32x4*)(gate0 + (size_t)b * 6 * D + c); *(LAS f32x4*)(cA1 + c) = g * t; }
            if constexpr (HAS_H) { const f32x4 g = *(const f32x4*)(gpre + c), s = *(const f32x4*)(sc0 + (size_t)b * 6 * D + c), h = *(const f32x4*)(sh0 + (size_t)b * 6 * D + c);
                *(LAS f32x4*)(cA2 + c) = g * (s + 1.0f); *(LAS f32x4*)(cB2 + c) = h; } }
        __syncthreads();
        const int LN = tid & 63;
#pragma unroll 1
        for (int i = 0; i < 4; ++i) {
            const size_t m = (size_t)chunk * 32 + F.wave * 4 + i;
            v4u yv[8]; f32x4 xv[16];
#pragma unroll
            for (int j = 0; j < 8; ++j) { const int c = 8 * LN + 512 * j;
                if constexpr (HAS_Y) yv[j] = *(const GAS v4u*)(Yb + m * D + c);
                if constexpr (XIN_BF) { const v4u xb = *(const GAS v4u*)((const bf16*)xin_ + m * D + c);
                    xv[2 * j] = (f32x4){bflo(xb.x), bfhi(xb.x), bflo(xb.y), bfhi(xb.y)}; xv[2 * j + 1] = (f32x4){bflo(xb.z), bfhi(xb.z), bflo(xb.w), bfhi(xb.w)}; }
                else { xv[2 * j] = *(const f32x4*)((const float*)xin_ + m * D + c); xv[2 * j + 1] = *(const f32x4*)((const float*)xin_ + m * D + c + 4); } }
            float ssq2 = 0.f;
            if constexpr (HAS_Y) {
                float ssq = 0.f;
#pragma unroll
                for (int j = 0; j < 8; ++j) { const unsigned w[4] = {yv[j].x, yv[j].y, yv[j].z, yv[j].w};
#pragma unroll
                    for (int q = 0; q < 4; ++q) { const float a = bflo(w[q]), c2 = bfhi(w[q]); ssq += a * a + c2 * c2; } }
                ssq = wave_sum(ssq); const float r = 1.0f / sqrtf(ssq * (1.0f / D) + EPS);
#pragma unroll
                for (int j = 0; j < 8; ++j) { const int c = 8 * LN + 512 * j; const unsigned w[4] = {yv[j].x, yv[j].y, yv[j].z, yv[j].w};
                    const f32x4 a0 = *(const LAS f32x4*)(cA1 + c), a1 = *(const LAS f32x4*)(cA1 + c + 4);
                    f32x4 y0 = {bflo(w[0]), bfhi(w[0]), bflo(w[1]), bfhi(w[1])}, y1 = {bflo(w[2]), bfhi(w[2]), bflo(w[3]), bfhi(w[3])};
                    xv[2 * j] = xv[2 * j] + a0 * (y0 * r); xv[2 * j + 1] = xv[2 * j + 1] + a1 * (y1 * r);
                    if constexpr (XOUT_BF) { v4u xw; xw.x = pk2(xv[2 * j][0], xv[2 * j][1]); xw.y = pk2(xv[2 * j][2], xv[2 * j][3]); xw.z = pk2(xv[2 * j + 1][0], xv[2 * j + 1][1]); xw.w = pk2(xv[2 * j + 1][2], xv[2 * j + 1][3]);
                        *(GAS v4u*)((bf16*)xout_ + m * D + c) = xw; }
                    else { *(f32x4*)((float*)xout_ + m * D + c) = xv[2 * j]; *(f32x4*)((float*)xout_ + m * D + c + 4) = xv[2 * j + 1]; } } }
            if constexpr (HAS_H) {
#pragma unroll
                for (int j = 0; j < 16; ++j) ssq2 += (xv[j][0] * xv[j][0] + xv[j][1] * xv[j][1]) + (xv[j][2] * xv[j][2] + xv[j][3] * xv[j][3]);
                ssq2 = wave_sum(ssq2); const float r2 = 1.0f / sqrtf(ssq2 * (1.0f / D) + EPS);
#pragma unroll
                for (int j = 0; j < 8; ++j) { const int c = 8 * LN + 512 * j;
                    const f32x4 a0 = *(const LAS f32x4*)(cA2 + c), a1 = *(const LAS f32x4*)(cA2 + c + 4), b0 = *(const LAS f32x4*)(cB2 + c), b1 = *(const LAS f32x4*)(cB2 + c + 4);
                    const f32x4 h0 = (xv[2 * j] * r2) * a0 + b0, h1 = (xv[2 * j + 1] * r2) * a1 + b1;
                    v4u w; w.x = pk2(h0[0], h0[1]); w.y = pk2(h0[2], h0[3]); w.z = pk2(h1[0], h1[1]); w.w = pk2(h1[2], h1[3]);
                    *(GAS v4u*)(Hout + m * D + c) = w; } }
        }
    }
    __syncthreads();
}

__device__ __forceinline__ int gate_row(int j) { const int which = j / D, oc = j % D; return C_GSB + 256 * (oc / 128) + 128 * which + (oc % 128); }
constexpr int NB_IN = IN_W / 64, I_IN = (D / 64) * NB_IN, I_UQ = (QRANK / 64) * (QW / 64), I_UKV = (KVRANK / 64) * (KVW / 64), I_OSB = (SBW / 64) * (D / 64), I_OMLA = I_OSB,
              I_OUT = (D / 64) * (D / 64), I_UP = (D / 64) * (DFF / 64), I_DOWN = (DFF / 64) * (D / 64), I_LAYER = I_IN + I_UQ + I_UKV + I_OSB + I_OMLA + I_OUT + I_UP + I_DOWN;
#define CONVERT_ITEMS(lo, hi, start, stride) do { int cl_ = F.lane; asm volatile("" : "+v"(cl_));     \
        for (int it = (lo) + (start); it < (hi); it += (stride)) { \
            const int l = it / I_LAYER; int r = it % I_LAYER; \
            if (r < I_IN) { const int kb = r / NB_IN, nb = r % NB_IN, n0 = nb * 64; transpose_item(KIN(I_WIN) + (size_t)l * D * IN_W, IN_W, (bf16*)(wl + W_IN), D, kb, nb, n0 < C_GATE_SRC ? n0 : gate_row(n0 - C_GATE_SRC), n0 == C_KVD + KVRANK  , scr, cl_); continue; } r -= I_IN; \
            if (r < I_UQ) { const int kb = r / (QW / 64), nb = r % (QW / 64); transpose_item(KIN(I_WUQ) + (size_t)l * QRANK * QW, QW, (bf16*)(wl + W_UQ), QRANK, kb, nb, nb * 64, (nb % 3) == 2, scr, cl_, KIN(I_GQ) + (size_t)l * QRANK); continue; } r -= I_UQ; \
            if (r < I_UKV) { const int kb = r / (KVW / 64), nb = r % (KVW / 64); transpose_item(KIN(I_WUKV) + (size_t)l * KVRANK * KVW, KVW, (bf16*)(wl + W_UKV), KVRANK, kb, nb, nb * 64, false, scr, cl_, KIN(I_GKV) + (size_t)l * KVRANK); continue; } r -= I_UKV; \
            if (r < I_OSB) { const int kb = r / (D / 64), nb = r % (D / 64); transpose_item(KIN(I_WOSB) + (size_t)l * SBW * D, D, (bf16*)(wl + W_OSB), 2 * SBW, kb, nb, nb * 64, false, scr, cl_); continue; } r -= I_OSB; \
            if (r < I_OMLA) { const int kb = r / (D / 64), nb = r % (D / 64); transpose_item(KIN(I_WOMLA) + (size_t)l * SBW * D, D, (bf16*)(wl + W_OSB) + SBW, 2 * SBW, kb, nb, nb * 64, false, scr, cl_); continue; } r -= I_OMLA; \
            if (r < I_OUT) { const int kb = r / (D / 64), nb = r % (D / 64); transpose_item(KIN(I_WOUT) + (size_t)l * D * D, D, (bf16*)(wl + W_OUT), D, kb, nb, nb * 64, false, scr, cl_); continue; } r -= I_OUT; \
            if (r < I_UP) { const int kb = r / (DFF / 64), nb = r % (DFF / 64); transpose_item(KIN(I_WUP) + (size_t)l * D * DFF, DFF, (bf16*)(wl + W_UP), D, kb, nb, nb * 64, false, scr, cl_); continue; } r -= I_UP; \
            { const int kb = r / (D / 64), nb = r % (D / 64); transpose_item(KIN(I_WDOWN) + (size_t)l * DFF * D, D, (bf16*)(wl + W_DOWN), DFF, kb, nb, nb * 64, false, scr, cl_); } \
        } } while (0)

#ifndef XRES_BF16
#define XRES_BF16 1
#endif
#ifndef PG8_SP2
#define PG8_SP2 true
#endif
#ifndef PG8_ALIGN
#define PG8_ALIGN true
#endif
#ifndef PG8_ALIGN_P1
#define PG8_ALIGN_P1 PG8_ALIGN
#endif
#ifndef PH_MASK
#define PH_MASK 0xFFFFFFFFu
#endif
#define PH(k) ((PH_MASK >> (k)) & 1u)
struct Args { const float* in[19]; float* out; unsigned char* ws; };
enum { I_X = 0, I_C, I_POS, I_WADA, I_BADA, I_GPREMIX, I_GPOSTMIX, I_GPREMLP, I_GPOSTMLP, I_WIN, I_GQ, I_WUQ, I_GKV, I_WUKV, I_WOSB, I_WOMLA, I_WOUT, I_WUP, I_WDOWN };

typedef __attribute__((address_space(4))) const unsigned char* kargp_t;
__device__ __forceinline__ __attribute__((address_space(1))) unsigned char* lw_(unsigned char* p) { __attribute__((address_space(1))) unsigned char* q = (__attribute__((address_space(1))) unsigned char*)p; asm volatile("" : "+s"(q)); return q; }
__device__ __forceinline__ kargp_t lwk_() { kargp_t p = (kargp_t)__builtin_amdgcn_kernarg_segment_ptr(); asm volatile("" : "+s"(p)); return p; }
#define KIN(k) ((const float*)(*(const __attribute__((address_space(1))) float* const __attribute__((address_space(4)))*)(lwk_() + 8 * (k))))
__global__ void __launch_bounds__(NWAVES * 64, 2) hybrid_fwd(Args args) {
    extern __shared__ __attribute__((aligned(16))) unsigned char lds_raw[];
    Frame F;
    F.lds = (LAS unsigned char*)lds_raw;
    F.tid = threadIdx.x; F.lane = F.tid & 63; F.wave = __builtin_amdgcn_readfirstlane(F.tid >> 6);
    F.G = gridDim.x; F.gw = blockIdx.x * NWAVES + F.wave; F.NGW = F.G * NWAVES;
    unsigned char* ws = args.ws;
    gu32* ctl = (gu32*)(ws + WS_CTL);
    for (int u = F.tid; u < (LDS_BYTES - LDSCTL_OFF) / 4; u += NWAVES * 64) ((LAS unsigned*)(F.lds + LDSCTL_OFF))[u] = 0u;
    __syncthreads();
    XcdBarrier bar = xcd_barrier_post((unsigned*)(ctl + CW_BAR), (volatile LAS unsigned*)(F.lds + MISC_OFF) + 8);
#define GRID_BAR() xcd_barrier(bar)

#define ada ((float*)(lw_(ws) + WS_ADA))
#define tab ((float*)(lw_(ws) + WS_TAB))
#define adap ((float*)(lw_(ws) + WS_ADAP))
#define Hb ((bf16*)(lw_(ws) + A_H))
#define PROJ ((bf16*)(lw_(ws) + A_PROJ))
#define SSQ ((float*)(lw_(ws) + A_CQ))
#define KR ((bf16*)(lw_(ws) + A_KR))
#define QF ((bf16*)(lw_(ws) + A_Q))
#define KVF ((bf16*)(lw_(ws) + A_KV))
#define OSB ((bf16*)(lw_(ws) + A_OSB))
#define MRG ((bf16*)(lw_(ws) + A_MRG))
#define Yb ((bf16*)(lw_(ws) + A_Y))
#define XB ((bf16*)(lw_(ws) + A_TMP))
#define U ((bf16*)(lw_(ws) + A_U))
#define GRB (lw_(ws) + A_TMP + 64 * MiB)
#define GSB (lw_(ws) + A_Y + 64 * MiB)
#define x_in KIN(I_X)
#define wl (lw_(ws) + WS_W + (size_t)l * W_LAYER)
#define adl (ada + (size_t)l * BATCH * 6 * D)
    float* xo = args.out;


    if (PH(0)) {
        LAS float* cact = (LAS float*)F.lds;
        for (int i = F.tid; i < BATCH * D; i += NWAVES * 64) { const float cv = KIN(I_C)[i]; cact[i] = cv / (1.0f + __expf(-cv)); }
        __syncthreads();
        for (int task = blockIdx.x; task < DEPTH * 32 * 12; task += F.G) {
            const int l = task / (32 * 12), s = (task / 12) % 32, cb = task % 12;
            const int col = cb * 2048 + F.tid * 4;
            const float* wp = KIN(I_WADA) + ((size_t)l * D + s * 128) * (6 * D) + col;
            f32x4 a0 = {0.f, 0.f, 0.f, 0.f}, a1 = {0.f, 0.f, 0.f, 0.f};
#pragma unroll 8
            for (int k = 0; k < 128; ++k) { const f32x4 w = NT_LD((const f32x4*)(wp + (size_t)k * (6 * D))); const float c0 = cact[s * 128 + k], c1 = cact[D + s * 128 + k];
                a0 += w * c0; a1 += w * c1; }
            *(f32x4*)(adap + (((size_t)s * DEPTH + l) * BATCH + 0) * (6 * D) + col) = a0;
            *(f32x4*)(adap + (((size_t)s * DEPTH + l) * BATCH + 1) * (6 * D) + col) = a1;
        }
        __syncthreads();
        for (int e = blockIdx.x * (NWAVES * 64) + F.tid; e < M * 32; e += F.G * NWAVES * 64) {
            const int m = e >> 5, i = e & 31;
            const float inv = powf(10000.0f, -(float)i / 32.0f);
            const float ang = (float)(((const int*)KIN(I_POS))[m]) * inv;
            const double rev = (double)ang * 0.15915494309189533577; const float fr = (float)(rev - rint(rev));
            tab[2 * e] = __builtin_amdgcn_cosf(fr); tab[2 * e + 1] = __builtin_amdgcn_sinf(fr);
        }
        for (int l = 0; l < DEPTH; ++l) { v4u* z = (v4u*)(ws + WS_W + l * W_LAYER + W_IN + (size_t)C_GATE_SRC * D * 2);
            for (int i = blockIdx.x * (NWAVES * 64) + F.tid; i < 192 * D * 2 / 16; i += F.G * NWAVES * 64) z[i] = (v4u){0u, 0u, 0u, 0u}; }
        LAS float* scr = (LAS float*)(F.lds) + F.wave * (64 * 65);
        CONVERT_ITEMS(0, DEPTH * I_LAYER, F.gw, F.NGW);
    }
    GRID_BAR();
    if (PH(1)) for (int e = blockIdx.x * (NWAVES * 64) + F.tid; e < DEPTH * BATCH * 6 * D; e += F.G * NWAVES * 64) {
        const int l = e / (BATCH * 6 * D), n = e % (6 * D);
        float s = KIN(I_BADA)[(size_t)l * 6 * D + n];
#pragma unroll 8
        for (int k = 0; k < 32; ++k) s += adap[(size_t)k * (DEPTH * BATCH * 6 * D) + e];
        ada[e] = s;
    }
    GRID_BAR();
    if (PH(2)) thin_phase<false, true>(F, x_in, nullptr, nullptr, Hb, nullptr, nullptr, KIN(I_GPREMIX), ada + D, ada);
    GRID_BAR();

    for (int l = 0; l < DEPTH; ++l) {
        if (PH(3)) { pg8::Gemm g{Hb, (const bf16*)(wl + W_IN), M, PROJ_W, D}; pg8::StaticOrder S; S.init(M, PROJ_W, F.G, (int)blockIdx.x);
          pg8::EpiProj E{PROJ, PROJ_W, SSQ, KR, tab, (pg8::u32x4*)GRB, (pg8::u32x4*)GSB};
          pg8::gemm_phase<pg8::EpiProj, pg8::StaticOrder, PG8_ALIGN_P1, PG8_SP2>(F.lds, g, S, E); }
        GRID_BAR();
#ifndef P3_REP
#define P3_REP 1
#endif
#pragma unroll 1
        for (int rep3 = 0; rep3 < P3_REP; ++rep3) {
        if (PH(5)) { pg8::Gemm g{PROJ + C_QD, (const bf16*)(wl + W_UQ), M, QW, QRANK, PROJ_W}; pg8::StaticOrder S; S.init(M, QW, F.G, (int)blockIdx.x);
          pg8::EpiRope E{QF, QW, tab, SSQ};
          pg8::gemm_phase<pg8::EpiRope, pg8::StaticOrder, PG8_ALIGN, PG8_SP2>(F.lds, g, S, E); }
        if (PH(5)) { pg8::Gemm g{PROJ + C_KVD, (const bf16*)(wl + W_UKV), M, KVW, KVRANK, PROJ_W}; pg8::EpiScale E{KVF, KVW, SSQ};
          if (F.G == 256) { pg8::UnevenOrder S; S.init(M, KVW, F.G, (int)blockIdx.x);
            pg8::gemm_phase<pg8::EpiScale, pg8::UnevenOrder, PG8_ALIGN, PG8_SP2>(F.lds, g, S, E); }
          else { pg8::StaticOrder S; S.init(M, KVW, F.G, (int)blockIdx.x);
            pg8::gemm_phase<pg8::EpiScale, pg8::StaticOrder, PG8_ALIGN, PG8_SP2>(F.lds, g, S, E); } }
        }
        GRID_BAR();
        if (PH(6)) for (int item = blockIdx.x; item < 512; item += F.G) {
            const int kind = item >> 8, c = item & 255, bh = (c & 7) * 4 + ((c >> 3) >> 3), y = (c >> 3) & 7, b = bh >> 4, h = bh & 15;
            const size_t rb = (size_t)b * SEQ;
            if (kind == 0) { if (PH(14)) {
                att::Tensors T{PROJ + rb * PROJ_W + h * 128, PROJ_W, PROJ + rb * PROJ_W + SBW + h * 128, PROJ_W, PROJ + rb * PROJ_W + 2 * SBW + h * 128, PROJ_W, nullptr, OSB + rb * (2 * SBW) + h * 128, 2 * SBW};
                att::attn_unit<0>(T, 15 - y, 0.08838834764831845f * 1.4426950408889634f, (LAS char*)F.lds);
                att::attn_unit<0>(T, y, 0.08838834764831845f * 1.4426950408889634f, (LAS char*)F.lds); }
            } else if (PH(15)) {
                att::Tensors T{QF + rb * QW + h * 192, QW, KVF + rb * KVW + h * 256, KVW, KVF + rb * KVW + h * 256 + 128, KVW, KR + rb * ROPE, OSB + rb * (2 * SBW) + SBW + h * 128, 2 * SBW};
                att::attn_unit<1>(T, 15 - y, 0.07216878364870323f * 1.4426950408889634f, (LAS char*)F.lds);
                att::attn_unit<1>(T, y, 0.07216878364870323f * 1.4426950408889634f, (LAS char*)F.lds);
            }
        }
        GRID_BAR();
#ifndef P5_REP
#define P5_REP 1
#endif
#pragma unroll 1
        for (int rep5 = 0; rep5 < P5_REP; ++rep5)
        if (PH(7)) { pg8::Gemm g{OSB, (const bf16*)(wl + W_OSB), M, D, 2 * SBW}; pg8::StaticOrder S; S.init(M, D, F.G, (int)blockIdx.x);
          pg8::EpiGateMerge E{MRG, D, (const pg8::u32x4*)GRB, (const pg8::u32x4*)GSB};
          pg8::gemm_phase<pg8::EpiGateMerge, pg8::StaticOrder, PG8_ALIGN, PG8_SP2>(F.lds, g, S, E); }
        GRID_BAR();
#ifndef P7_REP
#define P7_REP 1
#endif
#pragma unroll 1
        for (int rep7 = 0; rep7 < P7_REP; ++rep7) {
#ifdef P7_REPB
        if (rep7) GRID_BAR();
#endif
#ifdef P7_MREP
        if (PH(9)) { pg8::Gemm g{MRG, (const bf16*)(wl + W_OUT), M, D, D}; pg8::RepOrder S; S.init(M, D, F.G, (int)blockIdx.x); S.reps = P7_MREP;
          pg8::EpiBf16<0> E{Yb, D};
          pg8::gemm_phase<pg8::EpiBf16<0>, pg8::RepOrder, PG8_ALIGN, PG8_SP2>(F.lds, g, S, E); }
#else
        if (PH(9)) { pg8::Gemm g{MRG, (const bf16*)(wl + W_OUT), M, D, D}; pg8::StaticOrder S; S.init(M, D, F.G, (int)blockIdx.x);
          pg8::EpiBf16<0> E{Yb, D};
          pg8::gemm_phase<pg8::EpiBf16<0>, pg8::StaticOrder, PG8_ALIGN, PG8_SP2>(F.lds, g, S, E); }
#endif
        }
        GRID_BAR();
#if XRES_BF16
        if (PH(10)) { if (l == 0) thin_phase<true, true, false, true>(F, x_in, XB, Yb, Hb, KIN(I_GPOSTMIX) + (size_t)l * D, adl + 2 * D, KIN(I_GPREMLP) + (size_t)l * D, adl + 4 * D, adl + 3 * D);
            else thin_phase<true, true, true, true>(F, XB, XB, Yb, Hb, KIN(I_GPOSTMIX) + (size_t)l * D, adl + 2 * D, KIN(I_GPREMLP) + (size_t)l * D, adl + 4 * D, adl + 3 * D); }
#else
        if (PH(10)) thin_phase<true, true>(F, l == 0 ? x_in : (const float*)xo, xo, Yb, Hb, KIN(I_GPOSTMIX) + (size_t)l * D, adl + 2 * D, KIN(I_GPREMLP) + (size_t)l * D, adl + 4 * D, adl + 3 * D);
#endif
        GRID_BAR();
        if (PH(11)) { pg8::Gemm g{Hb, (const bf16*)(wl + W_UP), M, DFF, D}; pg8::StaticOrder S; S.init(M, DFF, F.G, (int)blockIdx.x);
          pg8::EpiBf16<1> E{U, DFF};
          pg8::gemm_phase<pg8::EpiBf16<1>, pg8::StaticOrder, PG8_ALIGN, PG8_SP2>(F.lds, g, S, E); }
        GRID_BAR();
        if (PH(12)) { pg8::Gemm g{U, (const bf16*)(wl + W_DOWN), M, D, DFF}; pg8::StaticOrder S; S.init(M, D, F.G, (int)blockIdx.x);
          pg8::EpiBf16<0> E{Yb, D};
          pg8::gemm_phase<pg8::EpiBf16<0>, pg8::StaticOrder, PG8_ALIGN, PG8_SP2>(F.lds, g, S, E); }
        GRID_BAR();
#if XRES_BF16
        if (PH(13)) { if (l + 1 < DEPTH) { const float* adn = ada + (size_t)(l + 1) * BATCH * 6 * D;
                thin_phase<true, true, true, true>(F, XB, XB, Yb, Hb, KIN(I_GPOSTMLP) + (size_t)l * D, adl + 5 * D, KIN(I_GPREMIX) + (size_t)(l + 1) * D, adn + D, adn); }
            else thin_phase<true, false, true, false>(F, XB, xo, Yb, nullptr, KIN(I_GPOSTMLP) + (size_t)l * D, adl + 5 * D, nullptr, nullptr, nullptr); }
#else
        if (PH(13)) { if (l + 1 < DEPTH) { const float* adn = ada + (size_t)(l + 1) * BATCH * 6 * D;
                thin_phase<true, true>(F, xo, xo, Yb, Hb, KIN(I_GPOSTMLP) + (size_t)l * D, adl + 5 * D, KIN(I_GPREMIX) + (size_t)(l + 1) * D, adn + D, adn); }
            else thin_phase<true, false>(F, xo, xo, Yb, nullptr, KIN(I_GPOSTMLP) + (size_t)l * D, adl + 5 * D, nullptr, nullptr, nullptr); }
#endif
        if (l + 1 < DEPTH) GRID_BAR();
    }
    if (blockIdx.x == 0 && F.tid == 0 && __hip_atomic_load((unsigned*)(ctl + CW_BAR) + XB_TMO, RLX_AGENT) != 0u) xo[0] = __builtin_nanf("");
}
#undef ada
#undef tab
#undef adap
#undef Hb
#undef PROJ
#undef SSQ
#undef KR
#undef QF
#undef KVF
#undef OSB
#undef MRG
#undef Yb
#undef XB
#undef U
#undef GRB
#undef GSB
#undef x_in
#undef wl
#undef adl


extern "C" void kernel_launch(void* const* d_in, const int* in_sizes, int n_in, void* d_out, int out_size, void* d_ws, size_t ws_size, hipStream_t stream) {
    static int grid = 0;
    if (grid == 0) {
        if (n_in != 19 || out_size != M * D || ws_size < WS_END) { fprintf(stderr, "kernel_launch: unexpected shapes (n_in %d, out %d, ws %zu < %zu)\n", n_in, out_size, ws_size, (size_t)WS_END); grid = -1; return; }
        int dev = 0, cus = 0, per_cu = 0;
        if (hipGetDevice(&dev) != hipSuccess || hipDeviceGetAttribute(&cus, hipDeviceAttributeMultiprocessorCount, dev) != hipSuccess) { grid = -1; return; }
        if (hipFuncSetAttribute((const void*)hybrid_fwd, hipFuncAttributeMaxDynamicSharedMemorySize, LDS_BYTES) != hipSuccess) { fprintf(stderr, "kernel_launch: hipFuncSetAttribute failed\n"); grid = -1; return; }
        if (hipOccupancyMaxActiveBlocksPerMultiprocessor(&per_cu, (const void*)hybrid_fwd, NWAVES * 64, LDS_BYTES) != hipSuccess || per_cu < 1) { fprintf(stderr, "kernel_launch: occupancy query says %d\n", per_cu); (void)hipGetLastError(); }
        grid = cus;
    }
    if (grid < 0) return;
    if (hipMemsetAsync((char*)d_ws + WS_CTL, 0, CTL_ZERO_BYTES, stream) != hipSuccess) return;
    Args a{};
    for (int i = 0; i < 19; ++i) a.in[i] = (const float*)d_in[i];
    a.out = (float*)d_out; a.ws = (unsigned char*)d_ws;
    hipLaunchKernelGGL(hybrid_fwd, dim3(grid), dim3(NWAVES * 64), LDS_BYTES, stream, a);
#ifdef DBG_CHECK
    hipLaunchKernelGGL(dbg_check, dim3(DBG_NCHK), dim3(256), 0, stream, a, (unsigned*)((char*)d_ws + 4096));
    hipLaunchKernelGGL(dbg_report, dim3(1), dim3(64), 0, stream, (float*)d_out, (const unsigned*)((char*)d_ws + 4096));
#endif
}
```

```cpp
#include <hip/hip_runtime.h>
#include <cstdio>
#include <cstdint>
#include <cmath>
#ifndef PG8_WGM
#define PG8_WGM 8
#endif
namespace pg8 {
#define PG8_LAS __attribute__((address_space(3)))
typedef unsigned short bf16_t;
typedef short bf16x8 __attribute__((ext_vector_type(8)));
typedef float f32x4 __attribute__((ext_vector_type(4)));
typedef unsigned u32x4 __attribute__((ext_vector_type(4)));
constexpr int BM = 256, BK = 64, HALF = 128, HTB = HALF * BK * 2  , STAGE_BYTES = 8 * HTB, NXCD = 8, WGM = PG8_WGM;

__host__ __device__ __forceinline__ int lds_byte(int r, int c) { const int st = (r >> 4) * 2 + (c >> 5), rr = r & 15, cc = c & 31, ob = rr * 64 + cc * 2; return st * 1024 + (ob ^ (((ob >> 9) & 1) << 5)); }
__host__ __device__ __forceinline__ void stage_rc(int b, int& R, int& C) { const int st = b / 1024, sb = b % 1024, swz = sb ^ (((sb >> 9) & 1) << 5); R = (st >> 1) * 16 + swz / 64; C = (st & 1) * 32 + (swz % 64) / 2; }
__host__ __device__ __forceinline__ int perm32(int rho) { const int n = rho >> 4, i = rho & 15; return 8 * (i >> 2) + 4 * n + (i & 3); }

struct Unit { int pm, pn; };
struct Gemm { const bf16_t* A; const bf16_t* Bt; int M, N, K; int lda = 0; };

struct StaticOrder {
    int nM, nN, nwg, G, c;
    __host__ __device__ void init(int M, int N, int G_, int c_) { nM = M / BM; nN = N / BM; nwg = nM * nN; G = G_; c = c_; }
    __host__ __device__ bool next(int i, Unit& u) const {
        const long L = (long)i * G + c; if (L >= nwg) return false;
        int wgid = (int)L; { const int q = nwg / NXCD, r = nwg % NXCD, xcd = wgid % NXCD, off = wgid / NXCD; wgid = (xcd < r ? xcd * (q + 1) : r * (q + 1) + (xcd - r) * q) + off; }
        const int nig = WGM * nN, gid = wgid / nig, fm = gid * WGM, gsz = (nM - fm) < WGM ? (nM - fm) : WGM;
        u.pm = fm + ((wgid % nig) % gsz); u.pn = (wgid % nig) / gsz; return true;
    }
    __device__ __forceinline__ void a_ready(const Unit&) const {}
    __device__ __forceinline__ void done(const Unit&) const {}
};

struct UnevenOrder : StaticOrder {
    __host__ __device__ bool next(int i, Unit& u) const {
        long L; const int h = G / 2;
        if (c < h) { if (i > 0) return false; L = c; } else { if (i > 2) return false; L = h + (long)h * i + (c - h); }
        if (L >= nwg) return false;
        int wgid = (int)L; { const int q = nwg / NXCD, r = nwg % NXCD, xcd = wgid % NXCD, off = wgid / NXCD; wgid = (xcd < r ? xcd * (q + 1) : r * (q + 1) + (xcd - r) * q) + off; }
        const int nig = WGM * nN, gid = wgid / nig, fm = gid * WGM, gsz = (nM - fm) < WGM ? (nM - fm) : WGM;
        u.pm = fm + ((wgid % nig) % gsz); u.pn = (wgid % nig) / gsz; return true;
    }
};

struct RepOrder : StaticOrder {
    int reps;
    __host__ __device__ bool next(int i, Unit& u) const { const int per = (nwg + G - 1) / G; if (i >= per * reps) return false; return StaticOrder::next(i % per, u); }
};
__device__ __forceinline__ unsigned cvt_pk_bf16(float lo, float hi) { unsigned r; asm volatile("v_cvt_pk_bf16_f32 %0, %1, %2" : "=v"(r) : "v"(lo), "v"(hi)); return r; }
typedef float f32x2 __attribute__((ext_vector_type(2)));

__device__ __forceinline__ float bf_lo(unsigned w) { return __builtin_bit_cast(float, w << 16); }
__device__ __forceinline__ float bf_hi(unsigned w) { return __builtin_bit_cast(float, w & 0xffff0000u); }
__device__ __forceinline__ float sigmoidf_fast(float x) { return __builtin_amdgcn_rcpf(1.0f + __builtin_amdgcn_exp2f(-1.4426950408889634f * x)); }

#ifndef EPI_WT
#define EPI_WT 0
#endif
__device__ __forceinline__ void st16_out(bf16_t* p, u32x4 w) {
#if EPI_WT
    asm volatile("global_store_dwordx4 %0, %1, off sc1" :: "v"((__attribute__((address_space(1))) u32x4*)p), "v"(w) : "memory");
#else
    *(u32x4*)p = w;
#endif
}
template <int ACT  > struct EpiBf16 {
    static constexpr bool PERM = true, AFTER_DRAIN = false, MID = false;
    bf16_t* O; int ldc;
    __device__ __forceinline__ void operator()(const f32x4 (&acc)[2][2][4][2], const Unit& u, int wr, int wc, int fr, int fq) const {
        const int row0 = u.pm * BM + wr * 64 + fr, col0 = u.pn * BM + wc * 32 + 8 * fq;
#pragma unroll
        for (int ai = 0; ai < 2; ++ai)
#pragma unroll
            for (int m = 0; m < 4; ++m) { bf16_t* rowp = O + (size_t)(row0 + ai * HALF + m * 16) * ldc + col0;
#pragma unroll
                for (int bj = 0; bj < 2; ++bj) { f32x4 v0 = acc[ai][bj][m][0], v1 = acc[ai][bj][m][1];
                    if (ACT == 1) {
#pragma unroll
                        for (int j = 0; j < 4; ++j) { const float a = fmaxf(v0[j], 0.f), b = fmaxf(v1[j], 0.f); v0[j] = a * a; v1[j] = b * b; } }
                    u32x4 w; w.x = cvt_pk_bf16(v0[0], v0[1]); w.y = cvt_pk_bf16(v0[2], v0[3]); w.z = cvt_pk_bf16(v1[0], v1[1]); w.w = cvt_pk_bf16(v1[2], v1[3]);
                    st16_out(rowp + bj * HALF, w);
                    } }
    }
};
struct EpiProj {
    static constexpr bool PERM = true, AFTER_DRAIN = false, MID = false;
    static constexpr int SSQ_T0 = 24, ROPE_T = 30, GATE_T0 = 31;
    bf16_t* O; int ldc; float* SSQ; bf16_t* KRo; const float* tab; u32x4* GR; u32x4* GS;
    __device__ __forceinline__ void operator()(const f32x4 (&acc)[2][2][4][2], const Unit& u, int wr, int wc, int fr, int fq) const {
        const int row0 = u.pm * BM + wr * 64 + fr, col0 = u.pn * BM + wc * 32 + 8 * fq;
        const bool do_ssq = (u.pn >= SSQ_T0) && (u.pn < SSQ_T0 + 6), do_rope = (u.pn == ROPE_T) && (wc < 2);
        if (u.pn >= GATE_T0) {
            const int t = u.pn - GATE_T0; const size_t e0 = ((size_t)((u.pm * 16 + (t >> 1)) * 16 + (t & 1))) * 512 + (size_t)((wr * 4 + wc) * 64 + fr + 16 * fq);
#pragma unroll
            for (int ai = 0; ai < 2; ++ai)
#pragma unroll
                for (int m = 0; m < 4; ++m) { float r[8], sg[8];
#pragma unroll
                    for (int n = 0; n < 2; ++n)
#pragma unroll
                        for (int j = 0; j < 4; ++j) { const float e1 = __builtin_amdgcn_exp2f(-1.4426950408889634f * acc[ai][0][m][n][j]), e2 = __builtin_amdgcn_exp2f(-1.4426950408889634f * acc[ai][1][m][n][j]);
                            sg[4 * n + j] = __builtin_amdgcn_rcpf(1.0f + e2); r[4 * n + j] = (1.0f + e2) * __builtin_amdgcn_rcpf(1.0f + e1); }
                    u32x4 rw, sw; rw.x = cvt_pk_bf16(r[0], r[1]); rw.y = cvt_pk_bf16(r[2], r[3]); rw.z = cvt_pk_bf16(r[4], r[5]); rw.w = cvt_pk_bf16(r[6], r[7]);
                    sw.x = cvt_pk_bf16(sg[0], sg[1]); sw.y = cvt_pk_bf16(sg[2], sg[3]); sw.z = cvt_pk_bf16(sg[4], sg[5]); sw.w = cvt_pk_bf16(sg[6], sg[7]);
                    GR[e0 + (size_t)(ai * 8 + m * 2) * 512] = rw; GS[e0 + (size_t)(ai * 8 + m * 2) * 512] = sw; }
            return;
        }
#pragma unroll
        for (int ai = 0; ai < 2; ++ai)
#pragma unroll
            for (int m = 0; m < 4; ++m) { const int row = row0 + ai * HALF + m * 16; bf16_t* rowp = O + (size_t)row * ldc + col0;
                float ss = 0.f;
#pragma unroll
                for (int bj = 0; bj < 2; ++bj) { const f32x4 v0 = acc[ai][bj][m][0], v1 = acc[ai][bj][m][1];
                    u32x4 w; w.x = cvt_pk_bf16(v0[0], v0[1]); w.y = cvt_pk_bf16(v0[2], v0[3]); w.z = cvt_pk_bf16(v1[0], v1[1]); w.w = cvt_pk_bf16(v1[2], v1[3]);
                    st16_out(rowp + bj * HALF, w);
                    if (do_ssq) { const unsigned ww[4] = {w.x, w.y, w.z, w.w};
#pragma unroll
                        for (int q = 0; q < 4; ++q) { const float a = bf_lo(ww[q]), b = bf_hi(ww[q]); ss += a * a + b * b; } }
                    if (bj == 0 && do_rope) { const int co = wc * 32 + 8 * fq; const float* tp = tab + (size_t)row * 64 + co;
                        const f32x4 t0 = *(const f32x4*)tp, t1 = *(const f32x4*)(tp + 4);
                        f32x4 r0, r1;
                        r0[0] = v0[0] * t0[0] - v0[1] * t0[1]; r0[1] = v0[1] * t0[0] + v0[0] * t0[1];
                        r0[2] = v0[2] * t0[2] - v0[3] * t0[3]; r0[3] = v0[3] * t0[2] + v0[2] * t0[3];
                        r1[0] = v1[0] * t1[0] - v1[1] * t1[1]; r1[1] = v1[1] * t1[0] + v1[0] * t1[1];
                        r1[2] = v1[2] * t1[2] - v1[3] * t1[3]; r1[3] = v1[3] * t1[2] + v1[2] * t1[3];
                        u32x4 k; k.x = cvt_pk_bf16(r0[0], r0[1]); k.y = cvt_pk_bf16(r0[2], r0[3]); k.z = cvt_pk_bf16(r1[0], r1[1]); k.w = cvt_pk_bf16(r1[2], r1[3]);
                        *(u32x4*)(KRo + (size_t)row * 64 + co) = k; } }
                if (do_ssq) { ss += __shfl_xor(ss, 16); ss += __shfl_xor(ss, 32);
                    if (fq == 0) SSQ[(size_t)row * 32 + 4 * (u.pn - SSQ_T0) + wc] = ss; } }
    }
};
template <int S0, int NS> __device__ __forceinline__ void row_rms_scales(float (&rs)[2][4], const float* SSQ, int row0, int fq, float inv_dim) {
    float part[2][4];
#pragma unroll
    for (int ai = 0; ai < 2; ++ai)
#pragma unroll
        for (int m = 0; m < 4; ++m) { const float* p = SSQ + (size_t)(row0 + ai * HALF + m * 16) * 32 + S0 + (NS / 4) * fq;
            if constexpr (NS == 16) { const f32x4 v = *(const f32x4*)p; part[ai][m] = (v[0] + v[1]) + (v[2] + v[3]); }
            else { const f32x2 v = *(const f32x2*)p; part[ai][m] = v[0] + v[1]; } }
#pragma unroll
    for (int ai = 0; ai < 2; ++ai)
#pragma unroll
        for (int m = 0; m < 4; ++m) { float t = part[ai][m]; t += __shfl_xor(t, 16); t += __shfl_xor(t, 32); rs[ai][m] = 1.0f / sqrtf(t * inv_dim + 1e-6f); }
}
struct EpiScale {
    static constexpr bool PERM = true, AFTER_DRAIN = false, MID = false;
    bf16_t* O; int ldc; const float* SSQ;
    __device__ __forceinline__ void operator()(const f32x4 (&acc)[2][2][4][2], const Unit& u, int wr, int wc, int fr, int fq) const {
        const int row0 = u.pm * BM + wr * 64 + fr, col0 = u.pn * BM + wc * 32 + 8 * fq;
        float rs[2][4]; row_rms_scales<16, 8>(rs, SSQ, row0, fq, 1.0f / 512.0f);
#pragma unroll
        for (int ai = 0; ai < 2; ++ai)
#pragma unroll
            for (int m = 0; m < 4; ++m) { bf16_t* rowp = O + (size_t)(row0 + ai * HALF + m * 16) * ldc + col0; const float r = rs[ai][m];
#pragma unroll
                for (int bj = 0; bj < 2; ++bj) { const f32x4 v0 = acc[ai][bj][m][0] * r, v1 = acc[ai][bj][m][1] * r;
                    u32x4 w; w.x = cvt_pk_bf16(v0[0], v0[1]); w.y = cvt_pk_bf16(v0[2], v0[3]); w.z = cvt_pk_bf16(v1[0], v1[1]); w.w = cvt_pk_bf16(v1[2], v1[3]);
                    st16_out(rowp + bj * HALF, w); } }
    }
};
struct EpiRope {
    static constexpr bool PERM = true, AFTER_DRAIN = false, MID = false;
    bf16_t* O; int ldc; const float* tab; const float* SSQ;
    __device__ __forceinline__ void operator()(const f32x4 (&acc)[2][2][4][2], const Unit& u, int wr, int wc, int fr, int fq) const {
        const int row0 = u.pm * BM + wr * 64 + fr, col0 = u.pn * BM + wc * 32 + 8 * fq;
        float rs[2][4]; row_rms_scales<0, 16>(rs, SSQ, row0, fq, 1.0f / 1024.0f);
        const int j0 = col0 % 192, j1 = (col0 + HALF) % 192, rbj = (j0 >= 128) ? 0 : (j1 >= 128) ? 1 : -1, jr = (rbj == 0 ? j0 : j1) - 128;
#pragma unroll
        for (int ai = 0; ai < 2; ++ai) {
            f32x4 t0[4], t1[4];
            if (rbj >= 0) {
#pragma unroll
                for (int m = 0; m < 4; ++m) { const float* tp = tab + (size_t)(row0 + ai * HALF + m * 16) * 64 + jr;
                    t0[m] = *(const f32x4*)tp; t1[m] = *(const f32x4*)(tp + 4); }
            }
#pragma unroll
            for (int m = 0; m < 4; ++m) { const int row = row0 + ai * HALF + m * 16; bf16_t* rowp = O + (size_t)row * ldc + col0;
#pragma unroll
                for (int bj = 0; bj < 2; ++bj) { f32x4 v0 = acc[ai][bj][m][0] * rs[ai][m], v1 = acc[ai][bj][m][1] * rs[ai][m];
                    if (bj == rbj) { const f32x4 a0 = t0[m], a1 = t1[m];
                        f32x4 r0, r1;
                        r0[0] = v0[0] * a0[0] - v0[1] * a0[1]; r0[1] = v0[1] * a0[0] + v0[0] * a0[1];
                        r0[2] = v0[2] * a0[2] - v0[3] * a0[3]; r0[3] = v0[3] * a0[2] + v0[2] * a0[3];
                        r1[0] = v1[0] * a1[0] - v1[1] * a1[1]; r1[1] = v1[1] * a1[0] + v1[0] * a1[1];
                        r1[2] = v1[2] * a1[2] - v1[3] * a1[3]; r1[3] = v1[3] * a1[2] + v1[2] * a1[3];
                        v0 = r0; v1 = r1; }
                    u32x4 w; w.x = cvt_pk_bf16(v0[0], v0[1]); w.y = cvt_pk_bf16(v0[2], v0[3]); w.z = cvt_pk_bf16(v1[0], v1[1]); w.w = cvt_pk_bf16(v1[2], v1[3]);
                    st16_out(rowp + bj * HALF, w); } }
            asm volatile("" ::: "memory"); }
    }
};
struct EpiGateMerge {
    static constexpr bool PERM = true, AFTER_DRAIN = false, MID = true;
    bf16_t* O; int ldo; const u32x4* GR; const u32x4* GS;
    __device__ __forceinline__ void mid(f32x4 (&acc)[2][2][4][2], const Unit& u, int wr, int wc, int fr, int fq) const {
        int fr_ = fr, fq_ = fq; asm volatile("" : "+v"(fr_), "+v"(fq_));
        const u32x4* p = GR + (size_t)((u.pm * 16 + u.pn) * 16) * 512 + (size_t)((wr * 4 + wc) * 64 + fr_ + 16 * fq_);
        u32x4 g[2][4][2];
#pragma unroll
        for (int ai = 0; ai < 2; ++ai)
#pragma unroll
            for (int m = 0; m < 4; ++m)
#pragma unroll
                for (int bj = 0; bj < 2; ++bj) g[ai][m][bj] = p[(ai * 8 + m * 2 + bj) * 512];
#pragma unroll
        for (int ai = 0; ai < 2; ++ai)
#pragma unroll
            for (int m = 0; m < 4; ++m)
#pragma unroll
                for (int bj = 0; bj < 2; ++bj) { const u32x4 a = g[ai][m][bj]; const unsigned aw[4] = {a.x, a.y, a.z, a.w};
#pragma unroll
                    for (int q = 0; q < 4; ++q) { acc[ai][bj][m][q >> 1][2 * (q & 1)] *= bf_lo(aw[q]); acc[ai][bj][m][q >> 1][2 * (q & 1) + 1] *= bf_hi(aw[q]); } }
    }
    __device__ __forceinline__ void operator()(const f32x4 (&acc)[2][2][4][2], const Unit& u, int wr, int wc, int fr, int fq) const {
        const int row0 = u.pm * BM + wr * 64 + fr, col0 = u.pn * BM + wc * 32 + 8 * fq;
        const u32x4* p = GS + (size_t)((u.pm * 16 + u.pn) * 16) * 512 + (size_t)((wr * 4 + wc) * 64 + fr + 16 * fq);
        u32x4 g[2][4][2];
#pragma unroll
        for (int ai = 0; ai < 2; ++ai)
#pragma unroll
            for (int m = 0; m < 4; ++m)
#pragma unroll
                for (int bj = 0; bj < 2; ++bj) g[ai][m][bj] = p[(ai * 8 + m * 2 + bj) * 512];
#pragma unroll
        for (int ai = 0; ai < 2; ++ai)
#pragma unroll
            for (int m = 0; m < 4; ++m) { bf16_t* op = O + (size_t)(row0 + ai * HALF + m * 16) * ldo + col0;
#pragma unroll
                for (int bj = 0; bj < 2; ++bj) { const f32x4 v0 = acc[ai][bj][m][0], v1 = acc[ai][bj][m][1]; const u32x4 s = g[ai][m][bj];
                    u32x4 w; w.x = cvt_pk_bf16(v0[0] * bf_lo(s.x), v0[1] * bf_hi(s.x)); w.y = cvt_pk_bf16(v0[2] * bf_lo(s.y), v0[3] * bf_hi(s.y));
                    w.z = cvt_pk_bf16(v1[0] * bf_lo(s.z), v1[1] * bf_hi(s.z)); w.w = cvt_pk_bf16(v1[2] * bf_lo(s.w), v1[3] * bf_hi(s.w));
                    st16_out(op + bj * HALF, w); } }
    }
};

template <class Epi, class Sched, bool ALIGN_EPI = false, bool SP2 = false>
__device__ __forceinline__ void gemm_phase(PG8_LAS unsigned char* lds, const Gemm g, const Sched& S, const Epi& E) {
    int tid_ = threadIdx.x; asm volatile("" : "+v"(tid_));
    const int tid = tid_, wid = __builtin_amdgcn_readfirstlane(tid >> 6), lane = tid & 63, wr = wid >> 2, wc = wid & 3, fr = lane & 15, fq = lane >> 4;
    const int K = g.K, nt = K / BK, lda = g.lda ? g.lda : K;
#ifndef PG8_KROT
#define PG8_KROT 0
#endif
#if PG8_KROT
    const int ktm = nt - 1, kt0 = Epi::MID ? 0 : ((int)((blockIdx.x & 7u) * (unsigned)(nt >> 3)) * PG8_KROT) & ktm;
#define PG8_KP(base, t) ((base) + (size_t)(((t) + kt0) & ktm) * kstep)
#define PG8_KPB(base, t) ((base) + (size_t)(((t) + kt0) & ktm) * kstepB)
#else
#define PG8_KP(base, t) ((base) + (size_t)(t) * kstep)
#define PG8_KPB(base, t) ((base) + (size_t)(t) * kstepB)
#endif
    unsigned voffA[2], voffB[2];
#pragma unroll
    for (int i = 0; i < 2; ++i) { int R, C; stage_rc(tid * 16 + i * 8192, R, C); const int Rb = Epi::PERM ? ((R & ~31) + perm32(R & 31)) : R;
        voffA[i] = (unsigned)(R * lda + C) * 2u; voffB[i] = (unsigned)(Rb * BK + C) * 2u; }
    const size_t kstep = (size_t)(BK * 2);
    const size_t kstepB = (size_t)g.N * (BK * 2);
    const size_t hstepA = (size_t)HALF * lda * 2, hstepB = (size_t)HALF * BK * 2;
    const size_t tstepA = 2 * hstepA, tstepB = 2 * hstepB;
    const unsigned ldsw = (unsigned)wid * 1024u;
    const int aoff = lds_byte(wr * 64 + fr, fq * 8), boff = lds_byte(wc * 32 + fr, fq * 8);
#define PG8_SA(b, h) (((b) * 2 + (h)) * HTB)
#define PG8_SB(b, h) ((4 + (b) * 2 + (h)) * HTB)
#define PG8_STAGE(bufoff, gbase, voff) do { _Pragma("unroll") for (int _i = 0; _i < 2; ++_i) \
        __builtin_amdgcn_global_load_lds((const unsigned*)((const char*)(gbase) + (voff)[_i]), (PG8_LAS unsigned*)(lds + (bufoff) + ldsw + _i * 8192), 16, 0, 0); } while (0)
#define PG8_LDA(dst, b, h) do { _Pragma("unroll") for (int m = 0; m < 4; ++m) _Pragma("unroll") for (int k = 0; k < 2; ++k) dst[m][k] = *(const PG8_LAS bf16x8*)(lds + PG8_SA(b, h) + aoff + m * 2048 + k * 1024); } while (0)
#define PG8_LDB(dst, b, h) do { _Pragma("unroll") for (int n = 0; n < 2; ++n) _Pragma("unroll") for (int k = 0; k < 2; ++k) dst[n][k] = *(const PG8_LAS bf16x8*)(lds + PG8_SB(b, h) + boff + n * 2048 + k * 1024); } while (0)
#ifndef PG8_PRIO
#define PG8_PRIO 1
#endif
#define PG8_MMA(ai, bj, At, Bt) do { if (PG8_PRIO) __builtin_amdgcn_s_setprio(PG8_PRIO); _Pragma("unroll") for (int m = 0; m < 4; ++m) _Pragma("unroll") for (int n = 0; n < 2; ++n) _Pragma("unroll") for (int k = 0; k < 2; ++k) \
        acc[ai][bj][m][n] = __builtin_amdgcn_mfma_f32_16x16x32_bf16(Bt[n][k], At[m][k], acc[ai][bj][m][n], 0, 0, 0); if (PG8_PRIO) __builtin_amdgcn_s_setprio(0); } while (0)
#define PG8_WAIT_V(n) asm volatile("s_waitcnt vmcnt(" #n ")" ::: "memory")
#define PG8_WAIT_L(n) asm volatile("s_waitcnt lgkmcnt(" #n ")" ::: "memory")
#define PG8_BAR __builtin_amdgcn_s_barrier()
#define PG8_SCHED __builtin_amdgcn_sched_barrier(0)
    Unit cur, nxt; int ui = 0;
    if (!S.next(0, cur)) return;
    f32x4 acc[2][2][4][2];
#pragma unroll
    for (int a = 0; a < 2; ++a)
#pragma unroll
        for (int b = 0; b < 2; ++b)
#pragma unroll
            for (int m = 0; m < 4; ++m)
#pragma unroll
                for (int n = 0; n < 2; ++n) acc[a][b][m][n] = (f32x4){0.f, 0.f, 0.f, 0.f};
    bf16x8 At[4][2], B0[2][2], B1[2][2];
    const char* cA = (const char*)g.A + (size_t)cur.pm * tstepA; const char* cB = (const char*)g.Bt + (size_t)cur.pn * tstepB;
    S.a_ready(cur);
    if constexpr (SP2) {
        PG8_STAGE(PG8_SB(0, 0), PG8_KPB(cB, 0), voffB); PG8_STAGE(PG8_SB(0, 1), PG8_KPB(cB, 0) + hstepB, voffB); PG8_STAGE(PG8_SA(0, 0), PG8_KP(cA, 0), voffA); PG8_STAGE(PG8_SA(0, 1), PG8_KP(cA, 0) + hstepA, voffA);
        if (wr == 1) PG8_BAR;
        PG8_WAIT_V(2); PG8_BAR;
        PG8_STAGE(PG8_SB(1, 0), PG8_KPB(cB, 1), voffB); PG8_STAGE(PG8_SA(1, 0), PG8_KP(cA, 1), voffA); PG8_STAGE(PG8_SB(1, 1), PG8_KPB(cB, 1) + hstepB, voffB);
        PG8_WAIT_V(6); PG8_BAR;
    } else {
        PG8_STAGE(PG8_SB(0, 0), cB, voffB); PG8_STAGE(PG8_SA(0, 0), cA, voffA); PG8_STAGE(PG8_SB(0, 1), cB + hstepB, voffB); PG8_STAGE(PG8_SA(0, 1), cA + hstepA, voffA);
        if (wr == 1) PG8_BAR;
        PG8_WAIT_V(4); PG8_BAR;
        PG8_STAGE(PG8_SB(1, 0), cB + kstepB, voffB); PG8_STAGE(PG8_SA(1, 0), cA + kstep, voffA); PG8_STAGE(PG8_SB(1, 1), cB + hstepB + kstepB, voffB);
        PG8_WAIT_V(6); PG8_BAR;
    }
    for (;;) {
        const bool has_next = S.next(ui + 1, nxt);
        const char* nA = has_next ? (const char*)g.A + (size_t)nxt.pm * tstepA : cA; const char* nB = has_next ? (const char*)g.Bt + (size_t)nxt.pn * tstepB : cB;
        for (int t = 0; t < nt; t += 2) {
            const bool last = (t == nt - 2);
            const char* a1 = PG8_KP(cA, t + 1);
            const char* a2 = last ? PG8_KP(nA, 0) : PG8_KP(cA, t + 2); const char* b2 = last ? PG8_KPB(nB, 0) : PG8_KPB(cB, t + 2);
            const char* a3 = last ? PG8_KP(nA, 1) : PG8_KP(cA, t + 3); const char* b3 = last ? PG8_KPB(nB, 1) : PG8_KPB(cB, t + 3);
            if (last && has_next) S.a_ready(nxt);
            if constexpr (Epi::MID) { if (t == (nt >> 1)) E.mid(acc, cur, wr, wc, fr, fq); }
            if constexpr (SP2) {
            PG8_LDB(B0, 0, 0); PG8_LDB(B1, 0, 1); PG8_SCHED; PG8_LDA(At, 0, 0); PG8_STAGE(PG8_SA(1, 1), a1 + hstepA, voffA);
            PG8_WAIT_V(8); PG8_WAIT_L(0); PG8_BAR; PG8_MMA(0, 0, At, B0); PG8_MMA(0, 1, At, B1); PG8_BAR; PG8_SCHED;
            PG8_LDA(At, 0, 1); PG8_STAGE(PG8_SB(0, 0), b2, voffB); PG8_STAGE(PG8_SB(0, 1), b2 + hstepB, voffB); PG8_STAGE(PG8_SA(0, 0), a2, voffA);
            PG8_WAIT_V(8); PG8_WAIT_L(0); PG8_BAR; PG8_MMA(1, 0, At, B0); PG8_MMA(1, 1, At, B1); PG8_BAR; PG8_SCHED;
            PG8_LDB(B0, 1, 0); PG8_LDB(B1, 1, 1); PG8_SCHED; PG8_LDA(At, 1, 0); PG8_STAGE(PG8_SA(0, 1), a2 + hstepA, voffA);
            PG8_WAIT_V(8); PG8_WAIT_L(0); PG8_BAR; PG8_MMA(0, 0, At, B0); PG8_MMA(0, 1, At, B1); PG8_BAR; PG8_SCHED;
            PG8_LDA(At, 1, 1); PG8_STAGE(PG8_SB(1, 0), b3, voffB); PG8_STAGE(PG8_SB(1, 1), b3 + hstepB, voffB); PG8_STAGE(PG8_SA(1, 0), a3, voffA);
            PG8_WAIT_V(8); PG8_WAIT_L(0); PG8_BAR; PG8_MMA(1, 0, At, B0); PG8_MMA(1, 1, At, B1); PG8_BAR; PG8_SCHED;
            } else {
            PG8_LDB(B0, 0, 0); PG8_SCHED; PG8_LDA(At, 0, 0); PG8_STAGE(PG8_SA(1, 1), a1 + hstepA, voffA);
            PG8_WAIT_L(8); PG8_BAR; PG8_WAIT_L(0); PG8_MMA(0, 0, At, B0); PG8_BAR; PG8_SCHED;
            PG8_LDB(B1, 0, 1); PG8_STAGE(PG8_SB(0, 0), b2, voffB);
            PG8_BAR; PG8_WAIT_L(0); PG8_MMA(0, 1, At, B1); PG8_BAR;
            PG8_LDA(At, 0, 1); PG8_STAGE(PG8_SA(0, 0), a2, voffA);
            PG8_BAR; PG8_WAIT_L(0); PG8_MMA(1, 0, At, B0); PG8_BAR; PG8_SCHED;
            PG8_STAGE(PG8_SB(0, 1), b2 + hstepB, voffB);
            PG8_WAIT_V(6); PG8_BAR; PG8_MMA(1, 1, At, B1); PG8_BAR;
            PG8_LDB(B0, 1, 0); PG8_SCHED; PG8_LDA(At, 1, 0); PG8_STAGE(PG8_SA(0, 1), a2 + hstepA, voffA);
            PG8_WAIT_L(8); PG8_BAR; PG8_WAIT_L(0); PG8_MMA(0, 0, At, B0); PG8_BAR; PG8_SCHED;
            PG8_LDB(B1, 1, 1); PG8_STAGE(PG8_SB(1, 0), b3, voffB);
            PG8_BAR; PG8_WAIT_L(0); PG8_MMA(0, 1, At, B1); PG8_BAR;
            PG8_LDA(At, 1, 1); PG8_STAGE(PG8_SA(1, 0), a3, voffA);
            PG8_BAR; PG8_WAIT_L(0); PG8_MMA(1, 0, At, B0); PG8_BAR; PG8_SCHED;
            PG8_STAGE(PG8_SB(1, 1), b3 + hstepB, voffB);
            PG8_WAIT_V(6); PG8_BAR; PG8_MMA(1, 1, At, B1); PG8_BAR;
            }
        }
        if constexpr (ALIGN_EPI) { if (wr == 0) PG8_BAR; }
        if constexpr (!Epi::AFTER_DRAIN) { E(acc, cur, wr, wc, fr, fq); S.done(cur); }
        if (!has_next) break;
#pragma unroll
        for (int a = 0; a < 2; ++a)
#pragma unroll
            for (int b = 0; b < 2; ++b)
#pragma unroll
                for (int m = 0; m < 4; ++m)
#pragma unroll
                    for (int n = 0; n < 2; ++n) acc[a][b][m][n] = (f32x4){0.f, 0.f, 0.f, 0.f};
        cur = nxt; cA = nA; cB = nB; ++ui;
        if constexpr (ALIGN_EPI) { if (wr == 1) PG8_BAR; }
    }
    PG8_WAIT_V(0);
    if constexpr (!ALIGN_EPI) { if (wr == 0) PG8_BAR; }
    PG8_BAR;
    if constexpr (Epi::AFTER_DRAIN) { E.fused(acc, cur, wr, wc, fr, fq, lds, wid, lane); S.done(cur); }
#undef PG8_SA
#undef PG8_KP
#undef PG8_KPB
#undef PG8_SB
#undef PG8_STAGE
#undef PG8_LDA
#undef PG8_LDB
#undef PG8_MMA
#undef PG8_WAIT_V
#undef PG8_WAIT_L
#undef PG8_BAR
#undef PG8_SCHED
}
}

namespace att {
#define ATT_LAS __attribute__((address_space(3)))
typedef unsigned short bf16_t;
typedef short bf16x8 __attribute__((ext_vector_type(8)));
typedef short s16x4 __attribute__((ext_vector_type(4)));
typedef float f32x16 __attribute__((ext_vector_type(16)));
typedef unsigned u32x4 __attribute__((ext_vector_type(4)));
constexpr int SHM_V = 16384, SHM_K = 16384, SHM_R = 8192, BUFB = SHM_V + SHM_K + SHM_R;
constexpr int LDS_SCR = 2 * BUFB;
constexpr int LDS_FLAGS = LDS_SCR + 8 * 256;
constexpr int LDS_QR = LDS_FLAGS + 64;
constexpr int ATT_LDS_BYTES = LDS_QR + 8 * 4096;
#define KSWZ(row, colB) ((row) * 256 + ((colB) ^ (((row) & 7) << 4)))
#define RSWZ(row, colB) ((row) * 128 + ((colB) ^ ((((row) >> 1) & 7) << 4)))
__device__ __forceinline__ int v_st(int k, int c) { const int kk = (k & ~0xC) | ((k & 4) << 1) | ((k & 8) >> 1); return ((kk >> 3) * 4 + (c >> 5)) * 512 + ((kk & 7) * 32 + (c & 31)) * 2; }
__device__ __forceinline__ int v_rd_base(int lane) { return ((lane & 3) << 3) | (((lane >> 2) & 3) << 6) | (((lane >> 4) & 1) << 5) | (((lane >> 5) & 1) << 8); }
constexpr int v_rd_off(int d0, int ks, int half) { return d0 * 512 + ks * 4096 + half * 2048; }
__device__ __forceinline__ int crow(int r, int hi) { return (r & 3) + 8 * (r >> 2) + 4 * hi; }
__device__ __forceinline__ unsigned cvtpk(float lo, float hi) { unsigned r; asm volatile("v_cvt_pk_bf16_f32 %0, %1, %2" : "=v"(r) : "v"(lo), "v"(hi)); return r; }
#define ATT_SBAR() __builtin_amdgcn_sched_barrier(0)
#ifndef ATT_PRIO
#define ATT_PRIO 0
#endif
#ifndef ATT_EARLYW
#define ATT_EARLYW 0
#endif

template <int ND>
__device__ __forceinline__ void qkt_half(f32x16& p, const ATT_LAS char* Kb, const ATT_LAS char* Rb, int r32, int hi, const bf16x8* qr, const ATT_LAS char* qrl, int lane, int half) {
    bf16x8 kf[8];
#pragma unroll
    for (int d0 = 0; d0 < 8; ++d0) kf[d0] = *(const ATT_LAS bf16x8*)(Kb + KSWZ(r32, ((d0 & 3) * 16 + hi * 8) * 2) + (d0 >> 2) * 128 + half * (32 * 256));
    ATT_SBAR();
    p = f32x16{};
    if constexpr (ND == 12) {
        bf16x8 rf[4], qf[4];
#pragma unroll
        for (int d0 = 0; d0 < 4; ++d0) p = __builtin_amdgcn_mfma_f32_32x32x16_bf16(kf[d0], qr[d0], p, 0, 0, 0);
        ATT_SBAR();
#pragma unroll
        for (int dr = 0; dr < 4; ++dr) { rf[dr] = *(const ATT_LAS bf16x8*)(Rb + RSWZ(r32, (dr * 16 + hi * 8) * 2) + half * (32 * 128)); qf[dr] = *(const ATT_LAS bf16x8*)(qrl + dr * 1024 + lane * 16); }
        ATT_SBAR();
#pragma unroll
        for (int d0 = 4; d0 < 8; ++d0) p = __builtin_amdgcn_mfma_f32_32x32x16_bf16(kf[d0], qr[d0], p, 0, 0, 0);
#pragma unroll
        for (int dr = 0; dr < 4; ++dr) p = __builtin_amdgcn_mfma_f32_32x32x16_bf16(rf[dr], qf[dr], p, 0, 0, 0);
    } else {
#pragma unroll
        for (int d0 = 0; d0 < 8; ++d0) p = __builtin_amdgcn_mfma_f32_32x32x16_bf16(kf[d0], qr[d0], p, 0, 0, 0);
    }
}
__device__ __forceinline__ void pv_tile(f32x16* o, int vb, bf16x8 pa0, bf16x8 pa1, bf16x8 pa2, bf16x8 pa3) {
#define ATT_TRRD(dst, off) asm volatile("ds_read_b64_tr_b16 %0, %1 offset:%2" : "=&v"(dst) : "v"(vb), "i"(off) : "memory")
#define ATT_PV_D0(d0) do { s16x4 l0, l1, l2, l3, h0, h1, h2, h3; constexpr int b_ = v_rd_off(d0, 0, 0); \
        ATT_TRRD(l0, b_); ATT_TRRD(h0, b_ + 2048); ATT_TRRD(l1, b_ + 4096); ATT_TRRD(h1, b_ + 6144); ATT_TRRD(l2, b_ + 8192); ATT_TRRD(h2, b_ + 10240); ATT_TRRD(l3, b_ + 12288); ATT_TRRD(h3, b_ + 14336); \
        asm volatile("s_waitcnt lgkmcnt(0)" ::: "memory"); ATT_SBAR(); \
        o[d0] = __builtin_amdgcn_mfma_f32_32x32x16_bf16(pa0, (bf16x8){l0[0], l0[1], l0[2], l0[3], h0[0], h0[1], h0[2], h0[3]}, o[d0], 0, 0, 0); \
        o[d0] = __builtin_amdgcn_mfma_f32_32x32x16_bf16(pa1, (bf16x8){l1[0], l1[1], l1[2], l1[3], h1[0], h1[1], h1[2], h1[3]}, o[d0], 0, 0, 0); \
        o[d0] = __builtin_amdgcn_mfma_f32_32x32x16_bf16(pa2, (bf16x8){l2[0], l2[1], l2[2], l2[3], h2[0], h2[1], h2[2], h2[3]}, o[d0], 0, 0, 0); \
        o[d0] = __builtin_amdgcn_mfma_f32_32x32x16_bf16(pa3, (bf16x8){l3[0], l3[1], l3[2], l3[3], h3[0], h3[1], h3[2], h3[3]}, o[d0], 0, 0, 0); } while (0)
    if (ATT_PRIO) __builtin_amdgcn_s_setprio(1);
    ATT_PV_D0(0); ATT_PV_D0(1); ATT_PV_D0(2); ATT_PV_D0(3);
    if (ATT_PRIO) __builtin_amdgcn_s_setprio(0);
#undef ATT_PV_D0
#undef ATT_TRRD
}
__device__ __forceinline__ void pack_half(const f32x16& p, bf16x8& pa0, bf16x8& pa1) {
#define ATT_PK4(P, B_, OUT) do { unsigned a0 = cvtpk(P[B_+0], P[B_+1]), a1 = cvtpk(P[B_+2], P[B_+3]); \
        unsigned b0 = cvtpk(P[B_+4], P[B_+5]), b1 = cvtpk(P[B_+6], P[B_+7]); \
        auto r0 = __builtin_amdgcn_permlane32_swap(a0, b0, false, false); auto r1 = __builtin_amdgcn_permlane32_swap(a1, b1, false, false); \
        u32x4 w = {r0[0], r1[0], r0[1], r1[1]}; OUT = __builtin_bit_cast(bf16x8, w); } while (0)
    ATT_PK4(p, 0, pa0); ATT_PK4(p, 8, pa1);
#undef ATT_PK4
}
__device__ __forceinline__ void half_xchg(float x, float& lo, float& hi) {
    unsigned a = __builtin_bit_cast(unsigned, x), b;
    asm volatile("s_nop 1\n\tv_mov_b32 %1, %0\n\ts_nop 1\n\tv_permlane32_swap_b32 %0, %1" : "+v"(a), "=&v"(b));
    lo = __builtin_bit_cast(float, a); hi = __builtin_bit_cast(float, b);
}
__device__ __forceinline__ float half_sum(float v) { float lo, hi; half_xchg(v, lo, hi); return lo + hi; }
__device__ __forceinline__ float half_max(float v) { float lo, hi; half_xchg(v, lo, hi); return fmaxf(lo, hi); }

struct Tensors { const bf16_t* Q; int ldq; const bf16_t* K; int ldk; const bf16_t* V; int ldv; const bf16_t* R; bf16_t* O; int ldo; };

template <int MODE>
__device__ __forceinline__ void attn_unit(const Tensors& T, int qb, float sc2, ATT_LAS char* lds) {
    constexpr int ND = MODE == 1 ? 12 : 8;
    int tid_ = threadIdx.x; asm volatile("" : "+v"(tid_));
    const int tid = tid_, wid = __builtin_amdgcn_readfirstlane(tid >> 6), lane = tid & 63, r32 = lane & 31, hi = lane >> 5;
    const int q0 = qb * 256, qw = q0 + wid * 32;
    const int NT = 4 * (qb + 1);
    const int wlast = 4 * qb + (wid >> 1);
    const int tq = qw + r32;
    ATT_LAS float* scr = (ATT_LAS float*)(lds + LDS_SCR) + wid * 64;
    volatile ATT_LAS unsigned* flags = (volatile ATT_LAS unsigned*)(lds + LDS_FLAGS);
    const ATT_LAS char* qrl = lds + LDS_QR + wid * 4096;
    bf16x8 qr[8];
    { const bf16_t* qp = T.Q + (size_t)tq * T.ldq + hi * 8;
#pragma unroll
      for (int d0 = 0; d0 < 8; ++d0) qr[d0] = *(const bf16x8*)(qp + d0 * 16);
      if constexpr (MODE == 1) {
#pragma unroll
          for (int dr = 0; dr < 4; ++dr) *(ATT_LAS bf16x8*)(lds + LDS_QR + wid * 4096 + dr * 1024 + lane * 16) = *(const bf16x8*)(qp + 128 + dr * 16); } }
    const int sr = tid >> 4, sc = (tid & 15) * 8, kws = KSWZ(sr, sc * 2), vst0 = v_st(sr, sc), vst1 = v_st(32 + sr, sc);
    const int rr_ = tid >> 3, rc = (tid & 7) * 8, rws = RSWZ(rr_, rc * 2);
    bf16x8 sk0, sk1, sv0, sv1, srp;
#define ATT_LOAD(kt) do { const size_t k0_ = (size_t)(kt) * 64; \
        sk0 = *(const bf16x8*)(T.K + (k0_ + sr) * T.ldk + sc); sk1 = *(const bf16x8*)(T.K + (k0_ + 32 + sr) * T.ldk + sc); \
        sv0 = *(const bf16x8*)(T.V + (k0_ + sr) * T.ldv + sc); sv1 = *(const bf16x8*)(T.V + (k0_ + 32 + sr) * T.ldv + sc); \
        if constexpr (MODE == 1) srp = *(const bf16x8*)(T.R + (k0_ + rr_) * 64 + rc); } while (0)
#define ATT_WRITE(bf) do { ATT_LAS char* b_ = lds + (bf) * BUFB; \
        *(ATT_LAS bf16x8*)(b_ + vst0) = sv0; *(ATT_LAS bf16x8*)(b_ + vst1) = sv1; \
        *(ATT_LAS bf16x8*)(b_ + SHM_V + kws) = sk0; *(ATT_LAS bf16x8*)(b_ + SHM_V + kws + 32 * 256) = sk1; \
        if constexpr (MODE == 1) *(ATT_LAS bf16x8*)(b_ + SHM_V + SHM_K + rws) = srp; } while (0)
#define ATT_TILE(it) (MODE == 0 ? (NT - 1 - (it)) : (it))
    f32x16 o[4] = {};
    float carry = 0.f;
    float m_reg = -1e30f, l_reg = 0.f;
    bool dead = false;
    const float hsel = hi ? 0.f : 1.f;
    ATT_LOAD(ATT_TILE(0)); asm volatile("s_waitcnt vmcnt(0)" ::: "memory"); ATT_WRITE(0);
    __syncthreads();
    for (int it = 0; it < NT; ++it) {
        const int cur = it & 1, kt = ATT_TILE(it), kb = kt * 64;
        if (it + 1 < NT) ATT_LOAD(ATT_TILE(it + 1));
        const ATT_LAS char* bufp = lds + cur * BUFB;
        bool staged = false;
        if (kt <= wlast && !dead) {
            f32x16 p0, p1;
            bf16x8 pa0, pa1, pa2, pa3;
            if constexpr (MODE == 0) {
                const bool diag = (kb + 63 >= qw);
                qkt_half<ND>(p1, bufp + SHM_V, bufp + SHM_V + SHM_K, r32, hi, qr, qrl, lane, 1);
                qkt_half<ND>(p0, bufp + SHM_V, bufp + SHM_V + SHM_K, r32, hi, qr, qrl, lane, 0);
                float tsum = carry;
#define ATT_SB_HALF(P, KOFF) do { f32x16 f; \
                    _Pragma("unroll") for (int r = 0; r < 16; ++r) { P[r] *= sc2; \
                        f[r] = fminf(-P[r], 0.f) - __builtin_amdgcn_logf(1.0f + __builtin_amdgcn_exp2f(-__builtin_fabsf(P[r]))); } \
                    if (diag) { _Pragma("unroll") for (int r = 0; r < 16; ++r) { if (kb + (KOFF) + crow(r, hi) >= tq) f[r] = 0.f; } } \
                    float gs_[4], oh_[4], ps_[4]; \
                    _Pragma("unroll") for (int i = 0; i < 4; ++i) { f[4*i+2] += f[4*i+3]; f[4*i+1] += f[4*i+2]; f[4*i] += f[4*i+1]; gs_[i] = f[4*i]; } \
                    _Pragma("unroll") for (int i = 0; i < 4; ++i) { float lo_; half_xchg(gs_[i], lo_, oh_[i]); ps_[i] = lo_ + oh_[i]; } \
                    _Pragma("unroll") for (int i = 3; i >= 0; --i) { const float Tg = tsum + hsel * oh_[i]; \
                        _Pragma("unroll") for (int e = 0; e < 4; ++e) P[4*i+e] = __builtin_amdgcn_exp2f(P[4*i+e] + f[4*i+e] + Tg); \
                        tsum += ps_[i]; } \
                    if (diag) { _Pragma("unroll") for (int r = 0; r < 16; ++r) { if (kb + (KOFF) + crow(r, hi) >= tq) P[r] = 0.f; } } } while (0)
                ATT_SB_HALF(p1, 32);
                pack_half(p1, pa2, pa3);
                ATT_SB_HALF(p0, 0);
                pack_half(p0, pa0, pa1);
#undef ATT_SB_HALF
                carry = tsum;
                pv_tile(o, (int)(uintptr_t)(bufp) + v_rd_base(lane), pa0, pa1, pa2, pa3);
                if (__all(carry < -140.f)) dead = true;
            } else {
                qkt_half<ND>(p0, bufp + SHM_V, bufp + SHM_V + SHM_K, r32, hi, qr, qrl, lane, 0);
                qkt_half<ND>(p1, bufp + SHM_V, bufp + SHM_V + SHM_K, r32, hi, qr, qrl, lane, 1);
                float pmax = p0[0];
#pragma unroll
                for (int r = 1; r < 16; ++r) pmax = fmaxf(pmax, p0[r]);
#pragma unroll
                for (int r = 0; r < 16; ++r) pmax = fmaxf(pmax, p1[r]);
                pmax = half_max(pmax);
                const float mn = fmaxf(m_reg, pmax), alpha = __builtin_amdgcn_exp2f((m_reg - mn) * sc2); m_reg = mn;
                const float mnL = -mn * sc2;
                float psum = 0.f;
#pragma unroll
                for (int r = 0; r < 16; ++r) { p0[r] = __builtin_amdgcn_exp2f(fmaf(p0[r], sc2, mnL)); psum += p0[r]; }
                pack_half(p0, pa0, pa1);
#pragma unroll
                for (int r = 0; r < 16; ++r) { p1[r] = __builtin_amdgcn_exp2f(fmaf(p1[r], sc2, mnL)); psum += p1[r]; }
                pack_half(p1, pa2, pa3);
                l_reg = l_reg * alpha + half_sum(psum);
                if (__any(alpha < 1.f))
                { if (hi == 0) scr[r32] = alpha; asm volatile("s_waitcnt lgkmcnt(0)" ::: "memory");
#pragma unroll
                    for (int r = 0; r < 16; ++r) { const float a = scr[crow(r, hi)];
#pragma unroll
                        for (int d = 0; d < 4; ++d) o[d][r] *= a; } }
#if ATT_EARLYW
                if (it + 1 < NT) { asm volatile("s_waitcnt vmcnt(0)" ::: "memory"); ATT_WRITE(cur ^ 1); staged = true; }
#endif
                pv_tile(o, (int)(uintptr_t)(bufp) + v_rd_base(lane), pa0, pa1, pa2, pa3);
            }
        }
        if (it + 1 < NT && !staged) { asm volatile("s_waitcnt vmcnt(0)" ::: "memory"); ATT_WRITE(cur ^ 1); }
        if constexpr (MODE == 0) { if (lane == 0) flags[cur * 8 + wid] = dead ? 1u : 0u; }
        __syncthreads();
        if constexpr (MODE == 0) {
            unsigned alld = 1u;
#pragma unroll
            for (int w = 0; w < 8; ++w) alld &= flags[cur * 8 + w];
            if (alld) break;
        }
    }
    if constexpr (MODE == 1) { if (hi == 0) scr[32 + r32] = l_reg; asm volatile("s_waitcnt lgkmcnt(0)" ::: "memory"); }
    bf16_t* Ow = T.O + (size_t)qw * T.ldo;
    int obase = 4 * hi * T.ldo + r32; asm volatile("" : "+v"(obase));
#pragma unroll
    for (int r = 0; r < 16; ++r) { const int orow = crow(r, hi);
        float rl = 1.f; if constexpr (MODE == 1) rl = __builtin_amdgcn_rcpf(scr[32 + orow]);
        int ro = obase + ((r & 3) + 8 * (r >> 2)) * T.ldo; asm volatile("" : "+v"(ro));
#pragma unroll
        for (int d0 = 0; d0 < 4; ++d0) { const float v = o[d0][r] * rl; const float vn = __shfl_xor(v, 1);
            if ((r32 & 1) == 0) *(unsigned*)(Ow + ro + d0 * 32) = cvtpk(v, vn); } }
    __syncthreads();
#undef ATT_LOAD
#undef ATT_WRITE
#undef ATT_TILE
}
}

constexpr int BATCH = 2, SEQ = 4096, D = 4096, M = BATCH * SEQ, DEPTH = 2;
constexpr int SBW = 2048, QRANK = 1024, KVRANK = 512, ROPE = 64, DFF = 16384;
constexpr int IN_W = 3 * SBW + QRANK + KVRANK + ROPE + 2 * D;
constexpr int C_QD = 3 * SBW, C_KVD = C_QD + QRANK, C_GATE_SRC = C_KVD + KVRANK + ROPE;
constexpr int C_GSB = 7936, C_GMLA = C_GSB + D, PROJ_W = C_GMLA + D;
constexpr int QW = 16 * 192, KVW = 16 * 256;
constexpr float EPS = 1e-6f;
static_assert(IN_W == 15936 && PROJ_W == 16128 && PROJ_W % 256 == 0 && C_GSB % 256 == 0, "projection layout");

constexpr size_t MiB = 1u << 20;
constexpr size_t WS_CTL = 0, CTL_ZERO_BYTES = 1 * MiB;
constexpr size_t WS_ADA = 1 * MiB;
constexpr size_t WS_TAB = 2 * MiB;
constexpr size_t WS_ADAP = 4 * MiB;
constexpr size_t WS_W = 32 * MiB;
constexpr size_t W_IN = 0, W_UQ = 126 * MiB, W_UKV = 132 * MiB, W_OSB = 136 * MiB, W_OMLA = 152 * MiB, W_OUT = 168 * MiB, W_UP = 200 * MiB, W_DOWN = 328 * MiB, W_LAYER = 456 * MiB;
constexpr size_t WS_ACT = WS_W + DEPTH * W_LAYER;
constexpr size_t A_H = WS_ACT, A_PROJ = A_H + 64 * MiB, A_CQ = A_PROJ + 252 * MiB, A_CKV = A_CQ + 16 * MiB, A_KR = A_CKV + 8 * MiB, A_Q = A_KR + 1 * MiB, A_KV = A_Q + 48 * MiB,
                 A_OSB = A_KV + 64 * MiB, A_OMLA = A_OSB + 32 * MiB, A_TMP = A_OMLA + 32 * MiB, A_MRG = A_TMP + 128 * MiB, A_Y = A_MRG + 64 * MiB, A_U = A_Y + 128 * MiB, WS_END = A_U + 256 * MiB;
static_assert((size_t)PROJ_W * D * 2 == 126 * MiB && (size_t)M * PROJ_W * 2 == 252 * MiB, "sizes");
constexpr int CW_TMO = 0;
constexpr int CW_BAR = 4096;

constexpr int RING_BYTES = 135168;
constexpr int LDSCTL_OFF = RING_BYTES, MISC_OFF = LDSCTL_OFF + 320;
constexpr int LDS_BYTES = RING_BYTES + 1024;
constexpr int NWAVES = 8;
static_assert(att::ATT_LDS_BYTES <= RING_BYTES && pg8::STAGE_BYTES <= RING_BYTES, "LDS map");

#define GAS __attribute__((address_space(1)))
#define LAS __attribute__((address_space(3)))
typedef unsigned short bf16;
typedef unsigned v4u __attribute__((ext_vector_type(4)));
typedef unsigned v2u __attribute__((ext_vector_type(2)));
typedef float f32x4 __attribute__((ext_vector_type(4)));
typedef GAS unsigned gu32;
#define RLX_AGENT __ATOMIC_RELAXED, __HIP_MEMORY_SCOPE_AGENT
#ifndef USE_NT
#define USE_NT 0
#endif
#if USE_NT
#define NT_LD(p) __builtin_nontemporal_load(p)
#else
#define NT_LD(p) (*(p))
#endif
#define LDS_WAIT() asm volatile("s_waitcnt lgkmcnt(0)" ::: "memory")
#define VM_WAIT() asm volatile("s_waitcnt vmcnt(0)" ::: "memory")
__device__ __forceinline__ unsigned pk2(float lo, float hi) { return pg8::cvt_pk_bf16(lo, hi); }
__device__ __forceinline__ float bflo(unsigned w) { return __builtin_bit_cast(float, w << 16); }
__device__ __forceinline__ float bfhi(unsigned w) { return __builtin_bit_cast(float, w & 0xffff0000u); }

#define XB_TMO      128
#define XB_XCNT(j)  (256  + 64 * (j))
#define XB_XSUB(j)  (1280 + 64 * (j))
#define XB_XGEN(j)  (2304 + 64 * (j))
#define XB_TOP      3328
#define XB_TOPGEN   3392
#define XCD_BAR_WORDS 3456
#define XB_SPIN_CAP (1u << 21)

__device__ __forceinline__ unsigned xb_ld(unsigned* p)              { return __hip_atomic_load(p, __ATOMIC_RELAXED, __HIP_MEMORY_SCOPE_AGENT); }
__device__ __forceinline__ unsigned xb_add(unsigned* p, unsigned v) { return __hip_atomic_fetch_add(p, v, __ATOMIC_RELAXED, __HIP_MEMORY_SCOPE_AGENT); }
__device__ __forceinline__ unsigned xb_xcc_id() { return (unsigned)__builtin_amdgcn_s_getreg((3 << 11) | 20) & 0xFu; }
#define XB_SPIN(cond, bar) do { unsigned _sp = 0; while (cond) { __builtin_amdgcn_s_sleep(1); \
    if ((++_sp & 255u) == 0u) { if (xb_ld(&(bar)[XB_TMO])) break; if (_sp > XB_SPIN_CAP) { atomicAdd(&(bar)[XB_TMO], 1u); break; } } } } while (0)

struct XcdBarrier {
    unsigned* bar; unsigned x;
    volatile LAS unsigned* st;
};

__device__ __forceinline__ XcdBarrier xcd_barrier_post(unsigned* bar, volatile LAS unsigned* st) {
    XcdBarrier b; b.bar = bar; b.x = xb_xcc_id(); b.st = st;
    if (threadIdx.x == 0) (void)xb_add(&bar[XB_XCNT(b.x)], 1u);
    return b;
}
__device__ __forceinline__ void xcd_barrier_complete(unsigned* bar, unsigned x, unsigned& nloc, unsigned& nx) {
    const unsigned G = gridDim.x * gridDim.y * gridDim.z;
    unsigned sum, cnt, mine, sp = 0u;
    for (;;) {
        sum = 0u; cnt = 0u; mine = 0u;
#pragma unroll
        for (unsigned j = 0; j < 16; ++j) { const unsigned c = xb_ld(&bar[XB_XCNT(j)]); sum += c; cnt += (c > 0u) ? 1u : 0u; mine = (j == x) ? c : mine; }
        if (sum == G) break;
        __builtin_amdgcn_s_sleep(1);
        if ((++sp & 255u) == 0u) { if (xb_ld(&bar[XB_TMO])) break; if (sp > XB_SPIN_CAP) { atomicAdd(&bar[XB_TMO], 1u); break; } }
    }
    nloc = mine > 0u ? mine : 1u; nx = cnt > 0u ? cnt : 1u;
}

__device__ __forceinline__ void xcd_barrier(const XcdBarrier& b) {
    asm volatile("s_waitcnt vmcnt(0)" ::: "memory");
    __syncthreads();
    if (threadIdx.x == 0) {
        unsigned* bar = b.bar; unsigned bx_ = b.x; asm volatile("" : "+s"(bar), "+s"(bx_));
        __builtin_amdgcn_s_waitcnt(0);
        unsigned nloc = b.st[0], nx = b.st[1];
        if (nloc == 0u) { xcd_barrier_complete(bar, bx_, nloc, nx); b.st[0] = nloc; b.st[1] = nx; }
        const unsigned old = xb_add(&bar[XB_XSUB(bx_)], 1u);
        const unsigned gen = old / nloc;
        if (old + 1u == (gen + 1u) * nloc) {
            __builtin_amdgcn_fence(__ATOMIC_RELEASE, "agent");
            asm volatile("s_waitcnt vmcnt(0)" ::: "memory");
            const unsigned og = xb_add(&bar[XB_TOP], 1u);
            const unsigned tg = og / nx;
            if (og + 1u == (tg + 1u) * nx) xb_add(&bar[XB_TOPGEN], 1u);
            else XB_SPIN(xb_ld(&bar[XB_TOPGEN]) == tg, bar);
            __builtin_amdgcn_fence(__ATOMIC_ACQUIRE, "agent");
            xb_add(&bar[XB_XGEN(bx_)], 1u);
            asm volatile("s_waitcnt vmcnt(0)" ::: "memory");
        } else {
            XB_SPIN(xb_ld(&bar[XB_XGEN(bx_)]) == gen, bar);
            __builtin_amdgcn_fence(__ATOMIC_ACQUIRE, "agent");
            asm volatile("s_waitcnt vmcnt(0)" ::: "memory");
        }
    }
    __syncthreads();
}


struct Frame {
    LAS unsigned char* lds;
    int tid, lane, wave, G, gw, NGW;
};
__device__ __forceinline__ float wave_sum(float v) {
#pragma unroll
    for (int o = 1; o < 64; o <<= 1) v += __shfl_xor(v, o);
    return v;
}

#ifndef CONV_NT_ST
#define CONV_NT_ST 1
#endif
__device__ __forceinline__ void conv_load(f32x4 (&v)[16], f32x4& ks0, f32x4& ks1, const float* src, int N, const float* ks, int lane) {
    const float* s_ = src + (size_t)(lane >> 4) * N + 4 * (lane & 15);
#pragma unroll
    for (int i = 0; i < 16; ++i) v[i] = NT_LD((const f32x4*)(s_ + (size_t)(4 * i) * N));
    ks0 = (f32x4){1.f, 1.f, 1.f, 1.f}; ks1 = ks0;
    if (ks) { ks0 = *(const f32x4*)(ks + 8 * (lane & 7)); ks1 = *(const f32x4*)(ks + 8 * (lane & 7) + 4); }
}
__device__ __forceinline__ void conv_store(const f32x4 (&v)[16], f32x4 ks0, f32x4 ks1, bf16* dst, int ldt, int rowbase, int ropeperm, LAS float* scr, int lane) {
#pragma unroll
    for (int i = 0; i < 16; ++i) { LAS float* d = scr + (4 * i + (lane >> 4)) * 65 + 4 * (lane & 15); d[0] = v[i][0]; d[1] = v[i][1]; d[2] = v[i][2]; d[3] = v[i][3]; }
    LDS_WAIT(); asm volatile("" ::: "memory");
    const int c = lane & 7;
#pragma unroll
    for (int j = 0; j < 8; ++j) { const int nn = (lane >> 3) + 8 * j; const LAS float* s = scr + (8 * c) * 65 + nn;
        v4u o; o.x = pk2(s[0 * 65] * ks0[0], s[1 * 65] * ks0[1]); o.y = pk2(s[2 * 65] * ks0[2], s[3 * 65] * ks0[3]); o.z = pk2(s[4 * 65] * ks1[0], s[5 * 65] * ks1[1]); o.w = pk2(s[6 * 65] * ks1[2], s[7 * 65] * ks1[3]);
        const int orow = rowbase + ((ropeperm & 1) ? (2 * (nn & 31) + (nn >> 5)) : nn);
#ifdef P0A_REP_NOSTORE
        if (ropeperm < 2)
#endif
#if CONV_NT_ST
        __builtin_nontemporal_store(o, (GAS v4u*)(dst + (size_t)orow * 64 + 8 * c)); }
#else
        *(GAS v4u*)(dst + (size_t)orow * 64 + 8 * c) = o; }
#endif
    LDS_WAIT(); asm volatile("" ::: "memory");
}

__device__ __forceinline__ void norm_mod_row(const f32x4 (&v)[16], float ssq, const float* g, const float* scv, const float* shv, bf16* orow, int lane) {
    const float r = 1.0f / sqrtf(ssq * (1.0f / D) + EPS);
#pragma unroll
    for (int j = 0; j < 16; ++j) { int c = 4 * lane + 256 * j; asm volatile("" : "+v"(c));
        const f32x4 gg = *(const f32x4*)(g + c), ss = *(const f32x4*)(scv + c), hh = *(const f32x4*)(shv + c);
        f32x4 o;
#pragma unroll
        for (int e = 0; e < 4; ++e) o[e] = v[j][e] * r * gg[e] * (1.0f + ss[e]) + hh[e];
        v2u w; w.x = pk2(o[0], o[1]); w.y = pk2(o[2], o[3]);
        *(GAS v2u*)(orow + c) = w; }
}


template <bool HAS_Y, bool HAS_H, bool XIN_BF = false, bool XOUT_BF = false>
__device__ __forceinline__ void thin_phase(Frame& F, const void* xin_, void* xout_, const bf16* Yb, bf16* Hout,
                                           const float* gpost, const float* gate0, const float* gpre, const float* sc0, const float* sh0) {
    LAS float* cA1 = (LAS float*)F.lds; LAS float* cA2 = cA1 + D; LAS float* cB2 = cA2 + D;
    for (int chunk = blockIdx.x; chunk < M / 32; chunk += F.G) {
        int tid = F.tid; asm volatile("" : "+v"(tid));
        const int b = (chunk * 32) / SEQ;
        __syncthreads();
#pragma unroll
        for (int i = 0; i < 2; ++i) { const int c = 4 * tid + 2048 * i;
            if constexpr (HAS_Y) { const f32x4 g = *(const f32x4*)(gpost + c), t = *(const f32x4*)(gate0 + (size_t)b * 6 * D + c); *(LAS f32x4*)(cA1 + c) = g * t; }
            if constexpr (HAS_H) { const f32x4 g = *(const f32x4*)(gpre + c), s = *(const f32x4*)(sc0 + (size_t)b * 6 * D + c), h = *(const f32x4*)(sh0 + (size_t)b * 6 * D + c);
                *(LAS f32x4*)(cA2 + c) = g * (s + 1.0f); *(LAS f32x4*)(cB2 + c) = h; } }
        __syncthreads();
        const int LN = tid & 63;
#pragma unroll 1
        for (int i = 0; i < 4; ++i) {
            const size_t m = (size_t)chunk * 32 + F.wave * 4 + i;
            v4u yv[8]; f32x4 xv[16];
#pragma unroll
            for (int j = 0; j < 8; ++j) { const int c = 8 * LN + 512 * j;
                if constexpr (HAS_Y) yv[j] = *(const GAS v4u*)(Yb + m * D + c);
                if constexpr (XIN_BF) { const v4u xb = *(const GAS v4u*)((const bf16*)xin_ + m * D + c);
                    xv[2 * j] = (f32x4){bflo(xb.x), bfhi(xb.x), bflo(xb.y), bfhi(xb.y)}; xv[2 * j + 1] = (f32x4){bflo(xb.z), bfhi(xb.z), bflo(xb.w), bfhi(xb.w)}; }
                else { xv[2 * j] = *(const f32x4*)((const float*)xin_ + m * D + c); xv[2 * j + 1] = *(const f32x4*)((const float*)xin_ + m * D + c + 4); } }
            float ssq2 = 0.f;
            if constexpr (HAS_Y) {
                float ssq = 0.f;
#pragma unroll
                for (int j = 0; j < 8; ++j) { const unsigned w[4] = {yv[j].x, yv[j].y, yv[j].z, yv[j].w};
#pragma unroll
                    for (int q = 0; q < 4; ++q) { const float a = bflo(w[q]), c2 = bfhi(w[q]); ssq += a * a + c2 * c2; } }
                ssq = wave_sum(ssq); const float r = 1.0f / sqrtf(ssq * (1.0f / D) + EPS);
#pragma unroll
                for (int j = 0; j < 8; ++j) { const int c = 8 * LN + 512 * j; const unsigned w[4] = {yv[j].x, yv[j].y, yv[j].z, yv[j].w};
                    const f32x4 a0 = *(const LAS f32x4*)(cA1 + c), a1 = *(const LAS f32x4*)(cA1 + c + 4);
                    f32x4 y0 = {bflo(w[0]), bfhi(w[0]), bflo(w[1]), bfhi(w[1])}, y1 = {bflo(w[2]), bfhi(w[2]), bflo(w[3]), bfhi(w[3])};
                    xv[2 * j] = xv[2 * j] + a0 * (y0 * r); xv[2 * j + 1] = xv[2 * j + 1] + a1 * (y1 * r);
                    if constexpr (XOUT_BF) { v4u xw; xw.x = pk2(xv[2 * j][0], xv[2 * j][1]); xw.y = pk2(xv[2 * j][2], xv[2 * j][3]); xw.z = pk2(xv[2 * j + 1][0], xv[2 * j + 1][1]); xw.w = pk2(xv[2 * j + 1][2], xv[2 * j + 1][3]);
                        *(GAS v4u*)((bf16*)xout_ + m * D + c) = xw; }
                    else { *(f32x4*)((float*)xout_ + m * D + c) = xv[2 * j]; *(f32x4*)((float*)xout_ + m * D + c + 4) = xv[2 * j + 1]; } } }
            if constexpr (HAS_H) {
#pragma unroll
                for (int j = 0; j < 16; ++j) ssq2 += (xv[j][0] * xv[j][0] + xv[j][1] * xv[j][1]) + (xv[j][2] * xv[j][2] + xv[j][3] * xv[j][3]);
                ssq2 = wave_sum(ssq2); const float r2 = 1.0f / sqrtf(ssq2 * (1.0f / D) + EPS);
#pragma unroll
                for (int j = 0; j < 8; ++j) { const int c = 8 * LN + 512 * j;
                    const f32x4 a0 = *(const LAS f32x4*)(cA2 + c), a1 = *(const LAS f32x4*)(cA2 + c + 4), b0 = *(const LAS f32x4*)(cB2 + c), b1 = *(const LAS f32x4*)(cB2 + c + 4);
                    const f32x4 h0 = (xv[2 * j] * r2) * a0 + b0, h1 = (xv[2 * j + 1] * r2) * a1 + b1;
                    v4u w; w.x = pk2(h0[0], h0[1]); w.y = pk2(h0[2], h0[3]); w.z = pk2(h1[0], h1[1]); w.w = pk2(h1[2], h1[3]);
                    *(GAS v4u*)(Hout + m * D + c) = w; } }
        }
    }
    __syncthreads();
}

__device__ __forceinline__ int gate_row(int j) { const int which = j / D, oc = j % D; return C_GSB + 256 * (oc / 128) + 128 * which + (oc % 128); }
constexpr int NB_IN = IN_W / 64, I_IN = (D / 64) * NB_IN, I_UQ = (QRANK / 64) * (QW / 64), I_UKV = (KVRANK / 64) * (KVW / 64), I_OSB = (SBW / 64) * (D / 64), I_OMLA = I_OSB,
              I_OUT = (D / 64) * (D / 64), I_UP = (D / 64) * (DFF / 64), I_DOWN = (DFF / 64) * (D / 64), I_LAYER = I_IN + I_UQ + I_UKV + I_OSB + I_OMLA + I_OUT + I_UP + I_DOWN;
#define CONV_DECODE(it, SRC, NN, DST, LDT, RB, RP, KS) do { const int l = (it) / I_LAYER; int r = (it) % I_LAYER; KS = nullptr; RP = 0; \
        if (r < I_IN) { const int kb = r / NB_IN, nb = r % NB_IN, n0 = nb * 64; SRC = KIN(I_WIN) + (size_t)l * D * IN_W + (size_t)(64 * kb) * IN_W + n0; NN = IN_W; DST = (bf16*)(wl + W_IN) + (size_t)kb * PROJ_W * 64; LDT = 64; \
            RB = n0 < C_GATE_SRC ? n0 : gate_row(n0 - C_GATE_SRC); RP = (n0 == C_KVD + KVRANK)  ; break; } r -= I_IN; \
        if (r < I_UQ) { const int kb = r / (QW / 64), nb = r % (QW / 64); SRC = KIN(I_WUQ) + (size_t)l * QRANK * QW + (size_t)(64 * kb) * QW + 64 * nb; NN = QW; DST = (bf16*)(wl + W_UQ) + (size_t)kb * QW * 64; LDT = 64; \
            RB = nb * 64; RP = ((nb % 3) == 2); KS = KIN(I_GQ) + (size_t)l * QRANK + 64 * kb; break; } r -= I_UQ; \
        if (r < I_UKV) { const int kb = r / (KVW / 64), nb = r % (KVW / 64); SRC = KIN(I_WUKV) + (size_t)l * KVRANK * KVW + (size_t)(64 * kb) * KVW + 64 * nb; NN = KVW; DST = (bf16*)(wl + W_UKV) + (size_t)kb * KVW * 64; LDT = 64; \
            RB = nb * 64; KS = KIN(I_GKV) + (size_t)l * KVRANK + 64 * kb; break; } r -= I_UKV; \
        if (r < I_OSB) { const int kb = r / (D / 64), nb = r % (D / 64); SRC = KIN(I_WOSB) + (size_t)l * SBW * D + (size_t)(64 * kb) * D + 64 * nb; NN = D; DST = (bf16*)(wl + W_OSB) + (size_t)kb * D * 64; LDT = 64; RB = nb * 64; break; } r -= I_OSB; \
        if (r < I_OMLA) { const int kb = r / (D / 64), nb = r % (D / 64); SRC = KIN(I_WOMLA) + (size_t)l * SBW * D + (size_t)(64 * kb) * D + 64 * nb; NN = D; DST = (bf16*)(wl + W_OSB) + (size_t)(SBW / 64 + kb) * D * 64; LDT = 64; RB = nb * 64; break; } r -= I_OMLA; \
        if (r < I_OUT) { const int kb = r / (D / 64), nb = r % (D / 64); SRC = KIN(I_WOUT) + (size_t)l * D * D + (size_t)(64 * kb) * D + 64 * nb; NN = D; DST = (bf16*)(wl + W_OUT) + (size_t)kb * D * 64; LDT = 64; RB = nb * 64; break; } r -= I_OUT; \
        if (r < I_UP) { const int kb = r / (DFF / 64), nb = r % (DFF / 64); SRC = KIN(I_WUP) + (size_t)l * D * DFF + (size_t)(64 * kb) * DFF + 64 * nb; NN = DFF; DST = (bf16*)(wl + W_UP) + (size_t)kb * DFF * 64; LDT = 64; RB = nb * 64; break; } r -= I_UP; \
        { const int kb = r / (D / 64), nb = r % (D / 64); SRC = KIN(I_WDOWN) + (size_t)l * DFF * D + (size_t)(64 * kb) * D + 64 * nb; NN = D; DST = (bf16*)(wl + W_DOWN) + (size_t)kb * D * 64; LDT = 64; RB = nb * 64; } \
    } while (0)
#ifdef P0A_REP_NOSTORE
#define CONV_RPX (p0r_ > 0 ? 2 : 0)
#else
#define CONV_RPX 0
#endif
#define CONVERT_ITEMS(lo, hi, start, stride) do { int cl_ = F.lane; asm volatile("" : "+v"(cl_));     \
        int it = (lo) + (start); \
        if (it < (hi)) { \
            const float* srcA; int nA; bf16* dstA; int ldtA, rbA, rpA; const float* ksA; f32x4 vA[16], k0A, k1A; \
            CONV_DECODE(it, srcA, nA, dstA, ldtA, rbA, rpA, ksA); conv_load(vA, k0A, k1A, srcA, nA, ksA, cl_); \
            for (;;) { const int nx = it + (stride); const bool hn = nx < (hi); \
                const float* srcB = srcA; int nB = nA; bf16* dstB = dstA; int ldtB = ldtA, rbB = rbA, rpB = rpA; const float* ksB = ksA; f32x4 vB[16], k0B, k1B; \
                if (hn) { CONV_DECODE(nx, srcB, nB, dstB, ldtB, rbB, rpB, ksB); conv_load(vB, k0B, k1B, srcB, nB, ksB, cl_); } \
                conv_store(vA, k0A, k1A, dstA, ldtA, rbA, rpA + CONV_RPX, scr, cl_); \
                if (!hn) break; \
                srcA = srcB; nA = nB; dstA = dstB; ldtA = ldtB; rbA = rbB; rpA = rpB; ksA = ksB; k0A = k0B; k1A = k1B; it = nx; \
                _Pragma("unroll") for (int i_ = 0; i_ < 16; ++i_) vA[i_] = vB[i_]; } \
        } } while (0)

#ifndef XRES_BF16
#define XRES_BF16 1
#endif
#ifndef PG8_SP2
#define PG8_SP2 true
#endif
#ifndef PG8_ALIGN
#define PG8_ALIGN true
#endif
#ifndef PG8_ALIGN_P1
#define PG8_ALIGN_P1 PG8_ALIGN
#endif
#ifndef PH_MASK
#define PH_MASK 0xFFFFFFFFu
#endif
#define PH(k) ((PH_MASK >> (k)) & 1u)
struct Args { const float* in[19]; float* out; unsigned char* ws; };
enum { I_X = 0, I_C, I_POS, I_WADA, I_BADA, I_GPREMIX, I_GPOSTMIX, I_GPREMLP, I_GPOSTMLP, I_WIN, I_GQ, I_WUQ, I_GKV, I_WUKV, I_WOSB, I_WOMLA, I_WOUT, I_WUP, I_WDOWN };

typedef __attribute__((address_space(4))) const unsigned char* kargp_t;
__device__ __forceinline__ __attribute__((address_space(1))) unsigned char* lw_(unsigned char* p) { __attribute__((address_space(1))) unsigned char* q = (__attribute__((address_space(1))) unsigned char*)p; asm volatile("" : "+s"(q)); return q; }
__device__ __forceinline__ kargp_t lwk_() { kargp_t p = (kargp_t)__builtin_amdgcn_kernarg_segment_ptr(); asm volatile("" : "+s"(p)); return p; }
#define KIN(k) ((const float*)(*(const __attribute__((address_space(1))) float* const __attribute__((address_space(4)))*)(lwk_() + 8 * (k))))
__global__ void __launch_bounds__(NWAVES * 64, 2) hybrid_fwd(Args args) {
    extern __shared__ __attribute__((aligned(16))) unsigned char lds_raw[];
    Frame F;
    F.lds = (LAS unsigned char*)lds_raw;
    F.tid = threadIdx.x; F.lane = F.tid & 63; F.wave = __builtin_amdgcn_readfirstlane(F.tid >> 6);
    F.G = gridDim.x; F.gw = blockIdx.x * NWAVES + F.wave; F.NGW = F.G * NWAVES;
    unsigned char* ws = args.ws;
    gu32* ctl = (gu32*)(ws + WS_CTL);
    for (int u = F.tid; u < (LDS_BYTES - LDSCTL_OFF) / 4; u += NWAVES * 64) ((LAS unsigned*)(F.lds + LDSCTL_OFF))[u] = 0u;
    __syncthreads();
    XcdBarrier bar = xcd_barrier_post((unsigned*)(ctl + CW_BAR), (volatile LAS unsigned*)(F.lds + MISC_OFF) + 8);
#define GRID_BAR() xcd_barrier(bar)

#define ada ((float*)(lw_(ws) + WS_ADA))
#define tab ((float*)(lw_(ws) + WS_TAB))
#define adap ((float*)(lw_(ws) + WS_ADAP))
#define Hb ((bf16*)(lw_(ws) + A_H))
#define PROJ ((bf16*)(lw_(ws) + A_PROJ))
#define SSQ ((float*)(lw_(ws) + A_CQ))
#define KR ((bf16*)(lw_(ws) + A_KR))
#define QF ((bf16*)(lw_(ws) + A_Q))
#define KVF ((bf16*)(lw_(ws) + A_KV))
#define OSB ((bf16*)(lw_(ws) + A_OSB))
#define MRG ((bf16*)(lw_(ws) + A_MRG))
#define Yb ((bf16*)(lw_(ws) + A_Y))
#define XB ((bf16*)(lw_(ws) + A_TMP))
#define U ((bf16*)(lw_(ws) + A_U))
#define GRB (lw_(ws) + A_TMP + 64 * MiB)
#define GSB (lw_(ws) + A_Y + 64 * MiB)
#define x_in KIN(I_X)
#define wl (lw_(ws) + WS_W + (size_t)l * W_LAYER)
#define adl (ada + (size_t)l * BATCH * 6 * D)
    float* xo = args.out;


#ifndef PRO_REP
#define PRO_REP 1
#endif
#pragma unroll 1
    for (int prep_ = 0; prep_ < PRO_REP; ++prep_) {
#ifndef P0A_REP
#define P0A_REP 1
#endif
#pragma unroll 1
    for (int p0r_ = 0; p0r_ < P0A_REP; ++p0r_)
    if (PH(0)) {
        LAS float* cact = (LAS float*)F.lds;
        for (int i = F.tid; i < BATCH * D; i += NWAVES * 64) { const float cv = KIN(I_C)[i]; cact[i] = cv / (1.0f + __expf(-cv)); }
        __syncthreads();
#ifdef P0A_REP_NOGEMV
        if (p0r_ == 0)
#endif
        for (int task = blockIdx.x; task < DEPTH * 32 * 12; task += F.G) {
            const int l = task / (32 * 12), s = (task / 12) % 32, cb = task % 12;
            const int col = cb * 2048 + F.tid * 4;
            const float* wp = KIN(I_WADA) + ((size_t)l * D + s * 128) * (6 * D) + col;
            f32x4 a0 = {0.f, 0.f, 0.f, 0.f}, a1 = {0.f, 0.f, 0.f, 0.f};
            f32x4 w[8];
#pragma unroll
            for (int j = 0; j < 8; ++j) w[j] = NT_LD((const f32x4*)(wp + (size_t)j * (6 * D)));
#pragma unroll 1
            for (int k = 0; k < 128; k += 8) { f32x4 wn[8];
                if (k + 8 < 128) {
#pragma unroll
                    for (int j = 0; j < 8; ++j) wn[j] = NT_LD((const f32x4*)(wp + (size_t)(k + 8 + j) * (6 * D))); }
#pragma unroll
                for (int j = 0; j < 8; ++j) { const float c0 = cact[s * 128 + k + j], c1 = cact[D + s * 128 + k + j]; a0 += w[j] * c0; a1 += w[j] * c1; }
#pragma unroll
                for (int j = 0; j < 8; ++j) w[j] = wn[j]; }
            *(f32x4*)(adap + (((size_t)s * DEPTH + l) * BATCH + 0) * (6 * D) + col) = a0;
            *(f32x4*)(adap + (((size_t)s * DEPTH + l) * BATCH + 1) * (6 * D) + col) = a1;
        }
        __syncthreads();
        for (int e = blockIdx.x * (NWAVES * 64) + F.tid; e < M * 32; e += F.G * NWAVES * 64) {
            const int m = e >> 5, i = e & 31;
            const float inv = powf(10000.0f, -(float)i / 32.0f);
            const float ang = (float)(((const int*)KIN(I_POS))[m]) * inv;
            const double rev = (double)ang * 0.15915494309189533577; const float fr = (float)(rev - rint(rev));
            tab[2 * e] = __builtin_amdgcn_cosf(fr); tab[2 * e + 1] = __builtin_amdgcn_sinf(fr);
        }
        for (int l = 0; l < DEPTH; ++l) { unsigned char* zb = ws + WS_W + l * W_LAYER + W_IN;
            for (int i = blockIdx.x * (NWAVES * 64) + F.tid; i < (D / 64) * 1536; i += F.G * NWAVES * 64) { const int kt = i / 1536, u = i % 1536;
                *(v4u*)(zb + ((size_t)kt * PROJ_W + C_GATE_SRC) * 128 + (size_t)u * 16) = (v4u){0u, 0u, 0u, 0u}; } }
        LAS float* scr = (LAS float*)(F.lds) + F.wave * (64 * 65);
        CONVERT_ITEMS(0, DEPTH * I_LAYER, F.gw, F.NGW);
        if (P0A_REP > 1) __syncthreads();
    }
    GRID_BAR();
    if (PH(1)) for (int e = blockIdx.x * (NWAVES * 64) + F.tid; e < DEPTH * BATCH * 6 * D; e += F.G * NWAVES * 64) {
        const int l = e / (BATCH * 6 * D), n = e % (6 * D);
        float s = KIN(I_BADA)[(size_t)l * 6 * D + n];
#pragma unroll 8
        for (int k = 0; k < 32; ++k) s += adap[(size_t)k * (DEPTH * BATCH * 6 * D) + e];
        ada[e] = s;
    }
    GRID_BAR();
    if (PH(2)) thin_phase<false, true>(F, x_in, nullptr, nullptr, Hb, nullptr, nullptr, KIN(I_GPREMIX), ada + D, ada);
    GRID_BAR();
    }

    for (int l = 0; l < DEPTH; ++l) {
#ifndef P1_REP
#define P1_REP 1
#endif
#pragma unroll 1
        for (int rp_ = 0; rp_ < P1_REP; ++rp_) {
        if (PH(3)) { pg8::Gemm g{Hb, (const bf16*)(wl + W_IN), M, PROJ_W, D}; pg8::StaticOrder S; S.init(M, PROJ_W, F.G, (int)blockIdx.x);
          pg8::EpiProj E{PROJ, PROJ_W, SSQ, KR, tab, (pg8::u32x4*)GRB, (pg8::u32x4*)GSB};
          pg8::gemm_phase<pg8::EpiProj, pg8::StaticOrder, PG8_ALIGN_P1, PG8_SP2>(F.lds, g, S, E); }
        }
        GRID_BAR();
#ifndef P3_REP
#define P3_REP 1
#endif
#pragma unroll 1
        for (int rep3 = 0; rep3 < P3_REP; ++rep3) {
        if (PH(5)) { pg8::Gemm g{PROJ + C_QD, (const bf16*)(wl + W_UQ), M, QW, QRANK, PROJ_W}; pg8::StaticOrder S; S.init(M, QW, F.G, (int)blockIdx.x);
          pg8::EpiRope E{QF, QW, tab, SSQ};
          pg8::gemm_phase<pg8::EpiRope, pg8::StaticOrder, PG8_ALIGN, PG8_SP2>(F.lds, g, S, E); }
        if (PH(5)) { pg8::Gemm g{PROJ + C_KVD, (const bf16*)(wl + W_UKV), M, KVW, KVRANK, PROJ_W}; pg8::EpiScale E{KVF, KVW, SSQ};
          if (F.G == 256) { pg8::UnevenOrder S; S.init(M, KVW, F.G, (int)blockIdx.x);
            pg8::gemm_phase<pg8::EpiScale, pg8::UnevenOrder, PG8_ALIGN, PG8_SP2>(F.lds, g, S, E); }
          else { pg8::StaticOrder S; S.init(M, KVW, F.G, (int)blockIdx.x);
            pg8::gemm_phase<pg8::EpiScale, pg8::StaticOrder, PG8_ALIGN, PG8_SP2>(F.lds, g, S, E); } }
        }
        GRID_BAR();
#ifndef P4_REP
#define P4_REP 1
#endif
#pragma unroll 1
        for (int rp_ = 0; rp_ < P4_REP; ++rp_) {
        if (PH(6)) for (int item = blockIdx.x; item < 512; item += F.G) {
            const int kind = item >> 8, c = item & 255, bh = (c & 7) * 4 + ((c >> 3) >> 3), y = (c >> 3) & 7, b = bh >> 4, h = bh & 15;
            const size_t rb = (size_t)b * SEQ;
            if (kind == 0) { if (PH(14)) {
                att::Tensors T{PROJ + rb * PROJ_W + h * 128, PROJ_W, PROJ + rb * PROJ_W + SBW + h * 128, PROJ_W, PROJ + rb * PROJ_W + 2 * SBW + h * 128, PROJ_W, nullptr, OSB + rb * (2 * SBW) + h * 128, 2 * SBW};
                att::attn_unit<0>(T, 15 - y, 0.08838834764831845f * 1.4426950408889634f, (LAS char*)F.lds);
                att::attn_unit<0>(T, y, 0.08838834764831845f * 1.4426950408889634f, (LAS char*)F.lds); }
            } else if (PH(15)) {
                att::Tensors T{QF + rb * QW + h * 192, QW, KVF + rb * KVW + h * 256, KVW, KVF + rb * KVW + h * 256 + 128, KVW, KR + rb * ROPE, OSB + rb * (2 * SBW) + SBW + h * 128, 2 * SBW};
                att::attn_unit<1>(T, 15 - y, 0.07216878364870323f * 1.4426950408889634f, (LAS char*)F.lds);
                att::attn_unit<1>(T, y, 0.07216878364870323f * 1.4426950408889634f, (LAS char*)F.lds);
            }
        }
        }
        GRID_BAR();
#ifndef P5_REP
#define P5_REP 1
#endif
#pragma unroll 1
        for (int rep5 = 0; rep5 < P5_REP; ++rep5)
        if (PH(7)) { pg8::Gemm g{OSB, (const bf16*)(wl + W_OSB), M, D, 2 * SBW}; pg8::StaticOrder S; S.init(M, D, F.G, (int)blockIdx.x);
          pg8::EpiGateMerge E{MRG, D, (const pg8::u32x4*)GRB, (const pg8::u32x4*)GSB};
          pg8::gemm_phase<pg8::EpiGateMerge, pg8::StaticOrder, PG8_ALIGN, PG8_SP2>(F.lds, g, S, E); }
        GRID_BAR();
#ifndef P7_REP
#define P7_REP 1
#endif
#pragma unroll 1
        for (int rep7 = 0; rep7 < P7_REP; ++rep7) {
#ifdef P7_REPB
        if (rep7) GRID_BAR();
#endif
#ifdef P7_MREP
        if (PH(9)) { pg8::Gemm g{MRG, (const bf16*)(wl + W_OUT), M, D, D}; pg8::RepOrder S; S.init(M, D, F.G, (int)blockIdx.x); S.reps = P7_MREP;
          pg8::EpiBf16<0> E{Yb, D};
          pg8::gemm_phase<pg8::EpiBf16<0>, pg8::RepOrder, PG8_ALIGN, PG8_SP2>(F.lds, g, S, E); }
#else
        if (PH(9)) { pg8::Gemm g{MRG, (const bf16*)(wl + W_OUT), M, D, D}; pg8::StaticOrder S; S.init(M, D, F.G, (int)blockIdx.x);
          pg8::EpiBf16<0> E{Yb, D};
          pg8::gemm_phase<pg8::EpiBf16<0>, pg8::StaticOrder, PG8_ALIGN, PG8_SP2>(F.lds, g, S, E); }
#endif
        }
        GRID_BAR();
#if XRES_BF16
#ifdef THIN_REP
        for (int rp_ = 1; rp_ < THIN_REP; ++rp_) { if (l == 0) thin_phase<true, true, false, true>(F, x_in, (bf16*)GRB, Yb, (bf16*)GSB, KIN(I_GPOSTMIX) + (size_t)l * D, adl + 2 * D, KIN(I_GPREMLP) + (size_t)l * D, adl + 4 * D, adl + 3 * D);
            else thin_phase<true, true, true, true>(F, XB, (bf16*)GRB, Yb, (bf16*)GSB, KIN(I_GPOSTMIX) + (size_t)l * D, adl + 2 * D, KIN(I_GPREMLP) + (size_t)l * D, adl + 4 * D, adl + 3 * D); }
#endif
        if (PH(10)) { if (l == 0) thin_phase<true, true, false, true>(F, x_in, XB, Yb, Hb, KIN(I_GPOSTMIX) + (size_t)l * D, adl + 2 * D, KIN(I_GPREMLP) + (size_t)l * D, adl + 4 * D, adl + 3 * D);
            else thin_phase<true, true, true, true>(F, XB, XB, Yb, Hb, KIN(I_GPOSTMIX) + (size_t)l * D, adl + 2 * D, KIN(I_GPREMLP) + (size_t)l * D, adl + 4 * D, adl + 3 * D); }
#else
        if (PH(10)) thin_phase<true, true>(F, l == 0 ? x_in : (const float*)xo, xo, Yb, Hb, KIN(I_GPOSTMIX) + (size_t)l * D, adl + 2 * D, KIN(I_GPREMLP) + (size_t)l * D, adl + 4 * D, adl + 3 * D);
#endif
        GRID_BAR();
#ifndef P9_REP
#define P9_REP 1
#endif
#pragma unroll 1
        for (int rp_ = 0; rp_ < P9_REP; ++rp_) {
        if (PH(11)) { pg8::Gemm g{Hb, (const bf16*)(wl + W_UP), M, DFF, D}; pg8::StaticOrder S; S.init(M, DFF, F.G, (int)blockIdx.x);
          pg8::EpiBf16<1> E{U, DFF};
          pg8::gemm_phase<pg8::EpiBf16<1>, pg8::StaticOrder, PG8_ALIGN, PG8_SP2>(F.lds, g, S, E); }
        }
        GRID_BAR();
#ifndef P10_REP
#define P10_REP 1
#endif
#pragma unroll 1
        for (int rp_ = 0; rp_ < P10_REP; ++rp_) {
        if (PH(12)) { pg8::Gemm g{U, (const bf16*)(wl + W_DOWN), M, D, DFF}; pg8::StaticOrder S; S.init(M, D, F.G, (int)blockIdx.x);
          pg8::EpiBf16<0> E{Yb, D};
          pg8::gemm_phase<pg8::EpiBf16<0>, pg8::StaticOrder, PG8_ALIGN, PG8_SP2>(F.lds, g, S, E); }
        }
        GRID_BAR();
#if XRES_BF16
#ifdef THIN_REP
        for (int rp_ = 1; rp_ < THIN_REP; ++rp_) if (l + 1 < DEPTH) { const float* adn = ada + (size_t)(l + 1) * BATCH * 6 * D;
                thin_phase<true, true, true, true>(F, XB, (bf16*)GRB, Yb, (bf16*)GSB, KIN(I_GPOSTMLP) + (size_t)l * D, adl + 5 * D, KIN(I_GPREMIX) + (size_t)(l + 1) * D, adn + D, adn); }
#endif
        if (PH(13)) { if (l + 1 < DEPTH) { const float* adn = ada + (size_t)(l + 1) * BATCH * 6 * D;
                thin_phase<true, true, true, true>(F, XB, XB, Yb, Hb, KIN(I_GPOSTMLP) + (size_t)l * D, adl + 5 * D, KIN(I_GPREMIX) + (size_t)(l + 1) * D, adn + D, adn); }
            else thin_phase<true, false, true, false>(F, XB, xo, Yb, nullptr, KIN(I_GPOSTMLP) + (size_t)l * D, adl + 5 * D, nullptr, nullptr, nullptr); }
#else
        if (PH(13)) { if (l + 1 < DEPTH) { const float* adn = ada + (size_t)(l + 1) * BATCH * 6 * D;
                thin_phase<true, true>(F, xo, xo, Yb, Hb, KIN(I_GPOSTMLP) + (size_t)l * D, adl + 5 * D, KIN(I_GPREMIX) + (size_t)(l + 1) * D, adn + D, adn); }
            else thin_phase<true, false>(F, xo, xo, Yb, nullptr, KIN(I_GPOSTMLP) + (size_t)l * D, adl + 5 * D, nullptr, nullptr, nullptr); }
#endif
        if (l + 1 < DEPTH) GRID_BAR();
    }
    if (blockIdx.x == 0 && F.tid == 0 && __hip_atomic_load((unsigned*)(ctl + CW_BAR) + XB_TMO, RLX_AGENT) != 0u) xo[0] = __builtin_nanf("");
}
#undef ada
#undef tab
#undef adap
#undef Hb
#undef PROJ
#undef SSQ
#undef KR
#undef QF
#undef KVF
#undef OSB
#undef MRG
#undef Yb
#undef XB
#undef U
#undef GRB
#undef GSB
#undef x_in
#undef wl
#undef adl


extern "C" void kernel_launch(void* const* d_in, const int* in_sizes, int n_in, void* d_out, int out_size, void* d_ws, size_t ws_size, hipStream_t stream) {
    static int grid = 0;
    if (grid == 0) {
        if (n_in != 19 || out_size != M * D || ws_size < WS_END) { fprintf(stderr, "kernel_launch: unexpected shapes (n_in %d, out %d, ws %zu < %zu)\n", n_in, out_size, ws_size, (size_t)WS_END); grid = -1; return; }
        int dev = 0, cus = 0, per_cu = 0;
        if (hipGetDevice(&dev) != hipSuccess || hipDeviceGetAttribute(&cus, hipDeviceAttributeMultiprocessorCount, dev) != hipSuccess) { grid = -1; return; }
        if (hipFuncSetAttribute((const void*)hybrid_fwd, hipFuncAttributeMaxDynamicSharedMemorySize, LDS_BYTES) != hipSuccess) { fprintf(stderr, "kernel_launch: hipFuncSetAttribute failed\n"); grid = -1; return; }
        if (hipOccupancyMaxActiveBlocksPerMultiprocessor(&per_cu, (const void*)hybrid_fwd, NWAVES * 64, LDS_BYTES) != hipSuccess || per_cu < 1) { fprintf(stderr, "kernel_launch: occupancy query says %d\n", per_cu); (void)hipGetLastError(); }
        grid = cus;
    }
    if (grid < 0) return;
    if (hipMemsetAsync((char*)d_ws + WS_CTL, 0, CTL_ZERO_BYTES, stream) != hipSuccess) return;
    Args a{};
    for (int i = 0; i < 19; ++i) a.in[i] = (const float*)d_in[i];
    a.out = (float*)d_out; a.ws = (unsigned char*)d_ws;
    hipLaunchKernelGGL(hybrid_fwd, dim3(grid), dim3(NWAVES * 64), LDS_BYTES, stream, a);
#ifdef DBG_CHECK
    hipLaunchKernelGGL(dbg_check, dim3(DBG_NCHK), dim3(256), 0, stream, a, (unsigned*)((char*)d_ws + 4096));
    hipLaunchKernelGGL(dbg_report, dim3(1), dim3(64), 0, stream, (float*)d_out, (const unsigned*)((char*)d_ws + 4096));
#endif
}
```

```cpp
#include <hip/hip_runtime.h>
#include <cstdio>
#include <cstdint>
#include <cmath>
#ifndef PG8_WGM
#define PG8_WGM 8
#endif
namespace pg8 {
#define PG8_LAS __attribute__((address_space(3)))
typedef unsigned short bf16_t;
typedef short bf16x8 __attribute__((ext_vector_type(8)));
typedef float f32x4 __attribute__((ext_vector_type(4)));
typedef unsigned u32x4 __attribute__((ext_vector_type(4)));
constexpr int BM = 256, BK = 64, HALF = 128, HTB = HALF * BK * 2  , STAGE_BYTES = 8 * HTB, NXCD = 8, WGM = PG8_WGM;

__host__ __device__ __forceinline__ int lds_byte(int r, int c) { const int st = (r >> 4) * 2 + (c >> 5), rr = r & 15, cc = c & 31, ob = rr * 64 + cc * 2; return st * 1024 + (ob ^ (((ob >> 9) & 1) << 5)); }
__host__ __device__ __forceinline__ void stage_rc(int b, int& R, int& C) { const int st = b / 1024, sb = b % 1024, swz = sb ^ (((sb >> 9) & 1) << 5); R = (st >> 1) * 16 + swz / 64; C = (st & 1) * 32 + (swz % 64) / 2; }
__host__ __device__ __forceinline__ int perm32(int rho) { const int n = rho >> 4, i = rho & 15; return 8 * (i >> 2) + 4 * n + (i & 3); }

struct Unit { int pm, pn; };
struct Gemm { const bf16_t* A; const bf16_t* Bt; int M, N, K; int lda = 0; };

struct StaticOrder {
    int nM, nN, nwg, G, c;
    __host__ __device__ void init(int M, int N, int G_, int c_) { nM = M / BM; nN = N / BM; nwg = nM * nN; G = G_; c = c_; }
    __host__ __device__ bool next(int i, Unit& u) const {
        const long L = (long)i * G + c; if (L >= nwg) return false;
        int wgid = (int)L; { const int q = nwg / NXCD, r = nwg % NXCD, xcd = wgid % NXCD, off = wgid / NXCD; wgid = (xcd < r ? xcd * (q + 1) : r * (q + 1) + (xcd - r) * q) + off; }
        const int nig = WGM * nN, gid = wgid / nig, fm = gid * WGM, gsz = (nM - fm) < WGM ? (nM - fm) : WGM;
        u.pm = fm + ((wgid % nig) % gsz); u.pn = (wgid % nig) / gsz; return true;
    }
    __device__ __forceinline__ void a_ready(const Unit&) const {}
    __device__ __forceinline__ void done(const Unit&) const {}
};

struct UnevenOrder : StaticOrder {
    __host__ __device__ bool next(int i, Unit& u) const {
        long L; const int h = G / 2;
        if (c < h) { if (i > 0) return false; L = c; } else { if (i > 2) return false; L = h + (long)h * i + (c - h); }
        if (L >= nwg) return false;
        int wgid = (int)L; { const int q = nwg / NXCD, r = nwg % NXCD, xcd = wgid % NXCD, off = wgid / NXCD; wgid = (xcd < r ? xcd * (q + 1) : r * (q + 1) + (xcd - r) * q) + off; }
        const int nig = WGM * nN, gid = wgid / nig, fm = gid * WGM, gsz = (nM - fm) < WGM ? (nM - fm) : WGM;
        u.pm = fm + ((wgid % nig) % gsz); u.pn = (wgid % nig) / gsz; return true;
    }
};

struct RepOrder : StaticOrder {
    int reps;
    __host__ __device__ bool next(int i, Unit& u) const { const int per = (nwg + G - 1) / G; if (i >= per * reps) return false; return StaticOrder::next(i % per, u); }
};
__device__ __forceinline__ unsigned cvt_pk_bf16(float lo, float hi) { unsigned r; asm volatile("v_cvt_pk_bf16_f32 %0, %1, %2" : "=v"(r) : "v"(lo), "v"(hi)); return r; }
typedef float f32x2 __attribute__((ext_vector_type(2)));

__device__ __forceinline__ float bf_lo(unsigned w) { return __builtin_bit_cast(float, w << 16); }
__device__ __forceinline__ float bf_hi(unsigned w) { return __builtin_bit_cast(float, w & 0xffff0000u); }
__device__ __forceinline__ float sigmoidf_fast(float x) { return __builtin_amdgcn_rcpf(1.0f + __builtin_amdgcn_exp2f(-1.4426950408889634f * x)); }

#ifndef EPI_WT
#define EPI_WT 0
#endif
__device__ __forceinline__ void st16_out(bf16_t* p, u32x4 w) {
#if EPI_WT
    asm volatile("global_store_dwordx4 %0, %1, off sc1" :: "v"((__attribute__((address_space(1))) u32x4*)p), "v"(w) : "memory");
#else
    *(u32x4*)p = w;
#endif
}
template <int ACT  > struct EpiBf16 {
    static constexpr bool PERM = true, AFTER_DRAIN = false, MID = false;
    bf16_t* O; int ldc;
    __device__ __forceinline__ void operator()(const f32x4 (&acc)[2][2][4][2], const Unit& u, int wr, int wc, int fr, int fq) const {
        const int row0 = u.pm * BM + wr * 64 + fr, col0 = u.pn * BM + wc * 32 + 8 * fq;
#pragma unroll
        for (int ai = 0; ai < 2; ++ai)
#pragma unroll
            for (int m = 0; m < 4; ++m) { bf16_t* rowp = O + (size_t)(row0 + ai * HALF + m * 16) * ldc + col0;
#pragma unroll
                for (int bj = 0; bj < 2; ++bj) { f32x4 v0 = acc[ai][bj][m][0], v1 = acc[ai][bj][m][1];
                    if (ACT == 1) {
#pragma unroll
                        for (int j = 0; j < 4; ++j) { const float a = fmaxf(v0[j], 0.f), b = fmaxf(v1[j], 0.f); v0[j] = a * a; v1[j] = b * b; } }
                    u32x4 w; w.x = cvt_pk_bf16(v0[0], v0[1]); w.y = cvt_pk_bf16(v0[2], v0[3]); w.z = cvt_pk_bf16(v1[0], v1[1]); w.w = cvt_pk_bf16(v1[2], v1[3]);
                    st16_out(rowp + bj * HALF, w);
                    } }
    }
};
struct EpiProj {
    static constexpr bool PERM = true, AFTER_DRAIN = false, MID = false;
    static constexpr int SSQ_T0 = 24, ROPE_T = 30, GATE_T0 = 31;
    bf16_t* O; int ldc; float* SSQ; bf16_t* KRo; const float* tab; u32x4* GR; u32x4* GS;
    __device__ __forceinline__ void operator()(const f32x4 (&acc)[2][2][4][2], const Unit& u, int wr, int wc, int fr, int fq) const {
        const int row0 = u.pm * BM + wr * 64 + fr, col0 = u.pn * BM + wc * 32 + 8 * fq;
        const bool do_ssq = (u.pn >= SSQ_T0) && (u.pn < SSQ_T0 + 6), do_rope = (u.pn == ROPE_T) && (wc < 2);
        if (u.pn >= GATE_T0) {
            const int t = u.pn - GATE_T0; const size_t e0 = ((size_t)((u.pm * 16 + (t >> 1)) * 16 + (t & 1))) * 512 + (size_t)((wr * 4 + wc) * 64 + fr + 16 * fq);
#pragma unroll
            for (int ai = 0; ai < 2; ++ai)
#pragma unroll
                for (int m = 0; m < 4; ++m) { float r[8], sg[8];
#pragma unroll
                    for (int n = 0; n < 2; ++n)
#pragma unroll
                        for (int j = 0; j < 4; ++j) { const float e1 = __builtin_amdgcn_exp2f(-1.4426950408889634f * acc[ai][0][m][n][j]), e2 = __builtin_amdgcn_exp2f(-1.4426950408889634f * acc[ai][1][m][n][j]);
                            sg[4 * n + j] = __builtin_amdgcn_rcpf(1.0f + e2); r[4 * n + j] = (1.0f + e2) * __builtin_amdgcn_rcpf(1.0f + e1); }
                    u32x4 rw, sw; rw.x = cvt_pk_bf16(r[0], r[1]); rw.y = cvt_pk_bf16(r[2], r[3]); rw.z = cvt_pk_bf16(r[4], r[5]); rw.w = cvt_pk_bf16(r[6], r[7]);
                    sw.x = cvt_pk_bf16(sg[0], sg[1]); sw.y = cvt_pk_bf16(sg[2], sg[3]); sw.z = cvt_pk_bf16(sg[4], sg[5]); sw.w = cvt_pk_bf16(sg[6], sg[7]);
                    GR[e0 + (size_t)(ai * 8 + m * 2) * 512] = rw; GS[e0 + (size_t)(ai * 8 + m * 2) * 512] = sw; }
            return;
        }
#pragma unroll
        for (int ai = 0; ai < 2; ++ai)
#pragma unroll
            for (int m = 0; m < 4; ++m) { const int row = row0 + ai * HALF + m * 16; bf16_t* rowp = O + (size_t)row * ldc + col0;
                float ss = 0.f;
#pragma unroll
                for (int bj = 0; bj < 2; ++bj) { const f32x4 v0 = acc[ai][bj][m][0], v1 = acc[ai][bj][m][1];
                    u32x4 w; w.x = cvt_pk_bf16(v0[0], v0[1]); w.y = cvt_pk_bf16(v0[2], v0[3]); w.z = cvt_pk_bf16(v1[0], v1[1]); w.w = cvt_pk_bf16(v1[2], v1[3]);
                    st16_out(rowp + bj * HALF, w);
                    if (do_ssq) { const unsigned ww[4] = {w.x, w.y, w.z, w.w};
#pragma unroll
                        for (int q = 0; q < 4; ++q) { const float a = bf_lo(ww[q]), b = bf_hi(ww[q]); ss += a * a + b * b; } }
                    if (bj == 0 && do_rope) { const int co = wc * 32 + 8 * fq; const float* tp = tab + (size_t)row * 64 + co;
                        const f32x4 t0 = *(const f32x4*)tp, t1 = *(const f32x4*)(tp + 4);
                        f32x4 r0, r1;
                        r0[0] = v0[0] * t0[0] - v0[1] * t0[1]; r0[1] = v0[1] * t0[0] + v0[0] * t0[1];
                        r0[2] = v0[2] * t0[2] - v0[3] * t0[3]; r0[3] = v0[3] * t0[2] + v0[2] * t0[3];
                        r1[0] = v1[0] * t1[0] - v1[1] * t1[1]; r1[1] = v1[1] * t1[0] + v1[0] * t1[1];
                        r1[2] = v1[2] * t1[2] - v1[3] * t1[3]; r1[3] = v1[3] * t1[2] + v1[2] * t1[3];
                        u32x4 k; k.x = cvt_pk_bf16(r0[0], r0[1]); k.y = cvt_pk_bf16(r0[2], r0[3]); k.z = cvt_pk_bf16(r1[0], r1[1]); k.w = cvt_pk_bf16(r1[2], r1[3]);
                        *(u32x4*)(KRo + (size_t)row * 64 + co) = k; } }
                if (do_ssq) { ss += __shfl_xor(ss, 16); ss += __shfl_xor(ss, 32);
                    if (fq == 0) SSQ[(size_t)row * 32 + 4 * (u.pn - SSQ_T0) + wc] = ss; } }
    }
};
template <int S0, int NS> __device__ __forceinline__ void row_rms_scales(float (&rs)[2][4], const float* SSQ, int row0, int fq, float inv_dim) {
    float part[2][4];
#pragma unroll
    for (int ai = 0; ai < 2; ++ai)
#pragma unroll
        for (int m = 0; m < 4; ++m) { const float* p = SSQ + (size_t)(row0 + ai * HALF + m * 16) * 32 + S0 + (NS / 4) * fq;
            if constexpr (NS == 16) { const f32x4 v = *(const f32x4*)p; part[ai][m] = (v[0] + v[1]) + (v[2] + v[3]); }
            else { const f32x2 v = *(const f32x2*)p; part[ai][m] = v[0] + v[1]; } }
#pragma unroll
    for (int ai = 0; ai < 2; ++ai)
#pragma unroll
        for (int m = 0; m < 4; ++m) { float t = part[ai][m]; t += __shfl_xor(t, 16); t += __shfl_xor(t, 32); rs[ai][m] = 1.0f / sqrtf(t * inv_dim + 1e-6f); }
}
struct EpiScale {
    static constexpr bool PERM = true, AFTER_DRAIN = false, MID = false;
    bf16_t* O; int ldc; const float* SSQ;
    __device__ __forceinline__ void operator()(const f32x4 (&acc)[2][2][4][2], const Unit& u, int wr, int wc, int fr, int fq) const {
        const int row0 = u.pm * BM + wr * 64 + fr, col0 = u.pn * BM + wc * 32 + 8 * fq;
        float rs[2][4]; row_rms_scales<16, 8>(rs, SSQ, row0, fq, 1.0f / 512.0f);
#pragma unroll
        for (int ai = 0; ai < 2; ++ai)
#pragma unroll
            for (int m = 0; m < 4; ++m) { bf16_t* rowp = O + (size_t)(row0 + ai * HALF + m * 16) * ldc + col0; const float r = rs[ai][m];
#pragma unroll
                for (int bj = 0; bj < 2; ++bj) { const f32x4 v0 = acc[ai][bj][m][0] * r, v1 = acc[ai][bj][m][1] * r;
                    u32x4 w; w.x = cvt_pk_bf16(v0[0], v0[1]); w.y = cvt_pk_bf16(v0[2], v0[3]); w.z = cvt_pk_bf16(v1[0], v1[1]); w.w = cvt_pk_bf16(v1[2], v1[3]);
                    st16_out(rowp + bj * HALF, w); } }
    }
};
struct EpiRope {
    static constexpr bool PERM = true, AFTER_DRAIN = false, MID = false;
    bf16_t* O; int ldc; const float* tab; const float* SSQ;
    __device__ __forceinline__ void operator()(const f32x4 (&acc)[2][2][4][2], const Unit& u, int wr, int wc, int fr, int fq) const {
        const int row0 = u.pm * BM + wr * 64 + fr, col0 = u.pn * BM + wc * 32 + 8 * fq;
        float rs[2][4]; row_rms_scales<0, 16>(rs, SSQ, row0, fq, 1.0f / 1024.0f);
        const int j0 = col0 % 192, j1 = (col0 + HALF) % 192, rbj = (j0 >= 128) ? 0 : (j1 >= 128) ? 1 : -1, jr = (rbj == 0 ? j0 : j1) - 128;
#pragma unroll
        for (int ai = 0; ai < 2; ++ai) {
            f32x4 t0[4], t1[4];
            if (rbj >= 0) {
#pragma unroll
                for (int m = 0; m < 4; ++m) { const float* tp = tab + (size_t)(row0 + ai * HALF + m * 16) * 64 + jr;
                    t0[m] = *(const f32x4*)tp; t1[m] = *(const f32x4*)(tp + 4); }
            }
#pragma unroll
            for (int m = 0; m < 4; ++m) { const int row = row0 + ai * HALF + m * 16; bf16_t* rowp = O + (size_t)row * ldc + col0;
#pragma unroll
                for (int bj = 0; bj < 2; ++bj) { f32x4 v0 = acc[ai][bj][m][0] * rs[ai][m], v1 = acc[ai][bj][m][1] * rs[ai][m];
                    if (bj == rbj) { const f32x4 a0 = t0[m], a1 = t1[m];
                        f32x4 r0, r1;
                        r0[0] = v0[0] * a0[0] - v0[1] * a0[1]; r0[1] = v0[1] * a0[0] + v0[0] * a0[1];
                        r0[2] = v0[2] * a0[2] - v0[3] * a0[3]; r0[3] = v0[3] * a0[2] + v0[2] * a0[3];
                        r1[0] = v1[0] * a1[0] - v1[1] * a1[1]; r1[1] = v1[1] * a1[0] + v1[0] * a1[1];
                        r1[2] = v1[2] * a1[2] - v1[3] * a1[3]; r1[3] = v1[3] * a1[2] + v1[2] * a1[3];
                        v0 = r0; v1 = r1; }
                    u32x4 w; w.x = cvt_pk_bf16(v0[0], v0[1]); w.y = cvt_pk_bf16(v0[2], v0[3]); w.z = cvt_pk_bf16(v1[0], v1[1]); w.w = cvt_pk_bf16(v1[2], v1[3]);
                    st16_out(rowp + bj * HALF, w); } }
            asm volatile("" ::: "memory"); }
    }
};
struct EpiGateMerge {
    static constexpr bool PERM = true, AFTER_DRAIN = false, MID = true;
    bf16_t* O; int ldo; const u32x4* GR; const u32x4* GS;
    __device__ __forceinline__ void mid(f32x4 (&acc)[2][2][4][2], const Unit& u, int wr, int wc, int fr, int fq) const {
        int fr_ = fr, fq_ = fq; asm volatile("" : "+v"(fr_), "+v"(fq_));
        const u32x4* p = GR + (size_t)((u.pm * 16 + u.pn) * 16) * 512 + (size_t)((wr * 4 + wc) * 64 + fr_ + 16 * fq_);
        u32x4 g[2][4][2];
#pragma unroll
        for (int ai = 0; ai < 2; ++ai)
#pragma unroll
            for (int m = 0; m < 4; ++m)
#pragma unroll
                for (int bj = 0; bj < 2; ++bj) g[ai][m][bj] = p[(ai * 8 + m * 2 + bj) * 512];
#pragma unroll
        for (int ai = 0; ai < 2; ++ai)
#pragma unroll
            for (int m = 0; m < 4; ++m)
#pragma unroll
                for (int bj = 0; bj < 2; ++bj) { const u32x4 a = g[ai][m][bj]; const unsigned aw[4] = {a.x, a.y, a.z, a.w};
#pragma unroll
                    for (int q = 0; q < 4; ++q) { acc[ai][bj][m][q >> 1][2 * (q & 1)] *= bf_lo(aw[q]); acc[ai][bj][m][q >> 1][2 * (q & 1) + 1] *= bf_hi(aw[q]); } }
    }
    __device__ __forceinline__ void operator()(const f32x4 (&acc)[2][2][4][2], const Unit& u, int wr, int wc, int fr, int fq) const {
        const int row0 = u.pm * BM + wr * 64 + fr, col0 = u.pn * BM + wc * 32 + 8 * fq;
        const u32x4* p = GS + (size_t)((u.pm * 16 + u.pn) * 16) * 512 + (size_t)((wr * 4 + wc) * 64 + fr + 16 * fq);
        u32x4 g[2][4][2];
#pragma unroll
        for (int ai = 0; ai < 2; ++ai)
#pragma unroll
            for (int m = 0; m < 4; ++m)
#pragma unroll
                for (int bj = 0; bj < 2; ++bj) g[ai][m][bj] = p[(ai * 8 + m * 2 + bj) * 512];
#pragma unroll
        for (int ai = 0; ai < 2; ++ai)
#pragma unroll
            for (int m = 0; m < 4; ++m) { bf16_t* op = O + (size_t)(row0 + ai * HALF + m * 16) * ldo + col0;
#pragma unroll
                for (int bj = 0; bj < 2; ++bj) { const f32x4 v0 = acc[ai][bj][m][0], v1 = acc[ai][bj][m][1]; const u32x4 s = g[ai][m][bj];
                    u32x4 w; w.x = cvt_pk_bf16(v0[0] * bf_lo(s.x), v0[1] * bf_hi(s.x)); w.y = cvt_pk_bf16(v0[2] * bf_lo(s.y), v0[3] * bf_hi(s.y));
                    w.z = cvt_pk_bf16(v1[0] * bf_lo(s.z), v1[1] * bf_hi(s.z)); w.w = cvt_pk_bf16(v1[2] * bf_lo(s.w), v1[3] * bf_hi(s.w));
                    st16_out(op + bj * HALF, w); } }
    }
};

template <class Epi, class Sched, bool ALIGN_EPI = false, bool SP2 = false>
__device__ __forceinline__ void gemm_phase(PG8_LAS unsigned char* lds, const Gemm g, const Sched& S, const Epi& E) {
    int tid_ = threadIdx.x; asm volatile("" : "+v"(tid_));
    const int tid = tid_, wid = __builtin_amdgcn_readfirstlane(tid >> 6), lane = tid & 63, wr = wid >> 2, wc = wid & 3, fr = lane & 15, fq = lane >> 4;
    const int K = g.K, nt = K / BK, lda = g.lda ? g.lda : K;
#ifndef PG8_KROT
#define PG8_KROT 0
#endif
#if PG8_KROT
    const int ktm = nt - 1, kt0 = Epi::MID ? 0 : ((int)((blockIdx.x & 7u) * (unsigned)(nt >> 3)) * PG8_KROT) & ktm;
#define PG8_KP(base, t) ((base) + (size_t)(((t) + kt0) & ktm) * kstep)
#define PG8_KPB(base, t) ((base) + (size_t)(((t) + kt0) & ktm) * kstepB)
#else
#define PG8_KP(base, t) ((base) + (size_t)(t) * kstep)
#define PG8_KPB(base, t) ((base) + (size_t)(t) * kstepB)
#endif
    unsigned voffA[2], voffB[2];
#pragma unroll
    for (int i = 0; i < 2; ++i) { int R, C; stage_rc(tid * 16 + i * 8192, R, C); const int Rb = Epi::PERM ? ((R & ~31) + perm32(R & 31)) : R;
        voffA[i] = (unsigned)(R * lda + C) * 2u; voffB[i] = (unsigned)(Rb * BK + C) * 2u; }
    const size_t kstep = (size_t)(BK * 2);
    const size_t kstepB = (size_t)g.N * (BK * 2);
    const size_t hstepA = (size_t)HALF * lda * 2, hstepB = (size_t)HALF * BK * 2;
    const size_t tstepA = 2 * hstepA, tstepB = 2 * hstepB;
    const unsigned ldsw = (unsigned)wid * 1024u;
    const int aoff = lds_byte(wr * 64 + fr, fq * 8), boff = lds_byte(wc * 32 + fr, fq * 8);
#define PG8_SA(b, h) (((b) * 2 + (h)) * HTB)
#define PG8_SB(b, h) ((4 + (b) * 2 + (h)) * HTB)
#define PG8_STAGE(bufoff, gbase, voff) do { _Pragma("unroll") for (int _i = 0; _i < 2; ++_i) \
        __builtin_amdgcn_global_load_lds((const unsigned*)((const char*)(gbase) + (voff)[_i]), (PG8_LAS unsigned*)(lds + (bufoff) + ldsw + _i * 8192), 16, 0, 0); } while (0)
#define PG8_LDA(dst, b, h) do { _Pragma("unroll") for (int m = 0; m < 4; ++m) _Pragma("unroll") for (int k = 0; k < 2; ++k) dst[m][k] = *(const PG8_LAS bf16x8*)(lds + PG8_SA(b, h) + aoff + m * 2048 + k * 1024); } while (0)
#define PG8_LDB(dst, b, h) do { _Pragma("unroll") for (int n = 0; n < 2; ++n) _Pragma("unroll") for (int k = 0; k < 2; ++k) dst[n][k] = *(const PG8_LAS bf16x8*)(lds + PG8_SB(b, h) + boff + n * 2048 + k * 1024); } while (0)
#ifndef PG8_PRIO
#define PG8_PRIO 1
#endif
#define PG8_MMA(ai, bj, At, Bt) do { if (PG8_PRIO) __builtin_amdgcn_s_setprio(PG8_PRIO); _Pragma("unroll") for (int m = 0; m < 4; ++m) _Pragma("unroll") for (int n = 0; n < 2; ++n) _Pragma("unroll") for (int k = 0; k < 2; ++k) \
        acc[ai][bj][m][n] = __builtin_amdgcn_mfma_f32_16x16x32_bf16(Bt[n][k], At[m][k], acc[ai][bj][m][n], 0, 0, 0); if (PG8_PRIO) __builtin_amdgcn_s_setprio(0); } while (0)
#define PG8_WAIT_V(n) asm volatile("s_waitcnt vmcnt(" #n ")" ::: "memory")
#define PG8_WAIT_L(n) asm volatile("s_waitcnt lgkmcnt(" #n ")" ::: "memory")
#define PG8_BAR __builtin_amdgcn_s_barrier()
#define PG8_SCHED __builtin_amdgcn_sched_barrier(0)
    Unit cur, nxt; int ui = 0;
    if (!S.next(0, cur)) return;
    f32x4 acc[2][2][4][2];
#pragma unroll
    for (int a = 0; a < 2; ++a)
#pragma unroll
        for (int b = 0; b < 2; ++b)
#pragma unroll
            for (int m = 0; m < 4; ++m)
#pragma unroll
                for (int n = 0; n < 2; ++n) acc[a][b][m][n] = (f32x4){0.f, 0.f, 0.f, 0.f};
    bf16x8 At[4][2], B0[2][2], B1[2][2];
    const char* cA = (const char*)g.A + (size_t)cur.pm * tstepA; const char* cB = (const char*)g.Bt + (size_t)cur.pn * tstepB;
    S.a_ready(cur);
    if constexpr (SP2) {
        PG8_STAGE(PG8_SB(0, 0), PG8_KPB(cB, 0), voffB); PG8_STAGE(PG8_SB(0, 1), PG8_KPB(cB, 0) + hstepB, voffB); PG8_STAGE(PG8_SA(0, 0), PG8_KP(cA, 0), voffA); PG8_STAGE(PG8_SA(0, 1), PG8_KP(cA, 0) + hstepA, voffA);
        if (wr == 1) PG8_BAR;
        PG8_WAIT_V(2); PG8_BAR;
        PG8_STAGE(PG8_SB(1, 0), PG8_KPB(cB, 1), voffB); PG8_STAGE(PG8_SA(1, 0), PG8_KP(cA, 1), voffA); PG8_STAGE(PG8_SB(1, 1), PG8_KPB(cB, 1) + hstepB, voffB);
        PG8_WAIT_V(6); PG8_BAR;
    } else {
        PG8_STAGE(PG8_SB(0, 0), cB, voffB); PG8_STAGE(PG8_SA(0, 0), cA, voffA); PG8_STAGE(PG8_SB(0, 1), cB + hstepB, voffB); PG8_STAGE(PG8_SA(0, 1), cA + hstepA, voffA);
        if (wr == 1) PG8_BAR;
        PG8_WAIT_V(4); PG8_BAR;
        PG8_STAGE(PG8_SB(1, 0), cB + kstepB, voffB); PG8_STAGE(PG8_SA(1, 0), cA + kstep, voffA); PG8_STAGE(PG8_SB(1, 1), cB + hstepB + kstepB, voffB);
        PG8_WAIT_V(6); PG8_BAR;
    }
    for (;;) {
        const bool has_next = S.next(ui + 1, nxt);
        const char* nA = has_next ? (const char*)g.A + (size_t)nxt.pm * tstepA : cA; const char* nB = has_next ? (const char*)g.Bt + (size_t)nxt.pn * tstepB : cB;
        for (int t = 0; t < nt; t += 2) {
            const bool last = (t == nt - 2);
            const char* a1 = PG8_KP(cA, t + 1);
            const char* a2 = last ? PG8_KP(nA, 0) : PG8_KP(cA, t + 2); const char* b2 = last ? PG8_KPB(nB, 0) : PG8_KPB(cB, t + 2);
            const char* a3 = last ? PG8_KP(nA, 1) : PG8_KP(cA, t + 3); const char* b3 = last ? PG8_KPB(nB, 1) : PG8_KPB(cB, t + 3);
            if (last && has_next) S.a_ready(nxt);
            if constexpr (Epi::MID) { if (t == (nt >> 1)) E.mid(acc, cur, wr, wc, fr, fq); }
            if constexpr (SP2) {
            PG8_LDB(B0, 0, 0); PG8_LDB(B1, 0, 1); PG8_SCHED; PG8_LDA(At, 0, 0); PG8_STAGE(PG8_SA(1, 1), a1 + hstepA, voffA);
            PG8_WAIT_V(8); PG8_WAIT_L(0); PG8_BAR; PG8_MMA(0, 0, At, B0); PG8_MMA(0, 1, At, B1); PG8_BAR; PG8_SCHED;
            PG8_LDA(At, 0, 1); PG8_STAGE(PG8_SB(0, 0), b2, voffB); PG8_STAGE(PG8_SB(0, 1), b2 + hstepB, voffB); PG8_STAGE(PG8_SA(0, 0), a2, voffA);
            PG8_WAIT_V(8); PG8_WAIT_L(0); PG8_BAR; PG8_MMA(1, 0, At, B0); PG8_MMA(1, 1, At, B1); PG8_BAR; PG8_SCHED;
            PG8_LDB(B0, 1, 0); PG8_LDB(B1, 1, 1); PG8_SCHED; PG8_LDA(At, 1, 0); PG8_STAGE(PG8_SA(0, 1), a2 + hstepA, voffA);
            PG8_WAIT_V(8); PG8_WAIT_L(0); PG8_BAR; PG8_MMA(0, 0, At, B0); PG8_MMA(0, 1, At, B1); PG8_BAR; PG8_SCHED;
            PG8_LDA(At, 1, 1); PG8_STAGE(PG8_SB(1, 0), b3, voffB); PG8_STAGE(PG8_SB(1, 1), b3 + hstepB, voffB); PG8_STAGE(PG8_SA(1, 0), a3, voffA);
            PG8_WAIT_V(8); PG8_WAIT_L(0); PG8_BAR; PG8_MMA(1, 0, At, B0); PG8_MMA(1, 1, At, B1); PG8_BAR; PG8_SCHED;
            } else {
            PG8_LDB(B0, 0, 0); PG8_SCHED; PG8_LDA(At, 0, 0); PG8_STAGE(PG8_SA(1, 1), a1 + hstepA, voffA);
            PG8_WAIT_L(8); PG8_BAR; PG8_WAIT_L(0); PG8_MMA(0, 0, At, B0); PG8_BAR; PG8_SCHED;
            PG8_LDB(B1, 0, 1); PG8_STAGE(PG8_SB(0, 0), b2, voffB);
            PG8_BAR; PG8_WAIT_L(0); PG8_MMA(0, 1, At, B1); PG8_BAR;
            PG8_LDA(At, 0, 1); PG8_STAGE(PG8_SA(0, 0), a2, voffA);
            PG8_BAR; PG8_WAIT_L(0); PG8_MMA(1, 0, At, B0); PG8_BAR; PG8_SCHED;
            PG8_STAGE(PG8_SB(0, 1), b2 + hstepB, voffB);
            PG8_WAIT_V(6); PG8_BAR; PG8_MMA(1, 1, At, B1); PG8_BAR;
            PG8_LDB(B0, 1, 0); PG8_SCHED; PG8_LDA(At, 1, 0); PG8_STAGE(PG8_SA(0, 1), a2 + hstepA, voffA);
            PG8_WAIT_L(8); PG8_BAR; PG8_WAIT_L(0); PG8_MMA(0, 0, At, B0); PG8_BAR; PG8_SCHED;
            PG8_LDB(B1, 1, 1); PG8_STAGE(PG8_SB(1, 0), b3, voffB);
            PG8_BAR; PG8_WAIT_L(0); PG8_MMA(0, 1, At, B1); PG8_BAR;
            PG8_LDA(At, 1, 1); PG8_STAGE(PG8_SA(1, 0), a3, voffA);
            PG8_BAR; PG8_WAIT_L(0); PG8_MMA(1, 0, At, B0); PG8_BAR; PG8_SCHED;
            PG8_STAGE(PG8_SB(1, 1), b3 + hstepB, voffB);
            PG8_WAIT_V(6); PG8_BAR; PG8_MMA(1, 1, At, B1); PG8_BAR;
            }
        }
        if constexpr (ALIGN_EPI) { if (wr == 0) PG8_BAR; }
        if constexpr (!Epi::AFTER_DRAIN) { E(acc, cur, wr, wc, fr, fq); S.done(cur); }
        if (!has_next) break;
#pragma unroll
        for (int a = 0; a < 2; ++a)
#pragma unroll
            for (int b = 0; b < 2; ++b)
#pragma unroll
                for (int m = 0; m < 4; ++m)
#pragma unroll
                    for (int n = 0; n < 2; ++n) acc[a][b][m][n] = (f32x4){0.f, 0.f, 0.f, 0.f};
        cur = nxt; cA = nA; cB = nB; ++ui;
        if constexpr (ALIGN_EPI) { if (wr == 1) PG8_BAR; }
    }
    PG8_WAIT_V(0);
    if constexpr (!ALIGN_EPI) { if (wr == 0) PG8_BAR; }
    PG8_BAR;
    if constexpr (Epi::AFTER_DRAIN) { E.fused(acc, cur, wr, wc, fr, fq, lds, wid, lane); S.done(cur); }
#undef PG8_SA
#undef PG8_KP
#undef PG8_KPB
#undef PG8_SB
#undef PG8_STAGE
#undef PG8_LDA
#undef PG8_LDB
#undef PG8_MMA
#undef PG8_WAIT_V
#undef PG8_WAIT_L
#undef PG8_BAR
#undef PG8_SCHED
}
}

namespace att {
#define ATT_LAS __attribute__((address_space(3)))
typedef unsigned short bf16_t;
typedef short bf16x8 __attribute__((ext_vector_type(8)));
typedef short s16x4 __attribute__((ext_vector_type(4)));
typedef float f32x16 __attribute__((ext_vector_type(16)));
typedef unsigned u32x4 __attribute__((ext_vector_type(4)));
constexpr int SHM_V = 16384, SHM_K = 16384, SHM_R = 8192, BUFB = SHM_V + SHM_K + SHM_R;
constexpr int LDS_SCR = 2 * BUFB;
constexpr int LDS_FLAGS = LDS_SCR + 8 * 256;
constexpr int LDS_QR = LDS_FLAGS + 64;
constexpr int ATT_LDS_BYTES = LDS_QR + 8 * 4096;
#define KSWZ(row, colB) ((row) * 256 + ((colB) ^ (((row) & 7) << 4)))
#define RSWZ(row, colB) ((row) * 128 + ((colB) ^ ((((row) >> 1) & 7) << 4)))
__device__ __forceinline__ int v_st(int k, int c) { const int kk = (k & ~0xC) | ((k & 4) << 1) | ((k & 8) >> 1); return ((kk >> 3) * 4 + (c >> 5)) * 512 + ((kk & 7) * 32 + (c & 31)) * 2; }
__device__ __forceinline__ int v_rd_base(int lane) { return ((lane & 3) << 3) | (((lane >> 2) & 3) << 6) | (((lane >> 4) & 1) << 5) | (((lane >> 5) & 1) << 8); }
constexpr int v_rd_off(int d0, int ks, int half) { return d0 * 512 + ks * 4096 + half * 2048; }
__device__ __forceinline__ int crow(int r, int hi) { return (r & 3) + 8 * (r >> 2) + 4 * hi; }
__device__ __forceinline__ unsigned cvtpk(float lo, float hi) { unsigned r; asm volatile("v_cvt_pk_bf16_f32 %0, %1, %2" : "=v"(r) : "v"(lo), "v"(hi)); return r; }
#define ATT_SBAR() __builtin_amdgcn_sched_barrier(0)
#ifndef ATT_PRIO
#define ATT_PRIO 0
#endif
#ifndef ATT_QR_REG
#define ATT_QR_REG 1
#endif
#ifndef ATT_DEFER_MAX
#define ATT_DEFER_MAX 1
#endif
#ifndef ATT_EARLYW
#define ATT_EARLYW 0
#endif

template <int ND>
__device__ __forceinline__ void qkt_half(f32x16& p, const ATT_LAS char* Kb, const ATT_LAS char* Rb, int r32, int hi, const bf16x8* qr, const ATT_LAS char* qrl, int lane, int half) {
    bf16x8 kf[8];
#pragma unroll
    for (int d0 = 0; d0 < 8; ++d0) kf[d0] = *(const ATT_LAS bf16x8*)(Kb + KSWZ(r32, ((d0 & 3) * 16 + hi * 8) * 2) + (d0 >> 2) * 128 + half * (32 * 256));
    ATT_SBAR();
    p = f32x16{};
    if constexpr (ND == 12) {
        bf16x8 rf[4], qf[4];
#pragma unroll
        for (int d0 = 0; d0 < 4; ++d0) p = __builtin_amdgcn_mfma_f32_32x32x16_bf16(kf[d0], qr[d0], p, 0, 0, 0);
        ATT_SBAR();
#pragma unroll
#if ATT_QR_REG
        for (int dr = 0; dr < 4; ++dr) { rf[dr] = *(const ATT_LAS bf16x8*)(Rb + RSWZ(r32, (dr * 16 + hi * 8) * 2) + half * (32 * 128)); qf[dr] = qr[8 + dr]; }
#else
        for (int dr = 0; dr < 4; ++dr) { rf[dr] = *(const ATT_LAS bf16x8*)(Rb + RSWZ(r32, (dr * 16 + hi * 8) * 2) + half * (32 * 128)); qf[dr] = *(const ATT_LAS bf16x8*)(qrl + dr * 1024 + lane * 16); }
#endif
        ATT_SBAR();
#pragma unroll
        for (int d0 = 4; d0 < 8; ++d0) p = __builtin_amdgcn_mfma_f32_32x32x16_bf16(kf[d0], qr[d0], p, 0, 0, 0);
#pragma unroll
        for (int dr = 0; dr < 4; ++dr) p = __builtin_amdgcn_mfma_f32_32x32x16_bf16(rf[dr], qf[dr], p, 0, 0, 0);
    } else {
#pragma unroll
        for (int d0 = 0; d0 < 8; ++d0) p = __builtin_amdgcn_mfma_f32_32x32x16_bf16(kf[d0], qr[d0], p, 0, 0, 0);
    }
}
__device__ __forceinline__ void pv_tile(f32x16* o, int vb, bf16x8 pa0, bf16x8 pa1, bf16x8 pa2, bf16x8 pa3) {
#define ATT_TRRD(dst, off) asm volatile("ds_read_b64_tr_b16 %0, %1 offset:%2" : "=&v"(dst) : "v"(vb), "i"(off) : "memory")
#define ATT_PV_D0(d0) do { s16x4 l0, l1, l2, l3, h0, h1, h2, h3; constexpr int b_ = v_rd_off(d0, 0, 0); \
        ATT_TRRD(l0, b_); ATT_TRRD(h0, b_ + 2048); ATT_TRRD(l1, b_ + 4096); ATT_TRRD(h1, b_ + 6144); ATT_TRRD(l2, b_ + 8192); ATT_TRRD(h2, b_ + 10240); ATT_TRRD(l3, b_ + 12288); ATT_TRRD(h3, b_ + 14336); \
        asm volatile("s_waitcnt lgkmcnt(0)" ::: "memory"); ATT_SBAR(); \
        o[d0] = __builtin_amdgcn_mfma_f32_32x32x16_bf16(pa0, (bf16x8){l0[0], l0[1], l0[2], l0[3], h0[0], h0[1], h0[2], h0[3]}, o[d0], 0, 0, 0); \
        o[d0] = __builtin_amdgcn_mfma_f32_32x32x16_bf16(pa1, (bf16x8){l1[0], l1[1], l1[2], l1[3], h1[0], h1[1], h1[2], h1[3]}, o[d0], 0, 0, 0); \
        o[d0] = __builtin_amdgcn_mfma_f32_32x32x16_bf16(pa2, (bf16x8){l2[0], l2[1], l2[2], l2[3], h2[0], h2[1], h2[2], h2[3]}, o[d0], 0, 0, 0); \
        o[d0] = __builtin_amdgcn_mfma_f32_32x32x16_bf16(pa3, (bf16x8){l3[0], l3[1], l3[2], l3[3], h3[0], h3[1], h3[2], h3[3]}, o[d0], 0, 0, 0); } while (0)
    if (ATT_PRIO) __builtin_amdgcn_s_setprio(1);
    ATT_PV_D0(0); ATT_PV_D0(1); ATT_PV_D0(2); ATT_PV_D0(3);
    if (ATT_PRIO) __builtin_amdgcn_s_setprio(0);
#undef ATT_PV_D0
#undef ATT_TRRD
}
__device__ __forceinline__ void pack_half(const f32x16& p, bf16x8& pa0, bf16x8& pa1) {
#define ATT_PK4(P, B_, OUT) do { unsigned a0 = cvtpk(P[B_+0], P[B_+1]), a1 = cvtpk(P[B_+2], P[B_+3]); \
        unsigned b0 = cvtpk(P[B_+4], P[B_+5]), b1 = cvtpk(P[B_+6], P[B_+7]); \
        auto r0 = __builtin_amdgcn_permlane32_swap(a0, b0, false, false); auto r1 = __builtin_amdgcn_permlane32_swap(a1, b1, false, false); \
        u32x4 w = {r0[0], r1[0], r0[1], r1[1]}; OUT = __builtin_bit_cast(bf16x8, w); } while (0)
    ATT_PK4(p, 0, pa0); ATT_PK4(p, 8, pa1);
#undef ATT_PK4
}
__device__ __forceinline__ void half_xchg(float x, float& lo, float& hi) {
    unsigned a = __builtin_bit_cast(unsigned, x), b;
    asm volatile("s_nop 1\n\tv_mov_b32 %1, %0\n\ts_nop 1\n\tv_permlane32_swap_b32 %0, %1" : "+v"(a), "=&v"(b));
    lo = __builtin_bit_cast(float, a); hi = __builtin_bit_cast(float, b);
}
__device__ __forceinline__ float half_sum(float v) { float lo, hi; half_xchg(v, lo, hi); return lo + hi; }
__device__ __forceinline__ float half_max(float v) { float lo, hi; half_xchg(v, lo, hi); return fmaxf(lo, hi); }

struct Tensors { const bf16_t* Q; int ldq; const bf16_t* K; int ldk; const bf16_t* V; int ldv; const bf16_t* R; bf16_t* O; int ldo; };

template <int MODE>
__device__ __forceinline__ void attn_unit(const Tensors& T, int qb, float sc2, ATT_LAS char* lds) {
    constexpr int ND = MODE == 1 ? 12 : 8;
    int tid_ = threadIdx.x; asm volatile("" : "+v"(tid_));
    const int tid = tid_, wid = __builtin_amdgcn_readfirstlane(tid >> 6), lane = tid & 63, r32 = lane & 31, hi = lane >> 5;
    const int q0 = qb * 256, qw = q0 + wid * 32;
    const int NT = 4 * (qb + 1);
    const int wlast = 4 * qb + (wid >> 1);
    const int tq = qw + r32;
    ATT_LAS float* scr = (ATT_LAS float*)(lds + LDS_SCR) + wid * 64;
    volatile ATT_LAS unsigned* flags = (volatile ATT_LAS unsigned*)(lds + LDS_FLAGS);
    const ATT_LAS char* qrl = lds + LDS_QR + wid * 4096;
    bf16x8 qr[(MODE == 1 && ATT_QR_REG) ? 12 : 8];
    { const bf16_t* qp = T.Q + (size_t)tq * T.ldq + hi * 8;
#pragma unroll
      for (int d0 = 0; d0 < 8; ++d0) qr[d0] = *(const bf16x8*)(qp + d0 * 16);
      if constexpr (MODE == 1) {
#if ATT_QR_REG
#pragma unroll
          for (int dr = 0; dr < 4; ++dr) qr[8 + dr] = *(const bf16x8*)(qp + 128 + dr * 16);
#else
#pragma unroll
          for (int dr = 0; dr < 4; ++dr) *(ATT_LAS bf16x8*)(lds + LDS_QR + wid * 4096 + dr * 1024 + lane * 16) = *(const bf16x8*)(qp + 128 + dr * 16);
#endif
      } }
    const int sr = tid >> 4, sc = (tid & 15) * 8, kws = KSWZ(sr, sc * 2), vst0 = v_st(sr, sc), vst1 = v_st(32 + sr, sc);
    const int rr_ = tid >> 3, rc = (tid & 7) * 8, rws = RSWZ(rr_, rc * 2);
    bf16x8 sk0, sk1, sv0, sv1, srp;
#define ATT_LOAD(kt) do { const size_t k0_ = (size_t)(kt) * 64; \
        sk0 = *(const bf16x8*)(T.K + (k0_ + sr) * T.ldk + sc); sk1 = *(const bf16x8*)(T.K + (k0_ + 32 + sr) * T.ldk + sc); \
        sv0 = *(const bf16x8*)(T.V + (k0_ + sr) * T.ldv + sc); sv1 = *(const bf16x8*)(T.V + (k0_ + 32 + sr) * T.ldv + sc); \
        if constexpr (MODE == 1) srp = *(const bf16x8*)(T.R + (k0_ + rr_) * 64 + rc); } while (0)
#define ATT_WRITE(bf) do { ATT_LAS char* b_ = lds + (bf) * BUFB; \
        *(ATT_LAS bf16x8*)(b_ + vst0) = sv0; *(ATT_LAS bf16x8*)(b_ + vst1) = sv1; \
        *(ATT_LAS bf16x8*)(b_ + SHM_V + kws) = sk0; *(ATT_LAS bf16x8*)(b_ + SHM_V + kws + 32 * 256) = sk1; \
        if constexpr (MODE == 1) *(ATT_LAS bf16x8*)(b_ + SHM_V + SHM_K + rws) = srp; } while (0)
#define ATT_TILE(it) (MODE == 0 ? (NT - 1 - (it)) : (it))
    f32x16 o[4] = {};
    float carry = 0.f;
    float m_reg = -1e30f, l_reg = 0.f;
    bool dead = false;
    const float hsel = hi ? 0.f : 1.f;
    ATT_LOAD(ATT_TILE(0)); asm volatile("s_waitcnt vmcnt(0)" ::: "memory"); ATT_WRITE(0);
    __syncthreads();
    for (int it = 0; it < NT; ++it) {
        const int cur = it & 1, kt = ATT_TILE(it), kb = kt * 64;
        if (it + 1 < NT) ATT_LOAD(ATT_TILE(it + 1));
        const ATT_LAS char* bufp = lds + cur * BUFB;
        bool staged = false;
        if (kt <= wlast && !dead) {
            f32x16 p0, p1;
            bf16x8 pa0, pa1, pa2, pa3;
            if constexpr (MODE == 0) {
                const bool diag = (kb + 63 >= qw);
                qkt_half<ND>(p1, bufp + SHM_V, bufp + SHM_V + SHM_K, r32, hi, qr, qrl, lane, 1);
                qkt_half<ND>(p0, bufp + SHM_V, bufp + SHM_V + SHM_K, r32, hi, qr, qrl, lane, 0);
                float tsum = carry;
#define ATT_SB_HALF(P, KOFF) do { f32x16 f; \
                    _Pragma("unroll") for (int r = 0; r < 16; ++r) { P[r] *= sc2; \
                        f[r] = fminf(-P[r], 0.f) - __builtin_amdgcn_logf(1.0f + __builtin_amdgcn_exp2f(-__builtin_fabsf(P[r]))); } \
                    if (diag) { _Pragma("unroll") for (int r = 0; r < 16; ++r) { if (kb + (KOFF) + crow(r, hi) >= tq) f[r] = 0.f; } } \
                    float gs_[4], oh_[4], ps_[4]; \
                    _Pragma("unroll") for (int i = 0; i < 4; ++i) { f[4*i+2] += f[4*i+3]; f[4*i+1] += f[4*i+2]; f[4*i] += f[4*i+1]; gs_[i] = f[4*i]; } \
                    _Pragma("unroll") for (int i = 0; i < 4; ++i) { float lo_; half_xchg(gs_[i], lo_, oh_[i]); ps_[i] = lo_ + oh_[i]; } \
                    _Pragma("unroll") for (int i = 3; i >= 0; --i) { const float Tg = tsum + hsel * oh_[i]; \
                        _Pragma("unroll") for (int e = 0; e < 4; ++e) P[4*i+e] = __builtin_amdgcn_exp2f(P[4*i+e] + f[4*i+e] + Tg); \
                        tsum += ps_[i]; } \
                    if (diag) { _Pragma("unroll") for (int r = 0; r < 16; ++r) { if (kb + (KOFF) + crow(r, hi) >= tq) P[r] = 0.f; } } } while (0)
                ATT_SB_HALF(p1, 32);
                pack_half(p1, pa2, pa3);
                ATT_SB_HALF(p0, 0);
                pack_half(p0, pa0, pa1);
#undef ATT_SB_HALF
                carry = tsum;
                pv_tile(o, (int)(uintptr_t)(bufp) + v_rd_base(lane), pa0, pa1, pa2, pa3);
                if (__all(carry < -140.f)) dead = true;
            } else {
                qkt_half<ND>(p0, bufp + SHM_V, bufp + SHM_V + SHM_K, r32, hi, qr, qrl, lane, 0);
                qkt_half<ND>(p1, bufp + SHM_V, bufp + SHM_V + SHM_K, r32, hi, qr, qrl, lane, 1);
                float pmax = p0[0];
#pragma unroll
                for (int r = 1; r < 16; ++r) pmax = fmaxf(pmax, p0[r]);
#pragma unroll
                for (int r = 0; r < 16; ++r) pmax = fmaxf(pmax, p1[r]);
                pmax = half_max(pmax);
#if ATT_DEFER_MAX
                const float mn = (pmax > m_reg + 8.0f * __builtin_amdgcn_rcpf(sc2)) ? pmax : m_reg;
                const float alpha = __builtin_amdgcn_exp2f((m_reg - mn) * sc2); m_reg = mn;
#else
                const float mn = fmaxf(m_reg, pmax), alpha = __builtin_amdgcn_exp2f((m_reg - mn) * sc2); m_reg = mn;
#endif
                const float mnL = -mn * sc2;
                float psum = 0.f;
#pragma unroll
                for (int r = 0; r < 16; ++r) { p0[r] = __builtin_amdgcn_exp2f(fmaf(p0[r], sc2, mnL)); psum += p0[r]; }
                pack_half(p0, pa0, pa1);
#pragma unroll
                for (int r = 0; r < 16; ++r) { p1[r] = __builtin_amdgcn_exp2f(fmaf(p1[r], sc2, mnL)); psum += p1[r]; }
                pack_half(p1, pa2, pa3);
                l_reg = l_reg * alpha + half_sum(psum);
                if (__any(alpha < 1.f))
                { if (hi == 0) scr[r32] = alpha; asm volatile("s_waitcnt lgkmcnt(0)" ::: "memory");
#pragma unroll
                    for (int r = 0; r < 16; ++r) { const float a = scr[crow(r, hi)];
#pragma unroll
                        for (int d = 0; d < 4; ++d) o[d][r] *= a; } }
#if ATT_EARLYW
                if (it + 1 < NT) { asm volatile("s_waitcnt vmcnt(0)" ::: "memory"); ATT_WRITE(cur ^ 1); staged = true; }
#endif
                pv_tile(o, (int)(uintptr_t)(bufp) + v_rd_base(lane), pa0, pa1, pa2, pa3);
            }
        }
        if (it + 1 < NT && !staged) { asm volatile("s_waitcnt vmcnt(0)" ::: "memory"); ATT_WRITE(cur ^ 1); }
        if constexpr (MODE == 0) { if (lane == 0) flags[cur * 8 + wid] = dead ? 1u : 0u; }
        __syncthreads();
        if constexpr (MODE == 0) {
            unsigned alld = 1u;
#pragma unroll
            for (int w = 0; w < 8; ++w) alld &= flags[cur * 8 + w];
            if (alld) break;
        }
    }
    if constexpr (MODE == 1) { if (hi == 0) scr[32 + r32] = l_reg; asm volatile("s_waitcnt lgkmcnt(0)" ::: "memory"); }
    bf16_t* Ow = T.O + (size_t)qw * T.ldo;
    int obase = 4 * hi * T.ldo + r32; asm volatile("" : "+v"(obase));
#pragma unroll
    for (int r = 0; r < 16; ++r) { const int orow = crow(r, hi);
        float rl = 1.f; if constexpr (MODE == 1) rl = __builtin_amdgcn_rcpf(scr[32 + orow]);
        int ro = obase + ((r & 3) + 8 * (r >> 2)) * T.ldo; asm volatile("" : "+v"(ro));
#pragma unroll
        for (int d0 = 0; d0 < 4; ++d0) { const float v = o[d0][r] * rl; const float vn = __shfl_xor(v, 1);
            if ((r32 & 1) == 0) *(unsigned*)(Ow + ro + d0 * 32) = cvtpk(v, vn); } }
    __syncthreads();
#undef ATT_LOAD
#undef ATT_WRITE
#undef ATT_TILE
}
}

constexpr int BATCH = 2, SEQ = 4096, D = 4096, M = BATCH * SEQ, DEPTH = 2;
constexpr int SBW = 2048, QRANK = 1024, KVRANK = 512, ROPE = 64, DFF = 16384;
constexpr int IN_W = 3 * SBW + QRANK + KVRANK + ROPE + 2 * D;
constexpr int C_QD = 3 * SBW, C_KVD = C_QD + QRANK, C_GATE_SRC = C_KVD + KVRANK + ROPE;
constexpr int C_GSB = 7936, C_GMLA = C_GSB + D, PROJ_W = C_GMLA + D;
constexpr int QW = 16 * 192, KVW = 16 * 256;
constexpr float EPS = 1e-6f;
static_assert(IN_W == 15936 && PROJ_W == 16128 && PROJ_W % 256 == 0 && C_GSB % 256 == 0, "projection layout");

constexpr size_t MiB = 1u << 20;
constexpr size_t WS_CTL = 0, CTL_ZERO_BYTES = 1 * MiB;
constexpr size_t WS_ADA = 1 * MiB;
constexpr size_t WS_TAB = 2 * MiB;
constexpr size_t WS_ADAP = 4 * MiB;
constexpr size_t WS_W = 32 * MiB;
constexpr size_t W_IN = 0, W_UQ = 126 * MiB, W_UKV = 132 * MiB, W_OSB = 136 * MiB, W_OMLA = 152 * MiB, W_OUT = 168 * MiB, W_UP = 200 * MiB, W_DOWN = 328 * MiB, W_LAYER = 456 * MiB;
constexpr size_t WS_ACT = WS_W + DEPTH * W_LAYER;
constexpr size_t A_H = WS_ACT, A_PROJ = A_H + 64 * MiB, A_CQ = A_PROJ + 252 * MiB, A_CKV = A_CQ + 16 * MiB, A_KR = A_CKV + 8 * MiB, A_Q = A_KR + 1 * MiB, A_KV = A_Q + 48 * MiB,
                 A_OSB = A_KV + 64 * MiB, A_OMLA = A_OSB + 32 * MiB, A_TMP = A_OMLA + 32 * MiB, A_MRG = A_TMP + 128 * MiB, A_Y = A_MRG + 64 * MiB, A_U = A_Y + 128 * MiB, WS_END = A_U + 256 * MiB;
static_assert((size_t)PROJ_W * D * 2 == 126 * MiB && (size_t)M * PROJ_W * 2 == 252 * MiB, "sizes");
constexpr int CW_TMO = 0;
constexpr int CW_BAR = 4096;

constexpr int RING_BYTES = 135168;
constexpr int LDSCTL_OFF = RING_BYTES, MISC_OFF = LDSCTL_OFF + 320;
constexpr int LDS_BYTES = RING_BYTES + 1024;
constexpr int NWAVES = 8;
static_assert(att::ATT_LDS_BYTES <= RING_BYTES && pg8::STAGE_BYTES <= RING_BYTES, "LDS map");

#define GAS __attribute__((address_space(1)))
#define LAS __attribute__((address_space(3)))
typedef unsigned short bf16;
typedef unsigned v4u __attribute__((ext_vector_type(4)));
typedef unsigned v2u __attribute__((ext_vector_type(2)));
typedef float f32x4 __attribute__((ext_vector_type(4)));
typedef GAS unsigned gu32;
#define RLX_AGENT __ATOMIC_RELAXED, __HIP_MEMORY_SCOPE_AGENT
#ifndef USE_NT
#define USE_NT 0
#endif
#if USE_NT
#define NT_LD(p) __builtin_nontemporal_load(p)
#else
#define NT_LD(p) (*(p))
#endif
#define LDS_WAIT() asm volatile("s_waitcnt lgkmcnt(0)" ::: "memory")
#define VM_WAIT() asm volatile("s_waitcnt vmcnt(0)" ::: "memory")
__device__ __forceinline__ unsigned pk2(float lo, float hi) { return pg8::cvt_pk_bf16(lo, hi); }
__device__ __forceinline__ float bflo(unsigned w) { return __builtin_bit_cast(float, w << 16); }
__device__ __forceinline__ float bfhi(unsigned w) { return __builtin_bit_cast(float, w & 0xffff0000u); }

#define XB_TMO      128
#define XB_XCNT(j)  (256  + 64 * (j))
#define XB_XSUB(j)  (1280 + 64 * (j))
#define XB_XGEN(j)  (2304 + 64 * (j))
#define XB_TOP      3328
#define XB_TOPGEN   3392
#define XCD_BAR_WORDS 3456
#define XB_SPIN_CAP (1u << 21)

__device__ __forceinline__ unsigned xb_ld(unsigned* p)              { return __hip_atomic_load(p, __ATOMIC_RELAXED, __HIP_MEMORY_SCOPE_AGENT); }
__device__ __forceinline__ unsigned xb_add(unsigned* p, unsigned v) { return __hip_atomic_fetch_add(p, v, __ATOMIC_RELAXED, __HIP_MEMORY_SCOPE_AGENT); }
__device__ __forceinline__ unsigned xb_xcc_id() { return (unsigned)__builtin_amdgcn_s_getreg((3 << 11) | 20) & 0xFu; }
#define XB_SPIN(cond, bar) do { unsigned _sp = 0; while (cond) { __builtin_amdgcn_s_sleep(1); \
    if ((++_sp & 255u) == 0u) { if (xb_ld(&(bar)[XB_TMO])) break; if (_sp > XB_SPIN_CAP) { atomicAdd(&(bar)[XB_TMO], 1u); break; } } } } while (0)

struct XcdBarrier {
    unsigned* bar; unsigned x;
    volatile LAS unsigned* st;
};

__device__ __forceinline__ XcdBarrier xcd_barrier_post(unsigned* bar, volatile LAS unsigned* st) {
    XcdBarrier b; b.bar = bar; b.x = xb_xcc_id(); b.st = st;
    if (threadIdx.x == 0) (void)xb_add(&bar[XB_XCNT(b.x)], 1u);
    return b;
}
__device__ __forceinline__ void xcd_barrier_complete(unsigned* bar, unsigned x, unsigned& nloc, unsigned& nx) {
    const unsigned G = gridDim.x * gridDim.y * gridDim.z;
    unsigned sum, cnt, mine, sp = 0u;
    for (;;) {
        sum = 0u; cnt = 0u; mine = 0u;
#pragma unroll
        for (unsigned j = 0; j < 16; ++j) { const unsigned c = xb_ld(&bar[XB_XCNT(j)]); sum += c; cnt += (c > 0u) ? 1u : 0u; mine = (j == x) ? c : mine; }
        if (sum == G) break;
        __builtin_amdgcn_s_sleep(1);
        if ((++sp & 255u) == 0u) { if (xb_ld(&bar[XB_TMO])) break; if (sp > XB_SPIN_CAP) { atomicAdd(&bar[XB_TMO], 1u); break; } }
    }
    nloc = mine > 0u ? mine : 1u; nx = cnt > 0u ? cnt : 1u;
}

__device__ __forceinline__ void xcd_barrier(const XcdBarrier& b) {
    asm volatile("s_waitcnt vmcnt(0)" ::: "memory");
    __syncthreads();
    if (threadIdx.x == 0) {
        unsigned* bar = b.bar; unsigned bx_ = b.x; asm volatile("" : "+s"(bar), "+s"(bx_));
        __builtin_amdgcn_s_waitcnt(0);
        unsigned nloc = b.st[0], nx = b.st[1];
        if (nloc == 0u) { xcd_barrier_complete(bar, bx_, nloc, nx); b.st[0] = nloc; b.st[1] = nx; }
        const unsigned old = xb_add(&bar[XB_XSUB(bx_)], 1u);
        const unsigned gen = old / nloc;
        if (old + 1u == (gen + 1u) * nloc) {
            __builtin_amdgcn_fence(__ATOMIC_RELEASE, "agent");
            asm volatile("s_waitcnt vmcnt(0)" ::: "memory");
            const unsigned og = xb_add(&bar[XB_TOP], 1u);
            const unsigned tg = og / nx;
            if (og + 1u == (tg + 1u) * nx) xb_add(&bar[XB_TOPGEN], 1u);
            else XB_SPIN(xb_ld(&bar[XB_TOPGEN]) == tg, bar);
            __builtin_amdgcn_fence(__ATOMIC_ACQUIRE, "agent");
            xb_add(&bar[XB_XGEN(bx_)], 1u);
            asm volatile("s_waitcnt vmcnt(0)" ::: "memory");
        } else {
            XB_SPIN(xb_ld(&bar[XB_XGEN(bx_)]) == gen, bar);
            __builtin_amdgcn_fence(__ATOMIC_ACQUIRE, "agent");
            asm volatile("s_waitcnt vmcnt(0)" ::: "memory");
        }
    }
    __syncthreads();
}


struct Frame {
    LAS unsigned char* lds;
    int tid, lane, wave, G, gw, NGW;
};
__device__ __forceinline__ float wave_sum(float v) {
#pragma unroll
    for (int o = 1; o < 64; o <<= 1) v += __shfl_xor(v, o);
    return v;
}

#ifndef CONV_NT_ST
#define CONV_NT_ST 1
#endif
__device__ __forceinline__ void conv_load(f32x4 (&v)[16], f32x4& ks0, f32x4& ks1, const float* src, int N, const float* ks, int lane) {
    const float* s_ = src + (size_t)(lane >> 4) * N + 4 * (lane & 15);
#pragma unroll
    for (int i = 0; i < 16; ++i) v[i] = NT_LD((const f32x4*)(s_ + (size_t)(4 * i) * N));
    ks0 = (f32x4){1.f, 1.f, 1.f, 1.f}; ks1 = ks0;
    if (ks) { ks0 = *(const f32x4*)(ks + 8 * (lane & 7)); ks1 = *(const f32x4*)(ks + 8 * (lane & 7) + 4); }
}
__device__ __forceinline__ void conv_store(const f32x4 (&v)[16], f32x4 ks0, f32x4 ks1, bf16* dst, int ldt, int rowbase, int ropeperm, LAS float* scr, int lane) {
#pragma unroll
    for (int i = 0; i < 16; ++i) { LAS float* d = scr + (4 * i + (lane >> 4)) * 65 + 4 * (lane & 15); d[0] = v[i][0]; d[1] = v[i][1]; d[2] = v[i][2]; d[3] = v[i][3]; }
    LDS_WAIT(); asm volatile("" ::: "memory");
    const int c = lane & 7;
#pragma unroll
    for (int j = 0; j < 8; ++j) { const int nn = (lane >> 3) + 8 * j; const LAS float* s = scr + (8 * c) * 65 + nn;
        v4u o; o.x = pk2(s[0 * 65] * ks0[0], s[1 * 65] * ks0[1]); o.y = pk2(s[2 * 65] * ks0[2], s[3 * 65] * ks0[3]); o.z = pk2(s[4 * 65] * ks1[0], s[5 * 65] * ks1[1]); o.w = pk2(s[6 * 65] * ks1[2], s[7 * 65] * ks1[3]);
        const int orow = rowbase + ((ropeperm & 1) ? (2 * (nn & 31) + (nn >> 5)) : nn);
#ifdef P0A_REP_NOSTORE
        if (ropeperm < 2)
#endif
#if CONV_NT_ST
        __builtin_nontemporal_store(o, (GAS v4u*)(dst + (size_t)orow * 64 + 8 * c)); }
#else
        *(GAS v4u*)(dst + (size_t)orow * 64 + 8 * c) = o; }
#endif
    LDS_WAIT(); asm volatile("" ::: "memory");
}

__device__ __forceinline__ void norm_mod_row(const f32x4 (&v)[16], float ssq, const float* g, const float* scv, const float* shv, bf16* orow, int lane) {
    const float r = 1.0f / sqrtf(ssq * (1.0f / D) + EPS);
#pragma unroll
    for (int j = 0; j < 16; ++j) { int c = 4 * lane + 256 * j; asm volatile("" : "+v"(c));
        const f32x4 gg = *(const f32x4*)(g + c), ss = *(const f32x4*)(scv + c), hh = *(const f32x4*)(shv + c);
        f32x4 o;
#pragma unroll
        for (int e = 0; e < 4; ++e) o[e] = v[j][e] * r * gg[e] * (1.0f + ss[e]) + hh[e];
        v2u w; w.x = pk2(o[0], o[1]); w.y = pk2(o[2], o[3]);
        *(GAS v2u*)(orow + c) = w; }
}


template <bool HAS_Y, bool HAS_H, bool XIN_BF = false, bool XOUT_BF = false>
__device__ __forceinline__ void thin_phase(Frame& F, const void* xin_, void* xout_, const bf16* Yb, bf16* Hout,
                                           const float* gpost, const float* gate0, const float* gpre, const float* sc0, const float* sh0) {
    LAS float* cA1 = (LAS float*)F.lds; LAS float* cA2 = cA1 + D; LAS float* cB2 = cA2 + D;
    for (int chunk = blockIdx.x; chunk < M / 32; chunk += F.G) {
        int tid = F.tid; asm volatile("" : "+v"(tid));
        const int b = (chunk * 32) / SEQ;
        __syncthreads();
#pragma unroll
        for (int i = 0; i < 2; ++i) { const int c = 4 * tid + 2048 * i;
            if constexpr (HAS_Y) { const f32x4 g = *(const f32x4*)(gpost + c), t = *(const f32x4*)(gate0 + (size_t)b * 6 * D + c); *(LAS f32x4*)(cA1 + c) = g * t; }
            if constexpr (HAS_H) { const f32x4 g = *(const f32x4*)(gpre + c), s = *(const f32x4*)(sc0 + (size_t)b * 6 * D + c), h = *(const f32x4*)(sh0 + (size_t)b * 6 * D + c);
                *(LAS f32x4*)(cA2 + c) = g * (s + 1.0f); *(LAS f32x4*)(cB2 + c) = h; } }
        __syncthreads();
        const int LN = tid & 63;
#pragma unroll 1
        for (int i = 0; i < 4; ++i) {
            const size_t m = (size_t)chunk * 32 + F.wave * 4 + i;
            v4u yv[8]; f32x4 xv[16];
#pragma unroll
            for (int j = 0; j < 8; ++j) { const int c = 8 * LN + 512 * j;
                if constexpr (HAS_Y) yv[j] = *(const GAS v4u*)(Yb + m * D + c);
                if constexpr (XIN_BF) { const v4u xb = *(const GAS v4u*)((const bf16*)xin_ + m * D + c);
                    xv[2 * j] = (f32x4){bflo(xb.x), bfhi(xb.x), bflo(xb.y), bfhi(xb.y)}; xv[2 * j + 1] = (f32x4){bflo(xb.z), bfhi(xb.z), bflo(xb.w), bfhi(xb.w)}; }
                else { xv[2 * j] = *(const f32x4*)((const float*)xin_ + m * D + c); xv[2 * j + 1] = *(const f32x4*)((const float*)xin_ + m * D + c + 4); } }
            float ssq2 = 0.f;
            if constexpr (HAS_Y) {
                float ssq = 0.f;
#pragma unroll
                for (int j = 0; j < 8; ++j) { const unsigned w[4] = {yv[j].x, yv[j].y, yv[j].z, yv[j].w};
#pragma unroll
                    for (int q = 0; q < 4; ++q) { const float a = bflo(w[q]), c2 = bfhi(w[q]); ssq += a * a + c2 * c2; } }
                ssq = wave_sum(ssq); const float r = 1.0f / sqrtf(ssq * (1.0f / D) + EPS);
#pragma unroll
                for (int j = 0; j < 8; ++j) { const int c = 8 * LN + 512 * j; const unsigned w[4] = {yv[j].x, yv[j].y, yv[j].z, yv[j].w};
                    const f32x4 a0 = *(const LAS f32x4*)(cA1 + c), a1 = *(const LAS f32x4*)(cA1 + c + 4);
                    f32x4 y0 = {bflo(w[0]), bfhi(w[0]), bflo(w[1]), bfhi(w[1])}, y1 = {bflo(w[2]), bfhi(w[2]), bflo(w[3]), bfhi(w[3])};
                    xv[2 * j] = xv[2 * j] + a0 * (y0 * r); xv[2 * j + 1] = xv[2 * j + 1] + a1 * (y1 * r);
                    if constexpr (XOUT_BF) { v4u xw; xw.x = pk2(xv[2 * j][0], xv[2 * j][1]); xw.y = pk2(xv[2 * j][2], xv[2 * j][3]); xw.z = pk2(xv[2 * j + 1][0], xv[2 * j + 1][1]); xw.w = pk2(xv[2 * j + 1][2], xv[2 * j + 1][3]);
                        *(GAS v4u*)((bf16*)xout_ + m * D + c) = xw; }
                    else { *(f32x4*)((float*)xout_ + m * D + c) = xv[2 * j]; *(f32x4*)((float*)xout_ + m * D + c + 4) = xv[2 * j + 1]; } } }
            if constexpr (HAS_H) {
#pragma unroll
                for (int j = 0; j < 16; ++j) ssq2 += (xv[j][0] * xv[j][0] + xv[j][1] * xv[j][1]) + (xv[j][2] * xv[j][2] + xv[j][3] * xv[j][3]);
                ssq2 = wave_sum(ssq2); const float r2 = 1.0f / sqrtf(ssq2 * (1.0f / D) + EPS);
#pragma unroll
                for (int j = 0; j < 8; ++j) { const int c = 8 * LN + 512 * j;
                    const f32x4 a0 = *(const LAS f32x4*)(cA2 + c), a1 = *(const LAS f32x4*)(cA2 + c + 4), b0 = *(const LAS f32x4*)(cB2 + c), b1 = *(const LAS f32x4*)(cB2 + c + 4);
                    const f32x4 h0 = (xv[2 * j] * r2) * a0 + b0, h1 = (xv[2 * j + 1] * r2) * a1 + b1;
                    v4u w; w.x = pk2(h0[0], h0[1]); w.y = pk2(h0[2], h0[3]); w.z = pk2(h1[0], h1[1]); w.w = pk2(h1[2], h1[3]);
                    *(GAS v4u*)(Hout + m * D + c) = w; } }
        }
    }
    __syncthreads();
}

__device__ __forceinline__ int gate_row(int j) { const int which = j / D, oc = j % D; return C_GSB + 256 * (oc / 128) + 128 * which + (oc % 128); }
constexpr int NB_IN = IN_W / 64, I_IN = (D / 64) * NB_IN, I_UQ = (QRANK / 64) * (QW / 64), I_UKV = (KVRANK / 64) * (KVW / 64), I_OSB = (SBW / 64) * (D / 64), I_OMLA = I_OSB,
              I_OUT = (D / 64) * (D / 64), I_UP = (D / 64) * (DFF / 64), I_DOWN = (DFF / 64) * (D / 64), I_LAYER = I_IN + I_UQ + I_UKV + I_OSB + I_OMLA + I_OUT + I_UP + I_DOWN;
#define CONV_DECODE(it, SRC, NN, DST, LDT, RB, RP, KS) do { const int l = (it) / I_LAYER; int r = (it) % I_LAYER; KS = nullptr; RP = 0; \
        if (r < I_IN) { const int kb = r / NB_IN, nb = r % NB_IN, n0 = nb * 64; SRC = KIN(I_WIN) + (size_t)l * D * IN_W + (size_t)(64 * kb) * IN_W + n0; NN = IN_W; DST = (bf16*)(wl + W_IN) + (size_t)kb * PROJ_W * 64; LDT = 64; \
            RB = n0 < C_GATE_SRC ? n0 : gate_row(n0 - C_GATE_SRC); RP = (n0 == C_KVD + KVRANK)  ; break; } r -= I_IN; \
        if (r < I_UQ) { const int kb = r / (QW / 64), nb = r % (QW / 64); SRC = KIN(I_WUQ) + (size_t)l * QRANK * QW + (size_t)(64 * kb) * QW + 64 * nb; NN = QW; DST = (bf16*)(wl + W_UQ) + (size_t)kb * QW * 64; LDT = 64; \
            RB = nb * 64; RP = ((nb % 3) == 2); KS = KIN(I_GQ) + (size_t)l * QRANK + 64 * kb; break; } r -= I_UQ; \
        if (r < I_UKV) { const int kb = r / (KVW / 64), nb = r % (KVW / 64); SRC = KIN(I_WUKV) + (size_t)l * KVRANK * KVW + (size_t)(64 * kb) * KVW + 64 * nb; NN = KVW; DST = (bf16*)(wl + W_UKV) + (size_t)kb * KVW * 64; LDT = 64; \
            RB = nb * 64; KS = KIN(I_GKV) + (size_t)l * KVRANK + 64 * kb; break; } r -= I_UKV; \
        if (r < I_OSB) { const int kb = r / (D / 64), nb = r % (D / 64); SRC = KIN(I_WOSB) + (size_t)l * SBW * D + (size_t)(64 * kb) * D + 64 * nb; NN = D; DST = (bf16*)(wl + W_OSB) + (size_t)kb * D * 64; LDT = 64; RB = nb * 64; break; } r -= I_OSB; \
        if (r < I_OMLA) { const int kb = r / (D / 64), nb = r % (D / 64); SRC = KIN(I_WOMLA) + (size_t)l * SBW * D + (size_t)(64 * kb) * D + 64 * nb; NN = D; DST = (bf16*)(wl + W_OSB) + (size_t)(SBW / 64 + kb) * D * 64; LDT = 64; RB = nb * 64; break; } r -= I_OMLA; \
        if (r < I_OUT) { const int kb = r / (D / 64), nb = r % (D / 64); SRC = KIN(I_WOUT) + (size_t)l * D * D + (size_t)(64 * kb) * D + 64 * nb; NN = D; DST = (bf16*)(wl + W_OUT) + (size_t)kb * D * 64; LDT = 64; RB = nb * 64; break; } r -= I_OUT; \
        if (r < I_UP) { const int kb = r / (DFF / 64), nb = r % (DFF / 64); SRC = KIN(I_WUP) + (size_t)l * D * DFF + (size_t)(64 * kb) * DFF + 64 * nb; NN = DFF; DST = (bf16*)(wl + W_UP) + (size_t)kb * DFF * 64; LDT = 64; RB = nb * 64; break; } r -= I_UP; \
        { const int kb = r / (D / 64), nb = r % (D / 64); SRC = KIN(I_WDOWN) + (size_t)l * DFF * D + (size_t)(64 * kb) * D + 64 * nb; NN = D; DST = (bf16*)(wl + W_DOWN) + (size_t)kb * D * 64; LDT = 64; RB = nb * 64; } \
    } while (0)
#ifdef P0A_REP_NOSTORE
#define CONV_RPX (p0r_ > 0 ? 2 : 0)
#else
#define CONV_RPX 0
#endif
#define CONVERT_ITEMS(lo, hi, start, stride) do { int cl_ = F.lane; asm volatile("" : "+v"(cl_));     \
        int it = (lo) + (start); \
        if (it < (hi)) { \
            const float* srcA; int nA; bf16* dstA; int ldtA, rbA, rpA; const float* ksA; f32x4 vA[16], k0A, k1A; \
            CONV_DECODE(it, srcA, nA, dstA, ldtA, rbA, rpA, ksA); conv_load(vA, k0A, k1A, srcA, nA, ksA, cl_); \
            for (;;) { const int nx = it + (stride); const bool hn = nx < (hi); \
                const float* srcB = srcA; int nB = nA; bf16* dstB = dstA; int ldtB = ldtA, rbB = rbA, rpB = rpA; const float* ksB = ksA; f32x4 vB[16], k0B, k1B; \
                if (hn) { CONV_DECODE(nx, srcB, nB, dstB, ldtB, rbB, rpB, ksB); conv_load(vB, k0B, k1B, srcB, nB, ksB, cl_); } \
                conv_store(vA, k0A, k1A, dstA, ldtA, rbA, rpA + CONV_RPX, scr, cl_); \
                if (!hn) break; \
                srcA = srcB; nA = nB; dstA = dstB; ldtA = ldtB; rbA = rbB; rpA = rpB; ksA = ksB; k0A = k0B; k1A = k1B; it = nx; \
                _Pragma("unroll") for (int i_ = 0; i_ < 16; ++i_) vA[i_] = vB[i_]; } \
        } } while (0)

#ifndef XRES_BF16
#define XRES_BF16 1
#endif
#ifndef PG8_SP2
#define PG8_SP2 true
#endif
#ifndef PG8_ALIGN
#define PG8_ALIGN true
#endif
#ifndef PG8_ALIGN_P1
#define PG8_ALIGN_P1 PG8_ALIGN
#endif
#ifndef PH_MASK
#define PH_MASK 0xFFFFFFFFu
#endif
#define PH(k) ((PH_MASK >> (k)) & 1u)
struct Args { const float* in[19]; float* out; unsigned char* ws; };
enum { I_X = 0, I_C, I_POS, I_WADA, I_BADA, I_GPREMIX, I_GPOSTMIX, I_GPREMLP, I_GPOSTMLP, I_WIN, I_GQ, I_WUQ, I_GKV, I_WUKV, I_WOSB, I_WOMLA, I_WOUT, I_WUP, I_WDOWN };

typedef __attribute__((address_space(4))) const unsigned char* kargp_t;
__device__ __forceinline__ __attribute__((address_space(1))) unsigned char* lw_(unsigned char* p) { __attribute__((address_space(1))) unsigned char* q = (__attribute__((address_space(1))) unsigned char*)p; asm volatile("" : "+s"(q)); return q; }
__device__ __forceinline__ kargp_t lwk_() { kargp_t p = (kargp_t)__builtin_amdgcn_kernarg_segment_ptr(); asm volatile("" : "+s"(p)); return p; }
#define KIN(k) ((const float*)(*(const __attribute__((address_space(1))) float* const __attribute__((address_space(4)))*)(lwk_() + 8 * (k))))
__global__ void __launch_bounds__(NWAVES * 64, 2) hybrid_fwd(Args args) {
    extern __shared__ __attribute__((aligned(16))) unsigned char lds_raw[];
    Frame F;
    F.lds = (LAS unsigned char*)lds_raw;
    F.tid = threadIdx.x; F.lane = F.tid & 63; F.wave = __builtin_amdgcn_readfirstlane(F.tid >> 6);
    F.G = gridDim.x; F.gw = blockIdx.x * NWAVES + F.wave; F.NGW = F.G * NWAVES;
    unsigned char* ws = args.ws;
    gu32* ctl = (gu32*)(ws + WS_CTL);
    for (int u = F.tid; u < (LDS_BYTES - LDSCTL_OFF) / 4; u += NWAVES * 64) ((LAS unsigned*)(F.lds + LDSCTL_OFF))[u] = 0u;
    __syncthreads();
    XcdBarrier bar = xcd_barrier_post((unsigned*)(ctl + CW_BAR), (volatile LAS unsigned*)(F.lds + MISC_OFF) + 8);
#define GRID_BAR() xcd_barrier(bar)

#define ada ((float*)(lw_(ws) + WS_ADA))
#define tab ((float*)(lw_(ws) + WS_TAB))
#define adap ((float*)(lw_(ws) + WS_ADAP))
#define Hb ((bf16*)(lw_(ws) + A_H))
#define PROJ ((bf16*)(lw_(ws) + A_PROJ))
#define SSQ ((float*)(lw_(ws) + A_CQ))
#define KR ((bf16*)(lw_(ws) + A_KR))
#define QF ((bf16*)(lw_(ws) + A_Q))
#define KVF ((bf16*)(lw_(ws) + A_KV))
#define OSB ((bf16*)(lw_(ws) + A_OSB))
#define MRG ((bf16*)(lw_(ws) + A_MRG))
#define Yb ((bf16*)(lw_(ws) + A_Y))
#define XB ((bf16*)(lw_(ws) + A_TMP))
#define U ((bf16*)(lw_(ws) + A_U))
#define GRB (lw_(ws) + A_TMP + 64 * MiB)
#define GSB (lw_(ws) + A_Y + 64 * MiB)
#define x_in KIN(I_X)
#define wl (lw_(ws) + WS_W + (size_t)l * W_LAYER)
#define adl (ada + (size_t)l * BATCH * 6 * D)
    float* xo = args.out;


#ifndef PRO_REP
#define PRO_REP 1
#endif
#pragma unroll 1
    for (int prep_ = 0; prep_ < PRO_REP; ++prep_) {
#ifndef P0A_REP
#define P0A_REP 1
#endif
#pragma unroll 1
    for (int p0r_ = 0; p0r_ < P0A_REP; ++p0r_)
    if (PH(0)) {
        LAS float* cact = (LAS float*)F.lds;
        for (int i = F.tid; i < BATCH * D; i += NWAVES * 64) { const float cv = KIN(I_C)[i]; cact[i] = cv / (1.0f + __expf(-cv)); }
        __syncthreads();
#ifdef P0A_REP_NOGEMV
        if (p0r_ == 0)
#endif
        for (int task = blockIdx.x; task < DEPTH * 32 * 12; task += F.G) {
            const int l = task / (32 * 12), s = (task / 12) % 32, cb = task % 12;
            const int col = cb * 2048 + F.tid * 4;
            const float* wp = KIN(I_WADA) + ((size_t)l * D + s * 128) * (6 * D) + col;
            f32x4 a0 = {0.f, 0.f, 0.f, 0.f}, a1 = {0.f, 0.f, 0.f, 0.f};
            f32x4 w[8];
#pragma unroll
            for (int j = 0; j < 8; ++j) w[j] = NT_LD((const f32x4*)(wp + (size_t)j * (6 * D)));
#pragma unroll 1
            for (int k = 0; k < 128; k += 8) { f32x4 wn[8];
                if (k + 8 < 128) {
#pragma unroll
                    for (int j = 0; j < 8; ++j) wn[j] = NT_LD((const f32x4*)(wp + (size_t)(k + 8 + j) * (6 * D))); }
#pragma unroll
                for (int j = 0; j < 8; ++j) { const float c0 = cact[s * 128 + k + j], c1 = cact[D + s * 128 + k + j]; a0 += w[j] * c0; a1 += w[j] * c1; }
#pragma unroll
                for (int j = 0; j < 8; ++j) w[j] = wn[j]; }
            *(f32x4*)(adap + (((size_t)s * DEPTH + l) * BATCH + 0) * (6 * D) + col) = a0;
            *(f32x4*)(adap + (((size_t)s * DEPTH + l) * BATCH + 1) * (6 * D) + col) = a1;
        }
        __syncthreads();
        for (int e = blockIdx.x * (NWAVES * 64) + F.tid; e < M * 32; e += F.G * NWAVES * 64) {
            const int m = e >> 5, i = e & 31;
            const float inv = powf(10000.0f, -(float)i / 32.0f);
            const float ang = (float)(((const int*)KIN(I_POS))[m]) * inv;
            const double rev = (double)ang * 0.15915494309189533577; const float fr = (float)(rev - rint(rev));
            tab[2 * e] = __builtin_amdgcn_cosf(fr); tab[2 * e + 1] = __builtin_amdgcn_sinf(fr);
        }
        for (int l = 0; l < DEPTH; ++l) { unsigned char* zb = ws + WS_W + l * W_LAYER + W_IN;
            for (int i = blockIdx.x * (NWAVES * 64) + F.tid; i < (D / 64) * 1536; i += F.G * NWAVES * 64) { const int kt = i / 1536, u = i % 1536;
                *(v4u*)(zb + ((size_t)kt * PROJ_W + C_GATE_SRC) * 128 + (size_t)u * 16) = (v4u){0u, 0u, 0u, 0u}; } }
        LAS float* scr = (LAS float*)(F.lds) + F.wave * (64 * 65);
        CONVERT_ITEMS(0, DEPTH * I_LAYER, F.gw, F.NGW);
        if (P0A_REP > 1) __syncthreads();
    }
    GRID_BAR();
    if (PH(1)) for (int e = blockIdx.x * (NWAVES * 64) + F.tid; e < DEPTH * BATCH * 6 * D; e += F.G * NWAVES * 64) {
        const int l = e / (BATCH * 6 * D), n = e % (6 * D);
        float s = KIN(I_BADA)[(size_t)l * 6 * D + n];
#pragma unroll 8
        for (int k = 0; k < 32; ++k) s += adap[(size_t)k * (DEPTH * BATCH * 6 * D) + e];
        ada[e] = s;
    }
    GRID_BAR();
    if (PH(2)) thin_phase<false, true>(F, x_in, nullptr, nullptr, Hb, nullptr, nullptr, KIN(I_GPREMIX), ada + D, ada);
    GRID_BAR();
    }

    for (int l = 0; l < DEPTH; ++l) {
#ifndef P1_REP
#define P1_REP 1
#endif
#pragma unroll 1
        for (int rp_ = 0; rp_ < P1_REP; ++rp_) {
        if (PH(3)) { pg8::Gemm g{Hb, (const bf16*)(wl + W_IN), M, PROJ_W, D}; pg8::StaticOrder S; S.init(M, PROJ_W, F.G, (int)blockIdx.x);
          pg8::EpiProj E{PROJ, PROJ_W, SSQ, KR, tab, (pg8::u32x4*)GRB, (pg8::u32x4*)GSB};
          pg8::gemm_phase<pg8::EpiProj, pg8::StaticOrder, PG8_ALIGN_P1, PG8_SP2>(F.lds, g, S, E); }
        }
        GRID_BAR();
#ifndef P3_REP
#define P3_REP 1
#endif
#pragma unroll 1
        for (int rep3 = 0; rep3 < P3_REP; ++rep3) {
        if (PH(5)) { pg8::Gemm g{PROJ + C_QD, (const bf16*)(wl + W_UQ), M, QW, QRANK, PROJ_W}; pg8::StaticOrder S; S.init(M, QW, F.G, (int)blockIdx.x);
          pg8::EpiRope E{QF, QW, tab, SSQ};
          pg8::gemm_phase<pg8::EpiRope, pg8::StaticOrder, PG8_ALIGN, PG8_SP2>(F.lds, g, S, E); }
        if (PH(5)) { pg8::Gemm g{PROJ + C_KVD, (const bf16*)(wl + W_UKV), M, KVW, KVRANK, PROJ_W}; pg8::EpiScale E{KVF, KVW, SSQ};
          if (F.G == 256) { pg8::UnevenOrder S; S.init(M, KVW, F.G, (int)blockIdx.x);
            pg8::gemm_phase<pg8::EpiScale, pg8::UnevenOrder, PG8_ALIGN, PG8_SP2>(F.lds, g, S, E); }
          else { pg8::StaticOrder S; S.init(M, KVW, F.G, (int)blockIdx.x);
            pg8::gemm_phase<pg8::EpiScale, pg8::StaticOrder, PG8_ALIGN, PG8_SP2>(F.lds, g, S, E); } }
        }
        GRID_BAR();
#ifndef P4_REP
#define P4_REP 1
#endif
#pragma unroll 1
        for (int rp_ = 0; rp_ < P4_REP; ++rp_) {
        if (PH(6)) for (int item = blockIdx.x; item < 512; item += F.G) {
            const int kind = item >> 8, c = item & 255, bh = (c & 7) * 4 + ((c >> 3) >> 3), y = (c >> 3) & 7, b = bh >> 4, h = bh & 15;
            const size_t rb = (size_t)b * SEQ;
            if (kind == 0) { if (PH(14)) {
                att::Tensors T{PROJ + rb * PROJ_W + h * 128, PROJ_W, PROJ + rb * PROJ_W + SBW + h * 128, PROJ_W, PROJ + rb * PROJ_W + 2 * SBW + h * 128, PROJ_W, nullptr, OSB + rb * (2 * SBW) + h * 128, 2 * SBW};
                att::attn_unit<0>(T, 15 - y, 0.08838834764831845f * 1.4426950408889634f, (LAS char*)F.lds);
                att::attn_unit<0>(T, y, 0.08838834764831845f * 1.4426950408889634f, (LAS char*)F.lds); }
            } else if (PH(15)) {
                att::Tensors T{QF + rb * QW + h * 192, QW, KVF + rb * KVW + h * 256, KVW, KVF + rb * KVW + h * 256 + 128, KVW, KR + rb * ROPE, OSB + rb * (2 * SBW) + SBW + h * 128, 2 * SBW};
                att::attn_unit<1>(T, 15 - y, 0.07216878364870323f * 1.4426950408889634f, (LAS char*)F.lds);
                att::attn_unit<1>(T, y, 0.07216878364870323f * 1.4426950408889634f, (LAS char*)F.lds);
            }
        }
        }
        GRID_BAR();
#ifndef P5_REP
#define P5_REP 1
#endif
#pragma unroll 1
        for (int rep5 = 0; rep5 < P5_REP; ++rep5)
        if (PH(7)) { pg8::Gemm g{OSB, (const bf16*)(wl + W_OSB), M, D, 2 * SBW}; pg8::StaticOrder S; S.init(M, D, F.G, (int)blockIdx.x);
          pg8::EpiGateMerge E{MRG, D, (const pg8::u32x4*)GRB, (const pg8::u32x4*)GSB};
          pg8::gemm_phase<pg8::EpiGateMerge, pg8::StaticOrder, PG8_ALIGN, PG8_SP2>(F.lds, g, S, E); }
        GRID_BAR();
#ifndef P7_REP
#define P7_REP 1
#endif
#pragma unroll 1
        for (int rep7 = 0; rep7 < P7_REP; ++rep7) {
#ifdef P7_REPB
        if (rep7) GRID_BAR();
#endif
#ifdef P7_MREP
        if (PH(9)) { pg8::Gemm g{MRG, (const bf16*)(wl + W_OUT), M, D, D}; pg8::RepOrder S; S.init(M, D, F.G, (int)blockIdx.x); S.reps = P7_MREP;
          pg8::EpiBf16<0> E{Yb, D};
          pg8::gemm_phase<pg8::EpiBf16<0>, pg8::RepOrder, PG8_ALIGN, PG8_SP2>(F.lds, g, S, E); }
#else
        if (PH(9)) { pg8::Gemm g{MRG, (const bf16*)(wl + W_OUT), M, D, D}; pg8::StaticOrder S; S.init(M, D, F.G, (int)blockIdx.x);
          pg8::EpiBf16<0> E{Yb, D};
          pg8::gemm_phase<pg8::EpiBf16<0>, pg8::StaticOrder, PG8_ALIGN, PG8_SP2>(F.lds, g, S, E); }
#endif
        }
        GRID_BAR();
#if XRES_BF16
#ifdef THIN_REP
        for (int rp_ = 1; rp_ < THIN_REP; ++rp_) { if (l == 0) thin_phase<true, true, false, true>(F, x_in, (bf16*)GRB, Yb, (bf16*)GSB, KIN(I_GPOSTMIX) + (size_t)l * D, adl + 2 * D, KIN(I_GPREMLP) + (size_t)l * D, adl + 4 * D, adl + 3 * D);
            else thin_phase<true, true, true, true>(F, XB, (bf16*)GRB, Yb, (bf16*)GSB, KIN(I_GPOSTMIX) + (size_t)l * D, adl + 2 * D, KIN(I_GPREMLP) + (size_t)l * D, adl + 4 * D, adl + 3 * D); }
#endif
        if (PH(10)) { if (l == 0) thin_phase<true, true, false, true>(F, x_in, XB, Yb, Hb, KIN(I_GPOSTMIX) + (size_t)l * D, adl + 2 * D, KIN(I_GPREMLP) + (size_t)l * D, adl + 4 * D, adl + 3 * D);
            else thin_phase<true, true, true, true>(F, XB, XB, Yb, Hb, KIN(I_GPOSTMIX) + (size_t)l * D, adl + 2 * D, KIN(I_GPREMLP) + (size_t)l * D, adl + 4 * D, adl + 3 * D); }
#else
        if (PH(10)) thin_phase<true, true>(F, l == 0 ? x_in : (const float*)xo, xo, Yb, Hb, KIN(I_GPOSTMIX) + (size_t)l * D, adl + 2 * D, KIN(I_GPREMLP) + (size_t)l * D, adl + 4 * D, adl + 3 * D);
#endif
        GRID_BAR();
#ifndef P9_REP
#define P9_REP 1
#endif
#pragma unroll 1
        for (int rp_ = 0; rp_ < P9_REP; ++rp_) {
        if (PH(11)) { pg8::Gemm g{Hb, (const bf16*)(wl + W_UP), M, DFF, D}; pg8::StaticOrder S; S.init(M, DFF, F.G, (int)blockIdx.x);
          pg8::EpiBf16<1> E{U, DFF};
          pg8::gemm_phase<pg8::EpiBf16<1>, pg8::StaticOrder, PG8_ALIGN, PG8_SP2>(F.lds, g, S, E); }
        }
        GRID_BAR();
#ifndef P10_REP
#define P10_REP 1
#endif
#pragma unroll 1
        for (int rp_ = 0; rp_ < P10_REP; ++rp_) {
        if (PH(12)) { pg8::Gemm g{U, (const bf16*)(wl + W_DOWN), M, D, DFF}; pg8::StaticOrder S; S.init(M, D, F.G, (int)blockIdx.x);
          pg8::EpiBf16<0> E{Yb, D};
          pg8::gemm_phase<pg8::EpiBf16<0>, pg8::StaticOrder, PG8_ALIGN, PG8_SP2>(F.lds, g, S, E); }
        }
        GRID_BAR();
#if XRES_BF16
#ifdef THIN_REP
        for (int rp_ = 1; rp_ < THIN_REP; ++rp_) if (l + 1 < DEPTH) { const float* adn = ada + (size_t)(l + 1) * BATCH * 6 * D;
                thin_phase<true, true, true, true>(F, XB, (bf16*)GRB, Yb, (bf16*)GSB, KIN(I_GPOSTMLP) + (size_t)l * D, adl + 5 * D, KIN(I_GPREMIX) + (size_t)(l + 1) * D, adn + D, adn); }
#endif
        if (PH(13)) { if (l + 1 < DEPTH) { const float* adn = ada + (size_t)(l + 1) * BATCH * 6 * D;
                thin_phase<true, true, true, true>(F, XB, XB, Yb, Hb, KIN(I_GPOSTMLP) + (size_t)l * D, adl + 5 * D, KIN(I_GPREMIX) + (size_t)(l + 1) * D, adn + D, adn); }
            else thin_phase<true, false, true, false>(F, XB, xo, Yb, nullptr, KIN(I_GPOSTMLP) + (size_t)l * D, adl + 5 * D, nullptr, nullptr, nullptr); }
#else
        if (PH(13)) { if (l + 1 < DEPTH) { const float* adn = ada + (size_t)(l + 1) * BATCH * 6 * D;
                thin_phase<true, true>(F, xo, xo, Yb, Hb, KIN(I_GPOSTMLP) + (size_t)l * D, adl + 5 * D, KIN(I_GPREMIX) + (size_t)(l + 1) * D, adn + D, adn); }
            else thin_phase<true, false>(F, xo, xo, Yb, nullptr, KIN(I_GPOSTMLP) + (size_t)l * D, adl + 5 * D, nullptr, nullptr, nullptr); }
#endif
        if (l + 1 < DEPTH) GRID_BAR();
    }
    if (blockIdx.x == 0 && F.tid == 0 && __hip_atomic_load((unsigned*)(ctl + CW_BAR) + XB_TMO, RLX_AGENT) != 0u) xo[0] = __builtin_nanf("");
}
#undef ada
#undef tab
#undef adap
#undef Hb
#undef PROJ
#undef SSQ
#undef KR
#undef QF
#undef KVF
#undef OSB
#undef MRG
#undef Yb
#undef XB
#undef U
#undef GRB
#undef GSB
#undef x_in
#undef wl
#undef adl


extern "C" void kernel_launch(void* const* d_in, const int* in_sizes, int n_in, void* d_out, int out_size, void* d_ws, size_t ws_size, hipStream_t stream) {
    static int grid = 0;
    if (grid == 0) {
        if (n_in != 19 || out_size != M * D || ws_size < WS_END) { fprintf(stderr, "kernel_launch: unexpected shapes (n_in %d, out %d, ws %zu < %zu)\n", n_in, out_size, ws_size, (size_t)WS_END); grid = -1; return; }
        int dev = 0, cus = 0, per_cu = 0;
        if (hipGetDevice(&dev) != hipSuccess || hipDeviceGetAttribute(&cus, hipDeviceAttributeMultiprocessorCount, dev) != hipSuccess) { grid = -1; return; }
        if (hipFuncSetAttribute((const void*)hybrid_fwd, hipFuncAttributeMaxDynamicSharedMemorySize, LDS_BYTES) != hipSuccess) { fprintf(stderr, "kernel_launch: hipFuncSetAttribute failed\n"); grid = -1; return; }
        if (hipOccupancyMaxActiveBlocksPerMultiprocessor(&per_cu, (const void*)hybrid_fwd, NWAVES * 64, LDS_BYTES) != hipSuccess || per_cu < 1) { fprintf(stderr, "kernel_launch: occupancy query says %d\n", per_cu); (void)hipGetLastError(); }
        grid = cus;
    }
    if (grid < 0) return;
    if (hipMemsetAsync((char*)d_ws + WS_CTL, 0, CTL_ZERO_BYTES, stream) != hipSuccess) return;
    Args a{};
    for (int i = 0; i < 19; ++i) a.in[i] = (const float*)d_in[i];
    a.out = (float*)d_out; a.ws = (unsigned char*)d_ws;
    hipLaunchKernelGGL(hybrid_fwd, dim3(grid), dim3(NWAVES * 64), LDS_BYTES, stream, a);
#ifdef DBG_CHECK
    hipLaunchKernelGGL(dbg_check, dim3(DBG_NCHK), dim3(256), 0, stream, a, (unsigned*)((char*)d_ws + 4096));
    hipLaunchKernelGGL(dbg_report, dim3(1), dim3(64), 0, stream, (float*)d_out, (const unsigned*)((char*)d_ws + 4096));
#endif
}
```

```cpp
#include <hip/hip_runtime.h>
#include <cstdio>
#include <cstdint>
#include <cmath>
#ifndef PG8_WGM
#define PG8_WGM 8
#endif
namespace pg8 {
#define PG8_LAS __attribute__((address_space(3)))
typedef unsigned short bf16_t;
typedef short bf16x8 __attribute__((ext_vector_type(8)));
typedef float f32x4 __attribute__((ext_vector_type(4)));
typedef unsigned u32x4 __attribute__((ext_vector_type(4)));
constexpr int BM = 256, BK = 64, HALF = 128, HTB = HALF * BK * 2  , STAGE_BYTES = 8 * HTB, NXCD = 8, WGM = PG8_WGM;

__host__ __device__ __forceinline__ int lds_byte(int r, int c) { const int st = (r >> 4) * 2 + (c >> 5), rr = r & 15, cc = c & 31, ob = rr * 64 + cc * 2; return st * 1024 + (ob ^ (((ob >> 9) & 1) << 5)); }
__host__ __device__ __forceinline__ void stage_rc(int b, int& R, int& C) { const int st = b / 1024, sb = b % 1024, swz = sb ^ (((sb >> 9) & 1) << 5); R = (st >> 1) * 16 + swz / 64; C = (st & 1) * 32 + (swz % 64) / 2; }
__host__ __device__ __forceinline__ int perm32(int rho) { const int n = rho >> 4, i = rho & 15; return 8 * (i >> 2) + 4 * n + (i & 3); }

struct Unit { int pm, pn; };
struct Gemm { const bf16_t* A; const bf16_t* Bt; int M, N, K; int lda = 0; };

struct StaticOrder {
    int nM, nN, nwg, G, c;
    __host__ __device__ void init(int M, int N, int G_, int c_) { nM = M / BM; nN = N / BM; nwg = nM * nN; G = G_; c = c_; }
    __host__ __device__ bool next(int i, Unit& u) const {
        const long L = (long)i * G + c; if (L >= nwg) return false;
        int wgid = (int)L; { const int q = nwg / NXCD, r = nwg % NXCD, xcd = wgid % NXCD, off = wgid / NXCD; wgid = (xcd < r ? xcd * (q + 1) : r * (q + 1) + (xcd - r) * q) + off; }
        const int nig = WGM * nN, gid = wgid / nig, fm = gid * WGM, gsz = (nM - fm) < WGM ? (nM - fm) : WGM;
        u.pm = fm + ((wgid % nig) % gsz); u.pn = (wgid % nig) / gsz; return true;
    }
    __device__ __forceinline__ void a_ready(const Unit&) const {}
    __device__ __forceinline__ void done(const Unit&) const {}
};

struct UnevenOrder : StaticOrder {
    __host__ __device__ bool next(int i, Unit& u) const {
        long L; const int h = G / 2;
        if (c < h) { if (i > 0) return false; L = c; } else { if (i > 2) return false; L = h + (long)h * i + (c - h); }
        if (L >= nwg) return false;
        int wgid = (int)L; { const int q = nwg / NXCD, r = nwg % NXCD, xcd = wgid % NXCD, off = wgid / NXCD; wgid = (xcd < r ? xcd * (q + 1) : r * (q + 1) + (xcd - r) * q) + off; }
        const int nig = WGM * nN, gid = wgid / nig, fm = gid * WGM, gsz = (nM - fm) < WGM ? (nM - fm) : WGM;
        u.pm = fm + ((wgid % nig) % gsz); u.pn = (wgid % nig) / gsz; return true;
    }
};

struct RepOrder : StaticOrder {
    int reps;
    __host__ __device__ bool next(int i, Unit& u) const { const int per = (nwg + G - 1) / G; if (i >= per * reps) return false; return StaticOrder::next(i % per, u); }
};
__device__ __forceinline__ unsigned cvt_pk_bf16(float lo, float hi) { unsigned r; asm volatile("v_cvt_pk_bf16_f32 %0, %1, %2" : "=v"(r) : "v"(lo), "v"(hi)); return r; }
typedef float f32x2 __attribute__((ext_vector_type(2)));

__device__ __forceinline__ float bf_lo(unsigned w) { return __builtin_bit_cast(float, w << 16); }
__device__ __forceinline__ float bf_hi(unsigned w) { return __builtin_bit_cast(float, w & 0xffff0000u); }
__device__ __forceinline__ float sigmoidf_fast(float x) { return __builtin_amdgcn_rcpf(1.0f + __builtin_amdgcn_exp2f(-1.4426950408889634f * x)); }

#ifndef EPI_WT
#define EPI_WT 0
#endif
__device__ __forceinline__ void st16_out(bf16_t* p, u32x4 w) {
#if EPI_WT
    asm volatile("global_store_dwordx4 %0, %1, off sc1" :: "v"((__attribute__((address_space(1))) u32x4*)p), "v"(w) : "memory");
#else
    *(u32x4*)p = w;
#endif
}
template <int ACT  > struct EpiBf16 {
    static constexpr bool PERM = true, AFTER_DRAIN = false, MID = false;
    bf16_t* O; int ldc;
    __device__ __forceinline__ void operator()(const f32x4 (&acc)[2][2][4][2], const Unit& u, int wr, int wc, int fr, int fq) const {
        const int row0 = u.pm * BM + wr * 64 + fr, col0 = u.pn * BM + wc * 32 + 8 * fq;
#pragma unroll
        for (int ai = 0; ai < 2; ++ai)
#pragma unroll
            for (int m = 0; m < 4; ++m) { bf16_t* rowp = O + (size_t)(row0 + ai * HALF + m * 16) * ldc + col0;
#pragma unroll
                for (int bj = 0; bj < 2; ++bj) { f32x4 v0 = acc[ai][bj][m][0], v1 = acc[ai][bj][m][1];
                    if (ACT == 1) {
#pragma unroll
                        for (int j = 0; j < 4; ++j) { const float a = fmaxf(v0[j], 0.f), b = fmaxf(v1[j], 0.f); v0[j] = a * a; v1[j] = b * b; } }
                    u32x4 w; w.x = cvt_pk_bf16(v0[0], v0[1]); w.y = cvt_pk_bf16(v0[2], v0[3]); w.z = cvt_pk_bf16(v1[0], v1[1]); w.w = cvt_pk_bf16(v1[2], v1[3]);
                    st16_out(rowp + bj * HALF, w);
                    } }
    }
};
struct EpiProj {
    static constexpr bool PERM = true, AFTER_DRAIN = false, MID = false;
    static constexpr int SSQ_T0 = 24, ROPE_T = 30, GATE_T0 = 31;
    bf16_t* O; int ldc; float* SSQ; bf16_t* KRo; const float* tab; u32x4* GR; u32x4* GS;
    __device__ __forceinline__ void operator()(const f32x4 (&acc)[2][2][4][2], const Unit& u, int wr, int wc, int fr, int fq) const {
        const int row0 = u.pm * BM + wr * 64 + fr, col0 = u.pn * BM + wc * 32 + 8 * fq;
        const bool do_ssq = (u.pn >= SSQ_T0) && (u.pn < SSQ_T0 + 6), do_rope = (u.pn == ROPE_T) && (wc < 2);
        if (u.pn >= GATE_T0) {
            const int t = u.pn - GATE_T0; const size_t e0 = ((size_t)((u.pm * 16 + (t >> 1)) * 16 + (t & 1))) * 512 + (size_t)((wr * 4 + wc) * 64 + fr + 16 * fq);
#pragma unroll
            for (int ai = 0; ai < 2; ++ai)
#pragma unroll
                for (int m = 0; m < 4; ++m) { float r[8], sg[8];
#pragma unroll
                    for (int n = 0; n < 2; ++n)
#pragma unroll
                        for (int j = 0; j < 4; ++j) { const float e1 = __builtin_amdgcn_exp2f(-1.4426950408889634f * acc[ai][0][m][n][j]), e2 = __builtin_amdgcn_exp2f(-1.4426950408889634f * acc[ai][1][m][n][j]);
                            sg[4 * n + j] = __builtin_amdgcn_rcpf(1.0f + e2); r[4 * n + j] = (1.0f + e2) * __builtin_amdgcn_rcpf(1.0f + e1); }
                    u32x4 rw, sw; rw.x = cvt_pk_bf16(r[0], r[1]); rw.y = cvt_pk_bf16(r[2], r[3]); rw.z = cvt_pk_bf16(r[4], r[5]); rw.w = cvt_pk_bf16(r[6], r[7]);
                    sw.x = cvt_pk_bf16(sg[0], sg[1]); sw.y = cvt_pk_bf16(sg[2], sg[3]); sw.z = cvt_pk_bf16(sg[4], sg[5]); sw.w = cvt_pk_bf16(sg[6], sg[7]);
                    GR[e0 + (size_t)(ai * 8 + m * 2) * 512] = rw; GS[e0 + (size_t)(ai * 8 + m * 2) * 512] = sw; }
            return;
        }
#pragma unroll
        for (int ai = 0; ai < 2; ++ai)
#pragma unroll
            for (int m = 0; m < 4; ++m) { const int row = row0 + ai * HALF + m * 16; bf16_t* rowp = O + (size_t)row * ldc + col0;
                float ss = 0.f;
#pragma unroll
                for (int bj = 0; bj < 2; ++bj) { const f32x4 v0 = acc[ai][bj][m][0], v1 = acc[ai][bj][m][1];
                    u32x4 w; w.x = cvt_pk_bf16(v0[0], v0[1]); w.y = cvt_pk_bf16(v0[2], v0[3]); w.z = cvt_pk_bf16(v1[0], v1[1]); w.w = cvt_pk_bf16(v1[2], v1[3]);
                    st16_out(rowp + bj * HALF, w);
                    if (do_ssq) { const unsigned ww[4] = {w.x, w.y, w.z, w.w};
#pragma unroll
                        for (int q = 0; q < 4; ++q) { const float a = bf_lo(ww[q]), b = bf_hi(ww[q]); ss += a * a + b * b; } }
                    if (bj == 0 && do_rope) { const int co = wc * 32 + 8 * fq; const float* tp = tab + (size_t)row * 64 + co;
                        const f32x4 t0 = *(const f32x4*)tp, t1 = *(const f32x4*)(tp + 4);
                        f32x4 r0, r1;
                        r0[0] = v0[0] * t0[0] - v0[1] * t0[1]; r0[1] = v0[1] * t0[0] + v0[0] * t0[1];
                        r0[2] = v0[2] * t0[2] - v0[3] * t0[3]; r0[3] = v0[3] * t0[2] + v0[2] * t0[3];
                        r1[0] = v1[0] * t1[0] - v1[1] * t1[1]; r1[1] = v1[1] * t1[0] + v1[0] * t1[1];
                        r1[2] = v1[2] * t1[2] - v1[3] * t1[3]; r1[3] = v1[3] * t1[2] + v1[2] * t1[3];
                        u32x4 k; k.x = cvt_pk_bf16(r0[0], r0[1]); k.y = cvt_pk_bf16(r0[2], r0[3]); k.z = cvt_pk_bf16(r1[0], r1[1]); k.w = cvt_pk_bf16(r1[2], r1[3]);
                        *(u32x4*)(KRo + (size_t)row * 64 + co) = k; } }
                if (do_ssq) { ss += __shfl_xor(ss, 16); ss += __shfl_xor(ss, 32);
                    if (fq == 0) SSQ[(size_t)row * 32 + 4 * (u.pn - SSQ_T0) + wc] = ss; } }
    }
};
template <int S0, int NS> __device__ __forceinline__ void row_rms_scales(float (&rs)[2][4], const float* SSQ, int row0, int fq, float inv_dim) {
    float part[2][4];
#pragma unroll
    for (int ai = 0; ai < 2; ++ai)
#pragma unroll
        for (int m = 0; m < 4; ++m) { const float* p = SSQ + (size_t)(row0 + ai * HALF + m * 16) * 32 + S0 + (NS / 4) * fq;
            if constexpr (NS == 16) { const f32x4 v = *(const f32x4*)p; part[ai][m] = (v[0] + v[1]) + (v[2] + v[3]); }
            else { const f32x2 v = *(const f32x2*)p; part[ai][m] = v[0] + v[1]; } }
#pragma unroll
    for (int ai = 0; ai < 2; ++ai)
#pragma unroll
        for (int m = 0; m < 4; ++m) { float t = part[ai][m]; t += __shfl_xor(t, 16); t += __shfl_xor(t, 32); rs[ai][m] = 1.0f / sqrtf(t * inv_dim + 1e-6f); }
}
struct EpiScale {
    static constexpr bool PERM = true, AFTER_DRAIN = false, MID = false;
    bf16_t* O; int ldc; const float* SSQ;
    __device__ __forceinline__ void operator()(const f32x4 (&acc)[2][2][4][2], const Unit& u, int wr, int wc, int fr, int fq) const {
        const int row0 = u.pm * BM + wr * 64 + fr, col0 = u.pn * BM + wc * 32 + 8 * fq;
        float rs[2][4]; row_rms_scales<16, 8>(rs, SSQ, row0, fq, 1.0f / 512.0f);
#pragma unroll
        for (int ai = 0; ai < 2; ++ai)
#pragma unroll
            for (int m = 0; m < 4; ++m) { bf16_t* rowp = O + (size_t)(row0 + ai * HALF + m * 16) * ldc + col0; const float r = rs[ai][m];
#pragma unroll
                for (int bj = 0; bj < 2; ++bj) { const f32x4 v0 = acc[ai][bj][m][0] * r, v1 = acc[ai][bj][m][1] * r;
                    u32x4 w; w.x = cvt_pk_bf16(v0[0], v0[1]); w.y = cvt_pk_bf16(v0[2], v0[3]); w.z = cvt_pk_bf16(v1[0], v1[1]); w.w = cvt_pk_bf16(v1[2], v1[3]);
                    st16_out(rowp + bj * HALF, w); } }
    }
};
struct EpiRope {
    static constexpr bool PERM = true, AFTER_DRAIN = false, MID = false;
    bf16_t* O; int ldc; const float* tab; const float* SSQ;
    __device__ __forceinline__ void operator()(const f32x4 (&acc)[2][2][4][2], const Unit& u, int wr, int wc, int fr, int fq) const {
        const int row0 = u.pm * BM + wr * 64 + fr, col0 = u.pn * BM + wc * 32 + 8 * fq;
        float rs[2][4]; row_rms_scales<0, 16>(rs, SSQ, row0, fq, 1.0f / 1024.0f);
        const int j0 = col0 % 192, j1 = (col0 + HALF) % 192, rbj = (j0 >= 128) ? 0 : (j1 >= 128) ? 1 : -1, jr = (rbj == 0 ? j0 : j1) - 128;
#pragma unroll
        for (int ai = 0; ai < 2; ++ai) {
            f32x4 t0[4], t1[4];
            if (rbj >= 0) {
#pragma unroll
                for (int m = 0; m < 4; ++m) { const float* tp = tab + (size_t)(row0 + ai * HALF + m * 16) * 64 + jr;
                    t0[m] = *(const f32x4*)tp; t1[m] = *(const f32x4*)(tp + 4); }
            }
#pragma unroll
            for (int m = 0; m < 4; ++m) { const int row = row0 + ai * HALF + m * 16; bf16_t* rowp = O + (size_t)row * ldc + col0;
#pragma unroll
                for (int bj = 0; bj < 2; ++bj) { f32x4 v0 = acc[ai][bj][m][0] * rs[ai][m], v1 = acc[ai][bj][m][1] * rs[ai][m];
                    if (bj == rbj) { const f32x4 a0 = t0[m], a1 = t1[m];
                        f32x4 r0, r1;
                        r0[0] = v0[0] * a0[0] - v0[1] * a0[1]; r0[1] = v0[1] * a0[0] + v0[0] * a0[1];
                        r0[2] = v0[2] * a0[2] - v0[3] * a0[3]; r0[3] = v0[3] * a0[2] + v0[2] * a0[3];
                        r1[0] = v1[0] * a1[0] - v1[1] * a1[1]; r1[1] = v1[1] * a1[0] + v1[0] * a1[1];
                        r1[2] = v1[2] * a1[2] - v1[3] * a1[3]; r1[3] = v1[3] * a1[2] + v1[2] * a1[3];
                        v0 = r0; v1 = r1; }
                    u32x4 w; w.x = cvt_pk_bf16(v0[0], v0[1]); w.y = cvt_pk_bf16(v0[2], v0[3]); w.z = cvt_pk_bf16(v1[0], v1[1]); w.w = cvt_pk_bf16(v1[2], v1[3]);
                    st16_out(rowp + bj * HALF, w); } }
            asm volatile("" ::: "memory"); }
    }
};
struct EpiGateMerge {
    static constexpr bool PERM = true, AFTER_DRAIN = false, MID = true;
    bf16_t* O; int ldo; const u32x4* GR; const u32x4* GS;
    __device__ __forceinline__ void mid(f32x4 (&acc)[2][2][4][2], const Unit& u, int wr, int wc, int fr, int fq) const {
        int fr_ = fr, fq_ = fq; asm volatile("" : "+v"(fr_), "+v"(fq_));
        const u32x4* p = GR + (size_t)((u.pm * 16 + u.pn) * 16) * 512 + (size_t)((wr * 4 + wc) * 64 + fr_ + 16 * fq_);
        u32x4 g[2][4][2];
#pragma unroll
        for (int ai = 0; ai < 2; ++ai)
#pragma unroll
            for (int m = 0; m < 4; ++m)
#pragma unroll
                for (int bj = 0; bj < 2; ++bj) g[ai][m][bj] = p[(ai * 8 + m * 2 + bj) * 512];
#pragma unroll
        for (int ai = 0; ai < 2; ++ai)
#pragma unroll
            for (int m = 0; m < 4; ++m)
#pragma unroll
                for (int bj = 0; bj < 2; ++bj) { const u32x4 a = g[ai][m][bj]; const unsigned aw[4] = {a.x, a.y, a.z, a.w};
#pragma unroll
                    for (int q = 0; q < 4; ++q) { acc[ai][bj][m][q >> 1][2 * (q & 1)] *= bf_lo(aw[q]); acc[ai][bj][m][q >> 1][2 * (q & 1) + 1] *= bf_hi(aw[q]); } }
    }
    __device__ __forceinline__ void operator()(const f32x4 (&acc)[2][2][4][2], const Unit& u, int wr, int wc, int fr, int fq) const {
        const int row0 = u.pm * BM + wr * 64 + fr, col0 = u.pn * BM + wc * 32 + 8 * fq;
        const u32x4* p = GS + (size_t)((u.pm * 16 + u.pn) * 16) * 512 + (size_t)((wr * 4 + wc) * 64 + fr + 16 * fq);
        u32x4 g[2][4][2];
#pragma unroll
        for (int ai = 0; ai < 2; ++ai)
#pragma unroll
            for (int m = 0; m < 4; ++m)
#pragma unroll
                for (int bj = 0; bj < 2; ++bj) g[ai][m][bj] = p[(ai * 8 + m * 2 + bj) * 512];
#pragma unroll
        for (int ai = 0; ai < 2; ++ai)
#pragma unroll
            for (int m = 0; m < 4; ++m) { bf16_t* op = O + (size_t)(row0 + ai * HALF + m * 16) * ldo + col0;
#pragma unroll
                for (int bj = 0; bj < 2; ++bj) { const f32x4 v0 = acc[ai][bj][m][0], v1 = acc[ai][bj][m][1]; const u32x4 s = g[ai][m][bj];
                    u32x4 w; w.x = cvt_pk_bf16(v0[0] * bf_lo(s.x), v0[1] * bf_hi(s.x)); w.y = cvt_pk_bf16(v0[2] * bf_lo(s.y), v0[3] * bf_hi(s.y));
                    w.z = cvt_pk_bf16(v1[0] * bf_lo(s.z), v1[1] * bf_hi(s.z)); w.w = cvt_pk_bf16(v1[2] * bf_lo(s.w), v1[3] * bf_hi(s.w));
                    st16_out(op + bj * HALF, w); } }
    }
};

template <class Epi, class Sched, bool ALIGN_EPI = false, bool SP2 = false>
__device__ __forceinline__ void gemm_phase(PG8_LAS unsigned char* lds, const Gemm g, const Sched& S, const Epi& E) {
    int tid_ = threadIdx.x; asm volatile("" : "+v"(tid_));
    const int tid = tid_, wid = __builtin_amdgcn_readfirstlane(tid >> 6), lane = tid & 63, wr = wid >> 2, wc = wid & 3, fr = lane & 15, fq = lane >> 4;
    const int K = g.K, nt = K / BK, lda = g.lda ? g.lda : K;
#ifndef PG8_KROT
#define PG8_KROT 0
#endif
#if PG8_KROT
    const int ktm = nt - 1, kt0 = Epi::MID ? 0 : ((int)((blockIdx.x & 7u) * (unsigned)(nt >> 3)) * PG8_KROT) & ktm;
#define PG8_KP(base, t) ((base) + (size_t)(((t) + kt0) & ktm) * kstep)
#define PG8_KPB(base, t) ((base) + (size_t)(((t) + kt0) & ktm) * kstepB)
#else
#define PG8_KP(base, t) ((base) + (size_t)(t) * kstep)
#define PG8_KPB(base, t) ((base) + (size_t)(t) * kstepB)
#endif
    unsigned voffA[2], voffB[2];
#pragma unroll
    for (int i = 0; i < 2; ++i) { int R, C; stage_rc(tid * 16 + i * 8192, R, C); const int Rb = Epi::PERM ? ((R & ~31) + perm32(R & 31)) : R;
        voffA[i] = (unsigned)(R * lda + C) * 2u; voffB[i] = (unsigned)(Rb * BK + C) * 2u; }
    const size_t kstep = (size_t)(BK * 2);
    const size_t kstepB = (size_t)g.N * (BK * 2);
    const size_t hstepA = (size_t)HALF * lda * 2, hstepB = (size_t)HALF * BK * 2;
    const size_t tstepA = 2 * hstepA, tstepB = 2 * hstepB;
    const unsigned ldsw = (unsigned)wid * 1024u;
    const int aoff = lds_byte(wr * 64 + fr, fq * 8), boff = lds_byte(wc * 32 + fr, fq * 8);
#define PG8_SA(b, h) (((b) * 2 + (h)) * HTB)
#define PG8_SB(b, h) ((4 + (b) * 2 + (h)) * HTB)
#define PG8_STAGE(bufoff, gbase, voff) do { _Pragma("unroll") for (int _i = 0; _i < 2; ++_i) \
        __builtin_amdgcn_global_load_lds((const unsigned*)((const char*)(gbase) + (voff)[_i]), (PG8_LAS unsigned*)(lds + (bufoff) + ldsw + _i * 8192), 16, 0, 0); } while (0)
#define PG8_LDA(dst, b, h) do { _Pragma("unroll") for (int m = 0; m < 4; ++m) _Pragma("unroll") for (int k = 0; k < 2; ++k) dst[m][k] = *(const PG8_LAS bf16x8*)(lds + PG8_SA(b, h) + aoff + m * 2048 + k * 1024); } while (0)
#define PG8_LDB(dst, b, h) do { _Pragma("unroll") for (int n = 0; n < 2; ++n) _Pragma("unroll") for (int k = 0; k < 2; ++k) dst[n][k] = *(const PG8_LAS bf16x8*)(lds + PG8_SB(b, h) + boff + n * 2048 + k * 1024); } while (0)
#ifndef PG8_PRIO
#define PG8_PRIO 1
#endif
#define PG8_MMA(ai, bj, At, Bt) do { if (PG8_PRIO) __builtin_amdgcn_s_setprio(PG8_PRIO); _Pragma("unroll") for (int m = 0; m < 4; ++m) _Pragma("unroll") for (int n = 0; n < 2; ++n) _Pragma("unroll") for (int k = 0; k < 2; ++k) \
        acc[ai][bj][m][n] = __builtin_amdgcn_mfma_f32_16x16x32_bf16(Bt[n][k], At[m][k], acc[ai][bj][m][n], 0, 0, 0); if (PG8_PRIO) __builtin_amdgcn_s_setprio(0); } while (0)
#define PG8_WAIT_V(n) asm volatile("s_waitcnt vmcnt(" #n ")" ::: "memory")
#define PG8_WAIT_L(n) asm volatile("s_waitcnt lgkmcnt(" #n ")" ::: "memory")
#define PG8_BAR __builtin_amdgcn_s_barrier()
#define PG8_SCHED __builtin_amdgcn_sched_barrier(0)
    Unit cur, nxt; int ui = 0;
    if (!S.next(0, cur)) return;
    f32x4 acc[2][2][4][2];
#pragma unroll
    for (int a = 0; a < 2; ++a)
#pragma unroll
        for (int b = 0; b < 2; ++b)
#pragma unroll
            for (int m = 0; m < 4; ++m)
#pragma unroll
                for (int n = 0; n < 2; ++n) acc[a][b][m][n] = (f32x4){0.f, 0.f, 0.f, 0.f};
    bf16x8 At[4][2], B0[2][2], B1[2][2];
    const char* cA = (const char*)g.A + (size_t)cur.pm * tstepA; const char* cB = (const char*)g.Bt + (size_t)cur.pn * tstepB;
    S.a_ready(cur);
    if constexpr (SP2) {
        PG8_STAGE(PG8_SB(0, 0), PG8_KPB(cB, 0), voffB); PG8_STAGE(PG8_SB(0, 1), PG8_KPB(cB, 0) + hstepB, voffB); PG8_STAGE(PG8_SA(0, 0), PG8_KP(cA, 0), voffA); PG8_STAGE(PG8_SA(0, 1), PG8_KP(cA, 0) + hstepA, voffA);
        if (wr == 1) PG8_BAR;
        PG8_WAIT_V(2); PG8_BAR;
        PG8_STAGE(PG8_SB(1, 0), PG8_KPB(cB, 1), voffB); PG8_STAGE(PG8_SA(1, 0), PG8_KP(cA, 1), voffA); PG8_STAGE(PG8_SB(1, 1), PG8_KPB(cB, 1) + hstepB, voffB);
        PG8_WAIT_V(6); PG8_BAR;
    } else {
        PG8_STAGE(PG8_SB(0, 0), cB, voffB); PG8_STAGE(PG8_SA(0, 0), cA, voffA); PG8_STAGE(PG8_SB(0, 1), cB + hstepB, voffB); PG8_STAGE(PG8_SA(0, 1), cA + hstepA, voffA);
        if (wr == 1) PG8_BAR;
        PG8_WAIT_V(4); PG8_BAR;
        PG8_STAGE(PG8_SB(1, 0), cB + kstepB, voffB); PG8_STAGE(PG8_SA(1, 0), cA + kstep, voffA); PG8_STAGE(PG8_SB(1, 1), cB + hstepB + kstepB, voffB);
        PG8_WAIT_V(6); PG8_BAR;
    }
    for (;;) {
        const bool has_next = S.next(ui + 1, nxt);
        const char* nA = has_next ? (const char*)g.A + (size_t)nxt.pm * tstepA : cA; const char* nB = has_next ? (const char*)g.Bt + (size_t)nxt.pn * tstepB : cB;
        for (int t = 0; t < nt; t += 2) {
            const bool last = (t == nt - 2);
            const char* a1 = PG8_KP(cA, t + 1);
            const char* a2 = last ? PG8_KP(nA, 0) : PG8_KP(cA, t + 2); const char* b2 = last ? PG8_KPB(nB, 0) : PG8_KPB(cB, t + 2);
            const char* a3 = last ? PG8_KP(nA, 1) : PG8_KP(cA, t + 3); const char* b3 = last ? PG8_KPB(nB, 1) : PG8_KPB(cB, t + 3);
            if (last && has_next) S.a_ready(nxt);
            if constexpr (Epi::MID) { if (t == (nt >> 1)) E.mid(acc, cur, wr, wc, fr, fq); }
            if constexpr (SP2) {
            PG8_LDB(B0, 0, 0); PG8_LDB(B1, 0, 1); PG8_SCHED; PG8_LDA(At, 0, 0); PG8_STAGE(PG8_SA(1, 1), a1 + hstepA, voffA);
            PG8_WAIT_V(8); PG8_WAIT_L(0); PG8_BAR; PG8_MMA(0, 0, At, B0); PG8_MMA(0, 1, At, B1); PG8_BAR; PG8_SCHED;
            PG8_LDA(At, 0, 1); PG8_STAGE(PG8_SB(0, 0), b2, voffB); PG8_STAGE(PG8_SB(0, 1), b2 + hstepB, voffB); PG8_STAGE(PG8_SA(0, 0), a2, voffA);
            PG8_WAIT_V(8); PG8_WAIT_L(0); PG8_BAR; PG8_MMA(1, 0, At, B0); PG8_MMA(1, 1, At, B1); PG8_BAR; PG8_SCHED;
            PG8_LDB(B0, 1, 0); PG8_LDB(B1, 1, 1); PG8_SCHED; PG8_LDA(At, 1, 0); PG8_STAGE(PG8_SA(0, 1), a2 + hstepA, voffA);
            PG8_WAIT_V(8); PG8_WAIT_L(0); PG8_BAR; PG8_MMA(0, 0, At, B0); PG8_MMA(0, 1, At, B1); PG8_BAR; PG8_SCHED;
            PG8_LDA(At, 1, 1); PG8_STAGE(PG8_SB(1, 0), b3, voffB); PG8_STAGE(PG8_SB(1, 1), b3 + hstepB, voffB); PG8_STAGE(PG8_SA(1, 0), a3, voffA);
            PG8_WAIT_V(8); PG8_WAIT_L(0); PG8_BAR; PG8_MMA(1, 0, At, B0); PG8_MMA(1, 1, At, B1); PG8_BAR; PG8_SCHED;
            } else {
            PG8_LDB(B0, 0, 0); PG8_SCHED; PG8_LDA(At, 0, 0); PG8_STAGE(PG8_SA(1, 1), a1 + hstepA, voffA);
            PG8_WAIT_L(8); PG8_BAR; PG8_WAIT_L(0); PG8_MMA(0, 0, At, B0); PG8_BAR; PG8_SCHED;
            PG8_LDB(B1, 0, 1); PG8_STAGE(PG8_SB(0, 0), b2, voffB);
            PG8_BAR; PG8_WAIT_L(0); PG8_MMA(0, 1, At, B1); PG8_BAR;
            PG8_LDA(At, 0, 1); PG8_STAGE(PG8_SA(0, 0), a2, voffA);
            PG8_BAR; PG8_WAIT_L(0); PG8_MMA(1, 0, At, B0); PG8_BAR; PG8_SCHED;
            PG8_STAGE(PG8_SB(0, 1), b2 + hstepB, voffB);
            PG8_WAIT_V(6); PG8_BAR; PG8_MMA(1, 1, At, B1); PG8_BAR;
            PG8_LDB(B0, 1, 0); PG8_SCHED; PG8_LDA(At, 1, 0); PG8_STAGE(PG8_SA(0, 1), a2 + hstepA, voffA);
            PG8_WAIT_L(8); PG8_BAR; PG8_WAIT_L(0); PG8_MMA(0, 0, At, B0); PG8_BAR; PG8_SCHED;
            PG8_LDB(B1, 1, 1); PG8_STAGE(PG8_SB(1, 0), b3, voffB);
            PG8_BAR; PG8_WAIT_L(0); PG8_MMA(0, 1, At, B1); PG8_BAR;
            PG8_LDA(At, 1, 1); PG8_STAGE(PG8_SA(1, 0), a3, voffA);
            PG8_BAR; PG8_WAIT_L(0); PG8_MMA(1, 0, At, B0); PG8_BAR; PG8_SCHED;
            PG8_STAGE(PG8_SB(1, 1), b3 + hstepB, voffB);
            PG8_WAIT_V(6); PG8_BAR; PG8_MMA(1, 1, At, B1); PG8_BAR;
            }
        }
        if constexpr (ALIGN_EPI) { if (wr == 0) PG8_BAR; }
        if constexpr (!Epi::AFTER_DRAIN) { E(acc, cur, wr, wc, fr, fq); S.done(cur); }
        if (!has_next) break;
#pragma unroll
        for (int a = 0; a < 2; ++a)
#pragma unroll
            for (int b = 0; b < 2; ++b)
#pragma unroll
                for (int m = 0; m < 4; ++m)
#pragma unroll
                    for (int n = 0; n < 2; ++n) acc[a][b][m][n] = (f32x4){0.f, 0.f, 0.f, 0.f};
        cur = nxt; cA = nA; cB = nB; ++ui;
        if constexpr (ALIGN_EPI) { if (wr == 1) PG8_BAR; }
    }
    PG8_WAIT_V(0);
    if constexpr (!ALIGN_EPI) { if (wr == 0) PG8_BAR; }
    PG8_BAR;
    if constexpr (Epi::AFTER_DRAIN) { E.fused(acc, cur, wr, wc, fr, fq, lds, wid, lane); S.done(cur); }
#undef PG8_SA
#undef PG8_KP
#undef PG8_KPB
#undef PG8_SB
#undef PG8_STAGE
#undef PG8_LDA
#undef PG8_LDB
#undef PG8_MMA
#undef PG8_WAIT_V
#undef PG8_WAIT_L
#undef PG8_BAR
#undef PG8_SCHED
}
}

namespace att {
#define ATT_LAS __attribute__((address_space(3)))
typedef unsigned short bf16_t;
typedef short bf16x8 __attribute__((ext_vector_type(8)));
typedef short s16x4 __attribute__((ext_vector_type(4)));
typedef float f32x16 __attribute__((ext_vector_type(16)));
typedef unsigned u32x4 __attribute__((ext_vector_type(4)));
constexpr int SHM_V = 16384, SHM_K = 16384, SHM_R = 8192, BUFB = SHM_V + SHM_K + SHM_R;
constexpr int LDS_SCR = 2 * BUFB;
constexpr int LDS_FLAGS = LDS_SCR + 8 * 256;
constexpr int LDS_QR = LDS_FLAGS + 64;
constexpr int ATT_LDS_BYTES = LDS_QR + 8 * 4096;
#define KSWZ(row, colB) ((row) * 256 + ((colB) ^ (((row) & 7) << 4)))
#define RSWZ(row, colB) ((row) * 128 + ((colB) ^ ((((row) >> 1) & 7) << 4)))
__device__ __forceinline__ int v_st(int k, int c) { const int kk = (k & ~0xC) | ((k & 4) << 1) | ((k & 8) >> 1); return ((kk >> 3) * 4 + (c >> 5)) * 512 + ((kk & 7) * 32 + (c & 31)) * 2; }
__device__ __forceinline__ int v_rd_base(int lane) { return ((lane & 3) << 3) | (((lane >> 2) & 3) << 6) | (((lane >> 4) & 1) << 5) | (((lane >> 5) & 1) << 8); }
constexpr int v_rd_off(int d0, int ks, int half) { return d0 * 512 + ks * 4096 + half * 2048; }
__device__ __forceinline__ int crow(int r, int hi) { return (r & 3) + 8 * (r >> 2) + 4 * hi; }
__device__ __forceinline__ unsigned cvtpk(float lo, float hi) { unsigned r; asm volatile("v_cvt_pk_bf16_f32 %0, %1, %2" : "=v"(r) : "v"(lo), "v"(hi)); return r; }
#define ATT_SBAR() __builtin_amdgcn_sched_barrier(0)
#ifndef ATT_PRIO
#define ATT_PRIO 0
#endif
#ifndef ATT_QR_REG
#define ATT_QR_REG 1
#endif
#ifndef ATT_DEFER_MAX
#define ATT_DEFER_MAX 1
#endif
#ifndef ATT_SB_PROD
#define ATT_SB_PROD 1
#endif
#ifndef ATT_EARLYW
#define ATT_EARLYW 0
#endif

template <int ND>
__device__ __forceinline__ void qkt_half(f32x16& p, const ATT_LAS char* Kb, const ATT_LAS char* Rb, int r32, int hi, const bf16x8* qr, const ATT_LAS char* qrl, int lane, int half) {
    bf16x8 kf[8];
#pragma unroll
    for (int d0 = 0; d0 < 8; ++d0) kf[d0] = *(const ATT_LAS bf16x8*)(Kb + KSWZ(r32, ((d0 & 3) * 16 + hi * 8) * 2) + (d0 >> 2) * 128 + half * (32 * 256));
    ATT_SBAR();
    p = f32x16{};
    if constexpr (ND == 12) {
        bf16x8 rf[4], qf[4];
#pragma unroll
        for (int d0 = 0; d0 < 4; ++d0) p = __builtin_amdgcn_mfma_f32_32x32x16_bf16(kf[d0], qr[d0], p, 0, 0, 0);
        ATT_SBAR();
#pragma unroll
#if ATT_QR_REG
        for (int dr = 0; dr < 4; ++dr) { rf[dr] = *(const ATT_LAS bf16x8*)(Rb + RSWZ(r32, (dr * 16 + hi * 8) * 2) + half * (32 * 128)); qf[dr] = qr[8 + dr]; }
#else
        for (int dr = 0; dr < 4; ++dr) { rf[dr] = *(const ATT_LAS bf16x8*)(Rb + RSWZ(r32, (dr * 16 + hi * 8) * 2) + half * (32 * 128)); qf[dr] = *(const ATT_LAS bf16x8*)(qrl + dr * 1024 + lane * 16); }
#endif
        ATT_SBAR();
#pragma unroll
        for (int d0 = 4; d0 < 8; ++d0) p = __builtin_amdgcn_mfma_f32_32x32x16_bf16(kf[d0], qr[d0], p, 0, 0, 0);
#pragma unroll
        for (int dr = 0; dr < 4; ++dr) p = __builtin_amdgcn_mfma_f32_32x32x16_bf16(rf[dr], qf[dr], p, 0, 0, 0);
    } else {
#pragma unroll
        for (int d0 = 0; d0 < 8; ++d0) p = __builtin_amdgcn_mfma_f32_32x32x16_bf16(kf[d0], qr[d0], p, 0, 0, 0);
    }
}
__device__ __forceinline__ void pv_tile(f32x16* o, int vb, bf16x8 pa0, bf16x8 pa1, bf16x8 pa2, bf16x8 pa3) {
#define ATT_TRRD(dst, off) asm volatile("ds_read_b64_tr_b16 %0, %1 offset:%2" : "=&v"(dst) : "v"(vb), "i"(off) : "memory")
#define ATT_PV_D0(d0) do { s16x4 l0, l1, l2, l3, h0, h1, h2, h3; constexpr int b_ = v_rd_off(d0, 0, 0); \
        ATT_TRRD(l0, b_); ATT_TRRD(h0, b_ + 2048); ATT_TRRD(l1, b_ + 4096); ATT_TRRD(h1, b_ + 6144); ATT_TRRD(l2, b_ + 8192); ATT_TRRD(h2, b_ + 10240); ATT_TRRD(l3, b_ + 12288); ATT_TRRD(h3, b_ + 14336); \
        asm volatile("s_waitcnt lgkmcnt(0)" ::: "memory"); ATT_SBAR(); \
        o[d0] = __builtin_amdgcn_mfma_f32_32x32x16_bf16(pa0, (bf16x8){l0[0], l0[1], l0[2], l0[3], h0[0], h0[1], h0[2], h0[3]}, o[d0], 0, 0, 0); \
        o[d0] = __builtin_amdgcn_mfma_f32_32x32x16_bf16(pa1, (bf16x8){l1[0], l1[1], l1[2], l1[3], h1[0], h1[1], h1[2], h1[3]}, o[d0], 0, 0, 0); \
        o[d0] = __builtin_amdgcn_mfma_f32_32x32x16_bf16(pa2, (bf16x8){l2[0], l2[1], l2[2], l2[3], h2[0], h2[1], h2[2], h2[3]}, o[d0], 0, 0, 0); \
        o[d0] = __builtin_amdgcn_mfma_f32_32x32x16_bf16(pa3, (bf16x8){l3[0], l3[1], l3[2], l3[3], h3[0], h3[1], h3[2], h3[3]}, o[d0], 0, 0, 0); } while (0)
    if (ATT_PRIO) __builtin_amdgcn_s_setprio(1);
    ATT_PV_D0(0); ATT_PV_D0(1); ATT_PV_D0(2); ATT_PV_D0(3);
    if (ATT_PRIO) __builtin_amdgcn_s_setprio(0);
#undef ATT_PV_D0
#undef ATT_TRRD
}
__device__ __forceinline__ void pack_half(const f32x16& p, bf16x8& pa0, bf16x8& pa1) {
#define ATT_PK4(P, B_, OUT) do { unsigned a0 = cvtpk(P[B_+0], P[B_+1]), a1 = cvtpk(P[B_+2], P[B_+3]); \
        unsigned b0 = cvtpk(P[B_+4], P[B_+5]), b1 = cvtpk(P[B_+6], P[B_+7]); \
        auto r0 = __builtin_amdgcn_permlane32_swap(a0, b0, false, false); auto r1 = __builtin_amdgcn_permlane32_swap(a1, b1, false, false); \
        u32x4 w = {r0[0], r1[0], r0[1], r1[1]}; OUT = __builtin_bit_cast(bf16x8, w); } while (0)
    ATT_PK4(p, 0, pa0); ATT_PK4(p, 8, pa1);
#undef ATT_PK4
}
__device__ __forceinline__ void half_xchg(float x, float& lo, float& hi) {
    unsigned a = __builtin_bit_cast(unsigned, x), b;
    asm volatile("s_nop 1\n\tv_mov_b32 %1, %0\n\ts_nop 1\n\tv_permlane32_swap_b32 %0, %1" : "+v"(a), "=&v"(b));
    lo = __builtin_bit_cast(float, a); hi = __builtin_bit_cast(float, b);
}
__device__ __forceinline__ float half_sum(float v) { float lo, hi; half_xchg(v, lo, hi); return lo + hi; }
__device__ __forceinline__ float half_max(float v) { float lo, hi; half_xchg(v, lo, hi); return fmaxf(lo, hi); }

struct Tensors { const bf16_t* Q; int ldq; const bf16_t* K; int ldk; const bf16_t* V; int ldv; const bf16_t* R; bf16_t* O; int ldo; };

template <int MODE>
__device__ __forceinline__ void attn_unit(const Tensors& T, int qb, float sc2, ATT_LAS char* lds) {
    constexpr int ND = MODE == 1 ? 12 : 8;
    int tid_ = threadIdx.x; asm volatile("" : "+v"(tid_));
    const int tid = tid_, wid = __builtin_amdgcn_readfirstlane(tid >> 6), lane = tid & 63, r32 = lane & 31, hi = lane >> 5;
    const int q0 = qb * 256, qw = q0 + wid * 32;
    const int NT = 4 * (qb + 1);
    const int wlast = 4 * qb + (wid >> 1);
    const int tq = qw + r32;
    ATT_LAS float* scr = (ATT_LAS float*)(lds + LDS_SCR) + wid * 64;
    volatile ATT_LAS unsigned* flags = (volatile ATT_LAS unsigned*)(lds + LDS_FLAGS);
    const ATT_LAS char* qrl = lds + LDS_QR + wid * 4096;
    bf16x8 qr[(MODE == 1 && ATT_QR_REG) ? 12 : 8];
    { const bf16_t* qp = T.Q + (size_t)tq * T.ldq + hi * 8;
#pragma unroll
      for (int d0 = 0; d0 < 8; ++d0) qr[d0] = *(const bf16x8*)(qp + d0 * 16);
      if constexpr (MODE == 1) {
#if ATT_QR_REG
#pragma unroll
          for (int dr = 0; dr < 4; ++dr) qr[8 + dr] = *(const bf16x8*)(qp + 128 + dr * 16);
#else
#pragma unroll
          for (int dr = 0; dr < 4; ++dr) *(ATT_LAS bf16x8*)(lds + LDS_QR + wid * 4096 + dr * 1024 + lane * 16) = *(const bf16x8*)(qp + 128 + dr * 16);
#endif
      } }
    const int sr = tid >> 4, sc = (tid & 15) * 8, kws = KSWZ(sr, sc * 2), vst0 = v_st(sr, sc), vst1 = v_st(32 + sr, sc);
    const int rr_ = tid >> 3, rc = (tid & 7) * 8, rws = RSWZ(rr_, rc * 2);
    bf16x8 sk0, sk1, sv0, sv1, srp;
#define ATT_LOAD(kt) do { const size_t k0_ = (size_t)(kt) * 64; \
        sk0 = *(const bf16x8*)(T.K + (k0_ + sr) * T.ldk + sc); sk1 = *(const bf16x8*)(T.K + (k0_ + 32 + sr) * T.ldk + sc); \
        sv0 = *(const bf16x8*)(T.V + (k0_ + sr) * T.ldv + sc); sv1 = *(const bf16x8*)(T.V + (k0_ + 32 + sr) * T.ldv + sc); \
        if constexpr (MODE == 1) srp = *(const bf16x8*)(T.R + (k0_ + rr_) * 64 + rc); } while (0)
#define ATT_WRITE(bf) do { ATT_LAS char* b_ = lds + (bf) * BUFB; \
        *(ATT_LAS bf16x8*)(b_ + vst0) = sv0; *(ATT_LAS bf16x8*)(b_ + vst1) = sv1; \
        *(ATT_LAS bf16x8*)(b_ + SHM_V + kws) = sk0; *(ATT_LAS bf16x8*)(b_ + SHM_V + kws + 32 * 256) = sk1; \
        if constexpr (MODE == 1) *(ATT_LAS bf16x8*)(b_ + SHM_V + SHM_K + rws) = srp; } while (0)
#define ATT_TILE(it) (MODE == 0 ? (NT - 1 - (it)) : (it))
    f32x16 o[4] = {};
    float carry = 0.f;
    float m_reg = -1e30f, l_reg = 0.f;
    bool dead = false;
    const float hsel = hi ? 0.f : 1.f;
    ATT_LOAD(ATT_TILE(0)); asm volatile("s_waitcnt vmcnt(0)" ::: "memory"); ATT_WRITE(0);
    __syncthreads();
    for (int it = 0; it < NT; ++it) {
        const int cur = it & 1, kt = ATT_TILE(it), kb = kt * 64;
        if (it + 1 < NT) ATT_LOAD(ATT_TILE(it + 1));
        const ATT_LAS char* bufp = lds + cur * BUFB;
        bool staged = false;
        if (kt <= wlast && !dead) {
            f32x16 p0, p1;
            bf16x8 pa0, pa1, pa2, pa3;
            if constexpr (MODE == 0) {
                const bool diag = (kb + 63 >= qw);
                qkt_half<ND>(p1, bufp + SHM_V, bufp + SHM_V + SHM_K, r32, hi, qr, qrl, lane, 1);
                qkt_half<ND>(p0, bufp + SHM_V, bufp + SHM_V + SHM_K, r32, hi, qr, qrl, lane, 0);
#if ATT_SB_PROD
                float Tp = __builtin_amdgcn_exp2f(carry), tprod = 1.f;
#define ATT_SB_HALF(P, KOFF) do { f32x16 om; \
                    _Pragma("unroll") for (int r = 0; r < 16; ++r) { const float e_ = __builtin_amdgcn_exp2f(__builtin_amdgcn_fmed3f(P[r] * sc2, -120.f, 120.f)); P[r] = e_; om[r] = __builtin_amdgcn_rcpf(1.0f + e_); } \
                    if (diag) { _Pragma("unroll") for (int r = 0; r < 16; ++r) { if (kb + (KOFF) + crow(r, hi) >= tq) om[r] = 1.f; } } \
                    float gp_[4], oh_[4], pp_[4]; \
                    _Pragma("unroll") for (int i = 0; i < 4; ++i) { om[4*i+2] *= om[4*i+3]; om[4*i+1] *= om[4*i+2]; om[4*i] *= om[4*i+1]; gp_[i] = om[4*i]; } \
                    _Pragma("unroll") for (int i = 0; i < 4; ++i) { float lo_; half_xchg(gp_[i], lo_, oh_[i]); pp_[i] = lo_ * oh_[i]; } \
                    _Pragma("unroll") for (int i = 3; i >= 0; --i) { const float Tg = Tp * (hi ? 1.f : oh_[i]); \
                        _Pragma("unroll") for (int e = 0; e < 4; ++e) P[4*i+e] = (P[4*i+e] * om[4*i+e]) * Tg; \
                        Tp *= pp_[i]; tprod *= pp_[i]; } \
                    if (diag) { _Pragma("unroll") for (int r = 0; r < 16; ++r) { if (kb + (KOFF) + crow(r, hi) >= tq) P[r] = 0.f; } } } while (0)
                ATT_SB_HALF(p1, 32);
                pack_half(p1, pa2, pa3);
                ATT_SB_HALF(p0, 0);
                pack_half(p0, pa0, pa1);
#undef ATT_SB_HALF
                carry += __builtin_amdgcn_logf(tprod);
#else
                float tsum = carry;
#define ATT_SB_HALF(P, KOFF) do { f32x16 f; \
                    _Pragma("unroll") for (int r = 0; r < 16; ++r) { P[r] *= sc2; \
                        f[r] = fminf(-P[r], 0.f) - __builtin_amdgcn_logf(1.0f + __builtin_amdgcn_exp2f(-__builtin_fabsf(P[r]))); } \
                    if (diag) { _Pragma("unroll") for (int r = 0; r < 16; ++r) { if (kb + (KOFF) + crow(r, hi) >= tq) f[r] = 0.f; } } \
                    float gs_[4], oh_[4], ps_[4]; \
                    _Pragma("unroll") for (int i = 0; i < 4; ++i) { f[4*i+2] += f[4*i+3]; f[4*i+1] += f[4*i+2]; f[4*i] += f[4*i+1]; gs_[i] = f[4*i]; } \
                    _Pragma("unroll") for (int i = 0; i < 4; ++i) { float lo_; half_xchg(gs_[i], lo_, oh_[i]); ps_[i] = lo_ + oh_[i]; } \
                    _Pragma("unroll") for (int i = 3; i >= 0; --i) { const float Tg = tsum + hsel * oh_[i]; \
                        _Pragma("unroll") for (int e = 0; e < 4; ++e) P[4*i+e] = __builtin_amdgcn_exp2f(P[4*i+e] + f[4*i+e] + Tg); \
                        tsum += ps_[i]; } \
                    if (diag) { _Pragma("unroll") for (int r = 0; r < 16; ++r) { if (kb + (KOFF) + crow(r, hi) >= tq) P[r] = 0.f; } } } while (0)
                ATT_SB_HALF(p1, 32);
                pack_half(p1, pa2, pa3);
                ATT_SB_HALF(p0, 0);
                pack_half(p0, pa0, pa1);
#undef ATT_SB_HALF
                carry = tsum;
#endif
                pv_tile(o, (int)(uintptr_t)(bufp) + v_rd_base(lane), pa0, pa1, pa2, pa3);
                if (__all(carry < -140.f)) dead = true;
            } else {
                qkt_half<ND>(p0, bufp + SHM_V, bufp + SHM_V + SHM_K, r32, hi, qr, qrl, lane, 0);
                qkt_half<ND>(p1, bufp + SHM_V, bufp + SHM_V + SHM_K, r32, hi, qr, qrl, lane, 1);
                float pmax = p0[0];
#pragma unroll
                for (int r = 1; r < 16; ++r) pmax = fmaxf(pmax, p0[r]);
#pragma unroll
                for (int r = 0; r < 16; ++r) pmax = fmaxf(pmax, p1[r]);
                pmax = half_max(pmax);
#if ATT_DEFER_MAX
                const float mn = (pmax > m_reg + 8.0f * __builtin_amdgcn_rcpf(sc2)) ? pmax : m_reg;
                const float alpha = __builtin_amdgcn_exp2f((m_reg - mn) * sc2); m_reg = mn;
#else
                const float mn = fmaxf(m_reg, pmax), alpha = __builtin_amdgcn_exp2f((m_reg - mn) * sc2); m_reg = mn;
#endif
                const float mnL = -mn * sc2;
                float psum = 0.f;
#pragma unroll
                for (int r = 0; r < 16; ++r) { p0[r] = __builtin_amdgcn_exp2f(fmaf(p0[r], sc2, mnL)); psum += p0[r]; }
                pack_half(p0, pa0, pa1);
#pragma unroll
                for (int r = 0; r < 16; ++r) { p1[r] = __builtin_amdgcn_exp2f(fmaf(p1[r], sc2, mnL)); psum += p1[r]; }
                pack_half(p1, pa2, pa3);
                l_reg = l_reg * alpha + half_sum(psum);
                if (__any(alpha < 1.f))
                { if (hi == 0) scr[r32] = alpha; asm volatile("s_waitcnt lgkmcnt(0)" ::: "memory");
#pragma unroll
                    for (int r = 0; r < 16; ++r) { const float a = scr[crow(r, hi)];
#pragma unroll
                        for (int d = 0; d < 4; ++d) o[d][r] *= a; } }
#if ATT_EARLYW
                if (it + 1 < NT) { asm volatile("s_waitcnt vmcnt(0)" ::: "memory"); ATT_WRITE(cur ^ 1); staged = true; }
#endif
                pv_tile(o, (int)(uintptr_t)(bufp) + v_rd_base(lane), pa0, pa1, pa2, pa3);
            }
        }
        if (it + 1 < NT && !staged) { asm volatile("s_waitcnt vmcnt(0)" ::: "memory"); ATT_WRITE(cur ^ 1); }
        if constexpr (MODE == 0) { if (lane == 0) flags[cur * 8 + wid] = dead ? 1u : 0u; }
        __syncthreads();
        if constexpr (MODE == 0) {
            unsigned alld = 1u;
#pragma unroll
            for (int w = 0; w < 8; ++w) alld &= flags[cur * 8 + w];
            if (alld) break;
        }
    }
    if constexpr (MODE == 1) { if (hi == 0) scr[32 + r32] = l_reg; asm volatile("s_waitcnt lgkmcnt(0)" ::: "memory"); }
    bf16_t* Ow = T.O + (size_t)qw * T.ldo;
    int obase = 4 * hi * T.ldo + r32; asm volatile("" : "+v"(obase));
#pragma unroll
    for (int r = 0; r < 16; ++r) { const int orow = crow(r, hi);
        float rl = 1.f; if constexpr (MODE == 1) rl = __builtin_amdgcn_rcpf(scr[32 + orow]);
        int ro = obase + ((r & 3) + 8 * (r >> 2)) * T.ldo; asm volatile("" : "+v"(ro));
#pragma unroll
        for (int d0 = 0; d0 < 4; ++d0) { const float v = o[d0][r] * rl; const float vn = __shfl_xor(v, 1);
            if ((r32 & 1) == 0) *(unsigned*)(Ow + ro + d0 * 32) = cvtpk(v, vn); } }
    __syncthreads();
#undef ATT_LOAD
#undef ATT_WRITE
#undef ATT_TILE
}
}

constexpr int BATCH = 2, SEQ = 4096, D = 4096, M = BATCH * SEQ, DEPTH = 2;
constexpr int SBW = 2048, QRANK = 1024, KVRANK = 512, ROPE = 64, DFF = 16384;
constexpr int IN_W = 3 * SBW + QRANK + KVRANK + ROPE + 2 * D;
constexpr int C_QD = 3 * SBW, C_KVD = C_QD + QRANK, C_GATE_SRC = C_KVD + KVRANK + ROPE;
constexpr int C_GSB = 7936, C_GMLA = C_GSB + D, PROJ_W = C_GMLA + D;
constexpr int QW = 16 * 192, KVW = 16 * 256;
constexpr float EPS = 1e-6f;
static_assert(IN_W == 15936 && PROJ_W == 16128 && PROJ_W % 256 == 0 && C_GSB % 256 == 0, "projection layout");

constexpr size_t MiB = 1u << 20;
constexpr size_t WS_CTL = 0, CTL_ZERO_BYTES = 1 * MiB;
constexpr size_t WS_ADA = 1 * MiB;
constexpr size_t WS_TAB = 2 * MiB;
constexpr size_t WS_ADAP = 4 * MiB;
constexpr size_t WS_W = 32 * MiB;
constexpr size_t W_IN = 0, W_UQ = 126 * MiB, W_UKV = 132 * MiB, W_OSB = 136 * MiB, W_OMLA = 152 * MiB, W_OUT = 168 * MiB, W_UP = 200 * MiB, W_DOWN = 328 * MiB, W_LAYER = 456 * MiB;
constexpr size_t WS_ACT = WS_W + DEPTH * W_LAYER;
constexpr size_t A_H = WS_ACT, A_PROJ = A_H + 64 * MiB, A_CQ = A_PROJ + 252 * MiB, A_CKV = A_CQ + 16 * MiB, A_KR = A_CKV + 8 * MiB, A_Q = A_KR + 1 * MiB, A_KV = A_Q + 48 * MiB,
                 A_OSB = A_KV + 64 * MiB, A_OMLA = A_OSB + 32 * MiB, A_TMP = A_OMLA + 32 * MiB, A_MRG = A_TMP + 128 * MiB, A_Y = A_MRG + 64 * MiB, A_U = A_Y + 128 * MiB, WS_END = A_U + 256 * MiB;
static_assert((size_t)PROJ_W * D * 2 == 126 * MiB && (size_t)M * PROJ_W * 2 == 252 * MiB, "sizes");
constexpr int CW_TMO = 0;
constexpr int CW_BAR = 4096;

constexpr int RING_BYTES = 135168;
constexpr int LDSCTL_OFF = RING_BYTES, MISC_OFF = LDSCTL_OFF + 320;
constexpr int LDS_BYTES = RING_BYTES + 1024;
constexpr int NWAVES = 8;
static_assert(att::ATT_LDS_BYTES <= RING_BYTES && pg8::STAGE_BYTES <= RING_BYTES, "LDS map");

#define GAS __attribute__((address_space(1)))
#define LAS __attribute__((address_space(3)))
typedef unsigned short bf16;
typedef unsigned v4u __attribute__((ext_vector_type(4)));
typedef unsigned v2u __attribute__((ext_vector_type(2)));
typedef float f32x4 __attribute__((ext_vector_type(4)));
typedef GAS unsigned gu32;
#define RLX_AGENT __ATOMIC_RELAXED, __HIP_MEMORY_SCOPE_AGENT
#ifndef USE_NT
#define USE_NT 0
#endif
#if USE_NT
#define NT_LD(p) __builtin_nontemporal_load(p)
#else
#define NT_LD(p) (*(p))
#endif
#define LDS_WAIT() asm volatile("s_waitcnt lgkmcnt(0)" ::: "memory")
#define VM_WAIT() asm volatile("s_waitcnt vmcnt(0)" ::: "memory")
__device__ __forceinline__ unsigned pk2(float lo, float hi) { return pg8::cvt_pk_bf16(lo, hi); }
__device__ __forceinline__ float bflo(unsigned w) { return __builtin_bit_cast(float, w << 16); }
__device__ __forceinline__ float bfhi(unsigned w) { return __builtin_bit_cast(float, w & 0xffff0000u); }

#define XB_TMO      128
#define XB_XCNT(j)  (256  + 64 * (j))
#define XB_XSUB(j)  (1280 + 64 * (j))
#define XB_XGEN(j)  (2304 + 64 * (j))
#define XB_TOP      3328
#define XB_TOPGEN   3392
#define XCD_BAR_WORDS 3456
#define XB_SPIN_CAP (1u << 21)

__device__ __forceinline__ unsigned xb_ld(unsigned* p)              { return __hip_atomic_load(p, __ATOMIC_RELAXED, __HIP_MEMORY_SCOPE_AGENT); }
__device__ __forceinline__ unsigned xb_add(unsigned* p, unsigned v) { return __hip_atomic_fetch_add(p, v, __ATOMIC_RELAXED, __HIP_MEMORY_SCOPE_AGENT); }
__device__ __forceinline__ unsigned xb_xcc_id() { return (unsigned)__builtin_amdgcn_s_getreg((3 << 11) | 20) & 0xFu; }
#define XB_SPIN(cond, bar) do { unsigned _sp = 0; while (cond) { __builtin_amdgcn_s_sleep(1); \
    if ((++_sp & 255u) == 0u) { if (xb_ld(&(bar)[XB_TMO])) break; if (_sp > XB_SPIN_CAP) { atomicAdd(&(bar)[XB_TMO], 1u); break; } } } } while (0)

struct XcdBarrier {
    unsigned* bar; unsigned x;
    volatile LAS unsigned* st;
};

__device__ __forceinline__ XcdBarrier xcd_barrier_post(unsigned* bar, volatile LAS unsigned* st) {
    XcdBarrier b; b.bar = bar; b.x = xb_xcc_id(); b.st = st;
    if (threadIdx.x == 0) (void)xb_add(&bar[XB_XCNT(b.x)], 1u);
    return b;
}
__device__ __forceinline__ void xcd_barrier_complete(unsigned* bar, unsigned x, unsigned& nloc, unsigned& nx) {
    const unsigned G = gridDim.x * gridDim.y * gridDim.z;
    unsigned sum, cnt, mine, sp = 0u;
    for (;;) {
        sum = 0u; cnt = 0u; mine = 0u;
#pragma unroll
        for (unsigned j = 0; j < 16; ++j) { const unsigned c = xb_ld(&bar[XB_XCNT(j)]); sum += c; cnt += (c > 0u) ? 1u : 0u; mine = (j == x) ? c : mine; }
        if (sum == G) break;
        __builtin_amdgcn_s_sleep(1);
        if ((++sp & 255u) == 0u) { if (xb_ld(&bar[XB_TMO])) break; if (sp > XB_SPIN_CAP) { atomicAdd(&bar[XB_TMO], 1u); break; } }
    }
    nloc = mine > 0u ? mine : 1u; nx = cnt > 0u ? cnt : 1u;
}

__device__ __forceinline__ void xcd_barrier(const XcdBarrier& b) {
    asm volatile("s_waitcnt vmcnt(0)" ::: "memory");
    __syncthreads();
    if (threadIdx.x == 0) {
        unsigned* bar = b.bar; unsigned bx_ = b.x; asm volatile("" : "+s"(bar), "+s"(bx_));
        __builtin_amdgcn_s_waitcnt(0);
        unsigned nloc = b.st[0], nx = b.st[1];
        if (nloc == 0u) { xcd_barrier_complete(bar, bx_, nloc, nx); b.st[0] = nloc; b.st[1] = nx; }
        const unsigned old = xb_add(&bar[XB_XSUB(bx_)], 1u);
        const unsigned gen = old / nloc;
        if (old + 1u == (gen + 1u) * nloc) {
            __builtin_amdgcn_fence(__ATOMIC_RELEASE, "agent");
            asm volatile("s_waitcnt vmcnt(0)" ::: "memory");
            const unsigned og = xb_add(&bar[XB_TOP], 1u);
            const unsigned tg = og / nx;
            if (og + 1u == (tg + 1u) * nx) xb_add(&bar[XB_TOPGEN], 1u);
            else XB_SPIN(xb_ld(&bar[XB_TOPGEN]) == tg, bar);
            __builtin_amdgcn_fence(__ATOMIC_ACQUIRE, "agent");
            xb_add(&bar[XB_XGEN(bx_)], 1u);
            asm volatile("s_waitcnt vmcnt(0)" ::: "memory");
        } else {
            XB_SPIN(xb_ld(&bar[XB_XGEN(bx_)]) == gen, bar);
            __builtin_amdgcn_fence(__ATOMIC_ACQUIRE, "agent");
            asm volatile("s_waitcnt vmcnt(0)" ::: "memory");
        }
    }
    __syncthreads();
}


struct Frame {
    LAS unsigned char* lds;
    int tid, lane, wave, G, gw, NGW;
};
__device__ __forceinline__ float wave_sum(float v) {
#pragma unroll
    for (int o = 1; o < 64; o <<= 1) v += __shfl_xor(v, o);
    return v;
}

#ifndef CONV_NT_ST
#define CONV_NT_ST 1
#endif
__device__ __forceinline__ void conv_load(f32x4 (&v)[16], f32x4& ks0, f32x4& ks1, const float* src, int N, const float* ks, int lane) {
    const float* s_ = src + (size_t)(lane >> 4) * N + 4 * (lane & 15);
#pragma unroll
    for (int i = 0; i < 16; ++i) v[i] = NT_LD((const f32x4*)(s_ + (size_t)(4 * i) * N));
    ks0 = (f32x4){1.f, 1.f, 1.f, 1.f}; ks1 = ks0;
    if (ks) { ks0 = *(const f32x4*)(ks + 8 * (lane & 7)); ks1 = *(const f32x4*)(ks + 8 * (lane & 7) + 4); }
}
__device__ __forceinline__ void conv_store(const f32x4 (&v)[16], f32x4 ks0, f32x4 ks1, bf16* dst, int ldt, int rowbase, int ropeperm, LAS float* scr, int lane) {
#pragma unroll
    for (int i = 0; i < 16; ++i) { LAS float* d = scr + (4 * i + (lane >> 4)) * 65 + 4 * (lane & 15); d[0] = v[i][0]; d[1] = v[i][1]; d[2] = v[i][2]; d[3] = v[i][3]; }
    LDS_WAIT(); asm volatile("" ::: "memory");
    const int c = lane & 7;
#pragma unroll
    for (int j = 0; j < 8; ++j) { const int nn = (lane >> 3) + 8 * j; const LAS float* s = scr + (8 * c) * 65 + nn;
        v4u o; o.x = pk2(s[0 * 65] * ks0[0], s[1 * 65] * ks0[1]); o.y = pk2(s[2 * 65] * ks0[2], s[3 * 65] * ks0[3]); o.z = pk2(s[4 * 65] * ks1[0], s[5 * 65] * ks1[1]); o.w = pk2(s[6 * 65] * ks1[2], s[7 * 65] * ks1[3]);
        const int orow = rowbase + ((ropeperm & 1) ? (2 * (nn & 31) + (nn >> 5)) : nn);
#ifdef P0A_REP_NOSTORE
        if (ropeperm < 2)
#endif
#if CONV_NT_ST
        __builtin_nontemporal_store(o, (GAS v4u*)(dst + (size_t)orow * 64 + 8 * c)); }
#else
        *(GAS v4u*)(dst + (size_t)orow * 64 + 8 * c) = o; }
#endif
    LDS_WAIT(); asm volatile("" ::: "memory");
}

__device__ __forceinline__ void norm_mod_row(const f32x4 (&v)[16], float ssq, const float* g, const float* scv, const float* shv, bf16* orow, int lane) {
    const float r = 1.0f / sqrtf(ssq * (1.0f / D) + EPS);
#pragma unroll
    for (int j = 0; j < 16; ++j) { int c = 4 * lane + 256 * j; asm volatile("" : "+v"(c));
        const f32x4 gg = *(const f32x4*)(g + c), ss = *(const f32x4*)(scv + c), hh = *(const f32x4*)(shv + c);
        f32x4 o;
#pragma unroll
        for (int e = 0; e < 4; ++e) o[e] = v[j][e] * r * gg[e] * (1.0f + ss[e]) + hh[e];
        v2u w; w.x = pk2(o[0], o[1]); w.y = pk2(o[2], o[3]);
        *(GAS v2u*)(orow + c) = w; }
}


template <bool HAS_Y, bool HAS_H, bool XIN_BF = false, bool XOUT_BF = false>
__device__ __forceinline__ void thin_phase(Frame& F, const void* xin_, void* xout_, const bf16* Yb, bf16* Hout,
                                           const float* gpost, const float* gate0, const float* gpre, const float* sc0, const float* sh0) {
    LAS float* cA1 = (LAS float*)F.lds; LAS float* cA2 = cA1 + D; LAS float* cB2 = cA2 + D;
    for (int chunk = blockIdx.x; chunk < M / 32; chunk += F.G) {
        int tid = F.tid; asm volatile("" : "+v"(tid));
        const int b = (chunk * 32) / SEQ;
        __syncthreads();
#pragma unroll
        for (int i = 0; i < 2; ++i) { const int c = 4 * tid + 2048 * i;
            if constexpr (HAS_Y) { const f32x4 g = *(const f32x4*)(gpost + c), t = *(const f32x4*)(gate0 + (size_t)b * 6 * D + c); *(LAS f32x4*)(cA1 + c) = g * t; }
            if constexpr (HAS_H) { const f32x4 g = *(const f32x4*)(gpre + c), s = *(const f32x4*)(sc0 + (size_t)b * 6 * D + c), h = *(const f32x4*)(sh0 + (size_t)b * 6 * D + c);
                *(LAS f32x4*)(cA2 + c) = g * (s + 1.0f); *(LAS f32x4*)(cB2 + c) = h; } }
        __syncthreads();
        const int LN = tid & 63;
#pragma unroll 1
        for (int i = 0; i < 4; ++i) {
            const size_t m = (size_t)chunk * 32 + F.wave * 4 + i;
            v4u yv[8]; f32x4 xv[16];
#pragma unroll
            for (int j = 0; j < 8; ++j) { const int c = 8 * LN + 512 * j;
                if constexpr (HAS_Y) yv[j] = *(const GAS v4u*)(Yb + m * D + c);
                if constexpr (XIN_BF) { const v4u xb = *(const GAS v4u*)((const bf16*)xin_ + m * D + c);
                    xv[2 * j] = (f32x4){bflo(xb.x), bfhi(xb.x), bflo(xb.y), bfhi(xb.y)}; xv[2 * j + 1] = (f32x4){bflo(xb.z), bfhi(xb.z), bflo(xb.w), bfhi(xb.w)}; }
                else { xv[2 * j] = *(const f32x4*)((const float*)xin_ + m * D + c); xv[2 * j + 1] = *(const f32x4*)((const float*)xin_ + m * D + c + 4); } }
            float ssq2 = 0.f;
            if constexpr (HAS_Y) {
                float ssq = 0.f;
#pragma unroll
                for (int j = 0; j < 8; ++j) { const unsigned w[4] = {yv[j].x, yv[j].y, yv[j].z, yv[j].w};
#pragma unroll
                    for (int q = 0; q < 4; ++q) { const float a = bflo(w[q]), c2 = bfhi(w[q]); ssq += a * a + c2 * c2; } }
                ssq = wave_sum(ssq); const float r = 1.0f / sqrtf(ssq * (1.0f / D) + EPS);
#pragma unroll
                for (int j = 0; j < 8; ++j) { const int c = 8 * LN + 512 * j; const unsigned w[4] = {yv[j].x, yv[j].y, yv[j].z, yv[j].w};
                    const f32x4 a0 = *(const LAS f32x4*)(cA1 + c), a1 = *(const LAS f32x4*)(cA1 + c + 4);
                    f32x4 y0 = {bflo(w[0]), bfhi(w[0]), bflo(w[1]), bfhi(w[1])}, y1 = {bflo(w[2]), bfhi(w[2]), bflo(w[3]), bfhi(w[3])};
                    xv[2 * j] = xv[2 * j] + a0 * (y0 * r); xv[2 * j + 1] = xv[2 * j + 1] + a1 * (y1 * r);
                    if constexpr (XOUT_BF) { v4u xw; xw.x = pk2(xv[2 * j][0], xv[2 * j][1]); xw.y = pk2(xv[2 * j][2], xv[2 * j][3]); xw.z = pk2(xv[2 * j + 1][0], xv[2 * j + 1][1]); xw.w = pk2(xv[2 * j + 1][2], xv[2 * j + 1][3]);
                        *(GAS v4u*)((bf16*)xout_ + m * D + c) = xw; }
                    else { *(f32x4*)((float*)xout_ + m * D + c) = xv[2 * j]; *(f32x4*)((float*)xout_ + m * D + c + 4) = xv[2 * j + 1]; } } }
            if constexpr (HAS_H) {
#pragma unroll
                for (int j = 0; j < 16; ++j) ssq2 += (xv[j][0] * xv[j][0] + xv[j][1] * xv[j][1]) + (xv[j][2] * xv[j][2] + xv[j][3] * xv[j][3]);
                ssq2 = wave_sum(ssq2); const float r2 = 1.0f / sqrtf(ssq2 * (1.0f / D) + EPS);
#pragma unroll
                for (int j = 0; j < 8; ++j) { const int c = 8 * LN + 512 * j;
                    const f32x4 a0 = *(const LAS f32x4*)(cA2 + c), a1 = *(const LAS f32x4*)(cA2 + c + 4), b0 = *(const LAS f32x4*)(cB2 + c), b1 = *(const LAS f32x4*)(cB2 + c + 4);
                    const f32x4 h0 = (xv[2 * j] * r2) * a0 + b0, h1 = (xv[2 * j + 1] * r2) * a1 + b1;
                    v4u w; w.x = pk2(h0[0], h0[1]); w.y = pk2(h0[2], h0[3]); w.z = pk2(h1[0], h1[1]); w.w = pk2(h1[2], h1[3]);
                    *(GAS v4u*)(Hout + m * D + c) = w; } }
        }
    }
    __syncthreads();
}

__device__ __forceinline__ int gate_row(int j) { const int which = j / D, oc = j % D; return C_GSB + 256 * (oc / 128) + 128 * which + (oc % 128); }
constexpr int NB_IN = IN_W / 64, I_IN = (D / 64) * NB_IN, I_UQ = (QRANK / 64) * (QW / 64), I_UKV = (KVRANK / 64) * (KVW / 64), I_OSB = (SBW / 64) * (D / 64), I_OMLA = I_OSB,
              I_OUT = (D / 64) * (D / 64), I_UP = (D / 64) * (DFF / 64), I_DOWN = (DFF / 64) * (D / 64), I_LAYER = I_IN + I_UQ + I_UKV + I_OSB + I_OMLA + I_OUT + I_UP + I_DOWN;
#define CONV_DECODE(it, SRC, NN, DST, LDT, RB, RP, KS) do { const int l = (it) / I_LAYER; int r = (it) % I_LAYER; KS = nullptr; RP = 0; \
        if (r < I_IN) { const int kb = r / NB_IN, nb = r % NB_IN, n0 = nb * 64; SRC = KIN(I_WIN) + (size_t)l * D * IN_W + (size_t)(64 * kb) * IN_W + n0; NN = IN_W; DST = (bf16*)(wl + W_IN) + (size_t)kb * PROJ_W * 64; LDT = 64; \
            RB = n0 < C_GATE_SRC ? n0 : gate_row(n0 - C_GATE_SRC); RP = (n0 == C_KVD + KVRANK)  ; break; } r -= I_IN; \
        if (r < I_UQ) { const int kb = r / (QW / 64), nb = r % (QW / 64); SRC = KIN(I_WUQ) + (size_t)l * QRANK * QW + (size_t)(64 * kb) * QW + 64 * nb; NN = QW; DST = (bf16*)(wl + W_UQ) + (size_t)kb * QW * 64; LDT = 64; \
            RB = nb * 64; RP = ((nb % 3) == 2); KS = KIN(I_GQ) + (size_t)l * QRANK + 64 * kb; break; } r -= I_UQ; \
        if (r < I_UKV) { const int kb = r / (KVW / 64), nb = r % (KVW / 64); SRC = KIN(I_WUKV) + (size_t)l * KVRANK * KVW + (size_t)(64 * kb) * KVW + 64 * nb; NN = KVW; DST = (bf16*)(wl + W_UKV) + (size_t)kb * KVW * 64; LDT = 64; \
            RB = nb * 64; KS = KIN(I_GKV) + (size_t)l * KVRANK + 64 * kb; break; } r -= I_UKV; \
        if (r < I_OSB) { const int kb = r / (D / 64), nb = r % (D / 64); SRC = KIN(I_WOSB) + (size_t)l * SBW * D + (size_t)(64 * kb) * D + 64 * nb; NN = D; DST = (bf16*)(wl + W_OSB) + (size_t)kb * D * 64; LDT = 64; RB = nb * 64; break; } r -= I_OSB; \
        if (r < I_OMLA) { const int kb = r / (D / 64), nb = r % (D / 64); SRC = KIN(I_WOMLA) + (size_t)l * SBW * D + (size_t)(64 * kb) * D + 64 * nb; NN = D; DST = (bf16*)(wl + W_OSB) + (size_t)(SBW / 64 + kb) * D * 64; LDT = 64; RB = nb * 64; break; } r -= I_OMLA; \
        if (r < I_OUT) { const int kb = r / (D / 64), nb = r % (D / 64); SRC = KIN(I_WOUT) + (size_t)l * D * D + (size_t)(64 * kb) * D + 64 * nb; NN = D; DST = (bf16*)(wl + W_OUT) + (size_t)kb * D * 64; LDT = 64; RB = nb * 64; break; } r -= I_OUT; \
        if (r < I_UP) { const int kb = r / (DFF / 64), nb = r % (DFF / 64); SRC = KIN(I_WUP) + (size_t)l * D * DFF + (size_t)(64 * kb) * DFF + 64 * nb; NN = DFF; DST = (bf16*)(wl + W_UP) + (size_t)kb * DFF * 64; LDT = 64; RB = nb * 64; break; } r -= I_UP; \
        { const int kb = r / (D / 64), nb = r % (D / 64); SRC = KIN(I_WDOWN) + (size_t)l * DFF * D + (size_t)(64 * kb) * D + 64 * nb; NN = D; DST = (bf16*)(wl + W_DOWN) + (size_t)kb * D * 64; LDT = 64; RB = nb * 64; } \
    } while (0)
#ifdef P0A_REP_NOSTORE
#define CONV_RPX (p0r_ > 0 ? 2 : 0)
#else
#define CONV_RPX 0
#endif
#define CONVERT_ITEMS(lo, hi, start, stride) do { int cl_ = F.lane; asm volatile("" : "+v"(cl_));     \
        int it = (lo) + (start); \
        if (it < (hi)) { \
            const float* srcA; int nA; bf16* dstA; int ldtA, rbA, rpA; const float* ksA; f32x4 vA[16], k0A, k1A; \
            CONV_DECODE(it, srcA, nA, dstA, ldtA, rbA, rpA, ksA); conv_load(vA, k0A, k1A, srcA, nA, ksA, cl_); \
            for (;;) { const int nx = it + (stride); const bool hn = nx < (hi); \
                const float* srcB = srcA; int nB = nA; bf16* dstB = dstA; int ldtB = ldtA, rbB = rbA, rpB = rpA; const float* ksB = ksA; f32x4 vB[16], k0B, k1B; \
                if (hn) { CONV_DECODE(nx, srcB, nB, dstB, ldtB, rbB, rpB, ksB); conv_load(vB, k0B, k1B, srcB, nB, ksB, cl_); } \
                conv_store(vA, k0A, k1A, dstA, ldtA, rbA, rpA + CONV_RPX, scr, cl_); \
                if (!hn) break; \
                srcA = srcB; nA = nB; dstA = dstB; ldtA = ldtB; rbA = rbB; rpA = rpB; ksA = ksB; k0A = k0B; k1A = k1B; it = nx; \
                _Pragma("unroll") for (int i_ = 0; i_ < 16; ++i_) vA[i_] = vB[i_]; } \
        } } while (0)

#ifndef XRES_BF16
#define XRES_BF16 1
#endif
#ifndef PG8_SP2
#define PG8_SP2 true
#endif
#ifndef PG8_ALIGN
#define PG8_ALIGN true
#endif
#ifndef PG8_ALIGN_P1
#define PG8_ALIGN_P1 PG8_ALIGN
#endif
#ifndef PH_MASK
#define PH_MASK 0xFFFFFFFFu
#endif
#define PH(k) ((PH_MASK >> (k)) & 1u)
struct Args { const float* in[19]; float* out; unsigned char* ws; };
enum { I_X = 0, I_C, I_POS, I_WADA, I_BADA, I_GPREMIX, I_GPOSTMIX, I_GPREMLP, I_GPOSTMLP, I_WIN, I_GQ, I_WUQ, I_GKV, I_WUKV, I_WOSB, I_WOMLA, I_WOUT, I_WUP, I_WDOWN };

typedef __attribute__((address_space(4))) const unsigned char* kargp_t;
__device__ __forceinline__ __attribute__((address_space(1))) unsigned char* lw_(unsigned char* p) { __attribute__((address_space(1))) unsigned char* q = (__attribute__((address_space(1))) unsigned char*)p; asm volatile("" : "+s"(q)); return q; }
__device__ __forceinline__ kargp_t lwk_() { kargp_t p = (kargp_t)__builtin_amdgcn_kernarg_segment_ptr(); asm volatile("" : "+s"(p)); return p; }
#define KIN(k) ((const float*)(*(const __attribute__((address_space(1))) float* const __attribute__((address_space(4)))*)(lwk_() + 8 * (k))))
__global__ void __launch_bounds__(NWAVES * 64, 2) hybrid_fwd(Args args) {
    extern __shared__ __attribute__((aligned(16))) unsigned char lds_raw[];
    Frame F;
    F.lds = (LAS unsigned char*)lds_raw;
    F.tid = threadIdx.x; F.lane = F.tid & 63; F.wave = __builtin_amdgcn_readfirstlane(F.tid >> 6);
    F.G = gridDim.x; F.gw = blockIdx.x * NWAVES + F.wave; F.NGW = F.G * NWAVES;
    unsigned char* ws = args.ws;
    gu32* ctl = (gu32*)(ws + WS_CTL);
    for (int u = F.tid; u < (LDS_BYTES - LDSCTL_OFF) / 4; u += NWAVES * 64) ((LAS unsigned*)(F.lds + LDSCTL_OFF))[u] = 0u;
    __syncthreads();
    XcdBarrier bar = xcd_barrier_post((unsigned*)(ctl + CW_BAR), (volatile LAS unsigned*)(F.lds + MISC_OFF) + 8);
#define GRID_BAR() xcd_barrier(bar)

#define ada ((float*)(lw_(ws) + WS_ADA))
#define tab ((float*)(lw_(ws) + WS_TAB))
#define adap ((float*)(lw_(ws) + WS_ADAP))
#define Hb ((bf16*)(lw_(ws) + A_H))
#define PROJ ((bf16*)(lw_(ws) + A_PROJ))
#define SSQ ((float*)(lw_(ws) + A_CQ))
#define KR ((bf16*)(lw_(ws) + A_KR))
#define QF ((bf16*)(lw_(ws) + A_Q))
#define KVF ((bf16*)(lw_(ws) + A_KV))
#define OSB ((bf16*)(lw_(ws) + A_OSB))
#define MRG ((bf16*)(lw_(ws) + A_MRG))
#define Yb ((bf16*)(lw_(ws) + A_Y))
#define XB ((bf16*)(lw_(ws) + A_TMP))
#define U ((bf16*)(lw_(ws) + A_U))
#define GRB (lw_(ws) + A_TMP + 64 * MiB)
#define GSB (lw_(ws) + A_Y + 64 * MiB)
#define x_in KIN(I_X)
#define wl (lw_(ws) + WS_W + (size_t)l * W_LAYER)
#define adl (ada + (size_t)l * BATCH * 6 * D)
    float* xo = args.out;


#ifndef PRO_REP
#define PRO_REP 1
#endif
#pragma unroll 1
    for (int prep_ = 0; prep_ < PRO_REP; ++prep_) {
#ifndef P0A_REP
#define P0A_REP 1
#endif
#pragma unroll 1
    for (int p0r_ = 0; p0r_ < P0A_REP; ++p0r_)
    if (PH(0)) {
        LAS float* cact = (LAS float*)F.lds;
        for (int i = F.tid; i < BATCH * D; i += NWAVES * 64) { const float cv = KIN(I_C)[i]; cact[i] = cv / (1.0f + __expf(-cv)); }
        __syncthreads();
#ifdef P0A_REP_NOGEMV
        if (p0r_ == 0)
#endif
        for (int task = blockIdx.x; task < DEPTH * 32 * 12; task += F.G) {
            const int l = task / (32 * 12), s = (task / 12) % 32, cb = task % 12;
            const int col = cb * 2048 + F.tid * 4;
            const float* wp = KIN(I_WADA) + ((size_t)l * D + s * 128) * (6 * D) + col;
            f32x4 a0 = {0.f, 0.f, 0.f, 0.f}, a1 = {0.f, 0.f, 0.f, 0.f};
            f32x4 w[8];
#pragma unroll
            for (int j = 0; j < 8; ++j) w[j] = NT_LD((const f32x4*)(wp + (size_t)j * (6 * D)));
#pragma unroll 1
            for (int k = 0; k < 128; k += 8) { f32x4 wn[8];
                if (k + 8 < 128) {
#pragma unroll
                    for (int j = 0; j < 8; ++j) wn[j] = NT_LD((const f32x4*)(wp + (size_t)(k + 8 + j) * (6 * D))); }
#pragma unroll
                for (int j = 0; j < 8; ++j) { const float c0 = cact[s * 128 + k + j], c1 = cact[D + s * 128 + k + j]; a0 += w[j] * c0; a1 += w[j] * c1; }
#pragma unroll
                for (int j = 0; j < 8; ++j) w[j] = wn[j]; }
            *(f32x4*)(adap + (((size_t)s * DEPTH + l) * BATCH + 0) * (6 * D) + col) = a0;
            *(f32x4*)(adap + (((size_t)s * DEPTH + l) * BATCH + 1) * (6 * D) + col) = a1;
        }
        __syncthreads();
        for (int e = blockIdx.x * (NWAVES * 64) + F.tid; e < M * 32; e += F.G * NWAVES * 64) {
            const int m = e >> 5, i = e & 31;
            const float inv = powf(10000.0f, -(float)i / 32.0f);
            const float ang = (float)(((const int*)KIN(I_POS))[m]) * inv;
            const double rev = (double)ang * 0.15915494309189533577; const float fr = (float)(rev - rint(rev));
            tab[2 * e] = __builtin_amdgcn_cosf(fr); tab[2 * e + 1] = __builtin_amdgcn_sinf(fr);
        }
        for (int l = 0; l < DEPTH; ++l) { unsigned char* zb = ws + WS_W + l * W_LAYER + W_IN;
            for (int i = blockIdx.x * (NWAVES * 64) + F.tid; i < (D / 64) * 1536; i += F.G * NWAVES * 64) { const int kt = i / 1536, u = i % 1536;
                *(v4u*)(zb + ((size_t)kt * PROJ_W + C_GATE_SRC) * 128 + (size_t)u * 16) = (v4u){0u, 0u, 0u, 0u}; } }
        LAS float* scr = (LAS float*)(F.lds) + F.wave * (64 * 65);
        CONVERT_ITEMS(0, DEPTH * I_LAYER, F.gw, F.NGW);
        if (P0A_REP > 1) __syncthreads();
    }
    GRID_BAR();
    if (PH(1)) for (int e = blockIdx.x * (NWAVES * 64) + F.tid; e < DEPTH * BATCH * 6 * D; e += F.G * NWAVES * 64) {
        const int l = e / (BATCH * 6 * D), n = e % (6 * D);
        float s = KIN(I_BADA)[(size_t)l * 6 * D + n];
#pragma unroll 8
        for (int k = 0; k < 32; ++k) s += adap[(size_t)k * (DEPTH * BATCH * 6 * D) + e];
        ada[e] = s;
    }
    GRID_BAR();
    if (PH(2)) thin_phase<false, true>(F, x_in, nullptr, nullptr, Hb, nullptr, nullptr, KIN(I_GPREMIX), ada + D, ada);
    GRID_BAR();
    }

    for (int l = 0; l < DEPTH; ++l) {
#ifndef P1_REP
#define P1_REP 1
#endif
#pragma unroll 1
        for (int rp_ = 0; rp_ < P1_REP; ++rp_) {
        if (PH(3)) { pg8::Gemm g{Hb, (const bf16*)(wl + W_IN), M, PROJ_W, D}; pg8::StaticOrder S; S.init(M, PROJ_W, F.G, (int)blockIdx.x);
          pg8::EpiProj E{PROJ, PROJ_W, SSQ, KR, tab, (pg8::u32x4*)GRB, (pg8::u32x4*)GSB};
          pg8::gemm_phase<pg8::EpiProj, pg8::StaticOrder, PG8_ALIGN_P1, PG8_SP2>(F.lds, g, S, E); }
        }
        GRID_BAR();
#ifndef P3_REP
#define P3_REP 1
#endif
#pragma unroll 1
        for (int rep3 = 0; rep3 < P3_REP; ++rep3) {
        if (PH(5)) { pg8::Gemm g{PROJ + C_QD, (const bf16*)(wl + W_UQ), M, QW, QRANK, PROJ_W}; pg8::StaticOrder S; S.init(M, QW, F.G, (int)blockIdx.x);
          pg8::EpiRope E{QF, QW, tab, SSQ};
          pg8::gemm_phase<pg8::EpiRope, pg8::StaticOrder, PG8_ALIGN, PG8_SP2>(F.lds, g, S, E); }
        if (PH(5)) { pg8::Gemm g{PROJ + C_KVD, (const bf16*)(wl + W_UKV), M, KVW, KVRANK, PROJ_W}; pg8::EpiScale E{KVF, KVW, SSQ};
          if (F.G == 256) { pg8::UnevenOrder S; S.init(M, KVW, F.G, (int)blockIdx.x);
            pg8::gemm_phase<pg8::EpiScale, pg8::UnevenOrder, PG8_ALIGN, PG8_SP2>(F.lds, g, S, E); }
          else { pg8::StaticOrder S; S.init(M, KVW, F.G, (int)blockIdx.x);
            pg8::gemm_phase<pg8::EpiScale, pg8::StaticOrder, PG8_ALIGN, PG8_SP2>(F.lds, g, S, E); } }
        }
        GRID_BAR();
#ifndef P4_REP
#define P4_REP 1
#endif
#pragma unroll 1
        for (int rp_ = 0; rp_ < P4_REP; ++rp_) {
        if (PH(6)) for (int item = blockIdx.x; item < 512; item += F.G) {
            const int kind = item >> 8, c = item & 255, bh = (c & 7) * 4 + ((c >> 3) >> 3), y = (c >> 3) & 7, b = bh >> 4, h = bh & 15;
            const size_t rb = (size_t)b * SEQ;
            if (kind == 0) { if (PH(14)) {
                att::Tensors T{PROJ + rb * PROJ_W + h * 128, PROJ_W, PROJ + rb * PROJ_W + SBW + h * 128, PROJ_W, PROJ + rb * PROJ_W + 2 * SBW + h * 128, PROJ_W, nullptr, OSB + rb * (2 * SBW) + h * 128, 2 * SBW};
                att::attn_unit<0>(T, 15 - y, 0.08838834764831845f * 1.4426950408889634f, (LAS char*)F.lds);
                att::attn_unit<0>(T, y, 0.08838834764831845f * 1.4426950408889634f, (LAS char*)F.lds); }
            } else if (PH(15)) {
                att::Tensors T{QF + rb * QW + h * 192, QW, KVF + rb * KVW + h * 256, KVW, KVF + rb * KVW + h * 256 + 128, KVW, KR + rb * ROPE, OSB + rb * (2 * SBW) + SBW + h * 128, 2 * SBW};
                att::attn_unit<1>(T, 15 - y, 0.07216878364870323f * 1.4426950408889634f, (LAS char*)F.lds);
                att::attn_unit<1>(T, y, 0.07216878364870323f * 1.4426950408889634f, (LAS char*)F.lds);
            }
        }
        }
        GRID_BAR();
#ifndef P5_REP
#define P5_REP 1
#endif
#pragma unroll 1
        for (int rep5 = 0; rep5 < P5_REP; ++rep5)
        if (PH(7)) { pg8::Gemm g{OSB, (const bf16*)(wl + W_OSB), M, D, 2 * SBW}; pg8::StaticOrder S; S.init(M, D, F.G, (int)blockIdx.x);
          pg8::EpiGateMerge E{MRG, D, (const pg8::u32x4*)GRB, (const pg8::u32x4*)GSB};
          pg8::gemm_phase<pg8::EpiGateMerge, pg8::StaticOrder, PG8_ALIGN, PG8_SP2>(F.lds, g, S, E); }
        GRID_BAR();
#ifndef P7_REP
#define P7_REP 1
#endif
#pragma unroll 1
        for (int rep7 = 0; rep7 < P7_REP; ++rep7) {
#ifdef P7_REPB
        if (rep7) GRID_BAR();
#endif
#ifdef P7_MREP
        if (PH(9)) { pg8::Gemm g{MRG, (const bf16*)(wl + W_OUT), M, D, D}; pg8::RepOrder S; S.init(M, D, F.G, (int)blockIdx.x); S.reps = P7_MREP;
          pg8::EpiBf16<0> E{Yb, D};
          pg8::gemm_phase<pg8::EpiBf16<0>, pg8::RepOrder, PG8_ALIGN, PG8_SP2>(F.lds, g, S, E); }
#else
        if (PH(9)) { pg8::Gemm g{MRG, (const bf16*)(wl + W_OUT), M, D, D}; pg8::StaticOrder S; S.init(M, D, F.G, (int)blockIdx.x);
          pg8::EpiBf16<0> E{Yb, D};
          pg8::gemm_phase<pg8::EpiBf16<0>, pg8::StaticOrder, PG8_ALIGN, PG8_SP2>(F.lds, g, S, E); }
#endif
        }
        GRID_BAR();
#if XRES_BF16
#ifdef THIN_REP
        for (int rp_ = 1; rp_ < THIN_REP; ++rp_) { if (l == 0) thin_phase<true, true, false, true>(F, x_in, (bf16*)GRB, Yb, (bf16*)GSB, KIN(I_GPOSTMIX) + (size_t)l * D, adl + 2 * D, KIN(I_GPREMLP) + (size_t)l * D, adl + 4 * D, adl + 3 * D);
            else thin_phase<true, true, true, true>(F, XB, (bf16*)GRB, Yb, (bf16*)GSB, KIN(I_GPOSTMIX) + (size_t)l * D, adl + 2 * D, KIN(I_GPREMLP) + (size_t)l * D, adl + 4 * D, adl + 3 * D); }
#endif
        if (PH(10)) { if (l == 0) thin_phase<true, true, false, true>(F, x_in, XB, Yb, Hb, KIN(I_GPOSTMIX) + (size_t)l * D, adl + 2 * D, KIN(I_GPREMLP) + (size_t)l * D, adl + 4 * D, adl + 3 * D);
            else thin_phase<true, true, true, true>(F, XB, XB, Yb, Hb, KIN(I_GPOSTMIX) + (size_t)l * D, adl + 2 * D, KIN(I_GPREMLP) + (size_t)l * D, adl + 4 * D, adl + 3 * D); }
#else
        if (PH(10)) thin_phase<true, true>(F, l == 0 ? x_in : (const float*)xo, xo, Yb, Hb, KIN(I_GPOSTMIX) + (size_t)l * D, adl + 2 * D, KIN(I_GPREMLP) + (size_t)l * D, adl + 4 * D, adl + 3 * D);
#endif
        GRID_BAR();
#ifndef P9_REP
#define P9_REP 1
#endif
#pragma unroll 1
        for (int rp_ = 0; rp_ < P9_REP; ++rp_) {
        if (PH(11)) { pg8::Gemm g{Hb, (const bf16*)(wl + W_UP), M, DFF, D}; pg8::StaticOrder S; S.init(M, DFF, F.G, (int)blockIdx.x);
          pg8::EpiBf16<1> E{U, DFF};
          pg8::gemm_phase<pg8::EpiBf16<1>, pg8::StaticOrder, PG8_ALIGN, PG8_SP2>(F.lds, g, S, E); }
        }
        GRID_BAR();
#ifndef P10_REP
#define P10_REP 1
#endif
#pragma unroll 1
        for (int rp_ = 0; rp_ < P10_REP; ++rp_) {
        if (PH(12)) { pg8::Gemm g{U, (const bf16*)(wl + W_DOWN), M, D, DFF}; pg8::StaticOrder S; S.init(M, D, F.G, (int)blockIdx.x);
          pg8::EpiBf16<0> E{Yb, D};
          pg8::gemm_phase<pg8::EpiBf16<0>, pg8::StaticOrder, PG8_ALIGN, PG8_SP2>(F.lds, g, S, E); }
        }
        GRID_BAR();
#if XRES_BF16
#ifdef THIN_REP
        for (int rp_ = 1; rp_ < THIN_REP; ++rp_) if (l + 1 < DEPTH) { const float* adn = ada + (size_t)(l + 1) * BATCH * 6 * D;
                thin_phase<true, true, true, true>(F, XB, (bf16*)GRB, Yb, (bf16*)GSB, KIN(I_GPOSTMLP) + (size_t)l * D, adl + 5 * D, KIN(I_GPREMIX) + (size_t)(l + 1) * D, adn + D, adn); }
#endif
        if (PH(13)) { if (l + 1 < DEPTH) { const float* adn = ada + (size_t)(l + 1) * BATCH * 6 * D;
                thin_phase<true, true, true, true>(F, XB, XB, Yb, Hb, KIN(I_GPOSTMLP) + (size_t)l * D, adl + 5 * D, KIN(I_GPREMIX) + (size_t)(l + 1) * D, adn + D, adn); }
            else thin_phase<true, false, true, false>(F, XB, xo, Yb, nullptr, KIN(I_GPOSTMLP) + (size_t)l * D, adl + 5 * D, nullptr, nullptr, nullptr); }
#else
        if (PH(13)) { if (l + 1 < DEPTH) { const float* adn = ada + (size_t)(l + 1) * BATCH * 6 * D;
                thin_phase<true, true>(F, xo, xo, Yb, Hb, KIN(I_GPOSTMLP) + (size_t)l * D, adl + 5 * D, KIN(I_GPREMIX) + (size_t)(l + 1) * D, adn + D, adn); }
            else thin_phase<true, false>(F, xo, xo, Yb, nullptr, KIN(I_GPOSTMLP) + (size_t)l * D, adl + 5 * D, nullptr, nullptr, nullptr); }
#endif
        if (l + 1 < DEPTH) GRID_BAR();
    }
    if (blockIdx.x == 0 && F.tid == 0 && __hip_atomic_load((unsigned*)(ctl + CW_BAR) + XB_TMO, RLX_AGENT) != 0u) xo[0] = __builtin_nanf("");
}
#undef ada
#undef tab
#undef adap
#undef Hb
#undef PROJ
#undef SSQ
#undef KR
#undef QF
#undef KVF
#undef OSB
#undef MRG
#undef Yb
#undef XB
#undef U
#undef GRB
#undef GSB
#undef x_in
#undef wl
#undef adl


extern "C" void kernel_launch(void* const* d_in, const int* in_sizes, int n_in, void* d_out, int out_size, void* d_ws, size_t ws_size, hipStream_t stream) {
    static int grid = 0;
    if (grid == 0) {
        if (n_in != 19 || out_size != M * D || ws_size < WS_END) { fprintf(stderr, "kernel_launch: unexpected shapes (n_in %d, out %d, ws %zu < %zu)\n", n_in, out_size, ws_size, (size_t)WS_END); grid = -1; return; }
        int dev = 0, cus = 0, per_cu = 0;
        if (hipGetDevice(&dev) != hipSuccess || hipDeviceGetAttribute(&cus, hipDeviceAttributeMultiprocessorCount, dev) != hipSuccess) { grid = -1; return; }
        if (hipFuncSetAttribute((const void*)hybrid_fwd, hipFuncAttributeMaxDynamicSharedMemorySize, LDS_BYTES) != hipSuccess) { fprintf(stderr, "kernel_launch: hipFuncSetAttribute failed\n"); grid = -1; return; }
        if (hipOccupancyMaxActiveBlocksPerMultiprocessor(&per_cu, (const void*)hybrid_fwd, NWAVES * 64, LDS_BYTES) != hipSuccess || per_cu < 1) { fprintf(stderr, "kernel_launch: occupancy query says %d\n", per_cu); (void)hipGetLastError(); }
        grid = cus;
    }
    if (grid < 0) return;
    if (hipMemsetAsync((char*)d_ws + WS_CTL, 0, CTL_ZERO_BYTES, stream) != hipSuccess) return;
    Args a{};
    for (int i = 0; i < 19; ++i) a.in[i] = (const float*)d_in[i];
    a.out = (float*)d_out; a.ws = (unsigned char*)d_ws;
    hipLaunchKernelGGL(hybrid_fwd, dim3(grid), dim3(NWAVES * 64), LDS_BYTES, stream, a);
#ifdef DBG_CHECK
    hipLaunchKernelGGL(dbg_check, dim3(DBG_NCHK), dim3(256), 0, stream, a, (unsigned*)((char*)d_ws + 4096));
    hipLaunchKernelGGL(dbg_report, dim3(1), dim3(64), 0, stream, (float*)d_out, (const unsigned*)((char*)d_ws + 4096));
#endif
}
```

```cpp
#include <hip/hip_runtime.h>
#include <cstdio>
#include <cstdint>
#include <cmath>
#ifndef PG8_WGM
#define PG8_WGM 8
#endif
namespace pg8 {
#define PG8_LAS __attribute__((address_space(3)))
typedef unsigned short bf16_t;
typedef short bf16x8 __attribute__((ext_vector_type(8)));
typedef float f32x4 __attribute__((ext_vector_type(4)));
typedef unsigned u32x4 __attribute__((ext_vector_type(4)));
constexpr int BM = 256, BK = 64, HALF = 128, HTB = HALF * BK * 2  , STAGE_BYTES = 8 * HTB, NXCD = 8, WGM = PG8_WGM;

__host__ __device__ __forceinline__ int lds_byte(int r, int c) { const int st = (r >> 4) * 2 + (c >> 5), rr = r & 15, cc = c & 31, ob = rr * 64 + cc * 2; return st * 1024 + (ob ^ (((ob >> 9) & 1) << 5)); }
__host__ __device__ __forceinline__ void stage_rc(int b, int& R, int& C) { const int st = b / 1024, sb = b % 1024, swz = sb ^ (((sb >> 9) & 1) << 5); R = (st >> 1) * 16 + swz / 64; C = (st & 1) * 32 + (swz % 64) / 2; }
__host__ __device__ __forceinline__ int perm32(int rho) { const int n = rho >> 4, i = rho & 15; return 8 * (i >> 2) + 4 * n + (i & 3); }

struct Unit { int pm, pn; };
struct Gemm { const bf16_t* A; const bf16_t* Bt; int M, N, K; int lda = 0; };

struct StaticOrder {
    int nM, nN, nwg, G, c;
    __host__ __device__ void init(int M, int N, int G_, int c_) { nM = M / BM; nN = N / BM; nwg = nM * nN; G = G_; c = c_; }
    __host__ __device__ bool next(int i, Unit& u) const {
        const long L = (long)i * G + c; if (L >= nwg) return false;
        int wgid = (int)L; { const int q = nwg / NXCD, r = nwg % NXCD, xcd = wgid % NXCD, off = wgid / NXCD; wgid = (xcd < r ? xcd * (q + 1) : r * (q + 1) + (xcd - r) * q) + off; }
        const int nig = WGM * nN, gid = wgid / nig, fm = gid * WGM, gsz = (nM - fm) < WGM ? (nM - fm) : WGM;
        u.pm = fm + ((wgid % nig) % gsz); u.pn = (wgid % nig) / gsz; return true;
    }
    __device__ __forceinline__ void a_ready(const Unit&) const {}
    __device__ __forceinline__ void done(const Unit&) const {}
};

struct UnevenOrder : StaticOrder {
    __host__ __device__ bool next(int i, Unit& u) const {
        long L; const int h = G / 2;
        if (c < h) { if (i > 0) return false; L = c; } else { if (i > 2) return false; L = h + (long)h * i + (c - h); }
        if (L >= nwg) return false;
        int wgid = (int)L; { const int q = nwg / NXCD, r = nwg % NXCD, xcd = wgid % NXCD, off = wgid / NXCD; wgid = (xcd < r ? xcd * (q + 1) : r * (q + 1) + (xcd - r) * q) + off; }
        const int nig = WGM * nN, gid = wgid / nig, fm = gid * WGM, gsz = (nM - fm) < WGM ? (nM - fm) : WGM;
        u.pm = fm + ((wgid % nig) % gsz); u.pn = (wgid % nig) / gsz; return true;
    }
};

struct RepOrder : StaticOrder {
    int reps;
    __host__ __device__ bool next(int i, Unit& u) const { const int per = (nwg + G - 1) / G; if (i >= per * reps) return false; return StaticOrder::next(i % per, u); }
};
__device__ __forceinline__ unsigned cvt_pk_bf16(float lo, float hi) { unsigned r; asm volatile("v_cvt_pk_bf16_f32 %0, %1, %2" : "=v"(r) : "v"(lo), "v"(hi)); return r; }
typedef float f32x2 __attribute__((ext_vector_type(2)));

__device__ __forceinline__ float bf_lo(unsigned w) { return __builtin_bit_cast(float, w << 16); }
__device__ __forceinline__ float bf_hi(unsigned w) { return __builtin_bit_cast(float, w & 0xffff0000u); }
__device__ __forceinline__ float sigmoidf_fast(float x) { return __builtin_amdgcn_rcpf(1.0f + __builtin_amdgcn_exp2f(-1.4426950408889634f * x)); }

#ifndef EPI_WT
#define EPI_WT 0
#endif
__device__ __forceinline__ void st16_out(bf16_t* p, u32x4 w) {
#if EPI_WT
    asm volatile("global_store_dwordx4 %0, %1, off sc1" :: "v"((__attribute__((address_space(1))) u32x4*)p), "v"(w) : "memory");
#else
    *(u32x4*)p = w;
#endif
}
template <int ACT  > struct EpiBf16 {
    static constexpr bool PERM = true, AFTER_DRAIN = false, MID = false;
    bf16_t* O; int ldc;
    __device__ __forceinline__ void operator()(const f32x4 (&acc)[2][2][4][2], const Unit& u, int wr, int wc, int fr, int fq) const {
        const int row0 = u.pm * BM + wr * 64 + fr, col0 = u.pn * BM + wc * 32 + 8 * fq;
#pragma unroll
        for (int ai = 0; ai < 2; ++ai)
#pragma unroll
            for (int m = 0; m < 4; ++m) { bf16_t* rowp = O + (size_t)(row0 + ai * HALF + m * 16) * ldc + col0;
#pragma unroll
                for (int bj = 0; bj < 2; ++bj) { f32x4 v0 = acc[ai][bj][m][0], v1 = acc[ai][bj][m][1];
                    if (ACT == 1) {
#pragma unroll
                        for (int j = 0; j < 4; ++j) { const float a = fmaxf(v0[j], 0.f), b = fmaxf(v1[j], 0.f); v0[j] = a * a; v1[j] = b * b; } }
                    u32x4 w; w.x = cvt_pk_bf16(v0[0], v0[1]); w.y = cvt_pk_bf16(v0[2], v0[3]); w.z = cvt_pk_bf16(v1[0], v1[1]); w.w = cvt_pk_bf16(v1[2], v1[3]);
                    st16_out(rowp + bj * HALF, w);
                    } }
    }
};
struct EpiProj {
    static constexpr bool PERM = true, AFTER_DRAIN = false, MID = false;
    static constexpr int SSQ_T0 = 24, ROPE_T = 30, GATE_T0 = 31;
    bf16_t* O; int ldc; float* SSQ; bf16_t* KRo; const float* tab; u32x4* GR; u32x4* GS;
    __device__ __forceinline__ void operator()(const f32x4 (&acc)[2][2][4][2], const Unit& u, int wr, int wc, int fr, int fq) const {
        const int row0 = u.pm * BM + wr * 64 + fr, col0 = u.pn * BM + wc * 32 + 8 * fq;
        const bool do_ssq = (u.pn >= SSQ_T0) && (u.pn < SSQ_T0 + 6), do_rope = (u.pn == ROPE_T) && (wc < 2);
        if (u.pn >= GATE_T0) {
            const int t = u.pn - GATE_T0; const size_t e0 = ((size_t)((u.pm * 16 + (t >> 1)) * 16 + (t & 1))) * 512 + (size_t)((wr * 4 + wc) * 64 + fr + 16 * fq);
#pragma unroll
            for (int ai = 0; ai < 2; ++ai)
#pragma unroll
                for (int m = 0; m < 4; ++m) { float r[8], sg[8];
#pragma unroll
                    for (int n = 0; n < 2; ++n)
#pragma unroll
                        for (int j = 0; j < 4; ++j) { const float e1 = __builtin_amdgcn_exp2f(-1.4426950408889634f * acc[ai][0][m][n][j]), e2 = __builtin_amdgcn_exp2f(-1.4426950408889634f * acc[ai][1][m][n][j]);
                            sg[4 * n + j] = __builtin_amdgcn_rcpf(1.0f + e2); r[4 * n + j] = (1.0f + e2) * __builtin_amdgcn_rcpf(1.0f + e1); }
                    u32x4 rw, sw; rw.x = cvt_pk_bf16(r[0], r[1]); rw.y = cvt_pk_bf16(r[2], r[3]); rw.z = cvt_pk_bf16(r[4], r[5]); rw.w = cvt_pk_bf16(r[6], r[7]);
                    sw.x = cvt_pk_bf16(sg[0], sg[1]); sw.y = cvt_pk_bf16(sg[2], sg[3]); sw.z = cvt_pk_bf16(sg[4], sg[5]); sw.w = cvt_pk_bf16(sg[6], sg[7]);
                    GR[e0 + (size_t)(ai * 8 + m * 2) * 512] = rw; GS[e0 + (size_t)(ai * 8 + m * 2) * 512] = sw; }
            return;
        }
#pragma unroll
        for (int ai = 0; ai < 2; ++ai)
#pragma unroll
            for (int m = 0; m < 4; ++m) { const int row = row0 + ai * HALF + m * 16; bf16_t* rowp = O + (size_t)row * ldc + col0;
                float ss = 0.f;
#pragma unroll
                for (int bj = 0; bj < 2; ++bj) { const f32x4 v0 = acc[ai][bj][m][0], v1 = acc[ai][bj][m][1];
                    u32x4 w; w.x = cvt_pk_bf16(v0[0], v0[1]); w.y = cvt_pk_bf16(v0[2], v0[3]); w.z = cvt_pk_bf16(v1[0], v1[1]); w.w = cvt_pk_bf16(v1[2], v1[3]);
                    st16_out(rowp + bj * HALF, w);
                    if (do_ssq) { const unsigned ww[4] = {w.x, w.y, w.z, w.w};
#pragma unroll
                        for (int q = 0; q < 4; ++q) { const float a = bf_lo(ww[q]), b = bf_hi(ww[q]); ss += a * a + b * b; } }
                    if (bj == 0 && do_rope) { const int co = wc * 32 + 8 * fq; const float* tp = tab + (size_t)row * 64 + co;
                        const f32x4 t0 = *(const f32x4*)tp, t1 = *(const f32x4*)(tp + 4);
                        f32x4 r0, r1;
                        r0[0] = v0[0] * t0[0] - v0[1] * t0[1]; r0[1] = v0[1] * t0[0] + v0[0] * t0[1];
                        r0[2] = v0[2] * t0[2] - v0[3] * t0[3]; r0[3] = v0[3] * t0[2] + v0[2] * t0[3];
                        r1[0] = v1[0] * t1[0] - v1[1] * t1[1]; r1[1] = v1[1] * t1[0] + v1[0] * t1[1];
                        r1[2] = v1[2] * t1[2] - v1[3] * t1[3]; r1[3] = v1[3] * t1[2] + v1[2] * t1[3];
                        u32x4 k; k.x = cvt_pk_bf16(r0[0], r0[1]); k.y = cvt_pk_bf16(r0[2], r0[3]); k.z = cvt_pk_bf16(r1[0], r1[1]); k.w = cvt_pk_bf16(r1[2], r1[3]);
                        *(u32x4*)(KRo + (size_t)row * 64 + co) = k; } }
                if (do_ssq) { ss += __shfl_xor(ss, 16); ss += __shfl_xor(ss, 32);
                    if (fq == 0) SSQ[(size_t)row * 32 + 4 * (u.pn - SSQ_T0) + wc] = ss; } }
    }
};
template <int S0, int NS> __device__ __forceinline__ void row_rms_scales(float (&rs)[2][4], const float* SSQ, int row0, int fq, float inv_dim) {
    float part[2][4];
#pragma unroll
    for (int ai = 0; ai < 2; ++ai)
#pragma unroll
        for (int m = 0; m < 4; ++m) { const float* p = SSQ + (size_t)(row0 + ai * HALF + m * 16) * 32 + S0 + (NS / 4) * fq;
            if constexpr (NS == 16) { const f32x4 v = *(const f32x4*)p; part[ai][m] = (v[0] + v[1]) + (v[2] + v[3]); }
            else { const f32x2 v = *(const f32x2*)p; part[ai][m] = v[0] + v[1]; } }
#pragma unroll
    for (int ai = 0; ai < 2; ++ai)
#pragma unroll
        for (int m = 0; m < 4; ++m) { float t = part[ai][m]; t += __shfl_xor(t, 16); t += __shfl_xor(t, 32); rs[ai][m] = 1.0f / sqrtf(t * inv_dim + 1e-6f); }
}
struct EpiScale {
    static constexpr bool PERM = true, AFTER_DRAIN = false, MID = false;
    bf16_t* O; int ldc; const float* SSQ;
    __device__ __forceinline__ void operator()(const f32x4 (&acc)[2][2][4][2], const Unit& u, int wr, int wc, int fr, int fq) const {
        const int row0 = u.pm * BM + wr * 64 + fr, col0 = u.pn * BM + wc * 32 + 8 * fq;
        float rs[2][4]; row_rms_scales<16, 8>(rs, SSQ, row0, fq, 1.0f / 512.0f);
#pragma unroll
        for (int ai = 0; ai < 2; ++ai)
#pragma unroll
            for (int m = 0; m < 4; ++m) { bf16_t* rowp = O + (size_t)(row0 + ai * HALF + m * 16) * ldc + col0; const float r = rs[ai][m];
#pragma unroll
                for (int bj = 0; bj < 2; ++bj) { const f32x4 v0 = acc[ai][bj][m][0] * r, v1 = acc[ai][bj][m][1] * r;
                    u32x4 w; w.x = cvt_pk_bf16(v0[0], v0[1]); w.y = cvt_pk_bf16(v0[2], v0[3]); w.z = cvt_pk_bf16(v1[0], v1[1]); w.w = cvt_pk_bf16(v1[2], v1[3]);
                    st16_out(rowp + bj * HALF, w); } }
    }
};
struct EpiRope {
    static constexpr bool PERM = true, AFTER_DRAIN = false, MID = false;
    bf16_t* O; int ldc; const float* tab; const float* SSQ;
    __device__ __forceinline__ void operator()(const f32x4 (&acc)[2][2][4][2], const Unit& u, int wr, int wc, int fr, int fq) const {
        const int row0 = u.pm * BM + wr * 64 + fr, col0 = u.pn * BM + wc * 32 + 8 * fq;
        float rs[2][4]; row_rms_scales<0, 16>(rs, SSQ, row0, fq, 1.0f / 1024.0f);
        const int j0 = col0 % 192, j1 = (col0 + HALF) % 192, rbj = (j0 >= 128) ? 0 : (j1 >= 128) ? 1 : -1, jr = (rbj == 0 ? j0 : j1) - 128;
#pragma unroll
        for (int ai = 0; ai < 2; ++ai) {
            f32x4 t0[4], t1[4];
            if (rbj >= 0) {
#pragma unroll
                for (int m = 0; m < 4; ++m) { const float* tp = tab + (size_t)(row0 + ai * HALF + m * 16) * 64 + jr;
                    t0[m] = *(const f32x4*)tp; t1[m] = *(const f32x4*)(tp + 4); }
            }
#pragma unroll
            for (int m = 0; m < 4; ++m) { const int row = row0 + ai * HALF + m * 16; bf16_t* rowp = O + (size_t)row * ldc + col0;
#pragma unroll
                for (int bj = 0; bj < 2; ++bj) { f32x4 v0 = acc[ai][bj][m][0] * rs[ai][m], v1 = acc[ai][bj][m][1] * rs[ai][m];
                    if (bj == rbj) { const f32x4 a0 = t0[m], a1 = t1[m];
                        f32x4 r0, r1;
                        r0[0] = v0[0] * a0[0] - v0[1] * a0[1]; r0[1] = v0[1] * a0[0] + v0[0] * a0[1];
                        r0[2] = v0[2] * a0[2] - v0[3] * a0[3]; r0[3] = v0[3] * a0[2] + v0[2] * a0[3];
                        r1[0] = v1[0] * a1[0] - v1[1] * a1[1]; r1[1] = v1[1] * a1[0] + v1[0] * a1[1];
                        r1[2] = v1[2] * a1[2] - v1[3] * a1[3]; r1[3] = v1[3] * a1[2] + v1[2] * a1[3];
                        v0 = r0; v1 = r1; }
                    u32x4 w; w.x = cvt_pk_bf16(v0[0], v0[1]); w.y = cvt_pk_bf16(v0[2], v0[3]); w.z = cvt_pk_bf16(v1[0], v1[1]); w.w = cvt_pk_bf16(v1[2], v1[3]);
                    st16_out(rowp + bj * HALF, w); } }
            asm volatile("" ::: "memory"); }
    }
};
struct EpiGateMerge {
    static constexpr bool PERM = true, AFTER_DRAIN = false, MID = true;
    bf16_t* O; int ldo; const u32x4* GR; const u32x4* GS;
    __device__ __forceinline__ void mid(f32x4 (&acc)[2][2][4][2], const Unit& u, int wr, int wc, int fr, int fq) const {
        int fr_ = fr, fq_ = fq; asm volatile("" : "+v"(fr_), "+v"(fq_));
        const u32x4* p = GR + (size_t)((u.pm * 16 + u.pn) * 16) * 512 + (size_t)((wr * 4 + wc) * 64 + fr_ + 16 * fq_);
        u32x4 g[2][4][2];
#pragma unroll
        for (int ai = 0; ai < 2; ++ai)
#pragma unroll
            for (int m = 0; m < 4; ++m)
#pragma unroll
                for (int bj = 0; bj < 2; ++bj) g[ai][m][bj] = p[(ai * 8 + m * 2 + bj) * 512];
#pragma unroll
        for (int ai = 0; ai < 2; ++ai)
#pragma unroll
            for (int m = 0; m < 4; ++m)
#pragma unroll
                for (int bj = 0; bj < 2; ++bj) { const u32x4 a = g[ai][m][bj]; const unsigned aw[4] = {a.x, a.y, a.z, a.w};
#pragma unroll
                    for (int q = 0; q < 4; ++q) { acc[ai][bj][m][q >> 1][2 * (q & 1)] *= bf_lo(aw[q]); acc[ai][bj][m][q >> 1][2 * (q & 1) + 1] *= bf_hi(aw[q]); } }
    }
    __device__ __forceinline__ void operator()(const f32x4 (&acc)[2][2][4][2], const Unit& u, int wr, int wc, int fr, int fq) const {
        const int row0 = u.pm * BM + wr * 64 + fr, col0 = u.pn * BM + wc * 32 + 8 * fq;
        const u32x4* p = GS + (size_t)((u.pm * 16 + u.pn) * 16) * 512 + (size_t)((wr * 4 + wc) * 64 + fr + 16 * fq);
        u32x4 g[2][4][2];
#pragma unroll
        for (int ai = 0; ai < 2; ++ai)
#pragma unroll
            for (int m = 0; m < 4; ++m)
#pragma unroll
                for (int bj = 0; bj < 2; ++bj) g[ai][m][bj] = p[(ai * 8 + m * 2 + bj) * 512];
#pragma unroll
        for (int ai = 0; ai < 2; ++ai)
#pragma unroll
            for (int m = 0; m < 4; ++m) { bf16_t* op = O + (size_t)(row0 + ai * HALF + m * 16) * ldo + col0;
#pragma unroll
                for (int bj = 0; bj < 2; ++bj) { const f32x4 v0 = acc[ai][bj][m][0], v1 = acc[ai][bj][m][1]; const u32x4 s = g[ai][m][bj];
                    u32x4 w; w.x = cvt_pk_bf16(v0[0] * bf_lo(s.x), v0[1] * bf_hi(s.x)); w.y = cvt_pk_bf16(v0[2] * bf_lo(s.y), v0[3] * bf_hi(s.y));
                    w.z = cvt_pk_bf16(v1[0] * bf_lo(s.z), v1[1] * bf_hi(s.z)); w.w = cvt_pk_bf16(v1[2] * bf_lo(s.w), v1[3] * bf_hi(s.w));
                    st16_out(op + bj * HALF, w); } }
    }
};

template <class Epi, class Sched, bool ALIGN_EPI = false, bool SP2 = false>
__device__ __forceinline__ void gemm_phase(PG8_LAS unsigned char* lds, const Gemm g, const Sched& S, const Epi& E) {
    int tid_ = threadIdx.x; asm volatile("" : "+v"(tid_));
    const int tid = tid_, wid = __builtin_amdgcn_readfirstlane(tid >> 6), lane = tid & 63, wr = wid >> 2, wc = wid & 3, fr = lane & 15, fq = lane >> 4;
    const int K = g.K, nt = K / BK, lda = g.lda ? g.lda : K;
#ifndef PG8_KROT
#define PG8_KROT 0
#endif
#if PG8_KROT
    const int ktm = nt - 1, kt0 = Epi::MID ? 0 : ((int)((blockIdx.x & 7u) * (unsigned)(nt >> 3)) * PG8_KROT) & ktm;
#define PG8_KP(base, t) ((base) + (size_t)(((t) + kt0) & ktm) * kstep)
#define PG8_KPB(base, t) ((base) + (size_t)(((t) + kt0) & ktm) * kstepB)
#else
#define PG8_KP(base, t) ((base) + (size_t)(t) * kstep)
#define PG8_KPB(base, t) ((base) + (size_t)(t) * kstepB)
#endif
    unsigned voffA[2], voffB[2];
#pragma unroll
    for (int i = 0; i < 2; ++i) { int R, C; stage_rc(tid * 16 + i * 8192, R, C); const int Rb = Epi::PERM ? ((R & ~31) + perm32(R & 31)) : R;
        voffA[i] = (unsigned)(R * lda + C) * 2u; voffB[i] = (unsigned)(Rb * BK + C) * 2u; }
    const size_t kstep = (size_t)(BK * 2);
    const size_t kstepB = (size_t)g.N * (BK * 2);
    const size_t hstepA = (size_t)HALF * lda * 2, hstepB = (size_t)HALF * BK * 2;
    const size_t tstepA = 2 * hstepA, tstepB = 2 * hstepB;
    const unsigned ldsw = (unsigned)wid * 1024u;
    const int aoff = lds_byte(wr * 64 + fr, fq * 8), boff = lds_byte(wc * 32 + fr, fq * 8);
#define PG8_SA(b, h) (((b) * 2 + (h)) * HTB)
#define PG8_SB(b, h) ((4 + (b) * 2 + (h)) * HTB)
#define PG8_STAGE(bufoff, gbase, voff) do { _Pragma("unroll") for (int _i = 0; _i < 2; ++_i) \
        __builtin_amdgcn_global_load_lds((const unsigned*)((const char*)(gbase) + (voff)[_i]), (PG8_LAS unsigned*)(lds + (bufoff) + ldsw + _i * 8192), 16, 0, 0); } while (0)
#define PG8_LDA(dst, b, h) do { _Pragma("unroll") for (int m = 0; m < 4; ++m) _Pragma("unroll") for (int k = 0; k < 2; ++k) dst[m][k] = *(const PG8_LAS bf16x8*)(lds + PG8_SA(b, h) + aoff + m * 2048 + k * 1024); } while (0)
#define PG8_LDB(dst, b, h) do { _Pragma("unroll") for (int n = 0; n < 2; ++n) _Pragma("unroll") for (int k = 0; k < 2; ++k) dst[n][k] = *(const PG8_LAS bf16x8*)(lds + PG8_SB(b, h) + boff + n * 2048 + k * 1024); } while (0)
#ifndef PG8_PRIO
#define PG8_PRIO 1
#endif
#define PG8_MMA(ai, bj, At, Bt) do { if (PG8_PRIO) __builtin_amdgcn_s_setprio(PG8_PRIO); _Pragma("unroll") for (int m = 0; m < 4; ++m) _Pragma("unroll") for (int n = 0; n < 2; ++n) _Pragma("unroll") for (int k = 0; k < 2; ++k) \
        acc[ai][bj][m][n] = __builtin_amdgcn_mfma_f32_16x16x32_bf16(Bt[n][k], At[m][k], acc[ai][bj][m][n], 0, 0, 0); if (PG8_PRIO) __builtin_amdgcn_s_setprio(0); } while (0)
#define PG8_WAIT_V(n) asm volatile("s_waitcnt vmcnt(" #n ")" ::: "memory")
#define PG8_WAIT_L(n) asm volatile("s_waitcnt lgkmcnt(" #n ")" ::: "memory")
#define PG8_BAR __builtin_amdgcn_s_barrier()
#define PG8_SCHED __builtin_amdgcn_sched_barrier(0)
    Unit cur, nxt; int ui = 0;
    if (!S.next(0, cur)) return;
    f32x4 acc[2][2][4][2];
#pragma unroll
    for (int a = 0; a < 2; ++a)
#pragma unroll
        for (int b = 0; b < 2; ++b)
#pragma unroll
            for (int m = 0; m < 4; ++m)
#pragma unroll
                for (int n = 0; n < 2; ++n) acc[a][b][m][n] = (f32x4){0.f, 0.f, 0.f, 0.f};
    bf16x8 At[4][2], B0[2][2], B1[2][2];
    const char* cA = (const char*)g.A + (size_t)cur.pm * tstepA; const char* cB = (const char*)g.Bt + (size_t)cur.pn * tstepB;
    S.a_ready(cur);
    if constexpr (SP2) {
        PG8_STAGE(PG8_SB(0, 0), PG8_KPB(cB, 0), voffB); PG8_STAGE(PG8_SB(0, 1), PG8_KPB(cB, 0) + hstepB, voffB); PG8_STAGE(PG8_SA(0, 0), PG8_KP(cA, 0), voffA); PG8_STAGE(PG8_SA(0, 1), PG8_KP(cA, 0) + hstepA, voffA);
        if (wr == 1) PG8_BAR;
        PG8_WAIT_V(2); PG8_BAR;
        PG8_STAGE(PG8_SB(1, 0), PG8_KPB(cB, 1), voffB); PG8_STAGE(PG8_SA(1, 0), PG8_KP(cA, 1), voffA); PG8_STAGE(PG8_SB(1, 1), PG8_KPB(cB, 1) + hstepB, voffB);
        PG8_WAIT_V(6); PG8_BAR;
    } else {
        PG8_STAGE(PG8_SB(0, 0), cB, voffB); PG8_STAGE(PG8_SA(0, 0), cA, voffA); PG8_STAGE(PG8_SB(0, 1), cB + hstepB, voffB); PG8_STAGE(PG8_SA(0, 1), cA + hstepA, voffA);
        if (wr == 1) PG8_BAR;
        PG8_WAIT_V(4); PG8_BAR;
        PG8_STAGE(PG8_SB(1, 0), cB + kstepB, voffB); PG8_STAGE(PG8_SA(1, 0), cA + kstep, voffA); PG8_STAGE(PG8_SB(1, 1), cB + hstepB + kstepB, voffB);
        PG8_WAIT_V(6); PG8_BAR;
    }
    for (;;) {
        const bool has_next = S.next(ui + 1, nxt);
        const char* nA = has_next ? (const char*)g.A + (size_t)nxt.pm * tstepA : cA; const char* nB = has_next ? (const char*)g.Bt + (size_t)nxt.pn * tstepB : cB;
        for (int t = 0; t < nt; t += 2) {
            const bool last = (t == nt - 2);
            const char* a1 = PG8_KP(cA, t + 1);
            const char* a2 = last ? PG8_KP(nA, 0) : PG8_KP(cA, t + 2); const char* b2 = last ? PG8_KPB(nB, 0) : PG8_KPB(cB, t + 2);
            const char* a3 = last ? PG8_KP(nA, 1) : PG8_KP(cA, t + 3); const char* b3 = last ? PG8_KPB(nB, 1) : PG8_KPB(cB, t + 3);
            if (last && has_next) S.a_ready(nxt);
            if constexpr (Epi::MID) { if (t == (nt >> 1)) E.mid(acc, cur, wr, wc, fr, fq); }
            if constexpr (SP2) {
            PG8_LDB(B0, 0, 0); PG8_LDB(B1, 0, 1); PG8_SCHED; PG8_LDA(At, 0, 0); PG8_STAGE(PG8_SA(1, 1), a1 + hstepA, voffA);
            PG8_WAIT_V(8); PG8_WAIT_L(0); PG8_BAR; PG8_MMA(0, 0, At, B0); PG8_MMA(0, 1, At, B1); PG8_BAR; PG8_SCHED;
            PG8_LDA(At, 0, 1); PG8_STAGE(PG8_SB(0, 0), b2, voffB); PG8_STAGE(PG8_SB(0, 1), b2 + hstepB, voffB); PG8_STAGE(PG8_SA(0, 0), a2, voffA);
            PG8_WAIT_V(8); PG8_WAIT_L(0); PG8_BAR; PG8_MMA(1, 0, At, B0); PG8_MMA(1, 1, At, B1); PG8_BAR; PG8_SCHED;
            PG8_LDB(B0, 1, 0); PG8_LDB(B1, 1, 1); PG8_SCHED; PG8_LDA(At, 1, 0); PG8_STAGE(PG8_SA(0, 1), a2 + hstepA, voffA);
            PG8_WAIT_V(8); PG8_WAIT_L(0); PG8_BAR; PG8_MMA(0, 0, At, B0); PG8_MMA(0, 1, At, B1); PG8_BAR; PG8_SCHED;
            PG8_LDA(At, 1, 1); PG8_STAGE(PG8_SB(1, 0), b3, voffB); PG8_STAGE(PG8_SB(1, 1), b3 + hstepB, voffB); PG8_STAGE(PG8_SA(1, 0), a3, voffA);
            PG8_WAIT_V(8); PG8_WAIT_L(0); PG8_BAR; PG8_MMA(1, 0, At, B0); PG8_MMA(1, 1, At, B1); PG8_BAR; PG8_SCHED;
            } else {
            PG8_LDB(B0, 0, 0); PG8_SCHED; PG8_LDA(At, 0, 0); PG8_STAGE(PG8_SA(1, 1), a1 + hstepA, voffA);
            PG8_WAIT_L(8); PG8_BAR; PG8_WAIT_L(0); PG8_MMA(0, 0, At, B0); PG8_BAR; PG8_SCHED;
            PG8_LDB(B1, 0, 1); PG8_STAGE(PG8_SB(0, 0), b2, voffB);
            PG8_BAR; PG8_WAIT_L(0); PG8_MMA(0, 1, At, B1); PG8_BAR;
            PG8_LDA(At, 0, 1); PG8_STAGE(PG8_SA(0, 0), a2, voffA);
            PG8_BAR; PG8_WAIT_L(0); PG8_MMA(1, 0, At, B0); PG8_BAR; PG8_SCHED;
            PG8_STAGE(PG8_SB(0, 1), b2 + hstepB, voffB);
            PG8_WAIT_V(6); PG8_BAR; PG8_MMA(1, 1, At, B1); PG8_BAR;
            PG8_LDB(B0, 1, 0); PG8_SCHED; PG8_LDA(At, 1, 0); PG8_STAGE(PG8_SA(0, 1), a2 + hstepA, voffA);
            PG8_WAIT_L(8); PG8_BAR; PG8_WAIT_L(0); PG8_MMA(0, 0, At, B0); PG8_BAR; PG8_SCHED;
            PG8_LDB(B1, 1, 1); PG8_STAGE(PG8_SB(1, 0), b3, voffB);
            PG8_BAR; PG8_WAIT_L(0); PG8_MMA(0, 1, At, B1); PG8_BAR;
            PG8_LDA(At, 1, 1); PG8_STAGE(PG8_SA(1, 0), a3, voffA);
            PG8_BAR; PG8_WAIT_L(0); PG8_MMA(1, 0, At, B0); PG8_BAR; PG8_SCHED;
            PG8_STAGE(PG8_SB(1, 1), b3 + hstepB, voffB);
            PG8_WAIT_V(6); PG8_BAR; PG8_MMA(1, 1, At, B1); PG8_BAR;
            }
        }
        if constexpr (ALIGN_EPI) { if (wr == 0) PG8_BAR; }
        if constexpr (!Epi::AFTER_DRAIN) { E(acc, cur, wr, wc, fr, fq); S.done(cur); }
        if (!has_next) break;
#pragma unroll
        for (int a = 0; a < 2; ++a)
#pragma unroll
            for (int b = 0; b < 2; ++b)
#pragma unroll
                for (int m = 0; m < 4; ++m)
#pragma unroll
                    for (int n = 0; n < 2; ++n) acc[a][b][m][n] = (f32x4){0.f, 0.f, 0.f, 0.f};
        cur = nxt; cA = nA; cB = nB; ++ui;
        if constexpr (ALIGN_EPI) { if (wr == 1) PG8_BAR; }
    }
    PG8_WAIT_V(0);
    if constexpr (!ALIGN_EPI) { if (wr == 0) PG8_BAR; }
    PG8_BAR;
    if constexpr (Epi::AFTER_DRAIN) { E.fused(acc, cur, wr, wc, fr, fq, lds, wid, lane); S.done(cur); }
#undef PG8_SA
#undef PG8_KP
#undef PG8_KPB
#undef PG8_SB
#undef PG8_STAGE
#undef PG8_LDA
#undef PG8_LDB
#undef PG8_MMA
#undef PG8_WAIT_V
#undef PG8_WAIT_L
#undef PG8_BAR
#undef PG8_SCHED
}
}

namespace att {
#define ATT_LAS __attribute__((address_space(3)))
typedef unsigned short bf16_t;
typedef short bf16x8 __attribute__((ext_vector_type(8)));
typedef short s16x4 __attribute__((ext_vector_type(4)));
typedef float f32x16 __attribute__((ext_vector_type(16)));
typedef unsigned u32x4 __attribute__((ext_vector_type(4)));
constexpr int SHM_V = 16384, SHM_K = 16384, SHM_R = 8192, BUFB = SHM_V + SHM_K + SHM_R;
constexpr int LDS_SCR = 2 * BUFB;
constexpr int LDS_FLAGS = LDS_SCR + 8 * 256;
constexpr int LDS_QR = LDS_FLAGS + 64;
constexpr int ATT_LDS_BYTES = LDS_QR + 8 * 4096;
#define KSWZ(row, colB) ((row) * 256 + ((colB) ^ (((row) & 7) << 4)))
#define RSWZ(row, colB) ((row) * 128 + ((colB) ^ ((((row) >> 1) & 7) << 4)))
__device__ __forceinline__ int v_st(int k, int c) { const int kk = (k & ~0xC) | ((k & 4) << 1) | ((k & 8) >> 1); return ((kk >> 3) * 4 + (c >> 5)) * 512 + ((kk & 7) * 32 + (c & 31)) * 2; }
__device__ __forceinline__ int v_rd_base(int lane) { return ((lane & 3) << 3) | (((lane >> 2) & 3) << 6) | (((lane >> 4) & 1) << 5) | (((lane >> 5) & 1) << 8); }
constexpr int v_rd_off(int d0, int ks, int half) { return d0 * 512 + ks * 4096 + half * 2048; }
__device__ __forceinline__ int crow(int r, int hi) { return (r & 3) + 8 * (r >> 2) + 4 * hi; }
__device__ __forceinline__ unsigned cvtpk(float lo, float hi) { unsigned r; asm volatile("v_cvt_pk_bf16_f32 %0, %1, %2" : "=v"(r) : "v"(lo), "v"(hi)); return r; }
#define ATT_SBAR() __builtin_amdgcn_sched_barrier(0)
#ifndef ATT_PRIO
#define ATT_PRIO 0
#endif
#ifndef ATT_QR_REG
#define ATT_QR_REG 1
#endif
#ifndef ATT_DEFER_MAX
#define ATT_DEFER_MAX 1
#endif
#ifndef ATT_SB_PROD
#define ATT_SB_PROD 1
#endif
#ifndef ATT_EARLYW
#define ATT_EARLYW 0
#endif

template <int ND>
__device__ __forceinline__ void qkt_half(f32x16& p, const ATT_LAS char* Kb, const ATT_LAS char* Rb, int r32, int hi, const bf16x8* qr, const ATT_LAS char* qrl, int lane, int half) {
    bf16x8 kf[8];
#pragma unroll
    for (int d0 = 0; d0 < 8; ++d0) kf[d0] = *(const ATT_LAS bf16x8*)(Kb + KSWZ(r32, ((d0 & 3) * 16 + hi * 8) * 2) + (d0 >> 2) * 128 + half * (32 * 256));
    ATT_SBAR();
    p = f32x16{};
    if constexpr (ND == 12) {
        bf16x8 rf[4], qf[4];
#pragma unroll
        for (int d0 = 0; d0 < 4; ++d0) p = __builtin_amdgcn_mfma_f32_32x32x16_bf16(kf[d0], qr[d0], p, 0, 0, 0);
        ATT_SBAR();
#pragma unroll
#if ATT_QR_REG
        for (int dr = 0; dr < 4; ++dr) { rf[dr] = *(const ATT_LAS bf16x8*)(Rb + RSWZ(r32, (dr * 16 + hi * 8) * 2) + half * (32 * 128)); qf[dr] = qr[8 + dr]; }
#else
        for (int dr = 0; dr < 4; ++dr) { rf[dr] = *(const ATT_LAS bf16x8*)(Rb + RSWZ(r32, (dr * 16 + hi * 8) * 2) + half * (32 * 128)); qf[dr] = *(const ATT_LAS bf16x8*)(qrl + dr * 1024 + lane * 16); }
#endif
        ATT_SBAR();
#pragma unroll
        for (int d0 = 4; d0 < 8; ++d0) p = __builtin_amdgcn_mfma_f32_32x32x16_bf16(kf[d0], qr[d0], p, 0, 0, 0);
#pragma unroll
        for (int dr = 0; dr < 4; ++dr) p = __builtin_amdgcn_mfma_f32_32x32x16_bf16(rf[dr], qf[dr], p, 0, 0, 0);
    } else {
#pragma unroll
        for (int d0 = 0; d0 < 8; ++d0) p = __builtin_amdgcn_mfma_f32_32x32x16_bf16(kf[d0], qr[d0], p, 0, 0, 0);
    }
}
__device__ __forceinline__ void pv_tile(f32x16* o, int vb, bf16x8 pa0, bf16x8 pa1, bf16x8 pa2, bf16x8 pa3) {
#define ATT_TRRD(dst, off) asm volatile("ds_read_b64_tr_b16 %0, %1 offset:%2" : "=&v"(dst) : "v"(vb), "i"(off) : "memory")
#define ATT_PV_D0(d0) do { s16x4 l0, l1, l2, l3, h0, h1, h2, h3; constexpr int b_ = v_rd_off(d0, 0, 0); \
        ATT_TRRD(l0, b_); ATT_TRRD(h0, b_ + 2048); ATT_TRRD(l1, b_ + 4096); ATT_TRRD(h1, b_ + 6144); ATT_TRRD(l2, b_ + 8192); ATT_TRRD(h2, b_ + 10240); ATT_TRRD(l3, b_ + 12288); ATT_TRRD(h3, b_ + 14336); \
        asm volatile("s_waitcnt lgkmcnt(0)" ::: "memory"); ATT_SBAR(); \
        o[d0] = __builtin_amdgcn_mfma_f32_32x32x16_bf16(pa0, (bf16x8){l0[0], l0[1], l0[2], l0[3], h0[0], h0[1], h0[2], h0[3]}, o[d0], 0, 0, 0); \
        o[d0] = __builtin_amdgcn_mfma_f32_32x32x16_bf16(pa1, (bf16x8){l1[0], l1[1], l1[2], l1[3], h1[0], h1[1], h1[2], h1[3]}, o[d0], 0, 0, 0); \
        o[d0] = __builtin_amdgcn_mfma_f32_32x32x16_bf16(pa2, (bf16x8){l2[0], l2[1], l2[2], l2[3], h2[0], h2[1], h2[2], h2[3]}, o[d0], 0, 0, 0); \
        o[d0] = __builtin_amdgcn_mfma_f32_32x32x16_bf16(pa3, (bf16x8){l3[0], l3[1], l3[2], l3[3], h3[0], h3[1], h3[2], h3[3]}, o[d0], 0, 0, 0); } while (0)
    if (ATT_PRIO) __builtin_amdgcn_s_setprio(1);
    ATT_PV_D0(0); ATT_PV_D0(1); ATT_PV_D0(2); ATT_PV_D0(3);
    if (ATT_PRIO) __builtin_amdgcn_s_setprio(0);
#undef ATT_PV_D0
#undef ATT_TRRD
}
__device__ __forceinline__ void pack_half(const f32x16& p, bf16x8& pa0, bf16x8& pa1) {
#define ATT_PK4(P, B_, OUT) do { unsigned a0 = cvtpk(P[B_+0], P[B_+1]), a1 = cvtpk(P[B_+2], P[B_+3]); \
        unsigned b0 = cvtpk(P[B_+4], P[B_+5]), b1 = cvtpk(P[B_+6], P[B_+7]); \
        auto r0 = __builtin_amdgcn_permlane32_swap(a0, b0, false, false); auto r1 = __builtin_amdgcn_permlane32_swap(a1, b1, false, false); \
        u32x4 w = {r0[0], r1[0], r0[1], r1[1]}; OUT = __builtin_bit_cast(bf16x8, w); } while (0)
    ATT_PK4(p, 0, pa0); ATT_PK4(p, 8, pa1);
#undef ATT_PK4
}
__device__ __forceinline__ void half_xchg(float x, float& lo, float& hi) {
    unsigned a = __builtin_bit_cast(unsigned, x), b;
    asm volatile("s_nop 1\n\tv_mov_b32 %1, %0\n\ts_nop 1\n\tv_permlane32_swap_b32 %0, %1" : "+v"(a), "=&v"(b));
    lo = __builtin_bit_cast(float, a); hi = __builtin_bit_cast(float, b);
}
__device__ __forceinline__ float half_sum(float v) { float lo, hi; half_xchg(v, lo, hi); return lo + hi; }
__device__ __forceinline__ float half_max(float v) { float lo, hi; half_xchg(v, lo, hi); return fmaxf(lo, hi); }

struct Tensors { const bf16_t* Q; int ldq; const bf16_t* K; int ldk; const bf16_t* V; int ldv; const bf16_t* R; bf16_t* O; int ldo; };

template <int MODE>
__device__ __forceinline__ void attn_unit(const Tensors& T, int qb, float sc2, ATT_LAS char* lds) {
    constexpr int ND = MODE == 1 ? 12 : 8;
    int tid_ = threadIdx.x; asm volatile("" : "+v"(tid_));
    const int tid = tid_, wid = __builtin_amdgcn_readfirstlane(tid >> 6), lane = tid & 63, r32 = lane & 31, hi = lane >> 5;
    const int q0 = qb * 256, qw = q0 + wid * 32;
    const int NT = 4 * (qb + 1);
    const int wlast = 4 * qb + (wid >> 1);
    const int tq = qw + r32;
    ATT_LAS float* scr = (ATT_LAS float*)(lds + LDS_SCR) + wid * 64;
    volatile ATT_LAS unsigned* flags = (volatile ATT_LAS unsigned*)(lds + LDS_FLAGS);
    const ATT_LAS char* qrl = lds + LDS_QR + wid * 4096;
    bf16x8 qr[(MODE == 1 && ATT_QR_REG) ? 12 : 8];
    { const bf16_t* qp = T.Q + (size_t)tq * T.ldq + hi * 8;
#pragma unroll
      for (int d0 = 0; d0 < 8; ++d0) qr[d0] = *(const bf16x8*)(qp + d0 * 16);
      if constexpr (MODE == 1) {
#if ATT_QR_REG
#pragma unroll
          for (int dr = 0; dr < 4; ++dr) qr[8 + dr] = *(const bf16x8*)(qp + 128 + dr * 16);
#else
#pragma unroll
          for (int dr = 0; dr < 4; ++dr) *(ATT_LAS bf16x8*)(lds + LDS_QR + wid * 4096 + dr * 1024 + lane * 16) = *(const bf16x8*)(qp + 128 + dr * 16);
#endif
      } }
    const int sr = tid >> 4, sc = (tid & 15) * 8, kws = KSWZ(sr, sc * 2), vst0 = v_st(sr, sc), vst1 = v_st(32 + sr, sc);
    const int rr_ = tid >> 3, rc = (tid & 7) * 8, rws = RSWZ(rr_, rc * 2);
    bf16x8 sk0, sk1, sv0, sv1, srp;
#define ATT_LOAD(kt) do { const size_t k0_ = (size_t)(kt) * 64; \
        sk0 = *(const bf16x8*)(T.K + (k0_ + sr) * T.ldk + sc); sk1 = *(const bf16x8*)(T.K + (k0_ + 32 + sr) * T.ldk + sc); \
        sv0 = *(const bf16x8*)(T.V + (k0_ + sr) * T.ldv + sc); sv1 = *(const bf16x8*)(T.V + (k0_ + 32 + sr) * T.ldv + sc); \
        if constexpr (MODE == 1) srp = *(const bf16x8*)(T.R + (k0_ + rr_) * 64 + rc); } while (0)
#define ATT_WRITE(bf) do { ATT_LAS char* b_ = lds + (bf) * BUFB; \
        *(ATT_LAS bf16x8*)(b_ + vst0) = sv0; *(ATT_LAS bf16x8*)(b_ + vst1) = sv1; \
        *(ATT_LAS bf16x8*)(b_ + SHM_V + kws) = sk0; *(ATT_LAS bf16x8*)(b_ + SHM_V + kws + 32 * 256) = sk1; \
        if constexpr (MODE == 1) *(ATT_LAS bf16x8*)(b_ + SHM_V + SHM_K + rws) = srp; } while (0)
#define ATT_TILE(it) (MODE == 0 ? (NT - 1 - (it)) : (it))
    f32x16 o[4] = {};
    float carry = 0.f;
    float m_reg = -1e30f, l_reg = 0.f;
    bool dead = false;
    const float hsel = hi ? 0.f : 1.f;
    ATT_LOAD(ATT_TILE(0)); asm volatile("s_waitcnt vmcnt(0)" ::: "memory"); ATT_WRITE(0);
    __syncthreads();
    for (int it = 0; it < NT; ++it) {
        const int cur = it & 1, kt = ATT_TILE(it), kb = kt * 64;
        if (it + 1 < NT) ATT_LOAD(ATT_TILE(it + 1));
        const ATT_LAS char* bufp = lds + cur * BUFB;
        bool staged = false;
        if (kt <= wlast && !dead) {
            f32x16 p0, p1;
            bf16x8 pa0, pa1, pa2, pa3;
            if constexpr (MODE == 0) {
                const bool diag = (kb + 63 >= qw);
                qkt_half<ND>(p1, bufp + SHM_V, bufp + SHM_V + SHM_K, r32, hi, qr, qrl, lane, 1);
                qkt_half<ND>(p0, bufp + SHM_V, bufp + SHM_V + SHM_K, r32, hi, qr, qrl, lane, 0);
#if ATT_SB_PROD
                float Tp = __builtin_amdgcn_exp2f(carry), tprod = 1.f;
#define ATT_SB_HALF(P, KOFF) do { f32x16 om; \
                    _Pragma("unroll") for (int r = 0; r < 16; ++r) { const float e_ = __builtin_amdgcn_exp2f(__builtin_amdgcn_fmed3f(P[r] * sc2, -120.f, 120.f)); P[r] = e_; om[r] = __builtin_amdgcn_rcpf(1.0f + e_); } \
                    if (diag) { _Pragma("unroll") for (int r = 0; r < 16; ++r) { if (kb + (KOFF) + crow(r, hi) >= tq) om[r] = 1.f; } } \
                    float gp_[4], oh_[4], pp_[4]; \
                    _Pragma("unroll") for (int i = 0; i < 4; ++i) { om[4*i+2] *= om[4*i+3]; om[4*i+1] *= om[4*i+2]; om[4*i] *= om[4*i+1]; gp_[i] = om[4*i]; } \
                    _Pragma("unroll") for (int i = 0; i < 4; ++i) { float lo_; half_xchg(gp_[i], lo_, oh_[i]); pp_[i] = lo_ * oh_[i]; } \
                    _Pragma("unroll") for (int i = 3; i >= 0; --i) { const float Tg = Tp * (hi ? 1.f : oh_[i]); \
                        _Pragma("unroll") for (int e = 0; e < 4; ++e) P[4*i+e] = (P[4*i+e] * om[4*i+e]) * Tg; \
                        Tp *= pp_[i]; tprod *= pp_[i]; } \
                    if (diag) { _Pragma("unroll") for (int r = 0; r < 16; ++r) { if (kb + (KOFF) + crow(r, hi) >= tq) P[r] = 0.f; } } } while (0)
                ATT_SB_HALF(p1, 32);
                pack_half(p1, pa2, pa3);
                ATT_SB_HALF(p0, 0);
                pack_half(p0, pa0, pa1);
#undef ATT_SB_HALF
                carry += __builtin_amdgcn_logf(tprod);
#else
                float tsum = carry;
#define ATT_SB_HALF(P, KOFF) do { f32x16 f; \
                    _Pragma("unroll") for (int r = 0; r < 16; ++r) { P[r] *= sc2; \
                        f[r] = fminf(-P[r], 0.f) - __builtin_amdgcn_logf(1.0f + __builtin_amdgcn_exp2f(-__builtin_fabsf(P[r]))); } \
                    if (diag) { _Pragma("unroll") for (int r = 0; r < 16; ++r) { if (kb + (KOFF) + crow(r, hi) >= tq) f[r] = 0.f; } } \
                    float gs_[4], oh_[4], ps_[4]; \
                    _Pragma("unroll") for (int i = 0; i < 4; ++i) { f[4*i+2] += f[4*i+3]; f[4*i+1] += f[4*i+2]; f[4*i] += f[4*i+1]; gs_[i] = f[4*i]; } \
                    _Pragma("unroll") for (int i = 0; i < 4; ++i) { float lo_; half_xchg(gs_[i], lo_, oh_[i]); ps_[i] = lo_ + oh_[i]; } \
                    _Pragma("unroll") for (int i = 3; i >= 0; --i) { const float Tg = tsum + hsel * oh_[i]; \
                        _Pragma("unroll") for (int e = 0; e < 4; ++e) P[4*i+e] = __builtin_amdgcn_exp2f(P[4*i+e] + f[4*i+e] + Tg); \
                        tsum += ps_[i]; } \
                    if (diag) { _Pragma("unroll") for (int r = 0; r < 16; ++r) { if (kb + (KOFF) + crow(r, hi) >= tq) P[r] = 0.f; } } } while (0)
                ATT_SB_HALF(p1, 32);
                pack_half(p1, pa2, pa3);
                ATT_SB_HALF(p0, 0);
                pack_half(p0, pa0, pa1);
#undef ATT_SB_HALF
                carry = tsum;
#endif
                pv_tile(o, (int)(uintptr_t)(bufp) + v_rd_base(lane), pa0, pa1, pa2, pa3);
                if (__all(carry < -140.f)) dead = true;
            } else {
                qkt_half<ND>(p0, bufp + SHM_V, bufp + SHM_V + SHM_K, r32, hi, qr, qrl, lane, 0);
                qkt_half<ND>(p1, bufp + SHM_V, bufp + SHM_V + SHM_K, r32, hi, qr, qrl, lane, 1);
                float pmax = p0[0];
#pragma unroll
                for (int r = 1; r < 16; ++r) pmax = fmaxf(pmax, p0[r]);
#pragma unroll
                for (int r = 0; r < 16; ++r) pmax = fmaxf(pmax, p1[r]);
                pmax = half_max(pmax);
#if ATT_DEFER_MAX
                const float mn = (pmax > m_reg + 8.0f * __builtin_amdgcn_rcpf(sc2)) ? pmax : m_reg;
                const float alpha = __builtin_amdgcn_exp2f((m_reg - mn) * sc2); m_reg = mn;
#else
                const float mn = fmaxf(m_reg, pmax), alpha = __builtin_amdgcn_exp2f((m_reg - mn) * sc2); m_reg = mn;
#endif
                const float mnL = -mn * sc2;
                float psum = 0.f;
#pragma unroll
                for (int r = 0; r < 16; ++r) { p0[r] = __builtin_amdgcn_exp2f(fmaf(p0[r], sc2, mnL)); psum += p0[r]; }
                pack_half(p0, pa0, pa1);
#pragma unroll
                for (int r = 0; r < 16; ++r) { p1[r] = __builtin_amdgcn_exp2f(fmaf(p1[r], sc2, mnL)); psum += p1[r]; }
                pack_half(p1, pa2, pa3);
                l_reg = l_reg * alpha + half_sum(psum);
                if (__any(alpha < 1.f))
                { if (hi == 0) scr[r32] = alpha; asm volatile("s_waitcnt lgkmcnt(0)" ::: "memory");
#pragma unroll
                    for (int r = 0; r < 16; ++r) { const float a = scr[crow(r, hi)];
#pragma unroll
                        for (int d = 0; d < 4; ++d) o[d][r] *= a; } }
#if ATT_EARLYW
                if (it + 1 < NT) { asm volatile("s_waitcnt vmcnt(0)" ::: "memory"); ATT_WRITE(cur ^ 1); staged = true; }
#endif
                pv_tile(o, (int)(uintptr_t)(bufp) + v_rd_base(lane), pa0, pa1, pa2, pa3);
            }
        }
        if (it + 1 < NT && !staged) { asm volatile("s_waitcnt vmcnt(0)" ::: "memory"); ATT_WRITE(cur ^ 1); }
        if constexpr (MODE == 0) { if (lane == 0) flags[cur * 8 + wid] = dead ? 1u : 0u; }
        __syncthreads();
        if constexpr (MODE == 0) {
            unsigned alld = 1u;
#pragma unroll
            for (int w = 0; w < 8; ++w) alld &= flags[cur * 8 + w];
            if (alld) break;
        }
    }
    if constexpr (MODE == 1) { if (hi == 0) scr[32 + r32] = l_reg; asm volatile("s_waitcnt lgkmcnt(0)" ::: "memory"); }
    bf16_t* Ow = T.O + (size_t)qw * T.ldo;
    int obase = 4 * hi * T.ldo + r32; asm volatile("" : "+v"(obase));
#pragma unroll
    for (int r = 0; r < 16; ++r) { const int orow = crow(r, hi);
        float rl = 1.f; if constexpr (MODE == 1) rl = __builtin_amdgcn_rcpf(scr[32 + orow]);
        int ro = obase + ((r & 3) + 8 * (r >> 2)) * T.ldo; asm volatile("" : "+v"(ro));
#pragma unroll
        for (int d0 = 0; d0 < 4; ++d0) { const float v = o[d0][r] * rl; const float vn = __shfl_xor(v, 1);
            if ((r32 & 1) == 0) *(unsigned*)(Ow + ro + d0 * 32) = cvtpk(v, vn); } }
    __syncthreads();
#undef ATT_LOAD
#undef ATT_WRITE
#undef ATT_TILE
}
}

constexpr int BATCH = 2, SEQ = 4096, D = 4096, M = BATCH * SEQ, DEPTH = 2;
constexpr int SBW = 2048, QRANK = 1024, KVRANK = 512, ROPE = 64, DFF = 16384;
constexpr int IN_W = 3 * SBW + QRANK + KVRANK + ROPE + 2 * D;
constexpr int C_QD = 3 * SBW, C_KVD = C_QD + QRANK, C_GATE_SRC = C_KVD + KVRANK + ROPE;
constexpr int C_GSB = 7936, C_GMLA = C_GSB + D, PROJ_W = C_GMLA + D;
constexpr int QW = 16 * 192, KVW = 16 * 256;
constexpr float EPS = 1e-6f;
static_assert(IN_W == 15936 && PROJ_W == 16128 && PROJ_W % 256 == 0 && C_GSB % 256 == 0, "projection layout");

constexpr size_t MiB = 1u << 20;
constexpr size_t WS_CTL = 0, CTL_ZERO_BYTES = 1 * MiB;
constexpr size_t WS_ADA = 1 * MiB;
constexpr size_t WS_TAB = 2 * MiB;
constexpr size_t WS_ADAP = 4 * MiB;
constexpr size_t WS_W = 32 * MiB;
constexpr size_t W_IN = 0, W_UQ = 126 * MiB, W_UKV = 132 * MiB, W_OSB = 136 * MiB, W_OMLA = 152 * MiB, W_OUT = 168 * MiB, W_UP = 200 * MiB, W_DOWN = 328 * MiB, W_LAYER = 456 * MiB;
constexpr size_t WS_ACT = WS_W + DEPTH * W_LAYER;
constexpr size_t A_H = WS_ACT, A_PROJ = A_H + 64 * MiB, A_CQ = A_PROJ + 252 * MiB, A_CKV = A_CQ + 16 * MiB, A_KR = A_CKV + 8 * MiB, A_Q = A_KR + 1 * MiB, A_KV = A_Q + 48 * MiB,
                 A_OSB = A_KV + 64 * MiB, A_OMLA = A_OSB + 32 * MiB, A_TMP = A_OMLA + 32 * MiB, A_MRG = A_TMP + 128 * MiB, A_Y = A_MRG + 64 * MiB, A_U = A_Y + 128 * MiB, WS_END = A_U + 256 * MiB;
static_assert((size_t)PROJ_W * D * 2 == 126 * MiB && (size_t)M * PROJ_W * 2 == 252 * MiB, "sizes");
constexpr int CW_TMO = 0;
constexpr int CW_BAR = 4096;

constexpr int RING_BYTES = 135168;
constexpr int LDSCTL_OFF = RING_BYTES, MISC_OFF = LDSCTL_OFF + 320;
constexpr int LDS_BYTES = RING_BYTES + 1024;
constexpr int NWAVES = 8;
static_assert(att::ATT_LDS_BYTES <= RING_BYTES && pg8::STAGE_BYTES <= RING_BYTES, "LDS map");

#define GAS __attribute__((address_space(1)))
#define LAS __attribute__((address_space(3)))
typedef unsigned short bf16;
typedef unsigned v4u __attribute__((ext_vector_type(4)));
typedef unsigned v2u __attribute__((ext_vector_type(2)));
typedef float f32x4 __attribute__((ext_vector_type(4)));
typedef GAS unsigned gu32;
#define RLX_AGENT __ATOMIC_RELAXED, __HIP_MEMORY_SCOPE_AGENT
#ifndef USE_NT
#define USE_NT 0
#endif
#if USE_NT
#define NT_LD(p) __builtin_nontemporal_load(p)
#else
#define NT_LD(p) (*(p))
#endif
#define LDS_WAIT() asm volatile("s_waitcnt lgkmcnt(0)" ::: "memory")
#define VM_WAIT() asm volatile("s_waitcnt vmcnt(0)" ::: "memory")
__device__ __forceinline__ unsigned pk2(float lo, float hi) { return pg8::cvt_pk_bf16(lo, hi); }
__device__ __forceinline__ float bflo(unsigned w) { return __builtin_bit_cast(float, w << 16); }
__device__ __forceinline__ float bfhi(unsigned w) { return __builtin_bit_cast(float, w & 0xffff0000u); }

#define XB_TMO      128
#define XB_XCNT(j)  (256  + 64 * (j))
#define XB_XSUB(j)  (1280 + 64 * (j))
#define XB_XGEN(j)  (2304 + 64 * (j))
#define XB_TOP      3328
#define XB_TOPGEN   3392
#define XCD_BAR_WORDS 3456
#define XB_SPIN_CAP (1u << 21)

__device__ __forceinline__ unsigned xb_ld(unsigned* p)              { return __hip_atomic_load(p, __ATOMIC_RELAXED, __HIP_MEMORY_SCOPE_AGENT); }
__device__ __forceinline__ unsigned xb_add(unsigned* p, unsigned v) { return __hip_atomic_fetch_add(p, v, __ATOMIC_RELAXED, __HIP_MEMORY_SCOPE_AGENT); }
__device__ __forceinline__ unsigned xb_xcc_id() { return (unsigned)__builtin_amdgcn_s_getreg((3 << 11) | 20) & 0xFu; }
#define XB_SPIN(cond, bar) do { unsigned _sp = 0; while (cond) { __builtin_amdgcn_s_sleep(1); \
    if ((++_sp & 255u) == 0u) { if (xb_ld(&(bar)[XB_TMO])) break; if (_sp > XB_SPIN_CAP) { atomicAdd(&(bar)[XB_TMO], 1u); break; } } } } while (0)

struct XcdBarrier {
    unsigned* bar; unsigned x;
    volatile LAS unsigned* st;
};

__device__ __forceinline__ XcdBarrier xcd_barrier_post(unsigned* bar, volatile LAS unsigned* st) {
    XcdBarrier b; b.bar = bar; b.x = xb_xcc_id(); b.st = st;
    if (threadIdx.x == 0) (void)xb_add(&bar[XB_XCNT(b.x)], 1u);
    return b;
}
__device__ __forceinline__ void xcd_barrier_complete(unsigned* bar, unsigned x, unsigned& nloc, unsigned& nx) {
    const unsigned G = gridDim.x * gridDim.y * gridDim.z;
    unsigned sum, cnt, mine, sp = 0u;
    for (;;) {
        sum = 0u; cnt = 0u; mine = 0u;
#pragma unroll
        for (unsigned j = 0; j < 16; ++j) { const unsigned c = xb_ld(&bar[XB_XCNT(j)]); sum += c; cnt += (c > 0u) ? 1u : 0u; mine = (j == x) ? c : mine; }
        if (sum == G) break;
        __builtin_amdgcn_s_sleep(1);
        if ((++sp & 255u) == 0u) { if (xb_ld(&bar[XB_TMO])) break; if (sp > XB_SPIN_CAP) { atomicAdd(&bar[XB_TMO], 1u); break; } }
    }
    nloc = mine > 0u ? mine : 1u; nx = cnt > 0u ? cnt : 1u;
}

__device__ __forceinline__ void xcd_barrier(const XcdBarrier& b) {
    asm volatile("s_waitcnt vmcnt(0)" ::: "memory");
    __syncthreads();
    if (threadIdx.x == 0) {
        unsigned* bar = b.bar; unsigned bx_ = b.x; asm volatile("" : "+s"(bar), "+s"(bx_));
        __builtin_amdgcn_s_waitcnt(0);
        unsigned nloc = b.st[0], nx = b.st[1];
        if (nloc == 0u) { xcd_barrier_complete(bar, bx_, nloc, nx); b.st[0] = nloc; b.st[1] = nx; }
        const unsigned old = xb_add(&bar[XB_XSUB(bx_)], 1u);
        const unsigned gen = old / nloc;
        if (old + 1u == (gen + 1u) * nloc) {
            __builtin_amdgcn_fence(__ATOMIC_RELEASE, "agent");
            asm volatile("s_waitcnt vmcnt(0)" ::: "memory");
            const unsigned og = xb_add(&bar[XB_TOP], 1u);
            const unsigned tg = og / nx;
            if (og + 1u == (tg + 1u) * nx) xb_add(&bar[XB_TOPGEN], 1u);
            else XB_SPIN(xb_ld(&bar[XB_TOPGEN]) == tg, bar);
            __builtin_amdgcn_fence(__ATOMIC_ACQUIRE, "agent");
            xb_add(&bar[XB_XGEN(bx_)], 1u);
            asm volatile("s_waitcnt vmcnt(0)" ::: "memory");
        } else {
            XB_SPIN(xb_ld(&bar[XB_XGEN(bx_)]) == gen, bar);
            __builtin_amdgcn_fence(__ATOMIC_ACQUIRE, "agent");
            asm volatile("s_waitcnt vmcnt(0)" ::: "memory");
        }
    }
    __syncthreads();
}


struct Frame {
    LAS unsigned char* lds;
    int tid, lane, wave, G, gw, NGW;
};
__device__ __forceinline__ float wave_sum(float v) {
#pragma unroll
    for (int o = 1; o < 64; o <<= 1) v += __shfl_xor(v, o);
    return v;
}

#ifndef CONV_NT_ST
#define CONV_NT_ST 1
#endif
__device__ __forceinline__ void conv_load(f32x4 (&v)[16], f32x4& ks0, f32x4& ks1, const float* src, int N, const float* ks, int lane) {
    const float* s_ = src + (size_t)(lane >> 4) * N + 4 * (lane & 15);
#pragma unroll
    for (int i = 0; i < 16; ++i) v[i] = NT_LD((const f32x4*)(s_ + (size_t)(4 * i) * N));
    ks0 = (f32x4){1.f, 1.f, 1.f, 1.f}; ks1 = ks0;
    if (ks) { ks0 = *(const f32x4*)(ks + 8 * (lane & 7)); ks1 = *(const f32x4*)(ks + 8 * (lane & 7) + 4); }
}
__device__ __forceinline__ void conv_store(const f32x4 (&v)[16], f32x4 ks0, f32x4 ks1, bf16* dst, int ldt, int rowbase, int ropeperm, LAS float* scr, int lane) {
#pragma unroll
    for (int i = 0; i < 16; ++i) { LAS float* d = scr + (4 * i + (lane >> 4)) * 65 + 4 * (lane & 15); d[0] = v[i][0]; d[1] = v[i][1]; d[2] = v[i][2]; d[3] = v[i][3]; }
    LDS_WAIT(); asm volatile("" ::: "memory");
    const int c = lane & 7;
#pragma unroll
    for (int j = 0; j < 8; ++j) { const int nn = (lane >> 3) + 8 * j; const LAS float* s = scr + (8 * c) * 65 + nn;
        v4u o; o.x = pk2(s[0 * 65] * ks0[0], s[1 * 65] * ks0[1]); o.y = pk2(s[2 * 65] * ks0[2], s[3 * 65] * ks0[3]); o.z = pk2(s[4 * 65] * ks1[0], s[5 * 65] * ks1[1]); o.w = pk2(s[6 * 65] * ks1[2], s[7 * 65] * ks1[3]);
        const int orow = rowbase + ((ropeperm & 1) ? (2 * (nn & 31) + (nn >> 5)) : nn);
#ifdef P0A_REP_NOSTORE
        if (ropeperm < 2)
#endif
#if CONV_NT_ST
        __builtin_nontemporal_store(o, (GAS v4u*)(dst + (size_t)orow * 64 + 8 * c)); }
#else
        *(GAS v4u*)(dst + (size_t)orow * 64 + 8 * c) = o; }
#endif
    LDS_WAIT(); asm volatile("" ::: "memory");
}

__device__ __forceinline__ void norm_mod_row(const f32x4 (&v)[16], float ssq, const float* g, const float* scv, const float* shv, bf16* orow, int lane) {
    const float r = 1.0f / sqrtf(ssq * (1.0f / D) + EPS);
#pragma unroll
    for (int j = 0; j < 16; ++j) { int c = 4 * lane + 256 * j; asm volatile("" : "+v"(c));
        const f32x4 gg = *(const f32x4*)(g + c), ss = *(const f32x4*)(scv + c), hh = *(const f32x4*)(shv + c);
        f32x4 o;
#pragma unroll
        for (int e = 0; e < 4; ++e) o[e] = v[j][e] * r * gg[e] * (1.0f + ss[e]) + hh[e];
        v2u w; w.x = pk2(o[0], o[1]); w.y = pk2(o[2], o[3]);
        *(GAS v2u*)(orow + c) = w; }
}


template <bool HAS_Y, bool HAS_H, bool XIN_BF = false, bool XOUT_BF = false>
__device__ __forceinline__ void thin_phase(Frame& F, const void* xin_, void* xout_, const bf16* Yb, bf16* Hout,
                                           const float* gpost, const float* gate0, const float* gpre, const float* sc0, const float* sh0) {
    LAS float* cA1 = (LAS float*)F.lds; LAS float* cA2 = cA1 + D; LAS float* cB2 = cA2 + D;
#ifndef THIN_XCDMAP
#define THIN_XCDMAP 1
#endif
    const int chunk0 = (THIN_XCDMAP && F.G == 256) ? (64 * ((int)(blockIdx.x & 7u) >> 1) + 32 * (int)(blockIdx.x & 1u) + (int)(blockIdx.x >> 3)) : (int)blockIdx.x;
    for (int chunk = chunk0; chunk < M / 32; chunk += F.G) {
        int tid = F.tid; asm volatile("" : "+v"(tid));
        const int b = (chunk * 32) / SEQ;
        __syncthreads();
#pragma unroll
        for (int i = 0; i < 2; ++i) { const int c = 4 * tid + 2048 * i;
            if constexpr (HAS_Y) { const f32x4 g = *(const f32x4*)(gpost + c), t = *(const f32x4*)(gate0 + (size_t)b * 6 * D + c); *(LAS f32x4*)(cA1 + c) = g * t; }
            if constexpr (HAS_H) { const f32x4 g = *(const f32x4*)(gpre + c), s = *(const f32x4*)(sc0 + (size_t)b * 6 * D + c), h = *(const f32x4*)(sh0 + (size_t)b * 6 * D + c);
                *(LAS f32x4*)(cA2 + c) = g * (s + 1.0f); *(LAS f32x4*)(cB2 + c) = h; } }
        __syncthreads();
        const int LN = tid & 63;
#pragma unroll 1
        for (int i = 0; i < 4; ++i) {
            const size_t m = (size_t)chunk * 32 + F.wave * 4 + i;
            v4u yv[8]; f32x4 xv[16];
#pragma unroll
            for (int j = 0; j < 8; ++j) { const int c = 8 * LN + 512 * j;
                if constexpr (HAS_Y) yv[j] = *(const GAS v4u*)(Yb + m * D + c);
                if constexpr (XIN_BF) { const v4u xb = *(const GAS v4u*)((const bf16*)xin_ + m * D + c);
                    xv[2 * j] = (f32x4){bflo(xb.x), bfhi(xb.x), bflo(xb.y), bfhi(xb.y)}; xv[2 * j + 1] = (f32x4){bflo(xb.z), bfhi(xb.z), bflo(xb.w), bfhi(xb.w)}; }
                else { xv[2 * j] = *(const f32x4*)((const float*)xin_ + m * D + c); xv[2 * j + 1] = *(const f32x4*)((const float*)xin_ + m * D + c + 4); } }
            float ssq2 = 0.f;
            if constexpr (HAS_Y) {
                float ssq = 0.f;
#pragma unroll
                for (int j = 0; j < 8; ++j) { const unsigned w[4] = {yv[j].x, yv[j].y, yv[j].z, yv[j].w};
#pragma unroll
                    for (int q = 0; q < 4; ++q) { const float a = bflo(w[q]), c2 = bfhi(w[q]); ssq += a * a + c2 * c2; } }
                ssq = wave_sum(ssq); const float r = 1.0f / sqrtf(ssq * (1.0f / D) + EPS);
#pragma unroll
                for (int j = 0; j < 8; ++j) { const int c = 8 * LN + 512 * j; const unsigned w[4] = {yv[j].x, yv[j].y, yv[j].z, yv[j].w};
                    const f32x4 a0 = *(const LAS f32x4*)(cA1 + c), a1 = *(const LAS f32x4*)(cA1 + c + 4);
                    f32x4 y0 = {bflo(w[0]), bfhi(w[0]), bflo(w[1]), bfhi(w[1])}, y1 = {bflo(w[2]), bfhi(w[2]), bflo(w[3]), bfhi(w[3])};
                    xv[2 * j] = xv[2 * j] + a0 * (y0 * r); xv[2 * j + 1] = xv[2 * j + 1] + a1 * (y1 * r);
                    if constexpr (XOUT_BF) { v4u xw; xw.x = pk2(xv[2 * j][0], xv[2 * j][1]); xw.y = pk2(xv[2 * j][2], xv[2 * j][3]); xw.z = pk2(xv[2 * j + 1][0], xv[2 * j + 1][1]); xw.w = pk2(xv[2 * j + 1][2], xv[2 * j + 1][3]);
                        *(GAS v4u*)((bf16*)xout_ + m * D + c) = xw; }
                    else { *(f32x4*)((float*)xout_ + m * D + c) = xv[2 * j]; *(f32x4*)((float*)xout_ + m * D + c + 4) = xv[2 * j + 1]; } } }
            if constexpr (HAS_H) {
#pragma unroll
                for (int j = 0; j < 16; ++j) ssq2 += (xv[j][0] * xv[j][0] + xv[j][1] * xv[j][1]) + (xv[j][2] * xv[j][2] + xv[j][3] * xv[j][3]);
                ssq2 = wave_sum(ssq2); const float r2 = 1.0f / sqrtf(ssq2 * (1.0f / D) + EPS);
#pragma unroll
                for (int j = 0; j < 8; ++j) { const int c = 8 * LN + 512 * j;
                    const f32x4 a0 = *(const LAS f32x4*)(cA2 + c), a1 = *(const LAS f32x4*)(cA2 + c + 4), b0 = *(const LAS f32x4*)(cB2 + c), b1 = *(const LAS f32x4*)(cB2 + c + 4);
                    const f32x4 h0 = (xv[2 * j] * r2) * a0 + b0, h1 = (xv[2 * j + 1] * r2) * a1 + b1;
                    v4u w; w.x = pk2(h0[0], h0[1]); w.y = pk2(h0[2], h0[3]); w.z = pk2(h1[0], h1[1]); w.w = pk2(h1[2], h1[3]);
                    *(GAS v4u*)(Hout + m * D + c) = w; } }
        }
    }
    __syncthreads();
}

__device__ __forceinline__ int gate_row(int j) { const int which = j / D, oc = j % D; return C_GSB + 256 * (oc / 128) + 128 * which + (oc % 128); }
constexpr int NB_IN = IN_W / 64, I_IN = (D / 64) * NB_IN, I_UQ = (QRANK / 64) * (QW / 64), I_UKV = (KVRANK / 64) * (KVW / 64), I_OSB = (SBW / 64) * (D / 64), I_OMLA = I_OSB,
              I_OUT = (D / 64) * (D / 64), I_UP = (D / 64) * (DFF / 64), I_DOWN = (DFF / 64) * (D / 64), I_LAYER = I_IN + I_UQ + I_UKV + I_OSB + I_OMLA + I_OUT + I_UP + I_DOWN;
#define CONV_DECODE(it, SRC, NN, DST, LDT, RB, RP, KS) do { const int l = (it) / I_LAYER; int r = (it) % I_LAYER; KS = nullptr; RP = 0; \
        if (r < I_IN) { const int kb = r / NB_IN, nb = r % NB_IN, n0 = nb * 64; SRC = KIN(I_WIN) + (size_t)l * D * IN_W + (size_t)(64 * kb) * IN_W + n0; NN = IN_W; DST = (bf16*)(wl + W_IN) + (size_t)kb * PROJ_W * 64; LDT = 64; \
            RB = n0 < C_GATE_SRC ? n0 : gate_row(n0 - C_GATE_SRC); RP = (n0 == C_KVD + KVRANK)  ; break; } r -= I_IN; \
        if (r < I_UQ) { const int kb = r / (QW / 64), nb = r % (QW / 64); SRC = KIN(I_WUQ) + (size_t)l * QRANK * QW + (size_t)(64 * kb) * QW + 64 * nb; NN = QW; DST = (bf16*)(wl + W_UQ) + (size_t)kb * QW * 64; LDT = 64; \
            RB = nb * 64; RP = ((nb % 3) == 2); KS = KIN(I_GQ) + (size_t)l * QRANK + 64 * kb; break; } r -= I_UQ; \
        if (r < I_UKV) { const int kb = r / (KVW / 64), nb = r % (KVW / 64); SRC = KIN(I_WUKV) + (size_t)l * KVRANK * KVW + (size_t)(64 * kb) * KVW + 64 * nb; NN = KVW; DST = (bf16*)(wl + W_UKV) + (size_t)kb * KVW * 64; LDT = 64; \
            RB = nb * 64; KS = KIN(I_GKV) + (size_t)l * KVRANK + 64 * kb; break; } r -= I_UKV; \
        if (r < I_OSB) { const int kb = r / (D / 64), nb = r % (D / 64); SRC = KIN(I_WOSB) + (size_t)l * SBW * D + (size_t)(64 * kb) * D + 64 * nb; NN = D; DST = (bf16*)(wl + W_OSB) + (size_t)kb * D * 64; LDT = 64; RB = nb * 64; break; } r -= I_OSB; \
        if (r < I_OMLA) { const int kb = r / (D / 64), nb = r % (D / 64); SRC = KIN(I_WOMLA) + (size_t)l * SBW * D + (size_t)(64 * kb) * D + 64 * nb; NN = D; DST = (bf16*)(wl + W_OSB) + (size_t)(SBW / 64 + kb) * D * 64; LDT = 64; RB = nb * 64; break; } r -= I_OMLA; \
        if (r < I_OUT) { const int kb = r / (D / 64), nb = r % (D / 64); SRC = KIN(I_WOUT) + (size_t)l * D * D + (size_t)(64 * kb) * D + 64 * nb; NN = D; DST = (bf16*)(wl + W_OUT) + (size_t)kb * D * 64; LDT = 64; RB = nb * 64; break; } r -= I_OUT; \
        if (r < I_UP) { const int kb = r / (DFF / 64), nb = r % (DFF / 64); SRC = KIN(I_WUP) + (size_t)l * D * DFF + (size_t)(64 * kb) * DFF + 64 * nb; NN = DFF; DST = (bf16*)(wl + W_UP) + (size_t)kb * DFF * 64; LDT = 64; RB = nb * 64; break; } r -= I_UP; \
        { const int kb = r / (D / 64), nb = r % (D / 64); SRC = KIN(I_WDOWN) + (size_t)l * DFF * D + (size_t)(64 * kb) * D + 64 * nb; NN = D; DST = (bf16*)(wl + W_DOWN) + (size_t)kb * D * 64; LDT = 64; RB = nb * 64; } \
    } while (0)
#ifdef P0A_REP_NOSTORE
#define CONV_RPX (p0r_ > 0 ? 2 : 0)
#else
#define CONV_RPX 0
#endif
#define CONVERT_ITEMS(lo, hi, start, stride) do { int cl_ = F.lane; asm volatile("" : "+v"(cl_));     \
        int it = (lo) + (start); \
        if (it < (hi)) { \
            const float* srcA; int nA; bf16* dstA; int ldtA, rbA, rpA; const float* ksA; f32x4 vA[16], k0A, k1A; \
            CONV_DECODE(it, srcA, nA, dstA, ldtA, rbA, rpA, ksA); conv_load(vA, k0A, k1A, srcA, nA, ksA, cl_); \
            for (;;) { const int nx = it + (stride); const bool hn = nx < (hi); \
                const float* srcB = srcA; int nB = nA; bf16* dstB = dstA; int ldtB = ldtA, rbB = rbA, rpB = rpA; const float* ksB = ksA; f32x4 vB[16], k0B, k1B; \
                if (hn) { CONV_DECODE(nx, srcB, nB, dstB, ldtB, rbB, rpB, ksB); conv_load(vB, k0B, k1B, srcB, nB, ksB, cl_); } \
                conv_store(vA, k0A, k1A, dstA, ldtA, rbA, rpA + CONV_RPX, scr, cl_); \
                if (!hn) break; \
                srcA = srcB; nA = nB; dstA = dstB; ldtA = ldtB; rbA = rbB; rpA = rpB; ksA = ksB; k0A = k0B; k1A = k1B; it = nx; \
                _Pragma("unroll") for (int i_ = 0; i_ < 16; ++i_) vA[i_] = vB[i_]; } \
        } } while (0)

#ifndef XRES_BF16
#define XRES_BF16 1
#endif
#ifndef PG8_SP2
#define PG8_SP2 true
#endif
#ifndef PG8_ALIGN
#define PG8_ALIGN true
#endif
#ifndef PG8_ALIGN_P1
#define PG8_ALIGN_P1 PG8_ALIGN
#endif
#ifndef PH_MASK
#define PH_MASK 0xFFFFFFFFu
#endif
#define PH(k) ((PH_MASK >> (k)) & 1u)
struct Args { const float* in[19]; float* out; unsigned char* ws; };
enum { I_X = 0, I_C, I_POS, I_WADA, I_BADA, I_GPREMIX, I_GPOSTMIX, I_GPREMLP, I_GPOSTMLP, I_WIN, I_GQ, I_WUQ, I_GKV, I_WUKV, I_WOSB, I_WOMLA, I_WOUT, I_WUP, I_WDOWN };

typedef __attribute__((address_space(4))) const unsigned char* kargp_t;
__device__ __forceinline__ __attribute__((address_space(1))) unsigned char* lw_(unsigned char* p) { __attribute__((address_space(1))) unsigned char* q = (__attribute__((address_space(1))) unsigned char*)p; asm volatile("" : "+s"(q)); return q; }
__device__ __forceinline__ kargp_t lwk_() { kargp_t p = (kargp_t)__builtin_amdgcn_kernarg_segment_ptr(); asm volatile("" : "+s"(p)); return p; }
#define KIN(k) ((const float*)(*(const __attribute__((address_space(1))) float* const __attribute__((address_space(4)))*)(lwk_() + 8 * (k))))
__global__ void __launch_bounds__(NWAVES * 64, 2) hybrid_fwd(Args args) {
    extern __shared__ __attribute__((aligned(16))) unsigned char lds_raw[];
    Frame F;
    F.lds = (LAS unsigned char*)lds_raw;
    F.tid = threadIdx.x; F.lane = F.tid & 63; F.wave = __builtin_amdgcn_readfirstlane(F.tid >> 6);
    F.G = gridDim.x; F.gw = blockIdx.x * NWAVES + F.wave; F.NGW = F.G * NWAVES;
    unsigned char* ws = args.ws;
    gu32* ctl = (gu32*)(ws + WS_CTL);
    for (int u = F.tid; u < (LDS_BYTES - LDSCTL_OFF) / 4; u += NWAVES * 64) ((LAS unsigned*)(F.lds + LDSCTL_OFF))[u] = 0u;
    __syncthreads();
    XcdBarrier bar = xcd_barrier_post((unsigned*)(ctl + CW_BAR), (volatile LAS unsigned*)(F.lds + MISC_OFF) + 8);
#define GRID_BAR() xcd_barrier(bar)

#define ada ((float*)(lw_(ws) + WS_ADA))
#define tab ((float*)(lw_(ws) + WS_TAB))
#define adap ((float*)(lw_(ws) + WS_ADAP))
#define Hb ((bf16*)(lw_(ws) + A_H))
#define PROJ ((bf16*)(lw_(ws) + A_PROJ))
#define SSQ ((float*)(lw_(ws) + A_CQ))
#define KR ((bf16*)(lw_(ws) + A_KR))
#define QF ((bf16*)(lw_(ws) + A_Q))
#define KVF ((bf16*)(lw_(ws) + A_KV))
#define OSB ((bf16*)(lw_(ws) + A_OSB))
#define MRG ((bf16*)(lw_(ws) + A_MRG))
#define Yb ((bf16*)(lw_(ws) + A_Y))
#define XB ((bf16*)(lw_(ws) + A_TMP))
#define U ((bf16*)(lw_(ws) + A_U))
#define GRB (lw_(ws) + A_TMP + 64 * MiB)
#define GSB (lw_(ws) + A_Y + 64 * MiB)
#define x_in KIN(I_X)
#define wl (lw_(ws) + WS_W + (size_t)l * W_LAYER)
#define adl (ada + (size_t)l * BATCH * 6 * D)
    float* xo = args.out;


#ifndef PRO_REP
#define PRO_REP 1
#endif
#pragma unroll 1
    for (int prep_ = 0; prep_ < PRO_REP; ++prep_) {
#ifndef P0A_REP
#define P0A_REP 1
#endif
#pragma unroll 1
    for (int p0r_ = 0; p0r_ < P0A_REP; ++p0r_)
    if (PH(0)) {
        LAS float* cact = (LAS float*)F.lds;
        for (int i = F.tid; i < BATCH * D; i += NWAVES * 64) { const float cv = KIN(I_C)[i]; cact[i] = cv / (1.0f + __expf(-cv)); }
        __syncthreads();
#ifdef P0A_REP_NOGEMV
        if (p0r_ == 0)
#endif
        for (int task = blockIdx.x; task < DEPTH * 32 * 12; task += F.G) {
            const int l = task / (32 * 12), s = (task / 12) % 32, cb = task % 12;
            const int col = cb * 2048 + F.tid * 4;
            const float* wp = KIN(I_WADA) + ((size_t)l * D + s * 128) * (6 * D) + col;
            f32x4 a0 = {0.f, 0.f, 0.f, 0.f}, a1 = {0.f, 0.f, 0.f, 0.f};
            f32x4 w[8];
#pragma unroll
            for (int j = 0; j < 8; ++j) w[j] = NT_LD((const f32x4*)(wp + (size_t)j * (6 * D)));
#pragma unroll 1
            for (int k = 0; k < 128; k += 8) { f32x4 wn[8];
                if (k + 8 < 128) {
#pragma unroll
                    for (int j = 0; j < 8; ++j) wn[j] = NT_LD((const f32x4*)(wp + (size_t)(k + 8 + j) * (6 * D))); }
#pragma unroll
                for (int j = 0; j < 8; ++j) { const float c0 = cact[s * 128 + k + j], c1 = cact[D + s * 128 + k + j]; a0 += w[j] * c0; a1 += w[j] * c1; }
#pragma unroll
                for (int j = 0; j < 8; ++j) w[j] = wn[j]; }
            *(f32x4*)(adap + (((size_t)s * DEPTH + l) * BATCH + 0) * (6 * D) + col) = a0;
            *(f32x4*)(adap + (((size_t)s * DEPTH + l) * BATCH + 1) * (6 * D) + col) = a1;
        }
        __syncthreads();
        for (int e = blockIdx.x * (NWAVES * 64) + F.tid; e < M * 32; e += F.G * NWAVES * 64) {
            const int m = e >> 5, i = e & 31;
            const float inv = powf(10000.0f, -(float)i / 32.0f);
            const float ang = (float)(((const int*)KIN(I_POS))[m]) * inv;
            const double rev = (double)ang * 0.15915494309189533577; const float fr = (float)(rev - rint(rev));
            tab[2 * e] = __builtin_amdgcn_cosf(fr); tab[2 * e + 1] = __builtin_amdgcn_sinf(fr);
        }
        for (int l = 0; l < DEPTH; ++l) { unsigned char* zb = ws + WS_W + l * W_LAYER + W_IN;
            for (int i = blockIdx.x * (NWAVES * 64) + F.tid; i < (D / 64) * 1536; i += F.G * NWAVES * 64) { const int kt = i / 1536, u = i % 1536;
                *(v4u*)(zb + ((size_t)kt * PROJ_W + C_GATE_SRC) * 128 + (size_t)u * 16) = (v4u){0u, 0u, 0u, 0u}; } }
        LAS float* scr = (LAS float*)(F.lds) + F.wave * (64 * 65);
        CONVERT_ITEMS(0, DEPTH * I_LAYER, F.gw, F.NGW);
        if (P0A_REP > 1) __syncthreads();
    }
    GRID_BAR();
    if (PH(1)) for (int e = blockIdx.x * (NWAVES * 64) + F.tid; e < DEPTH * BATCH * 6 * D; e += F.G * NWAVES * 64) {
        const int l = e / (BATCH * 6 * D), n = e % (6 * D);
        float s = KIN(I_BADA)[(size_t)l * 6 * D + n];
#pragma unroll 8
        for (int k = 0; k < 32; ++k) s += adap[(size_t)k * (DEPTH * BATCH * 6 * D) + e];
        ada[e] = s;
    }
    GRID_BAR();
    if (PH(2)) thin_phase<false, true>(F, x_in, nullptr, nullptr, Hb, nullptr, nullptr, KIN(I_GPREMIX), ada + D, ada);
    GRID_BAR();
    }

    for (int l = 0; l < DEPTH; ++l) {
#ifndef P1_REP
#define P1_REP 1
#endif
#pragma unroll 1
        for (int rp_ = 0; rp_ < P1_REP; ++rp_) {
        if (PH(3)) { pg8::Gemm g{Hb, (const bf16*)(wl + W_IN), M, PROJ_W, D}; pg8::StaticOrder S; S.init(M, PROJ_W, F.G, (int)blockIdx.x);
          pg8::EpiProj E{PROJ, PROJ_W, SSQ, KR, tab, (pg8::u32x4*)GRB, (pg8::u32x4*)GSB};
          pg8::gemm_phase<pg8::EpiProj, pg8::StaticOrder, PG8_ALIGN_P1, PG8_SP2>(F.lds, g, S, E); }
        }
        GRID_BAR();
#ifndef P3_REP
#define P3_REP 1
#endif
#pragma unroll 1
        for (int rep3 = 0; rep3 < P3_REP; ++rep3) {
        if (PH(5)) { pg8::Gemm g{PROJ + C_QD, (const bf16*)(wl + W_UQ), M, QW, QRANK, PROJ_W}; pg8::StaticOrder S; S.init(M, QW, F.G, (int)blockIdx.x);
          pg8::EpiRope E{QF, QW, tab, SSQ};
          pg8::gemm_phase<pg8::EpiRope, pg8::StaticOrder, PG8_ALIGN, PG8_SP2>(F.lds, g, S, E); }
        if (PH(5)) { pg8::Gemm g{PROJ + C_KVD, (const bf16*)(wl + W_UKV), M, KVW, KVRANK, PROJ_W}; pg8::EpiScale E{KVF, KVW, SSQ};
          if (F.G == 256) { pg8::UnevenOrder S; S.init(M, KVW, F.G, (int)blockIdx.x);
            pg8::gemm_phase<pg8::EpiScale, pg8::UnevenOrder, PG8_ALIGN, PG8_SP2>(F.lds, g, S, E); }
          else { pg8::StaticOrder S; S.init(M, KVW, F.G, (int)blockIdx.x);
            pg8::gemm_phase<pg8::EpiScale, pg8::StaticOrder, PG8_ALIGN, PG8_SP2>(F.lds, g, S, E); } }
        }
        GRID_BAR();
#ifndef P4_REP
#define P4_REP 1
#endif
#pragma unroll 1
        for (int rp_ = 0; rp_ < P4_REP; ++rp_) {
        if (PH(6)) for (int item = blockIdx.x; item < 512; item += F.G) {
            const int kind = item >> 8, c = item & 255, bh = (c & 7) * 4 + ((c >> 3) >> 3), y = (c >> 3) & 7, b = bh >> 4, h = bh & 15;
            const size_t rb = (size_t)b * SEQ;
            if (kind == 0) { if (PH(14)) {
                att::Tensors T{PROJ + rb * PROJ_W + h * 128, PROJ_W, PROJ + rb * PROJ_W + SBW + h * 128, PROJ_W, PROJ + rb * PROJ_W + 2 * SBW + h * 128, PROJ_W, nullptr, OSB + rb * (2 * SBW) + h * 128, 2 * SBW};
                att::attn_unit<0>(T, 15 - y, 0.08838834764831845f * 1.4426950408889634f, (LAS char*)F.lds);
                att::attn_unit<0>(T, y, 0.08838834764831845f * 1.4426950408889634f, (LAS char*)F.lds); }
            } else if (PH(15)) {
                att::Tensors T{QF + rb * QW + h * 192, QW, KVF + rb * KVW + h * 256, KVW, KVF + rb * KVW + h * 256 + 128, KVW, KR + rb * ROPE, OSB + rb * (2 * SBW) + SBW + h * 128, 2 * SBW};
                att::attn_unit<1>(T, 15 - y, 0.07216878364870323f * 1.4426950408889634f, (LAS char*)F.lds);
                att::attn_unit<1>(T, y, 0.07216878364870323f * 1.4426950408889634f, (LAS char*)F.lds);
            }
        }
        }
        GRID_BAR();
#ifndef P5_REP
#define P5_REP 1
#endif
#pragma unroll 1
        for (int rep5 = 0; rep5 < P5_REP; ++rep5)
        if (PH(7)) { pg8::Gemm g{OSB, (const bf16*)(wl + W_OSB), M, D, 2 * SBW}; pg8::StaticOrder S; S.init(M, D, F.G, (int)blockIdx.x);
          pg8::EpiGateMerge E{MRG, D, (const pg8::u32x4*)GRB, (const pg8::u32x4*)GSB};
          pg8::gemm_phase<pg8::EpiGateMerge, pg8::StaticOrder, PG8_ALIGN, PG8_SP2>(F.lds, g, S, E); }
        GRID_BAR();
#ifndef P7_REP
#define P7_REP 1
#endif
#pragma unroll 1
        for (int rep7 = 0; rep7 < P7_REP; ++rep7) {
#ifdef P7_REPB
        if (rep7) GRID_BAR();
#endif
#ifdef P7_MREP
        if (PH(9)) { pg8::Gemm g{MRG, (const bf16*)(wl + W_OUT), M, D, D}; pg8::RepOrder S; S.init(M, D, F.G, (int)blockIdx.x); S.reps = P7_MREP;
          pg8::EpiBf16<0> E{Yb, D};
          pg8::gemm_phase<pg8::EpiBf16<0>, pg8::RepOrder, PG8_ALIGN, PG8_SP2>(F.lds, g, S, E); }
#else
        if (PH(9)) { pg8::Gemm g{MRG, (const bf16*)(wl + W_OUT), M, D, D}; pg8::StaticOrder S; S.init(M, D, F.G, (int)blockIdx.x);
          pg8::EpiBf16<0> E{Yb, D};
          pg8::gemm_phase<pg8::EpiBf16<0>, pg8::StaticOrder, PG8_ALIGN, PG8_SP2>(F.lds, g, S, E); }
#endif
        }
        GRID_BAR();
#if XRES_BF16
#ifdef THIN_REP
        for (int rp_ = 1; rp_ < THIN_REP; ++rp_) { if (l == 0) thin_phase<true, true, false, true>(F, x_in, (bf16*)GRB, Yb, (bf16*)GSB, KIN(I_GPOSTMIX) + (size_t)l * D, adl + 2 * D, KIN(I_GPREMLP) + (size_t)l * D, adl + 4 * D, adl + 3 * D);
            else thin_phase<true, true, true, true>(F, XB, (bf16*)GRB, Yb, (bf16*)GSB, KIN(I_GPOSTMIX) + (size_t)l * D, adl + 2 * D, KIN(I_GPREMLP) + (size_t)l * D, adl + 4 * D, adl + 3 * D); }
#endif
        if (PH(10)) { if (l == 0) thin_phase<true, true, false, true>(F, x_in, XB, Yb, Hb, KIN(I_GPOSTMIX) + (size_t)l * D, adl + 2 * D, KIN(I_GPREMLP) + (size_t)l * D, adl + 4 * D, adl + 3 * D);
            else thin_phase<true, true, true, true>(F, XB, XB, Yb, Hb, KIN(I_GPOSTMIX) + (size_t)l * D, adl + 2 * D, KIN(I_GPREMLP) + (size_t)l * D, adl + 4 * D, adl + 3 * D); }
#else
        if (PH(10)) thin_phase<true, true>(F, l == 0 ? x_in : (const float*)xo, xo, Yb, Hb, KIN(I_GPOSTMIX) + (size_t)l * D, adl + 2 * D, KIN(I_GPREMLP) + (size_t)l * D, adl + 4 * D, adl + 3 * D);
#endif
        GRID_BAR();
#ifndef P9_REP
#define P9_REP 1
#endif
#pragma unroll 1
        for (int rp_ = 0; rp_ < P9_REP; ++rp_) {
        if (PH(11)) { pg8::Gemm g{Hb, (const bf16*)(wl + W_UP), M, DFF, D}; pg8::StaticOrder S; S.init(M, DFF, F.G, (int)blockIdx.x);
          pg8::EpiBf16<1> E{U, DFF};
          pg8::gemm_phase<pg8::EpiBf16<1>, pg8::StaticOrder, PG8_ALIGN, PG8_SP2>(F.lds, g, S, E); }
        }
        GRID_BAR();
#ifndef P10_REP
#define P10_REP 1
#endif
#pragma unroll 1
        for (int rp_ = 0; rp_ < P10_REP; ++rp_) {
        if (PH(12)) { pg8::Gemm g{U, (const bf16*)(wl + W_DOWN), M, D, DFF}; pg8::StaticOrder S; S.init(M, D, F.G, (int)blockIdx.x);
          pg8::EpiBf16<0> E{Yb, D};
          pg8::gemm_phase<pg8::EpiBf16<0>, pg8::StaticOrder, PG8_ALIGN, PG8_SP2>(F.lds, g, S, E); }
        }
        GRID_BAR();
#if XRES_BF16
#ifdef THIN_REP
        for (int rp_ = 1; rp_ < THIN_REP; ++rp_) if (l + 1 < DEPTH) { const float* adn = ada + (size_t)(l + 1) * BATCH * 6 * D;
                thin_phase<true, true, true, true>(F, XB, (bf16*)GRB, Yb, (bf16*)GSB, KIN(I_GPOSTMLP) + (size_t)l * D, adl + 5 * D, KIN(I_GPREMIX) + (size_t)(l + 1) * D, adn + D, adn); }
#endif
        if (PH(13)) { if (l + 1 < DEPTH) { const float* adn = ada + (size_t)(l + 1) * BATCH * 6 * D;
                thin_phase<true, true, true, true>(F, XB, XB, Yb, Hb, KIN(I_GPOSTMLP) + (size_t)l * D, adl + 5 * D, KIN(I_GPREMIX) + (size_t)(l + 1) * D, adn + D, adn); }
            else thin_phase<true, false, true, false>(F, XB, xo, Yb, nullptr, KIN(I_GPOSTMLP) + (size_t)l * D, adl + 5 * D, nullptr, nullptr, nullptr); }
#else
        if (PH(13)) { if (l + 1 < DEPTH) { const float* adn = ada + (size_t)(l + 1) * BATCH * 6 * D;
                thin_phase<true, true>(F, xo, xo, Yb, Hb, KIN(I_GPOSTMLP) + (size_t)l * D, adl + 5 * D, KIN(I_GPREMIX) + (size_t)(l + 1) * D, adn + D, adn); }
            else thin_phase<true, false>(F, xo, xo, Yb, nullptr, KIN(I_GPOSTMLP) + (size_t)l * D, adl + 5 * D, nullptr, nullptr, nullptr); }
#endif
        if (l + 1 < DEPTH) GRID_BAR();
    }
    if (blockIdx.x == 0 && F.tid == 0 && __hip_atomic_load((unsigned*)(ctl + CW_BAR) + XB_TMO, RLX_AGENT) != 0u) xo[0] = __builtin_nanf("");
}
#undef ada
#undef tab
#undef adap
#undef Hb
#undef PROJ
#undef SSQ
#undef KR
#undef QF
#undef KVF
#undef OSB
#undef MRG
#undef Yb
#undef XB
#undef U
#undef GRB
#undef GSB
#undef x_in
#undef wl
#undef adl


extern "C" void kernel_launch(void* const* d_in, const int* in_sizes, int n_in, void* d_out, int out_size, void* d_ws, size_t ws_size, hipStream_t stream) {
    static int grid = 0;
    if (grid == 0) {
        if (n_in != 19 || out_size != M * D || ws_size < WS_END) { fprintf(stderr, "kernel_launch: unexpected shapes (n_in %d, out %d, ws %zu < %zu)\n", n_in, out_size, ws_size, (size_t)WS_END); grid = -1; return; }
        int dev = 0, cus = 0, per_cu = 0;
        if (hipGetDevice(&dev) != hipSuccess || hipDeviceGetAttribute(&cus, hipDeviceAttributeMultiprocessorCount, dev) != hipSuccess) { grid = -1; return; }
        if (hipFuncSetAttribute((const void*)hybrid_fwd, hipFuncAttributeMaxDynamicSharedMemorySize, LDS_BYTES) != hipSuccess) { fprintf(stderr, "kernel_launch: hipFuncSetAttribute failed\n"); grid = -1; return; }
        if (hipOccupancyMaxActiveBlocksPerMultiprocessor(&per_cu, (const void*)hybrid_fwd, NWAVES * 64, LDS_BYTES) != hipSuccess || per_cu < 1) { fprintf(stderr, "kernel_launch: occupancy query says %d\n", per_cu); (void)hipGetLastError(); }
        grid = cus;
    }
    if (grid < 0) return;
    if (hipMemsetAsync((char*)d_ws + WS_CTL, 0, CTL_ZERO_BYTES, stream) != hipSuccess) return;
    Args a{};
    for (int i = 0; i < 19; ++i) a.in[i] = (const float*)d_in[i];
    a.out = (float*)d_out; a.ws = (unsigned char*)d_ws;
    hipLaunchKernelGGL(hybrid_fwd, dim3(grid), dim3(NWAVES * 64), LDS_BYTES, stream, a);
#ifdef DBG_CHECK
    hipLaunchKernelGGL(dbg_check, dim3(DBG_NCHK), dim3(256), 0, stream, a, (unsigned*)((char*)d_ws + 4096));
    hipLaunchKernelGGL(dbg_report, dim3(1), dim3(64), 0, stream, (float*)d_out, (const unsigned*)((char*)d_ws + 4096));
#endif
}
```

```cpp
#include <hip/hip_runtime.h>
#include <cstdio>
#include <cstdint>
#include <cmath>
#ifndef PG8_WGM
#define PG8_WGM 8
#endif
namespace pg8 {
#define PG8_LAS __attribute__((address_space(3)))
typedef unsigned short bf16_t;
typedef short bf16x8 __attribute__((ext_vector_type(8)));
typedef float f32x4 __attribute__((ext_vector_type(4)));
typedef unsigned u32x4 __attribute__((ext_vector_type(4)));
constexpr int BM = 256, BK = 64, HALF = 128, HTB = HALF * BK * 2  , STAGE_BYTES = 8 * HTB, NXCD = 8, WGM = PG8_WGM;

__host__ __device__ __forceinline__ int lds_byte(int r, int c) { const int st = (r >> 4) * 2 + (c >> 5), rr = r & 15, cc = c & 31, ob = rr * 64 + cc * 2; return st * 1024 + (ob ^ (((ob >> 9) & 1) << 5)); }
__host__ __device__ __forceinline__ void stage_rc(int b, int& R, int& C) { const int st = b / 1024, sb = b % 1024, swz = sb ^ (((sb >> 9) & 1) << 5); R = (st >> 1) * 16 + swz / 64; C = (st & 1) * 32 + (swz % 64) / 2; }
__host__ __device__ __forceinline__ int perm32(int rho) { const int n = rho >> 4, i = rho & 15; return 8 * (i >> 2) + 4 * n + (i & 3); }

struct Unit { int pm, pn; };
struct Gemm { const bf16_t* A; const bf16_t* Bt; int M, N, K; int lda = 0; };

struct StaticOrder {
    int nM, nN, nwg, G, c;
    __host__ __device__ void init(int M, int N, int G_, int c_) { nM = M / BM; nN = N / BM; nwg = nM * nN; G = G_; c = c_; }
    __host__ __device__ bool next(int i, Unit& u) const {
        const long L = (long)i * G + c; if (L >= nwg) return false;
        int wgid = (int)L; { const int q = nwg / NXCD, r = nwg % NXCD, xcd = wgid % NXCD, off = wgid / NXCD; wgid = (xcd < r ? xcd * (q + 1) : r * (q + 1) + (xcd - r) * q) + off; }
        const int nig = WGM * nN, gid = wgid / nig, fm = gid * WGM, gsz = (nM - fm) < WGM ? (nM - fm) : WGM;
        u.pm = fm + ((wgid % nig) % gsz); u.pn = (wgid % nig) / gsz; return true;
    }
    __device__ __forceinline__ void a_ready(const Unit&) const {}
    __device__ __forceinline__ void done(const Unit&) const {}
};

struct UnevenOrder : StaticOrder {
    __host__ __device__ bool next(int i, Unit& u) const {
        long L; const int h = G / 2;
        if (c < h) { if (i > 0) return false; L = c; } else { if (i > 2) return false; L = h + (long)h * i + (c - h); }
        if (L >= nwg) return false;
        int wgid = (int)L; { const int q = nwg / NXCD, r = nwg % NXCD, xcd = wgid % NXCD, off = wgid / NXCD; wgid = (xcd < r ? xcd * (q + 1) : r * (q + 1) + (xcd - r) * q) + off; }
        const int nig = WGM * nN, gid = wgid / nig, fm = gid * WGM, gsz = (nM - fm) < WGM ? (nM - fm) : WGM;
        u.pm = fm + ((wgid % nig) % gsz); u.pn = (wgid % nig) / gsz; return true;
    }
};

struct RepOrder : StaticOrder {
    int reps;
    __host__ __device__ bool next(int i, Unit& u) const { const int per = (nwg + G - 1) / G; if (i >= per * reps) return false; return StaticOrder::next(i % per, u); }
};
__device__ __forceinline__ unsigned cvt_pk_bf16(float lo, float hi) { unsigned r; asm volatile("v_cvt_pk_bf16_f32 %0, %1, %2" : "=v"(r) : "v"(lo), "v"(hi)); return r; }
typedef float f32x2 __attribute__((ext_vector_type(2)));

__device__ __forceinline__ float bf_lo(unsigned w) { return __builtin_bit_cast(float, w << 16); }
__device__ __forceinline__ float bf_hi(unsigned w) { return __builtin_bit_cast(float, w & 0xffff0000u); }
__device__ __forceinline__ float sigmoidf_fast(float x) { return __builtin_amdgcn_rcpf(1.0f + __builtin_amdgcn_exp2f(-1.4426950408889634f * x)); }

#ifndef EPI_WT
#define EPI_WT 0
#endif
__device__ __forceinline__ void st16_out(bf16_t* p, u32x4 w) {
#if EPI_WT
    asm volatile("global_store_dwordx4 %0, %1, off sc1" :: "v"((__attribute__((address_space(1))) u32x4*)p), "v"(w) : "memory");
#else
    *(u32x4*)p = w;
#endif
}
template <int ACT  > struct EpiBf16 {
    static constexpr bool PERM = true, AFTER_DRAIN = false, MID = false;
    bf16_t* O; int ldc;
    __device__ __forceinline__ void operator()(const f32x4 (&acc)[2][2][4][2], const Unit& u, int wr, int wc, int fr, int fq) const {
        const int row0 = u.pm * BM + wr * 64 + fr, col0 = u.pn * BM + wc * 32 + 8 * fq;
#pragma unroll
        for (int ai = 0; ai < 2; ++ai)
#pragma unroll
            for (int m = 0; m < 4; ++m) { bf16_t* rowp = O + (size_t)(row0 + ai * HALF + m * 16) * ldc + col0;
#pragma unroll
                for (int bj = 0; bj < 2; ++bj) { f32x4 v0 = acc[ai][bj][m][0], v1 = acc[ai][bj][m][1];
                    if (ACT == 1) {
#pragma unroll
                        for (int j = 0; j < 4; ++j) { const float a = fmaxf(v0[j], 0.f), b = fmaxf(v1[j], 0.f); v0[j] = a * a; v1[j] = b * b; } }
                    u32x4 w; w.x = cvt_pk_bf16(v0[0], v0[1]); w.y = cvt_pk_bf16(v0[2], v0[3]); w.z = cvt_pk_bf16(v1[0], v1[1]); w.w = cvt_pk_bf16(v1[2], v1[3]);
                    st16_out(rowp + bj * HALF, w);
                    } }
    }
};
struct EpiProj {
    static constexpr bool PERM = true, AFTER_DRAIN = false, MID = false;
    static constexpr int SSQ_T0 = 24, ROPE_T = 30, GATE_T0 = 31;
    bf16_t* O; int ldc; float* SSQ; bf16_t* KRo; const float* tab; u32x4* GR; u32x4* GS;
    __device__ __forceinline__ void operator()(const f32x4 (&acc)[2][2][4][2], const Unit& u, int wr, int wc, int fr, int fq) const {
        const int row0 = u.pm * BM + wr * 64 + fr, col0 = u.pn * BM + wc * 32 + 8 * fq;
        const bool do_ssq = (u.pn >= SSQ_T0) && (u.pn < SSQ_T0 + 6), do_rope = (u.pn == ROPE_T) && (wc < 2);
        if (u.pn >= GATE_T0) {
            const int t = u.pn - GATE_T0; const size_t e0 = ((size_t)((u.pm * 16 + (t >> 1)) * 16 + (t & 1))) * 512 + (size_t)((wr * 4 + wc) * 64 + fr + 16 * fq);
#pragma unroll
            for (int ai = 0; ai < 2; ++ai)
#pragma unroll
                for (int m = 0; m < 4; ++m) { float r[8], sg[8];
#pragma unroll
                    for (int n = 0; n < 2; ++n)
#pragma unroll
                        for (int j = 0; j < 4; ++j) { const float e1 = __builtin_amdgcn_exp2f(-1.4426950408889634f * acc[ai][0][m][n][j]), e2 = __builtin_amdgcn_exp2f(-1.4426950408889634f * acc[ai][1][m][n][j]);
                            sg[4 * n + j] = __builtin_amdgcn_rcpf(1.0f + e2); r[4 * n + j] = (1.0f + e2) * __builtin_amdgcn_rcpf(1.0f + e1); }
                    u32x4 rw, sw; rw.x = cvt_pk_bf16(r[0], r[1]); rw.y = cvt_pk_bf16(r[2], r[3]); rw.z = cvt_pk_bf16(r[4], r[5]); rw.w = cvt_pk_bf16(r[6], r[7]);
                    sw.x = cvt_pk_bf16(sg[0], sg[1]); sw.y = cvt_pk_bf16(sg[2], sg[3]); sw.z = cvt_pk_bf16(sg[4], sg[5]); sw.w = cvt_pk_bf16(sg[6], sg[7]);
                    GR[e0 + (size_t)(ai * 8 + m * 2) * 512] = rw; GS[e0 + (size_t)(ai * 8 + m * 2) * 512] = sw; }
            return;
        }
#pragma unroll
        for (int ai = 0; ai < 2; ++ai)
#pragma unroll
            for (int m = 0; m < 4; ++m) { const int row = row0 + ai * HALF + m * 16; bf16_t* rowp = O + (size_t)row * ldc + col0;
                float ss = 0.f;
#pragma unroll
                for (int bj = 0; bj < 2; ++bj) { const f32x4 v0 = acc[ai][bj][m][0], v1 = acc[ai][bj][m][1];
                    u32x4 w; w.x = cvt_pk_bf16(v0[0], v0[1]); w.y = cvt_pk_bf16(v0[2], v0[3]); w.z = cvt_pk_bf16(v1[0], v1[1]); w.w = cvt_pk_bf16(v1[2], v1[3]);
                    st16_out(rowp + bj * HALF, w);
                    if (do_ssq) { const unsigned ww[4] = {w.x, w.y, w.z, w.w};
#pragma unroll
                        for (int q = 0; q < 4; ++q) { const float a = bf_lo(ww[q]), b = bf_hi(ww[q]); ss += a * a + b * b; } }
                    if (bj == 0 && do_rope) { const int co = wc * 32 + 8 * fq; const float* tp = tab + (size_t)row * 64 + co;
                        const f32x4 t0 = *(const f32x4*)tp, t1 = *(const f32x4*)(tp + 4);
                        f32x4 r0, r1;
                        r0[0] = v0[0] * t0[0] - v0[1] * t0[1]; r0[1] = v0[1] * t0[0] + v0[0] * t0[1];
                        r0[2] = v0[2] * t0[2] - v0[3] * t0[3]; r0[3] = v0[3] * t0[2] + v0[2] * t0[3];
                        r1[0] = v1[0] * t1[0] - v1[1] * t1[1]; r1[1] = v1[1] * t1[0] + v1[0] * t1[1];
                        r1[2] = v1[2] * t1[2] - v1[3] * t1[3]; r1[3] = v1[3] * t1[2] + v1[2] * t1[3];
                        u32x4 k; k.x = cvt_pk_bf16(r0[0], r0[1]); k.y = cvt_pk_bf16(r0[2], r0[3]); k.z = cvt_pk_bf16(r1[0], r1[1]); k.w = cvt_pk_bf16(r1[2], r1[3]);
                        *(u32x4*)(KRo + (size_t)row * 64 + co) = k; } }
                if (do_ssq) { ss += __shfl_xor(ss, 16); ss += __shfl_xor(ss, 32);
                    if (fq == 0) SSQ[(size_t)row * 32 + 4 * (u.pn - SSQ_T0) + wc] = ss; } }
    }
};
template <int S0, int NS> __device__ __forceinline__ void row_rms_scales(float (&rs)[2][4], const float* SSQ, int row0, int fq, float inv_dim) {
    float part[2][4];
#pragma unroll
    for (int ai = 0; ai < 2; ++ai)
#pragma unroll
        for (int m = 0; m < 4; ++m) { const float* p = SSQ + (size_t)(row0 + ai * HALF + m * 16) * 32 + S0 + (NS / 4) * fq;
            if constexpr (NS == 16) { const f32x4 v = *(const f32x4*)p; part[ai][m] = (v[0] + v[1]) + (v[2] + v[3]); }
            else { const f32x2 v = *(const f32x2*)p; part[ai][m] = v[0] + v[1]; } }
#pragma unroll
    for (int ai = 0; ai < 2; ++ai)
#pragma unroll
        for (int m = 0; m < 4; ++m) { float t = part[ai][m]; t += __shfl_xor(t, 16); t += __shfl_xor(t, 32); rs[ai][m] = 1.0f / sqrtf(t * inv_dim + 1e-6f); }
}
struct EpiScale {
    static constexpr bool PERM = true, AFTER_DRAIN = false, MID = false;
    bf16_t* O; int ldc; const float* SSQ;
    __device__ __forceinline__ void operator()(const f32x4 (&acc)[2][2][4][2], const Unit& u, int wr, int wc, int fr, int fq) const {
        const int row0 = u.pm * BM + wr * 64 + fr, col0 = u.pn * BM + wc * 32 + 8 * fq;
        float rs[2][4]; row_rms_scales<16, 8>(rs, SSQ, row0, fq, 1.0f / 512.0f);
#pragma unroll
        for (int ai = 0; ai < 2; ++ai)
#pragma unroll
            for (int m = 0; m < 4; ++m) { bf16_t* rowp = O + (size_t)(row0 + ai * HALF + m * 16) * ldc + col0; const float r = rs[ai][m];
#pragma unroll
                for (int bj = 0; bj < 2; ++bj) { const f32x4 v0 = acc[ai][bj][m][0] * r, v1 = acc[ai][bj][m][1] * r;
                    u32x4 w; w.x = cvt_pk_bf16(v0[0], v0[1]); w.y = cvt_pk_bf16(v0[2], v0[3]); w.z = cvt_pk_bf16(v1[0], v1[1]); w.w = cvt_pk_bf16(v1[2], v1[3]);
                    st16_out(rowp + bj * HALF, w); } }
    }
};
struct EpiRope {
    static constexpr bool PERM = true, AFTER_DRAIN = false, MID = false;
    bf16_t* O; int ldc; const float* tab; const float* SSQ;
    __device__ __forceinline__ void operator()(const f32x4 (&acc)[2][2][4][2], const Unit& u, int wr, int wc, int fr, int fq) const {
        const int row0 = u.pm * BM + wr * 64 + fr, col0 = u.pn * BM + wc * 32 + 8 * fq;
        float rs[2][4]; row_rms_scales<0, 16>(rs, SSQ, row0, fq, 1.0f / 1024.0f);
        const int j0 = col0 % 192, j1 = (col0 + HALF) % 192, rbj = (j0 >= 128) ? 0 : (j1 >= 128) ? 1 : -1, jr = (rbj == 0 ? j0 : j1) - 128;
#pragma unroll
        for (int ai = 0; ai < 2; ++ai) {
            f32x4 t0[4], t1[4];
            if (rbj >= 0) {
#pragma unroll
                for (int m = 0; m < 4; ++m) { const float* tp = tab + (size_t)(row0 + ai * HALF + m * 16) * 64 + jr;
                    t0[m] = *(const f32x4*)tp; t1[m] = *(const f32x4*)(tp + 4); }
            }
#pragma unroll
            for (int m = 0; m < 4; ++m) { const int row = row0 + ai * HALF + m * 16; bf16_t* rowp = O + (size_t)row * ldc + col0;
#pragma unroll
                for (int bj = 0; bj < 2; ++bj) { f32x4 v0 = acc[ai][bj][m][0] * rs[ai][m], v1 = acc[ai][bj][m][1] * rs[ai][m];
                    if (bj == rbj) { const f32x4 a0 = t0[m], a1 = t1[m];
                        f32x4 r0, r1;
                        r0[0] = v0[0] * a0[0] - v0[1] * a0[1]; r0[1] = v0[1] * a0[0] + v0[0] * a0[1];
                        r0[2] = v0[2] * a0[2] - v0[3] * a0[3]; r0[3] = v0[3] * a0[2] + v0[2] * a0[3];
                        r1[0] = v1[0] * a1[0] - v1[1] * a1[1]; r1[1] = v1[1] * a1[0] + v1[0] * a1[1];
                        r1[2] = v1[2] * a1[2] - v1[3] * a1[3]; r1[3] = v1[3] * a1[2] + v1[2] * a1[3];
                        v0 = r0; v1 = r1; }
                    u32x4 w; w.x = cvt_pk_bf16(v0[0], v0[1]); w.y = cvt_pk_bf16(v0[2], v0[3]); w.z = cvt_pk_bf16(v1[0], v1[1]); w.w = cvt_pk_bf16(v1[2], v1[3]);
                    st16_out(rowp + bj * HALF, w); } }
            asm volatile("" ::: "memory"); }
    }
};
struct EpiGateMerge {
    static constexpr bool PERM = true, AFTER_DRAIN = false, MID = true;
    bf16_t* O; int ldo; const u32x4* GR; const u32x4* GS;
    __device__ __forceinline__ void mid(f32x4 (&acc)[2][2][4][2], const Unit& u, int wr, int wc, int fr, int fq) const {
        int fr_ = fr, fq_ = fq; asm volatile("" : "+v"(fr_), "+v"(fq_));
        const u32x4* p = GR + (size_t)((u.pm * 16 + u.pn) * 16) * 512 + (size_t)((wr * 4 + wc) * 64 + fr_ + 16 * fq_);
        u32x4 g[2][4][2];
#pragma unroll
        for (int ai = 0; ai < 2; ++ai)
#pragma unroll
            for (int m = 0; m < 4; ++m)
#pragma unroll
                for (int bj = 0; bj < 2; ++bj) g[ai][m][bj] = p[(ai * 8 + m * 2 + bj) * 512];
#pragma unroll
        for (int ai = 0; ai < 2; ++ai)
#pragma unroll
            for (int m = 0; m < 4; ++m)
#pragma unroll
                for (int bj = 0; bj < 2; ++bj) { const u32x4 a = g[ai][m][bj]; const unsigned aw[4] = {a.x, a.y, a.z, a.w};
#pragma unroll
                    for (int q = 0; q < 4; ++q) { acc[ai][bj][m][q >> 1][2 * (q & 1)] *= bf_lo(aw[q]); acc[ai][bj][m][q >> 1][2 * (q & 1) + 1] *= bf_hi(aw[q]); } }
    }
    __device__ __forceinline__ void operator()(const f32x4 (&acc)[2][2][4][2], const Unit& u, int wr, int wc, int fr, int fq) const {
        const int row0 = u.pm * BM + wr * 64 + fr, col0 = u.pn * BM + wc * 32 + 8 * fq;
        const u32x4* p = GS + (size_t)((u.pm * 16 + u.pn) * 16) * 512 + (size_t)((wr * 4 + wc) * 64 + fr + 16 * fq);
        u32x4 g[2][4][2];
#pragma unroll
        for (int ai = 0; ai < 2; ++ai)
#pragma unroll
            for (int m = 0; m < 4; ++m)
#pragma unroll
                for (int bj = 0; bj < 2; ++bj) g[ai][m][bj] = p[(ai * 8 + m * 2 + bj) * 512];
#pragma unroll
        for (int ai = 0; ai < 2; ++ai)
#pragma unroll
            for (int m = 0; m < 4; ++m) { bf16_t* op = O + (size_t)(row0 + ai * HALF + m * 16) * ldo + col0;
#pragma unroll
                for (int bj = 0; bj < 2; ++bj) { const f32x4 v0 = acc[ai][bj][m][0], v1 = acc[ai][bj][m][1]; const u32x4 s = g[ai][m][bj];
                    u32x4 w; w.x = cvt_pk_bf16(v0[0] * bf_lo(s.x), v0[1] * bf_hi(s.x)); w.y = cvt_pk_bf16(v0[2] * bf_lo(s.y), v0[3] * bf_hi(s.y));
                    w.z = cvt_pk_bf16(v1[0] * bf_lo(s.z), v1[1] * bf_hi(s.z)); w.w = cvt_pk_bf16(v1[2] * bf_lo(s.w), v1[3] * bf_hi(s.w));
                    st16_out(op + bj * HALF, w); } }
    }
};

template <class Epi, class Sched, bool ALIGN_EPI = false, bool SP2 = false>
__device__ __forceinline__ void gemm_phase(PG8_LAS unsigned char* lds, const Gemm g, const Sched& S, const Epi& E) {
    int tid_ = threadIdx.x; asm volatile("" : "+v"(tid_));
    const int tid = tid_, wid = __builtin_amdgcn_readfirstlane(tid >> 6), lane = tid & 63, wr = wid >> 2, wc = wid & 3, fr = lane & 15, fq = lane >> 4;
    const int K = g.K, nt = K / BK, lda = g.lda ? g.lda : K;
#ifndef PG8_KROT
#define PG8_KROT 0
#endif
#if PG8_KROT
    const int ktm = nt - 1, kt0 = Epi::MID ? 0 : ((int)((blockIdx.x & 7u) * (unsigned)(nt >> 3)) * PG8_KROT) & ktm;
#define PG8_KP(base, t) ((base) + (size_t)(((t) + kt0) & ktm) * kstep)
#define PG8_KPB(base, t) ((base) + (size_t)(((t) + kt0) & ktm) * kstepB)
#else
#define PG8_KP(base, t) ((base) + (size_t)(t) * kstep)
#define PG8_KPB(base, t) ((base) + (size_t)(t) * kstepB)
#endif
    unsigned voffA[2], voffB[2];
#pragma unroll
    for (int i = 0; i < 2; ++i) { int R, C; stage_rc(tid * 16 + i * 8192, R, C); const int Rb = Epi::PERM ? ((R & ~31) + perm32(R & 31)) : R;
        voffA[i] = (unsigned)(R * lda + C) * 2u; voffB[i] = (unsigned)(Rb * BK + C) * 2u; }
    const size_t kstep = (size_t)(BK * 2);
    const size_t kstepB = (size_t)g.N * (BK * 2);
    const size_t hstepA = (size_t)HALF * lda * 2, hstepB = (size_t)HALF * BK * 2;
    const size_t tstepA = 2 * hstepA, tstepB = 2 * hstepB;
    const unsigned ldsw = (unsigned)wid * 1024u;
    const int aoff = lds_byte(wr * 64 + fr, fq * 8), boff = lds_byte(wc * 32 + fr, fq * 8);
#define PG8_SA(b, h) (((b) * 2 + (h)) * HTB)
#define PG8_SB(b, h) ((4 + (b) * 2 + (h)) * HTB)
#define PG8_STAGE(bufoff, gbase, voff) do { _Pragma("unroll") for (int _i = 0; _i < 2; ++_i) \
        __builtin_amdgcn_global_load_lds((const unsigned*)((const char*)(gbase) + (voff)[_i]), (PG8_LAS unsigned*)(lds + (bufoff) + ldsw + _i * 8192), 16, 0, 0); } while (0)
#define PG8_LDA(dst, b, h) do { _Pragma("unroll") for (int m = 0; m < 4; ++m) _Pragma("unroll") for (int k = 0; k < 2; ++k) dst[m][k] = *(const PG8_LAS bf16x8*)(lds + PG8_SA(b, h) + aoff + m * 2048 + k * 1024); } while (0)
#define PG8_LDB(dst, b, h) do { _Pragma("unroll") for (int n = 0; n < 2; ++n) _Pragma("unroll") for (int k = 0; k < 2; ++k) dst[n][k] = *(const PG8_LAS bf16x8*)(lds + PG8_SB(b, h) + boff + n * 2048 + k * 1024); } while (0)
#ifndef PG8_PRIO
#define PG8_PRIO 1
#endif
#define PG8_MMA(ai, bj, At, Bt) do { if (PG8_PRIO) __builtin_amdgcn_s_setprio(PG8_PRIO); _Pragma("unroll") for (int m = 0; m < 4; ++m) _Pragma("unroll") for (int n = 0; n < 2; ++n) _Pragma("unroll") for (int k = 0; k < 2; ++k) \
        acc[ai][bj][m][n] = __builtin_amdgcn_mfma_f32_16x16x32_bf16(Bt[n][k], At[m][k], acc[ai][bj][m][n], 0, 0, 0); if (PG8_PRIO) __builtin_amdgcn_s_setprio(0); } while (0)
#define PG8_WAIT_V(n) asm volatile("s_waitcnt vmcnt(" #n ")" ::: "memory")
#define PG8_WAIT_L(n) asm volatile("s_waitcnt lgkmcnt(" #n ")" ::: "memory")
#define PG8_BAR __builtin_amdgcn_s_barrier()
#define PG8_SCHED __builtin_amdgcn_sched_barrier(0)
    Unit cur, nxt; int ui = 0;
    if (!S.next(0, cur)) return;
    f32x4 acc[2][2][4][2];
#pragma unroll
    for (int a = 0; a < 2; ++a)
#pragma unroll
        for (int b = 0; b < 2; ++b)
#pragma unroll
            for (int m = 0; m < 4; ++m)
#pragma unroll
                for (int n = 0; n < 2; ++n) acc[a][b][m][n] = (f32x4){0.f, 0.f, 0.f, 0.f};
    bf16x8 At[4][2], B0[2][2], B1[2][2];
    const char* cA = (const char*)g.A + (size_t)cur.pm * tstepA; const char* cB = (const char*)g.Bt + (size_t)cur.pn * tstepB;
    S.a_ready(cur);
    if constexpr (SP2) {
        PG8_STAGE(PG8_SB(0, 0), PG8_KPB(cB, 0), voffB); PG8_STAGE(PG8_SB(0, 1), PG8_KPB(cB, 0) + hstepB, voffB); PG8_STAGE(PG8_SA(0, 0), PG8_KP(cA, 0), voffA); PG8_STAGE(PG8_SA(0, 1), PG8_KP(cA, 0) + hstepA, voffA);
        if (wr == 1) PG8_BAR;
        PG8_WAIT_V(2); PG8_BAR;
        PG8_STAGE(PG8_SB(1, 0), PG8_KPB(cB, 1), voffB); PG8_STAGE(PG8_SA(1, 0), PG8_KP(cA, 1), voffA); PG8_STAGE(PG8_SB(1, 1), PG8_KPB(cB, 1) + hstepB, voffB);
        PG8_WAIT_V(6); PG8_BAR;
    } else {
        PG8_STAGE(PG8_SB(0, 0), cB, voffB); PG8_STAGE(PG8_SA(0, 0), cA, voffA); PG8_STAGE(PG8_SB(0, 1), cB + hstepB, voffB); PG8_STAGE(PG8_SA(0, 1), cA + hstepA, voffA);
        if (wr == 1) PG8_BAR;
        PG8_WAIT_V(4); PG8_BAR;
        PG8_STAGE(PG8_SB(1, 0), cB + kstepB, voffB); PG8_STAGE(PG8_SA(1, 0), cA + kstep, voffA); PG8_STAGE(PG8_SB(1, 1), cB + hstepB + kstepB, voffB);
        PG8_WAIT_V(6); PG8_BAR;
    }
    for (;;) {
        const bool has_next = S.next(ui + 1, nxt);
        const char* nA = has_next ? (const char*)g.A + (size_t)nxt.pm * tstepA : cA; const char* nB = has_next ? (const char*)g.Bt + (size_t)nxt.pn * tstepB : cB;
        for (int t = 0; t < nt; t += 2) {
            const bool last = (t == nt - 2);
            const char* a1 = PG8_KP(cA, t + 1);
            const char* a2 = last ? PG8_KP(nA, 0) : PG8_KP(cA, t + 2); const char* b2 = last ? PG8_KPB(nB, 0) : PG8_KPB(cB, t + 2);
            const char* a3 = last ? PG8_KP(nA, 1) : PG8_KP(cA, t + 3); const char* b3 = last ? PG8_KPB(nB, 1) : PG8_KPB(cB, t + 3);
            if (last && has_next) S.a_ready(nxt);
            if constexpr (Epi::MID) { if (t == (nt >> 1)) E.mid(acc, cur, wr, wc, fr, fq); }
            if constexpr (SP2) {
            PG8_LDB(B0, 0, 0); PG8_LDB(B1, 0, 1); PG8_SCHED; PG8_LDA(At, 0, 0); PG8_STAGE(PG8_SA(1, 1), a1 + hstepA, voffA);
            PG8_WAIT_V(8); PG8_WAIT_L(0); PG8_BAR; PG8_MMA(0, 0, At, B0); PG8_MMA(0, 1, At, B1); PG8_BAR; PG8_SCHED;
            PG8_LDA(At, 0, 1); PG8_STAGE(PG8_SB(0, 0), b2, voffB); PG8_STAGE(PG8_SB(0, 1), b2 + hstepB, voffB); PG8_STAGE(PG8_SA(0, 0), a2, voffA);
            PG8_WAIT_V(8); PG8_WAIT_L(0); PG8_BAR; PG8_MMA(1, 0, At, B0); PG8_MMA(1, 1, At, B1); PG8_BAR; PG8_SCHED;
            PG8_LDB(B0, 1, 0); PG8_LDB(B1, 1, 1); PG8_SCHED; PG8_LDA(At, 1, 0); PG8_STAGE(PG8_SA(0, 1), a2 + hstepA, voffA);
            PG8_WAIT_V(8); PG8_WAIT_L(0); PG8_BAR; PG8_MMA(0, 0, At, B0); PG8_MMA(0, 1, At, B1); PG8_BAR; PG8_SCHED;
            PG8_LDA(At, 1, 1); PG8_STAGE(PG8_SB(1, 0), b3, voffB); PG8_STAGE(PG8_SB(1, 1), b3 + hstepB, voffB); PG8_STAGE(PG8_SA(1, 0), a3, voffA);
            PG8_WAIT_V(8); PG8_WAIT_L(0); PG8_BAR; PG8_MMA(1, 0, At, B0); PG8_MMA(1, 1, At, B1); PG8_BAR; PG8_SCHED;
            } else {
            PG8_LDB(B0, 0, 0); PG8_SCHED; PG8_LDA(At, 0, 0); PG8_STAGE(PG8_SA(1, 1), a1 + hstepA, voffA);
            PG8_WAIT_L(8); PG8_BAR; PG8_WAIT_L(0); PG8_MMA(0, 0, At, B0); PG8_BAR; PG8_SCHED;
            PG8_LDB(B1, 0, 1); PG8_STAGE(PG8_SB(0, 0), b2, voffB);
            PG8_BAR; PG8_WAIT_L(0); PG8_MMA(0, 1, At, B1); PG8_BAR;
            PG8_LDA(At, 0, 1); PG8_STAGE(PG8_SA(0, 0), a2, voffA);
            PG8_BAR; PG8_WAIT_L(0); PG8_MMA(1, 0, At, B0); PG8_BAR; PG8_SCHED;
            PG8_STAGE(PG8_SB(0, 1), b2 + hstepB, voffB);
            PG8_WAIT_V(6); PG8_BAR; PG8_MMA(1, 1, At, B1); PG8_BAR;
            PG8_LDB(B0, 1, 0); PG8_SCHED; PG8_LDA(At, 1, 0); PG8_STAGE(PG8_SA(0, 1), a2 + hstepA, voffA);
            PG8_WAIT_L(8); PG8_BAR; PG8_WAIT_L(0); PG8_MMA(0, 0, At, B0); PG8_BAR; PG8_SCHED;
            PG8_LDB(B1, 1, 1); PG8_STAGE(PG8_SB(1, 0), b3, voffB);
            PG8_BAR; PG8_WAIT_L(0); PG8_MMA(0, 1, At, B1); PG8_BAR;
            PG8_LDA(At, 1, 1); PG8_STAGE(PG8_SA(1, 0), a3, voffA);
            PG8_BAR; PG8_WAIT_L(0); PG8_MMA(1, 0, At, B0); PG8_BAR; PG8_SCHED;
            PG8_STAGE(PG8_SB(1, 1), b3 + hstepB, voffB);
            PG8_WAIT_V(6); PG8_BAR; PG8_MMA(1, 1, At, B1); PG8_BAR;
            }
        }
        if constexpr (ALIGN_EPI) { if (wr == 0) PG8_BAR; }
        if constexpr (!Epi::AFTER_DRAIN) { E(acc, cur, wr, wc, fr, fq); S.done(cur); }
        if (!has_next) break;
#pragma unroll
        for (int a = 0; a < 2; ++a)
#pragma unroll
            for (int b = 0; b < 2; ++b)
#pragma unroll
                for (int m = 0; m < 4; ++m)
#pragma unroll
                    for (int n = 0; n < 2; ++n) acc[a][b][m][n] = (f32x4){0.f, 0.f, 0.f, 0.f};
        cur = nxt; cA = nA; cB = nB; ++ui;
        if constexpr (ALIGN_EPI) { if (wr == 1) PG8_BAR; }
    }
    PG8_WAIT_V(0);
    if constexpr (!ALIGN_EPI) { if (wr == 0) PG8_BAR; }
    PG8_BAR;
    if constexpr (Epi::AFTER_DRAIN) { E.fused(acc, cur, wr, wc, fr, fq, lds, wid, lane); S.done(cur); }
#undef PG8_SA
#undef PG8_KP
#undef PG8_KPB
#undef PG8_SB
#undef PG8_STAGE
#undef PG8_LDA
#undef PG8_LDB
#undef PG8_MMA
#undef PG8_WAIT_V
#undef PG8_WAIT_L
#undef PG8_BAR
#undef PG8_SCHED
}
}

namespace att {
#define ATT_LAS __attribute__((address_space(3)))
typedef unsigned short bf16_t;
typedef short bf16x8 __attribute__((ext_vector_type(8)));
typedef short s16x4 __attribute__((ext_vector_type(4)));
typedef float f32x16 __attribute__((ext_vector_type(16)));
typedef unsigned u32x4 __attribute__((ext_vector_type(4)));
constexpr int SHM_V = 16384, SHM_K = 16384, SHM_R = 8192, BUFB = SHM_V + SHM_K + SHM_R;
constexpr int LDS_SCR = 2 * BUFB;
constexpr int LDS_FLAGS = LDS_SCR + 8 * 256;
constexpr int LDS_QR = LDS_FLAGS + 64;
constexpr int ATT_LDS_BYTES = LDS_QR + 8 * 4096;
#define KSWZ(row, colB) ((row) * 256 + ((colB) ^ (((row) & 7) << 4)))
#define RSWZ(row, colB) ((row) * 128 + ((colB) ^ ((((row) >> 1) & 7) << 4)))
__device__ __forceinline__ int v_st(int k, int c) { const int kk = (k & ~0xC) | ((k & 4) << 1) | ((k & 8) >> 1); return ((kk >> 3) * 4 + (c >> 5)) * 512 + ((kk & 7) * 32 + (c & 31)) * 2; }
__device__ __forceinline__ int v_rd_base(int lane) { return ((lane & 3) << 3) | (((lane >> 2) & 3) << 6) | (((lane >> 4) & 1) << 5) | (((lane >> 5) & 1) << 8); }
constexpr int v_rd_off(int d0, int ks, int half) { return d0 * 512 + ks * 4096 + half * 2048; }
__device__ __forceinline__ int crow(int r, int hi) { return (r & 3) + 8 * (r >> 2) + 4 * hi; }
__device__ __forceinline__ unsigned cvtpk(float lo, float hi) { unsigned r; asm volatile("v_cvt_pk_bf16_f32 %0, %1, %2" : "=v"(r) : "v"(lo), "v"(hi)); return r; }
#define ATT_SBAR() __builtin_amdgcn_sched_barrier(0)
#ifndef ATT_PRIO
#define ATT_PRIO 0
#endif
#ifndef ATT_QR_REG
#define ATT_QR_REG 1
#endif
#ifndef ATT_DEFER_MAX
#define ATT_DEFER_MAX 1
#endif
#ifndef ATT_SB_PROD
#define ATT_SB_PROD 1
#endif
#ifndef ATT_EARLYW
#define ATT_EARLYW 0
#endif

template <int ND>
__device__ __forceinline__ void qkt_half(f32x16& p, const ATT_LAS char* Kb, const ATT_LAS char* Rb, int r32, int hi, const bf16x8* qr, const ATT_LAS char* qrl, int lane, int half) {
    bf16x8 kf[8];
#pragma unroll
    for (int d0 = 0; d0 < 8; ++d0) kf[d0] = *(const ATT_LAS bf16x8*)(Kb + KSWZ(r32, ((d0 & 3) * 16 + hi * 8) * 2) + (d0 >> 2) * 128 + half * (32 * 256));
    ATT_SBAR();
    p = f32x16{};
    if constexpr (ND == 12) {
        bf16x8 rf[4], qf[4];
#pragma unroll
        for (int d0 = 0; d0 < 4; ++d0) p = __builtin_amdgcn_mfma_f32_32x32x16_bf16(kf[d0], qr[d0], p, 0, 0, 0);
        ATT_SBAR();
#pragma unroll
#if ATT_QR_REG
        for (int dr = 0; dr < 4; ++dr) { rf[dr] = *(const ATT_LAS bf16x8*)(Rb + RSWZ(r32, (dr * 16 + hi * 8) * 2) + half * (32 * 128)); qf[dr] = qr[8 + dr]; }
#else
        for (int dr = 0; dr < 4; ++dr) { rf[dr] = *(const ATT_LAS bf16x8*)(Rb + RSWZ(r32, (dr * 16 + hi * 8) * 2) + half * (32 * 128)); qf[dr] = *(const ATT_LAS bf16x8*)(qrl + dr * 1024 + lane * 16); }
#endif
        ATT_SBAR();
#pragma unroll
        for (int d0 = 4; d0 < 8; ++d0) p = __builtin_amdgcn_mfma_f32_32x32x16_bf16(kf[d0], qr[d0], p, 0, 0, 0);
#pragma unroll
        for (int dr = 0; dr < 4; ++dr) p = __builtin_amdgcn_mfma_f32_32x32x16_bf16(rf[dr], qf[dr], p, 0, 0, 0);
    } else {
#pragma unroll
        for (int d0 = 0; d0 < 8; ++d0) p = __builtin_amdgcn_mfma_f32_32x32x16_bf16(kf[d0], qr[d0], p, 0, 0, 0);
    }
}
__device__ __forceinline__ void pv_tile(f32x16* o, int vb, bf16x8 pa0, bf16x8 pa1, bf16x8 pa2, bf16x8 pa3) {
#define ATT_TRRD(dst, off) asm volatile("ds_read_b64_tr_b16 %0, %1 offset:%2" : "=&v"(dst) : "v"(vb), "i"(off) : "memory")
#define ATT_PV_D0(d0) do { s16x4 l0, l1, l2, l3, h0, h1, h2, h3; constexpr int b_ = v_rd_off(d0, 0, 0); \
        ATT_TRRD(l0, b_); ATT_TRRD(h0, b_ + 2048); ATT_TRRD(l1, b_ + 4096); ATT_TRRD(h1, b_ + 6144); ATT_TRRD(l2, b_ + 8192); ATT_TRRD(h2, b_ + 10240); ATT_TRRD(l3, b_ + 12288); ATT_TRRD(h3, b_ + 14336); \
        asm volatile("s_waitcnt lgkmcnt(0)" ::: "memory"); ATT_SBAR(); \
        o[d0] = __builtin_amdgcn_mfma_f32_32x32x16_bf16((bf16x8){l0[0], l0[1], l0[2], l0[3], h0[0], h0[1], h0[2], h0[3]}, pa0, o[d0], 0, 0, 0); \
        o[d0] = __builtin_amdgcn_mfma_f32_32x32x16_bf16((bf16x8){l1[0], l1[1], l1[2], l1[3], h1[0], h1[1], h1[2], h1[3]}, pa1, o[d0], 0, 0, 0); \
        o[d0] = __builtin_amdgcn_mfma_f32_32x32x16_bf16((bf16x8){l2[0], l2[1], l2[2], l2[3], h2[0], h2[1], h2[2], h2[3]}, pa2, o[d0], 0, 0, 0); \
        o[d0] = __builtin_amdgcn_mfma_f32_32x32x16_bf16((bf16x8){l3[0], l3[1], l3[2], l3[3], h3[0], h3[1], h3[2], h3[3]}, pa3, o[d0], 0, 0, 0); } while (0)
    if (ATT_PRIO) __builtin_amdgcn_s_setprio(1);
    ATT_PV_D0(0); ATT_PV_D0(1); ATT_PV_D0(2); ATT_PV_D0(3);
    if (ATT_PRIO) __builtin_amdgcn_s_setprio(0);
#undef ATT_PV_D0
#undef ATT_TRRD
}
__device__ __forceinline__ void pack_half(const f32x16& p, bf16x8& pa0, bf16x8& pa1) {
#define ATT_PK4(P, B_, OUT) do { unsigned a0 = cvtpk(P[B_+0], P[B_+1]), a1 = cvtpk(P[B_+2], P[B_+3]); \
        unsigned b0 = cvtpk(P[B_+4], P[B_+5]), b1 = cvtpk(P[B_+6], P[B_+7]); \
        auto r0 = __builtin_amdgcn_permlane32_swap(a0, b0, false, false); auto r1 = __builtin_amdgcn_permlane32_swap(a1, b1, false, false); \
        u32x4 w = {r0[0], r1[0], r0[1], r1[1]}; OUT = __builtin_bit_cast(bf16x8, w); } while (0)
    ATT_PK4(p, 0, pa0); ATT_PK4(p, 8, pa1);
#undef ATT_PK4
}
__device__ __forceinline__ void half_xchg(float x, float& lo, float& hi) {
    unsigned a = __builtin_bit_cast(unsigned, x), b;
    asm volatile("s_nop 1\n\tv_mov_b32 %1, %0\n\ts_nop 1\n\tv_permlane32_swap_b32 %0, %1" : "+v"(a), "=&v"(b));
    lo = __builtin_bit_cast(float, a); hi = __builtin_bit_cast(float, b);
}
__device__ __forceinline__ float half_sum(float v) { float lo, hi; half_xchg(v, lo, hi); return lo + hi; }
__device__ __forceinline__ float half_max(float v) { float lo, hi; half_xchg(v, lo, hi); return fmaxf(lo, hi); }

struct Tensors { const bf16_t* Q; int ldq; const bf16_t* K; int ldk; const bf16_t* V; int ldv; const bf16_t* R; bf16_t* O; int ldo; };

template <int MODE>
__device__ __forceinline__ void attn_unit(const Tensors& T, int qb, float sc2, ATT_LAS char* lds) {
    constexpr int ND = MODE == 1 ? 12 : 8;
    int tid_ = threadIdx.x; asm volatile("" : "+v"(tid_));
    const int tid = tid_, wid = __builtin_amdgcn_readfirstlane(tid >> 6), lane = tid & 63, r32 = lane & 31, hi = lane >> 5;
    const int q0 = qb * 256, qw = q0 + wid * 32;
    const int NT = 4 * (qb + 1);
    const int wlast = 4 * qb + (wid >> 1);
    const int tq = qw + r32;
    ATT_LAS float* scr = (ATT_LAS float*)(lds + LDS_SCR) + wid * 64;
    volatile ATT_LAS unsigned* flags = (volatile ATT_LAS unsigned*)(lds + LDS_FLAGS);
    const ATT_LAS char* qrl = lds + LDS_QR + wid * 4096;
    bf16x8 qr[(MODE == 1 && ATT_QR_REG) ? 12 : 8];
    { const bf16_t* qp = T.Q + (size_t)tq * T.ldq + hi * 8;
#pragma unroll
      for (int d0 = 0; d0 < 8; ++d0) qr[d0] = *(const bf16x8*)(qp + d0 * 16);
      if constexpr (MODE == 1) {
#if ATT_QR_REG
#pragma unroll
          for (int dr = 0; dr < 4; ++dr) qr[8 + dr] = *(const bf16x8*)(qp + 128 + dr * 16);
#else
#pragma unroll
          for (int dr = 0; dr < 4; ++dr) *(ATT_LAS bf16x8*)(lds + LDS_QR + wid * 4096 + dr * 1024 + lane * 16) = *(const bf16x8*)(qp + 128 + dr * 16);
#endif
      } }
    const int sr = tid >> 4, sc = (tid & 15) * 8, kws = KSWZ(sr, sc * 2), vst0 = v_st(sr, sc), vst1 = v_st(32 + sr, sc);
    const int rr_ = tid >> 3, rc = (tid & 7) * 8, rws = RSWZ(rr_, rc * 2);
    bf16x8 sk0, sk1, sv0, sv1, srp;
#define ATT_LOAD(kt) do { const size_t k0_ = (size_t)(kt) * 64; \
        sk0 = *(const bf16x8*)(T.K + (k0_ + sr) * T.ldk + sc); sk1 = *(const bf16x8*)(T.K + (k0_ + 32 + sr) * T.ldk + sc); \
        sv0 = *(const bf16x8*)(T.V + (k0_ + sr) * T.ldv + sc); sv1 = *(const bf16x8*)(T.V + (k0_ + 32 + sr) * T.ldv + sc); \
        if constexpr (MODE == 1) srp = *(const bf16x8*)(T.R + (k0_ + rr_) * 64 + rc); } while (0)
#define ATT_WRITE(bf) do { ATT_LAS char* b_ = lds + (bf) * BUFB; \
        *(ATT_LAS bf16x8*)(b_ + vst0) = sv0; *(ATT_LAS bf16x8*)(b_ + vst1) = sv1; \
        *(ATT_LAS bf16x8*)(b_ + SHM_V + kws) = sk0; *(ATT_LAS bf16x8*)(b_ + SHM_V + kws + 32 * 256) = sk1; \
        if constexpr (MODE == 1) *(ATT_LAS bf16x8*)(b_ + SHM_V + SHM_K + rws) = srp; } while (0)
#define ATT_TILE(it) (MODE == 0 ? (NT - 1 - (it)) : (it))
    f32x16 o[4] = {};
    float carry = 0.f;
    float m_reg = -1e30f, l_reg = 0.f;
    bool dead = false;
    const float hsel = hi ? 0.f : 1.f;
    ATT_LOAD(ATT_TILE(0)); asm volatile("s_waitcnt vmcnt(0)" ::: "memory"); ATT_WRITE(0);
    __syncthreads();
    for (int it = 0; it < NT; ++it) {
        const int cur = it & 1, kt = ATT_TILE(it), kb = kt * 64;
        if (it + 1 < NT) ATT_LOAD(ATT_TILE(it + 1));
        const ATT_LAS char* bufp = lds + cur * BUFB;
        bool staged = false;
        if (kt <= wlast && !dead) {
            f32x16 p0, p1;
            bf16x8 pa0, pa1, pa2, pa3;
            if constexpr (MODE == 0) {
                const bool diag = (kb + 63 >= qw);
                qkt_half<ND>(p1, bufp + SHM_V, bufp + SHM_V + SHM_K, r32, hi, qr, qrl, lane, 1);
                qkt_half<ND>(p0, bufp + SHM_V, bufp + SHM_V + SHM_K, r32, hi, qr, qrl, lane, 0);
#if ATT_SB_PROD
                float Tp = __builtin_amdgcn_exp2f(carry), tprod = 1.f;
#define ATT_SB_HALF(P, KOFF) do { f32x16 om; \
                    _Pragma("unroll") for (int r = 0; r < 16; ++r) { const float e_ = __builtin_amdgcn_exp2f(__builtin_amdgcn_fmed3f(P[r] * sc2, -120.f, 120.f)); P[r] = e_; om[r] = __builtin_amdgcn_rcpf(1.0f + e_); } \
                    if (diag) { _Pragma("unroll") for (int r = 0; r < 16; ++r) { if (kb + (KOFF) + crow(r, hi) >= tq) om[r] = 1.f; } } \
                    float gp_[4], oh_[4], pp_[4]; \
                    _Pragma("unroll") for (int i = 0; i < 4; ++i) { om[4*i+2] *= om[4*i+3]; om[4*i+1] *= om[4*i+2]; om[4*i] *= om[4*i+1]; gp_[i] = om[4*i]; } \
                    _Pragma("unroll") for (int i = 0; i < 4; ++i) { float lo_; half_xchg(gp_[i], lo_, oh_[i]); pp_[i] = lo_ * oh_[i]; } \
                    _Pragma("unroll") for (int i = 3; i >= 0; --i) { const float Tg = Tp * (hi ? 1.f : oh_[i]); \
                        _Pragma("unroll") for (int e = 0; e < 4; ++e) P[4*i+e] = (P[4*i+e] * om[4*i+e]) * Tg; \
                        Tp *= pp_[i]; tprod *= pp_[i]; } \
                    if (diag) { _Pragma("unroll") for (int r = 0; r < 16; ++r) { if (kb + (KOFF) + crow(r, hi) >= tq) P[r] = 0.f; } } } while (0)
                ATT_SB_HALF(p1, 32);
                pack_half(p1, pa2, pa3);
                ATT_SB_HALF(p0, 0);
                pack_half(p0, pa0, pa1);
#undef ATT_SB_HALF
                carry += __builtin_amdgcn_logf(tprod);
#else
                float tsum = carry;
#define ATT_SB_HALF(P, KOFF) do { f32x16 f; \
                    _Pragma("unroll") for (int r = 0; r < 16; ++r) { P[r] *= sc2; \
                        f[r] = fminf(-P[r], 0.f) - __builtin_amdgcn_logf(1.0f + __builtin_amdgcn_exp2f(-__builtin_fabsf(P[r]))); } \
                    if (diag) { _Pragma("unroll") for (int r = 0; r < 16; ++r) { if (kb + (KOFF) + crow(r, hi) >= tq) f[r] = 0.f; } } \
                    float gs_[4], oh_[4], ps_[4]; \
                    _Pragma("unroll") for (int i = 0; i < 4; ++i) { f[4*i+2] += f[4*i+3]; f[4*i+1] += f[4*i+2]; f[4*i] += f[4*i+1]; gs_[i] = f[4*i]; } \
                    _Pragma("unroll") for (int i = 0; i < 4; ++i) { float lo_; half_xchg(gs_[i], lo_, oh_[i]); ps_[i] = lo_ + oh_[i]; } \
                    _Pragma("unroll") for (int i = 3; i >= 0; --i) { const float Tg = tsum + hsel * oh_[i]; \
                        _Pragma("unroll") for (int e = 0; e < 4; ++e) P[4*i+e] = __builtin_amdgcn_exp2f(P[4*i+e] + f[4*i+e] + Tg); \
                        tsum += ps_[i]; } \
                    if (diag) { _Pragma("unroll") for (int r = 0; r < 16; ++r) { if (kb + (KOFF) + crow(r, hi) >= tq) P[r] = 0.f; } } } while (0)
                ATT_SB_HALF(p1, 32);
                pack_half(p1, pa2, pa3);
                ATT_SB_HALF(p0, 0);
                pack_half(p0, pa0, pa1);
#undef ATT_SB_HALF
                carry = tsum;
#endif
                pv_tile(o, (int)(uintptr_t)(bufp) + v_rd_base(lane), pa0, pa1, pa2, pa3);
                if (__all(carry < -140.f)) dead = true;
            } else {
                qkt_half<ND>(p0, bufp + SHM_V, bufp + SHM_V + SHM_K, r32, hi, qr, qrl, lane, 0);
                qkt_half<ND>(p1, bufp + SHM_V, bufp + SHM_V + SHM_K, r32, hi, qr, qrl, lane, 1);
                float pmax = p0[0];
#pragma unroll
                for (int r = 1; r < 16; ++r) pmax = fmaxf(pmax, p0[r]);
#pragma unroll
                for (int r = 0; r < 16; ++r) pmax = fmaxf(pmax, p1[r]);
                pmax = half_max(pmax);
#if ATT_DEFER_MAX
                const float mn = (pmax > m_reg + 8.0f * __builtin_amdgcn_rcpf(sc2)) ? pmax : m_reg;
                const float alpha = __builtin_amdgcn_exp2f((m_reg - mn) * sc2); m_reg = mn;
#else
                const float mn = fmaxf(m_reg, pmax), alpha = __builtin_amdgcn_exp2f((m_reg - mn) * sc2); m_reg = mn;
#endif
                const float mnL = -mn * sc2;
                float psum = 0.f;
#pragma unroll
                for (int r = 0; r < 16; ++r) { p0[r] = __builtin_amdgcn_exp2f(fmaf(p0[r], sc2, mnL)); psum += p0[r]; }
                pack_half(p0, pa0, pa1);
#pragma unroll
                for (int r = 0; r < 16; ++r) { p1[r] = __builtin_amdgcn_exp2f(fmaf(p1[r], sc2, mnL)); psum += p1[r]; }
                pack_half(p1, pa2, pa3);
                l_reg = l_reg * alpha + half_sum(psum);
                if (__any(alpha < 1.f)) {
#pragma unroll
                    for (int r = 0; r < 16; ++r) {
#pragma unroll
                        for (int d = 0; d < 4; ++d) o[d][r] *= alpha; } }
#if ATT_EARLYW
                if (it + 1 < NT) { asm volatile("s_waitcnt vmcnt(0)" ::: "memory"); ATT_WRITE(cur ^ 1); staged = true; }
#endif
                pv_tile(o, (int)(uintptr_t)(bufp) + v_rd_base(lane), pa0, pa1, pa2, pa3);
            }
        }
        if (it + 1 < NT && !staged) { asm volatile("s_waitcnt vmcnt(0)" ::: "memory"); ATT_WRITE(cur ^ 1); }
        if constexpr (MODE == 0) { if (lane == 0) flags[cur * 8 + wid] = dead ? 1u : 0u; }
        __syncthreads();
        if constexpr (MODE == 0) {
            unsigned alld = 1u;
#pragma unroll
            for (int w = 0; w < 8; ++w) alld &= flags[cur * 8 + w];
            if (alld) break;
        }
    }
    float rl = 1.f; if constexpr (MODE == 1) rl = __builtin_amdgcn_rcpf(l_reg);
    int ooff = (qw + r32) * T.ldo + 8 * hi; asm volatile("" : "+v"(ooff));
    bf16_t* Ow = T.O + ooff;
#pragma unroll
    for (int d0 = 0; d0 < 4; ++d0)
#pragma unroll
        for (int kp = 0; kp < 2; ++kp) {
            unsigned ax = cvtpk(o[d0][8 * kp + 0] * rl, o[d0][8 * kp + 1] * rl), ay = cvtpk(o[d0][8 * kp + 2] * rl, o[d0][8 * kp + 3] * rl);
            unsigned bx = cvtpk(o[d0][8 * kp + 4] * rl, o[d0][8 * kp + 5] * rl), by = cvtpk(o[d0][8 * kp + 6] * rl, o[d0][8 * kp + 7] * rl);
            auto sx = __builtin_amdgcn_permlane32_swap(ax, bx, false, false); auto sy = __builtin_amdgcn_permlane32_swap(ay, by, false, false);
            u32x4 w = {sx[0], sy[0], sx[1], sy[1]};
            *(u32x4*)(Ow + d0 * 32 + 16 * kp) = w; }
    __syncthreads();
#undef ATT_LOAD
#undef ATT_WRITE
#undef ATT_TILE
}
}

constexpr int BATCH = 2, SEQ = 4096, D = 4096, M = BATCH * SEQ, DEPTH = 2;
constexpr int SBW = 2048, QRANK = 1024, KVRANK = 512, ROPE = 64, DFF = 16384;
constexpr int IN_W = 3 * SBW + QRANK + KVRANK + ROPE + 2 * D;
constexpr int C_QD = 3 * SBW, C_KVD = C_QD + QRANK, C_GATE_SRC = C_KVD + KVRANK + ROPE;
constexpr int C_GSB = 7936, C_GMLA = C_GSB + D, PROJ_W = C_GMLA + D;
constexpr int QW = 16 * 192, KVW = 16 * 256;
constexpr float EPS = 1e-6f;
static_assert(IN_W == 15936 && PROJ_W == 16128 && PROJ_W % 256 == 0 && C_GSB % 256 == 0, "projection layout");

constexpr size_t MiB = 1u << 20;
constexpr size_t WS_CTL = 0, CTL_ZERO_BYTES = 1 * MiB;
constexpr size_t WS_ADA = 1 * MiB;
constexpr size_t WS_TAB = 2 * MiB;
constexpr size_t WS_ADAP = 4 * MiB;
constexpr size_t WS_W = 32 * MiB;
constexpr size_t W_IN = 0, W_UQ = 126 * MiB, W_UKV = 132 * MiB, W_OSB = 136 * MiB, W_OMLA = 152 * MiB, W_OUT = 168 * MiB, W_UP = 200 * MiB, W_DOWN = 328 * MiB, W_LAYER = 456 * MiB;
constexpr size_t WS_ACT = WS_W + DEPTH * W_LAYER;
constexpr size_t A_H = WS_ACT, A_PROJ = A_H + 64 * MiB, A_CQ = A_PROJ + 252 * MiB, A_CKV = A_CQ + 16 * MiB, A_KR = A_CKV + 8 * MiB, A_Q = A_KR + 1 * MiB, A_KV = A_Q + 48 * MiB,
                 A_OSB = A_KV + 64 * MiB, A_OMLA = A_OSB + 32 * MiB, A_TMP = A_OMLA + 32 * MiB, A_MRG = A_TMP + 128 * MiB, A_Y = A_MRG + 64 * MiB, A_U = A_Y + 128 * MiB, WS_END = A_U + 256 * MiB;
static_assert((size_t)PROJ_W * D * 2 == 126 * MiB && (size_t)M * PROJ_W * 2 == 252 * MiB, "sizes");
constexpr int CW_TMO = 0;
constexpr int CW_BAR = 4096;

constexpr int RING_BYTES = 135168;
constexpr int LDSCTL_OFF = RING_BYTES, MISC_OFF = LDSCTL_OFF + 320;
constexpr int LDS_BYTES = RING_BYTES + 1024;
constexpr int NWAVES = 8;
static_assert(att::ATT_LDS_BYTES <= RING_BYTES && pg8::STAGE_BYTES <= RING_BYTES, "LDS map");

#define GAS __attribute__((address_space(1)))
#define LAS __attribute__((address_space(3)))
typedef unsigned short bf16;
typedef unsigned v4u __attribute__((ext_vector_type(4)));
typedef unsigned v2u __attribute__((ext_vector_type(2)));
typedef float f32x4 __attribute__((ext_vector_type(4)));
typedef GAS unsigned gu32;
#define RLX_AGENT __ATOMIC_RELAXED, __HIP_MEMORY_SCOPE_AGENT
#ifndef USE_NT
#define USE_NT 0
#endif
#if USE_NT
#define NT_LD(p) __builtin_nontemporal_load(p)
#else
#define NT_LD(p) (*(p))
#endif
#define LDS_WAIT() asm volatile("s_waitcnt lgkmcnt(0)" ::: "memory")
#define VM_WAIT() asm volatile("s_waitcnt vmcnt(0)" ::: "memory")
__device__ __forceinline__ unsigned pk2(float lo, float hi) { return pg8::cvt_pk_bf16(lo, hi); }
__device__ __forceinline__ float bflo(unsigned w) { return __builtin_bit_cast(float, w << 16); }
__device__ __forceinline__ float bfhi(unsigned w) { return __builtin_bit_cast(float, w & 0xffff0000u); }

#define XB_TMO      128
#define XB_XCNT(j)  (256  + 64 * (j))
#define XB_XSUB(j)  (1280 + 64 * (j))
#define XB_XGEN(j)  (2304 + 64 * (j))
#define XB_TOP      3328
#define XB_TOPGEN   3392
#define XCD_BAR_WORDS 3456
#define XB_SPIN_CAP (1u << 21)

__device__ __forceinline__ unsigned xb_ld(unsigned* p)              { return __hip_atomic_load(p, __ATOMIC_RELAXED, __HIP_MEMORY_SCOPE_AGENT); }
__device__ __forceinline__ unsigned xb_add(unsigned* p, unsigned v) { return __hip_atomic_fetch_add(p, v, __ATOMIC_RELAXED, __HIP_MEMORY_SCOPE_AGENT); }
__device__ __forceinline__ unsigned xb_xcc_id() { return (unsigned)__builtin_amdgcn_s_getreg((3 << 11) | 20) & 0xFu; }
#define XB_SPIN(cond, bar) do { unsigned _sp = 0; while (cond) { __builtin_amdgcn_s_sleep(1); \
    if ((++_sp & 255u) == 0u) { if (xb_ld(&(bar)[XB_TMO])) break; if (_sp > XB_SPIN_CAP) { atomicAdd(&(bar)[XB_TMO], 1u); break; } } } } while (0)

struct XcdBarrier {
    unsigned* bar; unsigned x;
    volatile LAS unsigned* st;
};

__device__ __forceinline__ XcdBarrier xcd_barrier_post(unsigned* bar, volatile LAS unsigned* st) {
    XcdBarrier b; b.bar = bar; b.x = xb_xcc_id(); b.st = st;
    if (threadIdx.x == 0) (void)xb_add(&bar[XB_XCNT(b.x)], 1u);
    return b;
}
__device__ __forceinline__ void xcd_barrier_complete(unsigned* bar, unsigned x, unsigned& nloc, unsigned& nx) {
    const unsigned G = gridDim.x * gridDim.y * gridDim.z;
    unsigned sum, cnt, mine, sp = 0u;
    for (;;) {
        sum = 0u; cnt = 0u; mine = 0u;
#pragma unroll
        for (unsigned j = 0; j < 16; ++j) { const unsigned c = xb_ld(&bar[XB_XCNT(j)]); sum += c; cnt += (c > 0u) ? 1u : 0u; mine = (j == x) ? c : mine; }
        if (sum == G) break;
        __builtin_amdgcn_s_sleep(1);
        if ((++sp & 255u) == 0u) { if (xb_ld(&bar[XB_TMO])) break; if (sp > XB_SPIN_CAP) { atomicAdd(&bar[XB_TMO], 1u); break; } }
    }
    nloc = mine > 0u ? mine : 1u; nx = cnt > 0u ? cnt : 1u;
}

__device__ __forceinline__ void xcd_barrier(const XcdBarrier& b) {
    asm volatile("s_waitcnt vmcnt(0)" ::: "memory");
    __syncthreads();
    if (threadIdx.x == 0) {
        unsigned* bar = b.bar; unsigned bx_ = b.x; asm volatile("" : "+s"(bar), "+s"(bx_));
        __builtin_amdgcn_s_waitcnt(0);
        unsigned nloc = b.st[0], nx = b.st[1];
        if (nloc == 0u) { xcd_barrier_complete(bar, bx_, nloc, nx); b.st[0] = nloc; b.st[1] = nx; }
        const unsigned old = xb_add(&bar[XB_XSUB(bx_)], 1u);
        const unsigned gen = old / nloc;
        if (old + 1u == (gen + 1u) * nloc) {
            __builtin_amdgcn_fence(__ATOMIC_RELEASE, "agent");
            asm volatile("s_waitcnt vmcnt(0)" ::: "memory");
            const unsigned og = xb_add(&bar[XB_TOP], 1u);
            const unsigned tg = og / nx;
            if (og + 1u == (tg + 1u) * nx) xb_add(&bar[XB_TOPGEN], 1u);
            else XB_SPIN(xb_ld(&bar[XB_TOPGEN]) == tg, bar);
            __builtin_amdgcn_fence(__ATOMIC_ACQUIRE, "agent");
            xb_add(&bar[XB_XGEN(bx_)], 1u);
            asm volatile("s_waitcnt vmcnt(0)" ::: "memory");
        } else {
            XB_SPIN(xb_ld(&bar[XB_XGEN(bx_)]) == gen, bar);
            __builtin_amdgcn_fence(__ATOMIC_ACQUIRE, "agent");
            asm volatile("s_waitcnt vmcnt(0)" ::: "memory");
        }
    }
    __syncthreads();
}


struct Frame {
    LAS unsigned char* lds;
    int tid, lane, wave, G, gw, NGW;
};
__device__ __forceinline__ float wave_sum(float v) {
#pragma unroll
    for (int o = 1; o < 64; o <<= 1) v += __shfl_xor(v, o);
    return v;
}

#ifndef CONV_NT_ST
#define CONV_NT_ST 1
#endif
__device__ __forceinline__ void conv_load(f32x4 (&v)[16], f32x4& ks0, f32x4& ks1, const float* src, int N, const float* ks, int lane) {
    const float* s_ = src + (size_t)(lane >> 4) * N + 4 * (lane & 15);
#pragma unroll
    for (int i = 0; i < 16; ++i) v[i] = NT_LD((const f32x4*)(s_ + (size_t)(4 * i) * N));
    ks0 = (f32x4){1.f, 1.f, 1.f, 1.f}; ks1 = ks0;
    if (ks) { ks0 = *(const f32x4*)(ks + 8 * (lane & 7)); ks1 = *(const f32x4*)(ks + 8 * (lane & 7) + 4); }
}
__device__ __forceinline__ void conv_store(const f32x4 (&v)[16], f32x4 ks0, f32x4 ks1, bf16* dst, int ldt, int rowbase, int ropeperm, LAS float* scr, int lane) {
#pragma unroll
    for (int i = 0; i < 16; ++i) { LAS float* d = scr + (4 * i + (lane >> 4)) * 65 + 4 * (lane & 15); d[0] = v[i][0]; d[1] = v[i][1]; d[2] = v[i][2]; d[3] = v[i][3]; }
    LDS_WAIT(); asm volatile("" ::: "memory");
    const int c = lane & 7;
#pragma unroll
    for (int j = 0; j < 8; ++j) { const int nn = (lane >> 3) + 8 * j; const LAS float* s = scr + (8 * c) * 65 + nn;
        v4u o; o.x = pk2(s[0 * 65] * ks0[0], s[1 * 65] * ks0[1]); o.y = pk2(s[2 * 65] * ks0[2], s[3 * 65] * ks0[3]); o.z = pk2(s[4 * 65] * ks1[0], s[5 * 65] * ks1[1]); o.w = pk2(s[6 * 65] * ks1[2], s[7 * 65] * ks1[3]);
        const int orow = rowbase + ((ropeperm & 1) ? (2 * (nn & 31) + (nn >> 5)) : nn);
#ifdef P0A_REP_NOSTORE
        if (ropeperm < 2)
#endif
#if CONV_NT_ST
        __builtin_nontemporal_store(o, (GAS v4u*)(dst + (size_t)orow * 64 + 8 * c)); }
#else
        *(GAS v4u*)(dst + (size_t)orow * 64 + 8 * c) = o; }
#endif
    LDS_WAIT(); asm volatile("" ::: "memory");
}

__device__ __forceinline__ void norm_mod_row(const f32x4 (&v)[16], float ssq, const float* g, const float* scv, const float* shv, bf16* orow, int lane) {
    const float r = 1.0f / sqrtf(ssq * (1.0f / D) + EPS);
#pragma unroll
    for (int j = 0; j < 16; ++j) { int c = 4 * lane + 256 * j; asm volatile("" : "+v"(c));
        const f32x4 gg = *(const f32x4*)(g + c), ss = *(const f32x4*)(scv + c), hh = *(const f32x4*)(shv + c);
        f32x4 o;
#pragma unroll
        for (int e = 0; e < 4; ++e) o[e] = v[j][e] * r * gg[e] * (1.0f + ss[e]) + hh[e];
        v2u w; w.x = pk2(o[0], o[1]); w.y = pk2(o[2], o[3]);
        *(GAS v2u*)(orow + c) = w; }
}


template <bool HAS_Y, bool HAS_H, bool XIN_BF = false, bool XOUT_BF = false>
__device__ __forceinline__ void thin_phase(Frame& F, const void* xin_, void* xout_, const bf16* Yb, bf16* Hout,
                                           const float* gpost, const float* gate0, const float* gpre, const float* sc0, const float* sh0) {
    LAS float* cA1 = (LAS float*)F.lds; LAS float* cA2 = cA1 + D; LAS float* cB2 = cA2 + D;
#ifndef THIN_XCDMAP
#define THIN_XCDMAP 1
#endif
    const int chunk0 = (THIN_XCDMAP && F.G == 256) ? (64 * ((int)(blockIdx.x & 7u) >> 1) + 32 * (int)(blockIdx.x & 1u) + (int)(blockIdx.x >> 3)) : (int)blockIdx.x;
    for (int chunk = chunk0; chunk < M / 32; chunk += F.G) {
        int tid = F.tid; asm volatile("" : "+v"(tid));
        const int b = (chunk * 32) / SEQ;
        __syncthreads();
#pragma unroll
        for (int i = 0; i < 2; ++i) { const int c = 4 * tid + 2048 * i;
            if constexpr (HAS_Y) { const f32x4 g = *(const f32x4*)(gpost + c), t = *(const f32x4*)(gate0 + (size_t)b * 6 * D + c); *(LAS f32x4*)(cA1 + c) = g * t; }
            if constexpr (HAS_H) { const f32x4 g = *(const f32x4*)(gpre + c), s = *(const f32x4*)(sc0 + (size_t)b * 6 * D + c), h = *(const f32x4*)(sh0 + (size_t)b * 6 * D + c);
                *(LAS f32x4*)(cA2 + c) = g * (s + 1.0f); *(LAS f32x4*)(cB2 + c) = h; } }
        __syncthreads();
        const int LN = tid & 63;
#pragma unroll 1
        for (int i = 0; i < 4; ++i) {
            const size_t m = (size_t)chunk * 32 + F.wave * 4 + i;
            v4u yv[8]; f32x4 xv[16];
#pragma unroll
            for (int j = 0; j < 8; ++j) { const int c = 8 * LN + 512 * j;
                if constexpr (HAS_Y) yv[j] = *(const GAS v4u*)(Yb + m * D + c);
                if constexpr (XIN_BF) { const v4u xb = *(const GAS v4u*)((const bf16*)xin_ + m * D + c);
                    xv[2 * j] = (f32x4){bflo(xb.x), bfhi(xb.x), bflo(xb.y), bfhi(xb.y)}; xv[2 * j + 1] = (f32x4){bflo(xb.z), bfhi(xb.z), bflo(xb.w), bfhi(xb.w)}; }
                else { xv[2 * j] = *(const f32x4*)((const float*)xin_ + m * D + c); xv[2 * j + 1] = *(const f32x4*)((const float*)xin_ + m * D + c + 4); } }
            float ssq2 = 0.f;
            if constexpr (HAS_Y) {
                float ssq = 0.f;
#pragma unroll
                for (int j = 0; j < 8; ++j) { const unsigned w[4] = {yv[j].x, yv[j].y, yv[j].z, yv[j].w};
#pragma unroll
                    for (int q = 0; q < 4; ++q) { const float a = bflo(w[q]), c2 = bfhi(w[q]); ssq += a * a + c2 * c2; } }
                ssq = wave_sum(ssq); const float r = 1.0f / sqrtf(ssq * (1.0f / D) + EPS);
#pragma unroll
                for (int j = 0; j < 8; ++j) { const int c = 8 * LN + 512 * j; const unsigned w[4] = {yv[j].x, yv[j].y, yv[j].z, yv[j].w};
                    const f32x4 a0 = *(const LAS f32x4*)(cA1 + c), a1 = *(const LAS f32x4*)(cA1 + c + 4);
                    f32x4 y0 = {bflo(w[0]), bfhi(w[0]), bflo(w[1]), bfhi(w[1])}, y1 = {bflo(w[2]), bfhi(w[2]), bflo(w[3]), bfhi(w[3])};
                    xv[2 * j] = xv[2 * j] + a0 * (y0 * r); xv[2 * j + 1] = xv[2 * j + 1] + a1 * (y1 * r);
                    if constexpr (XOUT_BF) { v4u xw; xw.x = pk2(xv[2 * j][0], xv[2 * j][1]); xw.y = pk2(xv[2 * j][2], xv[2 * j][3]); xw.z = pk2(xv[2 * j + 1][0], xv[2 * j + 1][1]); xw.w = pk2(xv[2 * j + 1][2], xv[2 * j + 1][3]);
                        *(GAS v4u*)((bf16*)xout_ + m * D + c) = xw; }
                    else { *(f32x4*)((float*)xout_ + m * D + c) = xv[2 * j]; *(f32x4*)((float*)xout_ + m * D + c + 4) = xv[2 * j + 1]; } } }
            if constexpr (HAS_H) {
#pragma unroll
                for (int j = 0; j < 16; ++j) ssq2 += (xv[j][0] * xv[j][0] + xv[j][1] * xv[j][1]) + (xv[j][2] * xv[j][2] + xv[j][3] * xv[j][3]);
                ssq2 = wave_sum(ssq2); const float r2 = 1.0f / sqrtf(ssq2 * (1.0f / D) + EPS);
#pragma unroll
                for (int j = 0; j < 8; ++j) { const int c = 8 * LN + 512 * j;
                    const f32x4 a0 = *(const LAS f32x4*)(cA2 + c), a1 = *(const LAS f32x4*)(cA2 + c + 4), b0 = *(const LAS f32x4*)(cB2 + c), b1 = *(const LAS f32x4*)(cB2 + c + 4);
                    const f32x4 h0 = (xv[2 * j] * r2) * a0 + b0, h1 = (xv[2 * j + 1] * r2) * a1 + b1;
                    v4u w; w.x = pk2(h0[0], h0[1]); w.y = pk2(h0[2], h0[3]); w.z = pk2(h1[0], h1[1]); w.w = pk2(h1[2], h1[3]);
                    *(GAS v4u*)(Hout + m * D + c) = w; } }
        }
    }
    __syncthreads();
}

__device__ __forceinline__ int gate_row(int j) { const int which = j / D, oc = j % D; return C_GSB + 256 * (oc / 128) + 128 * which + (oc % 128); }
constexpr int NB_IN = IN_W / 64, I_IN = (D / 64) * NB_IN, I_UQ = (QRANK / 64) * (QW / 64), I_UKV = (KVRANK / 64) * (KVW / 64), I_OSB = (SBW / 64) * (D / 64), I_OMLA = I_OSB,
              I_OUT = (D / 64) * (D / 64), I_UP = (D / 64) * (DFF / 64), I_DOWN = (DFF / 64) * (D / 64), I_LAYER = I_IN + I_UQ + I_UKV + I_OSB + I_OMLA + I_OUT + I_UP + I_DOWN;
#define CONV_DECODE(it, SRC, NN, DST, LDT, RB, RP, KS) do { const int l = (it) / I_LAYER; int r = (it) % I_LAYER; KS = nullptr; RP = 0; \
        if (r < I_IN) { const int kb = r / NB_IN, nb = r % NB_IN, n0 = nb * 64; SRC = KIN(I_WIN) + (size_t)l * D * IN_W + (size_t)(64 * kb) * IN_W + n0; NN = IN_W; DST = (bf16*)(wl + W_IN) + (size_t)kb * PROJ_W * 64; LDT = 64; \
            RB = n0 < C_GATE_SRC ? n0 : gate_row(n0 - C_GATE_SRC); RP = (n0 == C_KVD + KVRANK)  ; break; } r -= I_IN; \
        if (r < I_UQ) { const int kb = r / (QW / 64), nb = r % (QW / 64); SRC = KIN(I_WUQ) + (size_t)l * QRANK * QW + (size_t)(64 * kb) * QW + 64 * nb; NN = QW; DST = (bf16*)(wl + W_UQ) + (size_t)kb * QW * 64; LDT = 64; \
            RB = nb * 64; RP = ((nb % 3) == 2); KS = KIN(I_GQ) + (size_t)l * QRANK + 64 * kb; break; } r -= I_UQ; \
        if (r < I_UKV) { const int kb = r / (KVW / 64), nb = r % (KVW / 64); SRC = KIN(I_WUKV) + (size_t)l * KVRANK * KVW + (size_t)(64 * kb) * KVW + 64 * nb; NN = KVW; DST = (bf16*)(wl + W_UKV) + (size_t)kb * KVW * 64; LDT = 64; \
            RB = nb * 64; KS = KIN(I_GKV) + (size_t)l * KVRANK + 64 * kb; break; } r -= I_UKV; \
        if (r < I_OSB) { const int kb = r / (D / 64), nb = r % (D / 64); SRC = KIN(I_WOSB) + (size_t)l * SBW * D + (size_t)(64 * kb) * D + 64 * nb; NN = D; DST = (bf16*)(wl + W_OSB) + (size_t)kb * D * 64; LDT = 64; RB = nb * 64; break; } r -= I_OSB; \
        if (r < I_OMLA) { const int kb = r / (D / 64), nb = r % (D / 64); SRC = KIN(I_WOMLA) + (size_t)l * SBW * D + (size_t)(64 * kb) * D + 64 * nb; NN = D; DST = (bf16*)(wl + W_OSB) + (size_t)(SBW / 64 + kb) * D * 64; LDT = 64; RB = nb * 64; break; } r -= I_OMLA; \
        if (r < I_OUT) { const int kb = r / (D / 64), nb = r % (D / 64); SRC = KIN(I_WOUT) + (size_t)l * D * D + (size_t)(64 * kb) * D + 64 * nb; NN = D; DST = (bf16*)(wl + W_OUT) + (size_t)kb * D * 64; LDT = 64; RB = nb * 64; break; } r -= I_OUT; \
        if (r < I_UP) { const int kb = r / (DFF / 64), nb = r % (DFF / 64); SRC = KIN(I_WUP) + (size_t)l * D * DFF + (size_t)(64 * kb) * DFF + 64 * nb; NN = DFF; DST = (bf16*)(wl + W_UP) + (size_t)kb * DFF * 64; LDT = 64; RB = nb * 64; break; } r -= I_UP; \
        { const int kb = r / (D / 64), nb = r % (D / 64); SRC = KIN(I_WDOWN) + (size_t)l * DFF * D + (size_t)(64 * kb) * D + 64 * nb; NN = D; DST = (bf16*)(wl + W_DOWN) + (size_t)kb * D * 64; LDT = 64; RB = nb * 64; } \
    } while (0)
#ifdef P0A_REP_NOSTORE
#define CONV_RPX (p0r_ > 0 ? 2 : 0)
#else
#define CONV_RPX 0
#endif
#define CONVERT_ITEMS(lo, hi, start, stride) do { int cl_ = F.lane; asm volatile("" : "+v"(cl_));     \
        int it = (lo) + (start); \
        if (it < (hi)) { \
            const float* srcA; int nA; bf16* dstA; int ldtA, rbA, rpA; const float* ksA; f32x4 vA[16], k0A, k1A; \
            CONV_DECODE(it, srcA, nA, dstA, ldtA, rbA, rpA, ksA); conv_load(vA, k0A, k1A, srcA, nA, ksA, cl_); \
            for (;;) { const int nx = it + (stride); const bool hn = nx < (hi); \
                const float* srcB = srcA; int nB = nA; bf16* dstB = dstA; int ldtB = ldtA, rbB = rbA, rpB = rpA; const float* ksB = ksA; f32x4 vB[16], k0B, k1B; \
                if (hn) { CONV_DECODE(nx, srcB, nB, dstB, ldtB, rbB, rpB, ksB); conv_load(vB, k0B, k1B, srcB, nB, ksB, cl_); } \
                conv_store(vA, k0A, k1A, dstA, ldtA, rbA, rpA + CONV_RPX, scr, cl_); \
                if (!hn) break; \
                srcA = srcB; nA = nB; dstA = dstB; ldtA = ldtB; rbA = rbB; rpA = rpB; ksA = ksB; k0A = k0B; k1A = k1B; it = nx; \
                _Pragma("unroll") for (int i_ = 0; i_ < 16; ++i_) vA[i_] = vB[i_]; } \
        } } while (0)

#ifndef XRES_BF16
#define XRES_BF16 1
#endif
#ifndef PG8_SP2
#define PG8_SP2 true
#endif
#ifndef PG8_ALIGN
#define PG8_ALIGN true
#endif
#ifndef PG8_ALIGN_P1
#define PG8_ALIGN_P1 PG8_ALIGN
#endif
#ifndef PH_MASK
#define PH_MASK 0xFFFFFFFFu
#endif
#define PH(k) ((PH_MASK >> (k)) & 1u)
struct Args { const float* in[19]; float* out; unsigned char* ws; };
enum { I_X = 0, I_C, I_POS, I_WADA, I_BADA, I_GPREMIX, I_GPOSTMIX, I_GPREMLP, I_GPOSTMLP, I_WIN, I_GQ, I_WUQ, I_GKV, I_WUKV, I_WOSB, I_WOMLA, I_WOUT, I_WUP, I_WDOWN };

typedef __attribute__((address_space(4))) const unsigned char* kargp_t;
__device__ __forceinline__ __attribute__((address_space(1))) unsigned char* lw_(unsigned char* p) { __attribute__((address_space(1))) unsigned char* q = (__attribute__((address_space(1))) unsigned char*)p; asm volatile("" : "+s"(q)); return q; }
__device__ __forceinline__ kargp_t lwk_() { kargp_t p = (kargp_t)__builtin_amdgcn_kernarg_segment_ptr(); asm volatile("" : "+s"(p)); return p; }
#define KIN(k) ((const float*)(*(const __attribute__((address_space(1))) float* const __attribute__((address_space(4)))*)(lwk_() + 8 * (k))))
__global__ void __launch_bounds__(NWAVES * 64, 2) hybrid_fwd(Args args) {
    extern __shared__ __attribute__((aligned(16))) unsigned char lds_raw[];
    Frame F;
    F.lds = (LAS unsigned char*)lds_raw;
    F.tid = threadIdx.x; F.lane = F.tid & 63; F.wave = __builtin_amdgcn_readfirstlane(F.tid >> 6);
    F.G = gridDim.x; F.gw = blockIdx.x * NWAVES + F.wave; F.NGW = F.G * NWAVES;
    unsigned char* ws = args.ws;
    gu32* ctl = (gu32*)(ws + WS_CTL);
    for (int u = F.tid; u < (LDS_BYTES - LDSCTL_OFF) / 4; u += NWAVES * 64) ((LAS unsigned*)(F.lds + LDSCTL_OFF))[u] = 0u;
    __syncthreads();
    XcdBarrier bar = xcd_barrier_post((unsigned*)(ctl + CW_BAR), (volatile LAS unsigned*)(F.lds + MISC_OFF) + 8);
#define GRID_BAR() xcd_barrier(bar)

#define ada ((float*)(lw_(ws) + WS_ADA))
#define tab ((float*)(lw_(ws) + WS_TAB))
#define adap ((float*)(lw_(ws) + WS_ADAP))
#define Hb ((bf16*)(lw_(ws) + A_H))
#define PROJ ((bf16*)(lw_(ws) + A_PROJ))
#define SSQ ((float*)(lw_(ws) + A_CQ))
#define KR ((bf16*)(lw_(ws) + A_KR))
#define QF ((bf16*)(lw_(ws) + A_Q))
#define KVF ((bf16*)(lw_(ws) + A_KV))
#define OSB ((bf16*)(lw_(ws) + A_OSB))
#define MRG ((bf16*)(lw_(ws) + A_MRG))
#define Yb ((bf16*)(lw_(ws) + A_Y))
#define XB ((bf16*)(lw_(ws) + A_TMP))
#define U ((bf16*)(lw_(ws) + A_U))
#define GRB (lw_(ws) + A_TMP + 64 * MiB)
#define GSB (lw_(ws) + A_Y + 64 * MiB)
#define x_in KIN(I_X)
#define wl (lw_(ws) + WS_W + (size_t)l * W_LAYER)
#define adl (ada + (size_t)l * BATCH * 6 * D)
    float* xo = args.out;


#ifndef PRO_REP
#define PRO_REP 1
#endif
#pragma unroll 1
    for (int prep_ = 0; prep_ < PRO_REP; ++prep_) {
#ifndef P0A_REP
#define P0A_REP 1
#endif
#pragma unroll 1
    for (int p0r_ = 0; p0r_ < P0A_REP; ++p0r_)
    if (PH(0)) {
        LAS float* cact = (LAS float*)F.lds;
        for (int i = F.tid; i < BATCH * D; i += NWAVES * 64) { const float cv = KIN(I_C)[i]; cact[i] = cv / (1.0f + __expf(-cv)); }
        __syncthreads();
#ifdef P0A_REP_NOGEMV
        if (p0r_ == 0)
#endif
        for (int task = blockIdx.x; task < DEPTH * 32 * 12; task += F.G) {
            const int l = task / (32 * 12), s = (task / 12) % 32, cb = task % 12;
            const int col = cb * 2048 + F.tid * 4;
            const float* wp = KIN(I_WADA) + ((size_t)l * D + s * 128) * (6 * D) + col;
            f32x4 a0 = {0.f, 0.f, 0.f, 0.f}, a1 = {0.f, 0.f, 0.f, 0.f};
            f32x4 w[8];
#pragma unroll
            for (int j = 0; j < 8; ++j) w[j] = NT_LD((const f32x4*)(wp + (size_t)j * (6 * D)));
#pragma unroll 1
            for (int k = 0; k < 128; k += 8) { f32x4 wn[8];
                if (k + 8 < 128) {
#pragma unroll
                    for (int j = 0; j < 8; ++j) wn[j] = NT_LD((const f32x4*)(wp + (size_t)(k + 8 + j) * (6 * D))); }
#pragma unroll
                for (int j = 0; j < 8; ++j) { const float c0 = cact[s * 128 + k + j], c1 = cact[D + s * 128 + k + j]; a0 += w[j] * c0; a1 += w[j] * c1; }
#pragma unroll
                for (int j = 0; j < 8; ++j) w[j] = wn[j]; }
            *(f32x4*)(adap + (((size_t)s * DEPTH + l) * BATCH + 0) * (6 * D) + col) = a0;
            *(f32x4*)(adap + (((size_t)s * DEPTH + l) * BATCH + 1) * (6 * D) + col) = a1;
        }
        __syncthreads();
        for (int e = blockIdx.x * (NWAVES * 64) + F.tid; e < M * 32; e += F.G * NWAVES * 64) {
            const int m = e >> 5, i = e & 31;
            const float inv = powf(10000.0f, -(float)i / 32.0f);
            const float ang = (float)(((const int*)KIN(I_POS))[m]) * inv;
            const double rev = (double)ang * 0.15915494309189533577; const float fr = (float)(rev - rint(rev));
            tab[2 * e] = __builtin_amdgcn_cosf(fr); tab[2 * e + 1] = __builtin_amdgcn_sinf(fr);
        }
        for (int l = 0; l < DEPTH; ++l) { unsigned char* zb = ws + WS_W + l * W_LAYER + W_IN;
            for (int i = blockIdx.x * (NWAVES * 64) + F.tid; i < (D / 64) * 1536; i += F.G * NWAVES * 64) { const int kt = i / 1536, u = i % 1536;
                *(v4u*)(zb + ((size_t)kt * PROJ_W + C_GATE_SRC) * 128 + (size_t)u * 16) = (v4u){0u, 0u, 0u, 0u}; } }
        LAS float* scr = (LAS float*)(F.lds) + F.wave * (64 * 65);
        CONVERT_ITEMS(0, DEPTH * I_LAYER, F.gw, F.NGW);
        if (P0A_REP > 1) __syncthreads();
    }
    GRID_BAR();
    if (PH(1)) for (int e = blockIdx.x * (NWAVES * 64) + F.tid; e < DEPTH * BATCH * 6 * D; e += F.G * NWAVES * 64) {
        const int l = e / (BATCH * 6 * D), n = e % (6 * D);
        float s = KIN(I_BADA)[(size_t)l * 6 * D + n];
#pragma unroll 8
        for (int k = 0; k < 32; ++k) s += adap[(size_t)k * (DEPTH * BATCH * 6 * D) + e];
        ada[e] = s;
    }
    GRID_BAR();
    if (PH(2)) thin_phase<false, true>(F, x_in, nullptr, nullptr, Hb, nullptr, nullptr, KIN(I_GPREMIX), ada + D, ada);
    GRID_BAR();
    }

    for (int l = 0; l < DEPTH; ++l) {
#ifndef P1_REP
#define P1_REP 1
#endif
#pragma unroll 1
        for (int rp_ = 0; rp_ < P1_REP; ++rp_) {
        if (PH(3)) { pg8::Gemm g{Hb, (const bf16*)(wl + W_IN), M, PROJ_W, D}; pg8::StaticOrder S; S.init(M, PROJ_W, F.G, (int)blockIdx.x);
          pg8::EpiProj E{PROJ, PROJ_W, SSQ, KR, tab, (pg8::u32x4*)GRB, (pg8::u32x4*)GSB};
          pg8::gemm_phase<pg8::EpiProj, pg8::StaticOrder, PG8_ALIGN_P1, PG8_SP2>(F.lds, g, S, E); }
        }
        GRID_BAR();
#ifndef P3_REP
#define P3_REP 1
#endif
#pragma unroll 1
        for (int rep3 = 0; rep3 < P3_REP; ++rep3) {
        if (PH(5)) { pg8::Gemm g{PROJ + C_QD, (const bf16*)(wl + W_UQ), M, QW, QRANK, PROJ_W}; pg8::StaticOrder S; S.init(M, QW, F.G, (int)blockIdx.x);
          pg8::EpiRope E{QF, QW, tab, SSQ};
          pg8::gemm_phase<pg8::EpiRope, pg8::StaticOrder, PG8_ALIGN, PG8_SP2>(F.lds, g, S, E); }
        if (PH(5)) { pg8::Gemm g{PROJ + C_KVD, (const bf16*)(wl + W_UKV), M, KVW, KVRANK, PROJ_W}; pg8::EpiScale E{KVF, KVW, SSQ};
          if (F.G == 256) { pg8::UnevenOrder S; S.init(M, KVW, F.G, (int)blockIdx.x);
            pg8::gemm_phase<pg8::EpiScale, pg8::UnevenOrder, PG8_ALIGN, PG8_SP2>(F.lds, g, S, E); }
          else { pg8::StaticOrder S; S.init(M, KVW, F.G, (int)blockIdx.x);
            pg8::gemm_phase<pg8::EpiScale, pg8::StaticOrder, PG8_ALIGN, PG8_SP2>(F.lds, g, S, E); } }
        }
        GRID_BAR();
#ifndef P4_REP
#define P4_REP 1
#endif
#pragma unroll 1
        for (int rp_ = 0; rp_ < P4_REP; ++rp_) {
        if (PH(6)) for (int item = blockIdx.x; item < 512; item += F.G) {
            const int kind = item >> 8, c = item & 255, bh = (c & 7) * 4 + ((c >> 3) >> 3), y = (c >> 3) & 7, b = bh >> 4, h = bh & 15;
            const size_t rb = (size_t)b * SEQ;
            if (kind == 0) { if (PH(14)) {
                att::Tensors T{PROJ + rb * PROJ_W + h * 128, PROJ_W, PROJ + rb * PROJ_W + SBW + h * 128, PROJ_W, PROJ + rb * PROJ_W + 2 * SBW + h * 128, PROJ_W, nullptr, OSB + rb * (2 * SBW) + h * 128, 2 * SBW};
                att::attn_unit<0>(T, 15 - y, 0.08838834764831845f * 1.4426950408889634f, (LAS char*)F.lds);
                att::attn_unit<0>(T, y, 0.08838834764831845f * 1.4426950408889634f, (LAS char*)F.lds); }
            } else if (PH(15)) {
                att::Tensors T{QF + rb * QW + h * 192, QW, KVF + rb * KVW + h * 256, KVW, KVF + rb * KVW + h * 256 + 128, KVW, KR + rb * ROPE, OSB + rb * (2 * SBW) + SBW + h * 128, 2 * SBW};
                att::attn_unit<1>(T, 15 - y, 0.07216878364870323f * 1.4426950408889634f, (LAS char*)F.lds);
                att::attn_unit<1>(T, y, 0.07216878364870323f * 1.4426950408889634f, (LAS char*)F.lds);
            }
        }
        }
        GRID_BAR();
#ifndef P5_REP
#define P5_REP 1
#endif
#pragma unroll 1
        for (int rep5 = 0; rep5 < P5_REP; ++rep5)
        if (PH(7)) { pg8::Gemm g{OSB, (const bf16*)(wl + W_OSB), M, D, 2 * SBW}; pg8::StaticOrder S; S.init(M, D, F.G, (int)blockIdx.x);
          pg8::EpiGateMerge E{MRG, D, (const pg8::u32x4*)GRB, (const pg8::u32x4*)GSB};
          pg8::gemm_phase<pg8::EpiGateMerge, pg8::StaticOrder, PG8_ALIGN, PG8_SP2>(F.lds, g, S, E); }
        GRID_BAR();
#ifndef P7_REP
#define P7_REP 1
#endif
#pragma unroll 1
        for (int rep7 = 0; rep7 < P7_REP; ++rep7) {
#ifdef P7_REPB
        if (rep7) GRID_BAR();
#endif
#ifdef P7_MREP
        if (PH(9)) { pg8::Gemm g{MRG, (const bf16*)(wl + W_OUT), M, D, D}; pg8::RepOrder S; S.init(M, D, F.G, (int)blockIdx.x); S.reps = P7_MREP;
          pg8::EpiBf16<0> E{Yb, D};
          pg8::gemm_phase<pg8::EpiBf16<0>, pg8::RepOrder, PG8_ALIGN, PG8_SP2>(F.lds, g, S, E); }
#else
        if (PH(9)) { pg8::Gemm g{MRG, (const bf16*)(wl + W_OUT), M, D, D}; pg8::StaticOrder S; S.init(M, D, F.G, (int)blockIdx.x);
          pg8::EpiBf16<0> E{Yb, D};
          pg8::gemm_phase<pg8::EpiBf16<0>, pg8::StaticOrder, PG8_ALIGN, PG8_SP2>(F.lds, g, S, E); }
#endif
        }
        GRID_BAR();
#if XRES_BF16
#ifdef THIN_REP
        for (int rp_ = 1; rp_ < THIN_REP; ++rp_) { if (l == 0) thin_phase<true, true, false, true>(F, x_in, (bf16*)GRB, Yb, (bf16*)GSB, KIN(I_GPOSTMIX) + (size_t)l * D, adl + 2 * D, KIN(I_GPREMLP) + (size_t)l * D, adl + 4 * D, adl + 3 * D);
            else thin_phase<true, true, true, true>(F, XB, (bf16*)GRB, Yb, (bf16*)GSB, KIN(I_GPOSTMIX) + (size_t)l * D, adl + 2 * D, KIN(I_GPREMLP) + (size_t)l * D, adl + 4 * D, adl + 3 * D); }
#endif
        if (PH(10)) { if (l == 0) thin_phase<true, true, false, true>(F, x_in, XB, Yb, Hb, KIN(I_GPOSTMIX) + (size_t)l * D, adl + 2 * D, KIN(I_GPREMLP) + (size_t)l * D, adl + 4 * D, adl + 3 * D);
            else thin_phase<true, true, true, true>(F, XB, XB, Yb, Hb, KIN(I_GPOSTMIX) + (size_t)l * D, adl + 2 * D, KIN(I_GPREMLP) + (size_t)l * D, adl + 4 * D, adl + 3 * D); }
#else
        if (PH(10)) thin_phase<true, true>(F, l == 0 ? x_in : (const float*)xo, xo, Yb, Hb, KIN(I_GPOSTMIX) + (size_t)l * D, adl + 2 * D, KIN(I_GPREMLP) + (size_t)l * D, adl + 4 * D, adl + 3 * D);
#endif
        GRID_BAR();
#ifndef P9_REP
#define P9_REP 1
#endif
#pragma unroll 1
        for (int rp_ = 0; rp_ < P9_REP; ++rp_) {
        if (PH(11)) { pg8::Gemm g{Hb, (const bf16*)(wl + W_UP), M, DFF, D}; pg8::StaticOrder S; S.init(M, DFF, F.G, (int)blockIdx.x);
          pg8::EpiBf16<1> E{U, DFF};
          pg8::gemm_phase<pg8::EpiBf16<1>, pg8::StaticOrder, PG8_ALIGN, PG8_SP2>(F.lds, g, S, E); }
        }
        GRID_BAR();
#ifndef P10_REP
#define P10_REP 1
#endif
#pragma unroll 1
        for (int rp_ = 0; rp_ < P10_REP; ++rp_) {
        if (PH(12)) { pg8::Gemm g{U, (const bf16*)(wl + W_DOWN), M, D, DFF}; pg8::StaticOrder S; S.init(M, D, F.G, (int)blockIdx.x);
          pg8::EpiBf16<0> E{Yb, D};
          pg8::gemm_phase<pg8::EpiBf16<0>, pg8::StaticOrder, PG8_ALIGN, PG8_SP2>(F.lds, g, S, E); }
        }
        GRID_BAR();
#if XRES_BF16
#ifdef THIN_REP
        for (int rp_ = 1; rp_ < THIN_REP; ++rp_) if (l + 1 < DEPTH) { const float* adn = ada + (size_t)(l + 1) * BATCH * 6 * D;
                thin_phase<true, true, true, true>(F, XB, (bf16*)GRB, Yb, (bf16*)GSB, KIN(I_GPOSTMLP) + (size_t)l * D, adl + 5 * D, KIN(I_GPREMIX) + (size_t)(l + 1) * D, adn + D, adn); }
#endif
        if (PH(13)) { if (l + 1 < DEPTH) { const float* adn = ada + (size_t)(l + 1) * BATCH * 6 * D;
                thin_phase<true, true, true, true>(F, XB, XB, Yb, Hb, KIN(I_GPOSTMLP) + (size_t)l * D, adl + 5 * D, KIN(I_GPREMIX) + (size_t)(l + 1) * D, adn + D, adn); }
            else thin_phase<true, false, true, false>(F, XB, xo, Yb, nullptr, KIN(I_GPOSTMLP) + (size_t)l * D, adl + 5 * D, nullptr, nullptr, nullptr); }
#else
        if (PH(13)) { if (l + 1 < DEPTH) { const float* adn = ada + (size_t)(l + 1) * BATCH * 6 * D;
                thin_phase<true, true>(F, xo, xo, Yb, Hb, KIN(I_GPOSTMLP) + (size_t)l * D, adl + 5 * D, KIN(I_GPREMIX) + (size_t)(l + 1) * D, adn + D, adn); }
            else thin_phase<true, false>(F, xo, xo, Yb, nullptr, KIN(I_GPOSTMLP) + (size_t)l * D, adl + 5 * D, nullptr, nullptr, nullptr); }
#endif
        if (l + 1 < DEPTH) GRID_BAR();
    }
    if (blockIdx.x == 0 && F.tid == 0 && __hip_atomic_load((unsigned*)(ctl + CW_BAR) + XB_TMO, RLX_AGENT) != 0u) xo[0] = __builtin_nanf("");
}
#undef ada
#undef tab
#undef adap
#undef Hb
#undef PROJ
#undef SSQ
#undef KR
#undef QF
#undef KVF
#undef OSB
#undef MRG
#undef Yb
#undef XB
#undef U
#undef GRB
#undef GSB
#undef x_in
#undef wl
#undef adl


extern "C" void kernel_launch(void* const* d_in, const int* in_sizes, int n_in, void* d_out, int out_size, void* d_ws, size_t ws_size, hipStream_t stream) {
    static int grid = 0;
    if (grid == 0) {
        if (n_in != 19 || out_size != M * D || ws_size < WS_END) { fprintf(stderr, "kernel_launch: unexpected shapes (n_in %d, out %d, ws %zu < %zu)\n", n_in, out_size, ws_size, (size_t)WS_END); grid = -1; return; }
        int dev = 0, cus = 0, per_cu = 0;
        if (hipGetDevice(&dev) != hipSuccess || hipDeviceGetAttribute(&cus, hipDeviceAttributeMultiprocessorCount, dev) != hipSuccess) { grid = -1; return; }
        if (hipFuncSetAttribute((const void*)hybrid_fwd, hipFuncAttributeMaxDynamicSharedMemorySize, LDS_BYTES) != hipSuccess) { fprintf(stderr, "kernel_launch: hipFuncSetAttribute failed\n"); grid = -1; return; }
        if (hipOccupancyMaxActiveBlocksPerMultiprocessor(&per_cu, (const void*)hybrid_fwd, NWAVES * 64, LDS_BYTES) != hipSuccess || per_cu < 1) { fprintf(stderr, "kernel_launch: occupancy query says %d\n", per_cu); (void)hipGetLastError(); }
        grid = cus;
    }
    if (grid < 0) return;
    if (hipMemsetAsync((char*)d_ws + WS_CTL, 0, CTL_ZERO_BYTES, stream) != hipSuccess) return;
    Args a{};
    for (int i = 0; i < 19; ++i) a.in[i] = (const float*)d_in[i];
    a.out = (float*)d_out; a.ws = (unsigned char*)d_ws;
    hipLaunchKernelGGL(hybrid_fwd, dim3(grid), dim3(NWAVES * 64), LDS_BYTES, stream, a);
#ifdef DBG_CHECK
    hipLaunchKernelGGL(dbg_check, dim3(DBG_NCHK), dim3(256), 0, stream, a, (unsigned*)((char*)d_ws + 4096));
    hipLaunchKernelGGL(dbg_report, dim3(1), dim3(64), 0, stream, (float*)d_out, (const unsigned*)((char*)d_ws + 4096));
#endif
}
```
